# Optimizing an MI355X kernel written in HIP

```python
import jax, jax.numpy as jnp
from jax import lax
import numpy as np

D_MODEL = 1024
BATCH = 8
SEQ = 2048
DEPTH = 2

CTX_LEN = 256
GRID_W = 64
N_MOD = 9
D_FF = 2816
EPS = 1e-6
A_HEADS = 4
A_HEAD_DIM = 128
A_WIDTH = A_HEADS * A_HEAD_DIM
MLSTM_CHUNK = 128
CONV_W = 3
B_GROUPS = 4
B_GROUP_DIM = 128
B_WIDTH = B_GROUPS * B_GROUP_DIM
SGU_CHUNK = 128
EVEN_IN = 4 * A_WIDTH + 4 * A_HEADS + 2 * B_WIDTH
EVEN_MIX = A_WIDTH + B_WIDTH
C_HEADS = 16
C_KV_HEADS = 4
C_GROUP = C_HEADS // C_KV_HEADS
C_HEAD_DIM = 64
WINDOW = 128
ATTN_BLOCK = 128
ODD_QKV = (C_HEADS + 2 * C_KV_HEADS) * C_HEAD_DIM
ROPE_BASE = 10000.0
N_EVEN = (DEPTH + 1) // 2
N_ODD = DEPTH // 2

kernel_name = 'hybrid_mlstm_sgu_swa_dit_block'

f32 = jnp.float32


def _rms_norm(t):
    tf = t.astype(f32)
    return (tf * lax.rsqrt(jnp.mean(tf * tf, axis=-1, keepdims=True) + EPS)).astype(t.dtype)


def _modulation(s, w, b):
    m = s @ w + b
    return m.reshape(s.shape[0], N_MOD, 1, D_MODEL)


def _modulate(h, shift, scale):
    return _rms_norm(h) * (1.0 + scale) + shift


def _swiglu(h, w_in, w_out):
    g, u = jnp.split(h @ w_in, 2, axis=-1)
    return (jax.nn.silu(g) * u) @ w_out


def _axial_rope_tables(T):
    rows = T // GRID_W
    row, col = jnp.meshgrid(jnp.arange(rows), jnp.arange(GRID_W), indexing='ij')
    n_freq = C_HEAD_DIM // 4
    inv = ROPE_BASE ** (-jnp.arange(n_freq, dtype=f32) / n_freq)
    ang = jnp.concatenate([row.reshape(-1, 1).astype(f32) * inv,
                           col.reshape(-1, 1).astype(f32) * inv], axis=-1)
    return jnp.cos(ang), jnp.sin(ang)


def _apply_rope(t, cos, sin):
    x1, x2 = t[..., 0::2], t[..., 1::2]
    cs = cos[None, :, None, :].astype(t.dtype)
    sn = sin[None, :, None, :].astype(t.dtype)
    return jnp.stack([x1 * cs - x2 * sn, x1 * sn + x2 * cs], axis=-1).reshape(t.shape)


def _centred_depthwise_conv(x, w):
    C = x.shape[-1]
    return lax.conv_general_dilated(x, w[:, None, :].astype(x.dtype), window_strides=(1,),
                                    padding=[(CONV_W // 2, CONV_W // 2)],
                                    dimension_numbers=('NWC', 'WIO', 'NWC'),
                                    feature_group_count=C)


def _zero_state(B_):
    return (jnp.zeros((B_, A_HEADS, A_HEAD_DIM, A_HEAD_DIM), f32),
            jnp.zeros((B_, A_HEADS, A_HEAD_DIM), f32),
            jnp.zeros((B_, A_HEADS), f32))


def _mlstm_chunkwise(q, k, v, ig, lf, state):
    B_, H, T, d = q.shape
    L = MLSTM_CHUNK
    N = T // L
    q = q.reshape(B_, H, N, L, d)
    k = k.reshape(B_, H, N, L, d)
    v = v.reshape(B_, H, N, L, d)
    ig = ig.reshape(B_, H, N, L)
    b = jnp.cumsum(lf.reshape(B_, H, N, L), axis=-1)
    g = b[..., -1]
    a = g[..., None] - b + ig
    m_loc = jnp.max(a, axis=-1)
    w = jnp.exp(a - m_loc[..., None])
    C_loc = jnp.einsum('bhnl,bhnld,bhnle->bhnde', w, k, v)
    n_loc = jnp.einsum('bhnl,bhnld->bhnd', w, k)

    def step(carry, xs):
        C, n, m = carry
        g_j, m_loc_j, C_loc_j, n_loc_j = xs
        m_new = jnp.maximum(g_j + m, m_loc_j)
        dec = jnp.exp(g_j + m - m_new)
        add = jnp.exp(m_loc_j - m_new)
        C_new = dec[..., None, None] * C + add[..., None, None] * C_loc_j
        n_new = dec[..., None] * n + add[..., None] * n_loc_j
        return (C_new, n_new, m_new), (C, n, m)

    xs = (jnp.moveaxis(g, 2, 0), jnp.moveaxis(m_loc, 2, 0),
          jnp.moveaxis(C_loc, 2, 0), jnp.moveaxis(n_loc, 2, 0))
    final, (C_prev, n_prev, m_prev) = lax.scan(step, state, xs)
    C_prev = jnp.moveaxis(C_prev, 0, 2)
    n_prev = jnp.moveaxis(n_prev, 0, 2)
    m_prev = jnp.moveaxis(m_prev, 0, 2)

    e = b + m_prev[..., None]
    tril = jnp.tril(jnp.ones((L, L), dtype=bool))
    Dm = jnp.where(tril, b[..., :, None] - b[..., None, :] + ig[..., None, :], -jnp.inf)
    m_t = jnp.maximum(e, jnp.max(Dm, axis=-1))
    S = jnp.einsum('bhntd,bhnsd->bhnts', q, k) * jnp.exp(Dm - m_t[..., None])
    inter = jnp.exp(e - m_t)
    num = (jnp.einsum('bhnts,bhnse->bhnte', S, v)
           + inter[..., None] * jnp.einsum('bhntd,bhnde->bhnte', q, C_prev))
    den = jnp.sum(S, axis=-1) + inter * jnp.einsum('bhntd,bhnd->bhnt', q, n_prev)
    h = num / jnp.maximum(jnp.abs(den), jnp.exp(-m_t))[..., None]
    return h.reshape(B_, H, T, d), final


def _flip(ts):
    return tuple(jnp.flip(t, axis=2) for t in ts)


def _even_stream_inputs(n, w_in, conv_w, gate_b):
    B_, T, _ = n.shape
    p = n @ w_in
    qk, v, o, gates, uv = jnp.split(
        p, [2 * A_WIDTH, 3 * A_WIDTH, 4 * A_WIDTH, 4 * A_WIDTH + 4 * A_HEADS], axis=-1)
    q, k = jnp.split(jax.nn.silu(_centred_depthwise_conv(qk, conv_w)), 2, axis=-1)

    def heads(t):
        return t.reshape(B_, T, A_HEADS, A_HEAD_DIM).transpose(0, 2, 1, 3).astype(f32)

    q, k, v = heads(q), heads(k) * (A_HEAD_DIM ** -0.5), heads(v)
    gt = (gates.astype(f32) + gate_b.reshape(-1).astype(f32)).reshape(B_, T, 4, A_HEADS).transpose(2, 0, 3, 1)
    fwd = (gt[0], jax.nn.log_sigmoid(gt[1]))
    bwd = (gt[2], jax.nn.log_sigmoid(gt[3]))
    return (q, k, v), fwd, bwd, o, uv


def _spatial_gating(uv, norm_g, ws, sb):
    u, v = jnp.split(jax.nn.gelu(uv), 2, axis=-1)
    v = _rms_norm(v) * norm_g
    B_, T, _ = v.shape
    vb = v.reshape(B_, T // SGU_CHUNK, SGU_CHUNK, B_GROUPS, B_GROUP_DIM)
    mixed = jnp.einsum('gpq,bnqgc->bnpgc', ws, vb) + sb.T[:, :, None]
    return u * mixed.reshape(B_, T, B_WIDTH)


def _even_output(hsum, o, uv, mnorm, sgu_g, ws, sb, w_out):
    B_, H, T, d = hsum.shape
    hn = hsum * lax.rsqrt(jnp.mean(hsum * hsum, axis=-1, keepdims=True) + EPS) * mnorm[None, :, None, :].astype(f32)
    h_a = jax.nn.sigmoid(o) * hn.transpose(0, 2, 1, 3).reshape(B_, T, A_WIDTH).astype(o.dtype)
    h_b = _spatial_gating(uv, sgu_g, ws, sb)
    return jnp.concatenate([h_a, h_b], axis=-1) @ w_out


def _even_mixer(nx, nc, w_in, w_out, conv_w, gate_b, mnorm, sgu_g, ws, sb, need_ctx):
    qkv_c, fw_c, bw_c, o_c, uv_c = _even_stream_inputs(nc, w_in, conv_w, gate_b)
    qkv_x, fw_x, bw_x, o_x, uv_x = _even_stream_inputs(nx, w_in, conv_w, gate_b)
    zero = _zero_state(nx.shape[0])
    hc_f, st_f = _mlstm_chunkwise(*qkv_c, *fw_c, zero)
    hc_b, st_b = _mlstm_chunkwise(*_flip(qkv_c), *_flip(bw_c), zero)
    hx_f, _ = _mlstm_chunkwise(*qkv_x, *fw_x, st_f)
    hx_b, _ = _mlstm_chunkwise(*_flip(qkv_x), *_flip(bw_x), st_b)
    yx = _even_output(hx_f + jnp.flip(hx_b, axis=2), o_x, uv_x, mnorm, sgu_g, ws, sb, w_out)
    yc = None
    if need_ctx:
        yc = _even_output(hc_f + jnp.flip(hc_b, axis=2), o_c, uv_c, mnorm, sgu_g, ws, sb, w_out)
    return yx, yc


def _softmax_with_sink(sink, *scores):
    ref = scores[0]
    s0 = jnp.broadcast_to(sink[None, :, :, None, None].astype(f32), ref.shape[:-1] + (1,))
    p = jax.nn.softmax(jnp.concatenate([s0] + [s.astype(f32) for s in scores], axis=-1), axis=-1)
    parts = []
    off = 1
    for s in scores:
        parts.append(p[..., off:off + s.shape[-1]])
        off += s.shape[-1]
    return parts


def _window_attention(q, k, v, kc, vc, sink):
    B_, T, _, _ = q.shape
    nb = T // ATTN_BLOCK
    scale = C_HEAD_DIM ** -0.5
    qb = (q * scale).reshape(B_, nb, ATTN_BLOCK, C_KV_HEADS, C_GROUP, C_HEAD_DIM).transpose(1, 0, 2, 3, 4, 5)
    pad = ((0, 0), (ATTN_BLOCK, ATTN_BLOCK), (0, 0), (0, 0))
    kp, vp = jnp.pad(k, pad), jnp.pad(v, pad)
    offs = jnp.arange(ATTN_BLOCK)
    band_offs = jnp.arange(3 * ATTN_BLOCK) - ATTN_BLOCK

    def block(args):
        qj, j = args
        start = j * ATTN_BLOCK
        kj = lax.dynamic_slice_in_dim(kp, start, 3 * ATTN_BLOCK, axis=1)
        vj = lax.dynamic_slice_in_dim(vp, start, 3 * ATTN_BLOCK, axis=1)
        qpos = start + offs
        kpos = start + band_offs
        valid = (jnp.abs(qpos[:, None] - kpos[None, :]) <= WINDOW) & (kpos[None, :] >= 0) & (kpos[None, :] < T)
        s_band = jnp.where(valid, jnp.einsum('bqhgd,bkhd->bhgqk', qj, kj).astype(f32), -jnp.inf)
        s_ctx = jnp.einsum('bqhgd,bkhd->bhgqk', qj, kc)
        p_ctx, p_band = _softmax_with_sink(sink, s_ctx, s_band)
        return (jnp.einsum('bhgqk,bkhd->bqhgd', p_ctx.astype(vc.dtype), vc)
                + jnp.einsum('bhgqk,bkhd->bqhgd', p_band.astype(vj.dtype), vj))

    out = lax.map(block, (qb, jnp.arange(nb)))
    return out.transpose(1, 0, 2, 3, 4, 5).reshape(B_, T, C_HEADS * C_HEAD_DIM)


def _context_attention(qc, kc, vc, sink):
    B_, Tc = qc.shape[:2]
    q = (qc * (C_HEAD_DIM ** -0.5)).reshape(B_, Tc, C_KV_HEADS, C_GROUP, C_HEAD_DIM)
    (p,) = _softmax_with_sink(sink, jnp.einsum('bqhgd,bkhd->bhgqk', q, kc))
    return jnp.einsum('bhgqk,bkhd->bqhgd', p.astype(vc.dtype), vc).reshape(B_, Tc, C_HEADS * C_HEAD_DIM)


def _odd_mixer(nx, nc, w_qkv, w_out, sink, cos, sin, need_ctx):
    B_, T, _ = nx.shape
    Tc = nc.shape[1]
    qdim = C_HEADS * C_HEAD_DIM
    kvdim = C_KV_HEADS * C_HEAD_DIM
    q, k, v = jnp.split(nx @ w_qkv, [qdim, qdim + kvdim], axis=-1)
    q = _apply_rope(q.reshape(B_, T, C_HEADS, C_HEAD_DIM), cos, sin)
    k = _apply_rope(k.reshape(B_, T, C_KV_HEADS, C_HEAD_DIM), cos, sin)
    v = v.reshape(B_, T, C_KV_HEADS, C_HEAD_DIM)
    kc, vc = jnp.split(nc @ w_qkv[:, qdim:], 2, axis=-1)
    kc = kc.reshape(B_, Tc, C_KV_HEADS, C_HEAD_DIM)
    vc = vc.reshape(B_, Tc, C_KV_HEADS, C_HEAD_DIM)
    sink = sink.reshape(C_KV_HEADS, C_GROUP)
    yx = _window_attention(q, k, v, kc, vc, sink) @ w_out
    yc = None
    if need_ctx:
        qc = (nc @ w_qkv[:, :qdim]).reshape(B_, Tc, C_HEADS, C_HEAD_DIM)
        yc = _context_attention(qc, kc, vc, sink) @ w_out
    return yx, yc


def setup_inputs(seed: int = 0) -> dict:
    key = jax.random.key(seed)
    ks = jax.random.split(key, 20)
    D = D_MODEL

    def nrm(k, shape, scale):
        return jax.random.normal(k, shape, jnp.float32) * scale

    is_forget = jnp.array([0.0, 1.0, 0.0, 1.0], jnp.float32)[:, None]
    forget_lin = jnp.linspace(3.0, 6.0, A_HEADS, dtype=jnp.float32)[None, :]
    return {
        'x': nrm(ks[0], (BATCH, SEQ, D), 1.0),
        'c': nrm(ks[1], (BATCH, D), 1.0),
        'ctx': nrm(ks[2], (BATCH, CTX_LEN, D), 1.0),
        'c_ctx': nrm(ks[3], (D,), 1.0),
        'ada_w': nrm(ks[4], (DEPTH, D, N_MOD * D), 0.5 * D ** -0.5),
        'ada_b': nrm(ks[5], (DEPTH, N_MOD * D), 0.02),
        'ffn_w_in': nrm(ks[6], (DEPTH, 2, D, 2 * D_FF), D ** -0.5),
        'ffn_w_out': nrm(ks[7], (DEPTH, 2, D_FF, D), D_FF ** -0.5),
        'even_w_in': nrm(ks[8], (N_EVEN, D, EVEN_IN), D ** -0.5),
        'even_w_out': nrm(ks[9], (N_EVEN, EVEN_MIX, D), EVEN_MIX ** -0.5),
        'mlstm_conv': nrm(ks[10], (N_EVEN, CONV_W, 2 * A_WIDTH), CONV_W ** -0.5),
        'mlstm_gate_b': is_forget * forget_lin + nrm(ks[11], (N_EVEN, 4, A_HEADS), 0.1),
        'mlstm_norm': 1.0 + nrm(ks[12], (N_EVEN, A_HEADS, A_HEAD_DIM), 0.05),
        'sgu_norm': 1.0 + nrm(ks[13], (N_EVEN, B_WIDTH), 0.05),
        'sgu_ws': nrm(ks[14], (N_EVEN, B_GROUPS, SGU_CHUNK, SGU_CHUNK), SGU_CHUNK ** -0.5),
        'sgu_b': 1.0 + nrm(ks[15], (N_EVEN, B_GROUPS, SGU_CHUNK), 0.1),
        'odd_w_qkv': nrm(ks[16], (N_ODD, D, ODD_QKV), D ** -0.5),
        'odd_w_out': nrm(ks[17], (N_ODD, C_HEADS * C_HEAD_DIM, D), (C_HEADS * C_HEAD_DIM) ** -0.5),
        'attn_sink': nrm(ks[18], (N_ODD, C_HEADS), 0.5),
        'final_norm': 1.0 + nrm(ks[19], (D,), 0.05),
    }


def reference(x, c, ctx, c_ctx, ada_w, ada_b, ffn_w_in, ffn_w_out, even_w_in, even_w_out,
              mlstm_conv, mlstm_gate_b, mlstm_norm, sgu_norm, sgu_ws, sgu_b,
              odd_w_qkv, odd_w_out, attn_sink, final_norm):
    cos, sin = _axial_rope_tables(x.shape[1])
    sc = jax.nn.silu(c)
    scc = jax.nn.silu(c_ctx)[None]
    h, hc = x, ctx
    for layer in range(DEPTH):
        last = layer == DEPTH - 1
        mod = _modulation(sc, ada_w[layer], ada_b[layer])
        modc = _modulation(scc, ada_w[layer], ada_b[layer])
        h = h + 0.5 * mod[:, 2] * _swiglu(_modulate(h, mod[:, 0], mod[:, 1]),
                                          ffn_w_in[layer, 0], ffn_w_out[layer, 0])
        hc = hc + 0.5 * modc[:, 2] * _swiglu(_modulate(hc, modc[:, 0], modc[:, 1]),
                                             ffn_w_in[layer, 0], ffn_w_out[layer, 0])
        nx = _modulate(h, mod[:, 3], mod[:, 4])
        nc = _modulate(hc, modc[:, 3], modc[:, 4])
        if layer % 2 == 0:
            e = layer // 2
            yx, yc = _even_mixer(nx, nc, even_w_in[e], even_w_out[e], mlstm_conv[e], mlstm_gate_b[e],
                                 mlstm_norm[e], sgu_norm[e], sgu_ws[e], sgu_b[e], not last)
        else:
            o = layer // 2
            yx, yc = _odd_mixer(nx, nc, odd_w_qkv[o], odd_w_out[o], attn_sink[o], cos, sin, not last)
        h = h + mod[:, 5] * yx
        h = h + 0.5 * mod[:, 8] * _swiglu(_modulate(h, mod[:, 6], mod[:, 7]),
                                          ffn_w_in[layer, 1], ffn_w_out[layer, 1])
        if not last:
            hc = hc + modc[:, 5] * yc
            hc = hc + 0.5 * modc[:, 8] * _swiglu(_modulate(hc, modc[:, 6], modc[:, 7]),
                                                 ffn_w_in[layer, 1], ffn_w_out[layer, 1])
    return _rms_norm(h) * final_norm
```

```cpp
#include <hip/hip_runtime.h>
#include <hip/hip_cooperative_groups.h>
#include <cstdio>
#include <cstdint>
namespace cg = cooperative_groups;
namespace pg8 {
#define PG8_LAS __attribute__((address_space(3)))
typedef unsigned short bf16_t;
typedef short bf16x8 __attribute__((ext_vector_type(8)));
typedef float f32x4 __attribute__((ext_vector_type(4)));
typedef unsigned u32x4 __attribute__((ext_vector_type(4)));
constexpr int BM = 256, BK = 64, HALF = 128, HTB = HALF * BK * 2  , STAGE_BYTES = 8 * HTB, NXCD = 8, WGM = 8;

__host__ __device__ __forceinline__ int lds_byte(int r, int c) { const int st = (r >> 4) * 2 + (c >> 5), rr = r & 15, cc = c & 31, ob = rr * 64 + cc * 2; return st * 1024 + (ob ^ (((ob >> 9) & 1) << 5)); }
__host__ __device__ __forceinline__ void stage_rc(int b, int& R, int& C) { const int st = b / 1024, sb = b % 1024, swz = sb ^ (((sb >> 9) & 1) << 5); R = (st >> 1) * 16 + swz / 64; C = (st & 1) * 32 + (swz % 64) / 2; }
__host__ __device__ __forceinline__ int perm32(int rho) { const int n = rho >> 4, i = rho & 15; return 8 * (i >> 2) + 4 * n + (i & 3); }

struct Unit { int pm, pn; };
struct Gemm { const bf16_t* A; const bf16_t* Bt; int M, N, K; };

struct StaticOrder {
    int nM, nN, nwg, G, c;
    __host__ __device__ void init(int M, int N, int G_, int c_) { nM = M / BM; nN = N / BM; nwg = nM * nN; G = G_; c = c_; }
    __host__ __device__ bool next(int i, Unit& u) const {
        const long L = (long)i * G + c; if (L >= nwg) return false;
        int wgid = (int)L; { const int q = nwg / NXCD, r = nwg % NXCD, xcd = wgid % NXCD, off = wgid / NXCD; wgid = (xcd < r ? xcd * (q + 1) : r * (q + 1) + (xcd - r) * q) + off; }
        const int nig = WGM * nN, gid = wgid / nig, fm = gid * WGM, gsz = (nM - fm) < WGM ? (nM - fm) : WGM;
        u.pm = fm + ((wgid % nig) % gsz); u.pn = (wgid % nig) / gsz; return true;
    }
    __device__ __forceinline__ void a_ready(const Unit&) const {}
    __device__ __forceinline__ void done(const Unit&) const {}
};

__device__ __forceinline__ unsigned cvt_pk_bf16(float lo, float hi) { unsigned r; asm volatile("v_cvt_pk_bf16_f32 %0, %1, %2" : "=v"(r) : "v"(lo), "v"(hi)); return r; }
typedef float f32x2 __attribute__((ext_vector_type(2)));
template <class Epi, class Sched, bool ALIGN_EPI = false, bool SP2 = false>
__device__ __forceinline__ void gemm_phase(PG8_LAS unsigned char* lds, const Gemm g, const Sched& S, const Epi& E) {
    int tid_ = threadIdx.x; asm volatile("" : "+v"(tid_)); const int tid = tid_, wid = __builtin_amdgcn_readfirstlane(tid >> 6), lane = tid & 63, wr = wid >> 2, wc = wid & 3, fr = lane & 15, fq = lane >> 4;
    const int K = g.K, nt = K / BK;
    unsigned voffA[2], voffB[2];
#pragma unroll
    for (int i = 0; i < 2; ++i) { int R, C; stage_rc(tid * 16 + i * 8192, R, C); const int Rb = Epi::PERM ? ((R & ~31) + perm32(R & 31)) : R;
        voffA[i] = (unsigned)(R * K + C) * 2u; voffB[i] = (unsigned)(Rb * K + C) * 2u; }
    const size_t kstep = (size_t)(BK * 2);
    const size_t hstep = (size_t)HALF * K * 2;
    const size_t tstep = 2 * hstep;
    const unsigned ldsw = (unsigned)wid * 1024u;
    const int aoff = lds_byte(wr * 64 + fr, fq * 8), boff = lds_byte(wc * 32 + fr, fq * 8);
#define PG8_SA(b, h) (((b) * 2 + (h)) * HTB)
#define PG8_SB(b, h) ((4 + (b) * 2 + (h)) * HTB)
#define PG8_STAGE(bufoff, gbase, voff) do { _Pragma("unroll") for (int _i = 0; _i < 2; ++_i) \
        __builtin_amdgcn_global_load_lds((const unsigned*)((const char*)(gbase) + (voff)[_i]), (PG8_LAS unsigned*)(lds + (bufoff) + ldsw + _i * 8192), 16, 0, 0); } while (0)
#define PG8_LDA(dst, b, h) do { _Pragma("unroll") for (int m = 0; m < 4; ++m) _Pragma("unroll") for (int k = 0; k < 2; ++k) dst[m][k] = *(const PG8_LAS bf16x8*)(lds + PG8_SA(b, h) + aoff + m * 2048 + k * 1024); } while (0)
#define PG8_LDB(dst, b, h) do { _Pragma("unroll") for (int n = 0; n < 2; ++n) _Pragma("unroll") for (int k = 0; k < 2; ++k) dst[n][k] = *(const PG8_LAS bf16x8*)(lds + PG8_SB(b, h) + boff + n * 2048 + k * 1024); } while (0)
#define PG8_MMA(ai, bj, At, Bt) do { __builtin_amdgcn_s_setprio(1); _Pragma("unroll") for (int m = 0; m < 4; ++m) _Pragma("unroll") for (int n = 0; n < 2; ++n) _Pragma("unroll") for (int k = 0; k < 2; ++k) \
        acc[ai][bj][m][n] = __builtin_amdgcn_mfma_f32_16x16x32_bf16(Bt[n][k], At[m][k], acc[ai][bj][m][n], 0, 0, 0); __builtin_amdgcn_s_setprio(0); } while (0)
#define PG8_WAIT_V(n) asm volatile("s_waitcnt vmcnt(" #n ")" ::: "memory")
#define PG8_WAIT_L(n) asm volatile("s_waitcnt lgkmcnt(" #n ")" ::: "memory")
#define PG8_BAR __builtin_amdgcn_s_barrier()
#define PG8_SCHED __builtin_amdgcn_sched_barrier(0)
    Unit cur, nxt; int ui = 0;
    if (!S.next(0, cur)) return;
    f32x4 acc[2][2][4][2];
#pragma unroll
    for (int a = 0; a < 2; ++a)
#pragma unroll
        for (int b = 0; b < 2; ++b)
#pragma unroll
            for (int m = 0; m < 4; ++m)
#pragma unroll
                for (int n = 0; n < 2; ++n) acc[a][b][m][n] = (f32x4){0.f, 0.f, 0.f, 0.f};
    bf16x8 At[4][2], B0[2][2], B1[2][2];
    const char* cA = (const char*)g.A + (size_t)cur.pm * tstep; const char* cB = (const char*)g.Bt + (size_t)cur.pn * tstep;
    S.a_ready(cur);
    if constexpr (SP2) {
        PG8_STAGE(PG8_SB(0, 0), cB, voffB); PG8_STAGE(PG8_SB(0, 1), cB + hstep, voffB); PG8_STAGE(PG8_SA(0, 0), cA, voffA); PG8_STAGE(PG8_SA(0, 1), cA + hstep, voffA);
        if (wr == 1) PG8_BAR;
        PG8_WAIT_V(2); PG8_BAR;
        PG8_STAGE(PG8_SB(1, 0), cB + kstep, voffB); PG8_STAGE(PG8_SA(1, 0), cA + kstep, voffA); PG8_STAGE(PG8_SB(1, 1), cB + hstep + kstep, voffB);
        PG8_WAIT_V(6); PG8_BAR;
    } else {
        PG8_STAGE(PG8_SB(0, 0), cB, voffB); PG8_STAGE(PG8_SA(0, 0), cA, voffA); PG8_STAGE(PG8_SB(0, 1), cB + hstep, voffB); PG8_STAGE(PG8_SA(0, 1), cA + hstep, voffA);
        if (wr == 1) PG8_BAR;
        PG8_WAIT_V(4); PG8_BAR;
        PG8_STAGE(PG8_SB(1, 0), cB + kstep, voffB); PG8_STAGE(PG8_SA(1, 0), cA + kstep, voffA); PG8_STAGE(PG8_SB(1, 1), cB + hstep + kstep, voffB);
        PG8_WAIT_V(6); PG8_BAR;
    }
    for (;;) {
        const bool has_next = S.next(ui + 1, nxt);
        const char* nA = has_next ? (const char*)g.A + (size_t)nxt.pm * tstep : cA; const char* nB = has_next ? (const char*)g.Bt + (size_t)nxt.pn * tstep : cB;
        for (int t = 0; t < nt; t += 2) {
            const bool last = (t == nt - 2);
            const char* a1 = cA + (size_t)(t + 1) * kstep;
            const char* a2 = last ? nA : cA + (size_t)(t + 2) * kstep; const char* b2 = last ? nB : cB + (size_t)(t + 2) * kstep;
            const char* a3 = a2 + kstep; const char* b3 = b2 + kstep;
            if (last && has_next) S.a_ready(nxt);
            if constexpr (SP2) {
            PG8_LDB(B0, 0, 0); PG8_LDB(B1, 0, 1); PG8_SCHED; PG8_LDA(At, 0, 0); PG8_STAGE(PG8_SA(1, 1), a1 + hstep, voffA);
            PG8_WAIT_V(8); PG8_WAIT_L(0); PG8_BAR; PG8_MMA(0, 0, At, B0); PG8_MMA(0, 1, At, B1); PG8_BAR; PG8_SCHED;
            PG8_LDA(At, 0, 1); PG8_STAGE(PG8_SB(0, 0), b2, voffB); PG8_STAGE(PG8_SB(0, 1), b2 + hstep, voffB); PG8_STAGE(PG8_SA(0, 0), a2, voffA);
            PG8_WAIT_V(8); PG8_WAIT_L(0); PG8_BAR; PG8_MMA(1, 0, At, B0); PG8_MMA(1, 1, At, B1); PG8_BAR; PG8_SCHED;
            PG8_LDB(B0, 1, 0); PG8_LDB(B1, 1, 1); PG8_SCHED; PG8_LDA(At, 1, 0); PG8_STAGE(PG8_SA(0, 1), a2 + hstep, voffA);
            PG8_WAIT_V(8); PG8_WAIT_L(0); PG8_BAR; PG8_MMA(0, 0, At, B0); PG8_MMA(0, 1, At, B1); PG8_BAR; PG8_SCHED;
            PG8_LDA(At, 1, 1); PG8_STAGE(PG8_SB(1, 0), b3, voffB); PG8_STAGE(PG8_SB(1, 1), b3 + hstep, voffB); PG8_STAGE(PG8_SA(1, 0), a3, voffA);
            PG8_WAIT_V(8); PG8_WAIT_L(0); PG8_BAR; PG8_MMA(1, 0, At, B0); PG8_MMA(1, 1, At, B1); PG8_BAR; PG8_SCHED;
            } else {
            PG8_LDB(B0, 0, 0); PG8_SCHED; PG8_LDA(At, 0, 0); PG8_STAGE(PG8_SA(1, 1), a1 + hstep, voffA);
            PG8_WAIT_L(8); PG8_BAR; PG8_WAIT_L(0); PG8_MMA(0, 0, At, B0); PG8_BAR; PG8_SCHED;
            PG8_LDB(B1, 0, 1); PG8_STAGE(PG8_SB(0, 0), b2, voffB);
            PG8_BAR; PG8_WAIT_L(0); PG8_MMA(0, 1, At, B1); PG8_BAR;
            PG8_LDA(At, 0, 1); PG8_STAGE(PG8_SA(0, 0), a2, voffA);
            PG8_BAR; PG8_WAIT_L(0); PG8_MMA(1, 0, At, B0); PG8_BAR; PG8_SCHED;
            PG8_STAGE(PG8_SB(0, 1), b2 + hstep, voffB);
            PG8_WAIT_V(6); PG8_BAR; PG8_MMA(1, 1, At, B1); PG8_BAR;
            PG8_LDB(B0, 1, 0); PG8_SCHED; PG8_LDA(At, 1, 0); PG8_STAGE(PG8_SA(0, 1), a2 + hstep, voffA);
            PG8_WAIT_L(8); PG8_BAR; PG8_WAIT_L(0); PG8_MMA(0, 0, At, B0); PG8_BAR; PG8_SCHED;
            PG8_LDB(B1, 1, 1); PG8_STAGE(PG8_SB(1, 0), b3, voffB);
            PG8_BAR; PG8_WAIT_L(0); PG8_MMA(0, 1, At, B1); PG8_BAR;
            PG8_LDA(At, 1, 1); PG8_STAGE(PG8_SA(1, 0), a3, voffA);
            PG8_BAR; PG8_WAIT_L(0); PG8_MMA(1, 0, At, B0); PG8_BAR; PG8_SCHED;
            PG8_STAGE(PG8_SB(1, 1), b3 + hstep, voffB);
            PG8_WAIT_V(6); PG8_BAR; PG8_MMA(1, 1, At, B1); PG8_BAR;
            }
        }
        if constexpr (ALIGN_EPI) { if (wr == 0) PG8_BAR; }
        if constexpr (!Epi::AFTER_DRAIN) { E(acc, cur, wr, wc, fr, fq); S.done(cur); }
        if (!has_next) break;
#pragma unroll
        for (int a = 0; a < 2; ++a)
#pragma unroll
            for (int b = 0; b < 2; ++b)
#pragma unroll
                for (int m = 0; m < 4; ++m)
#pragma unroll
                    for (int n = 0; n < 2; ++n) acc[a][b][m][n] = (f32x4){0.f, 0.f, 0.f, 0.f};
        cur = nxt; cA = nA; cB = nB; ++ui;
        if constexpr (ALIGN_EPI) { if (wr == 1) PG8_BAR; }
    }
    PG8_WAIT_V(0);
    if constexpr (!ALIGN_EPI) { if (wr == 0) PG8_BAR; }
    PG8_BAR;
    if constexpr (Epi::AFTER_DRAIN) { E.fused(acc, cur, wr, wc, fr, fq, lds, wid, lane); S.done(cur); }
#undef PG8_SA
#undef PG8_SB
#undef PG8_STAGE
#undef PG8_LDA
#undef PG8_LDB
#undef PG8_MMA
#undef PG8_WAIT_V
#undef PG8_WAIT_L
#undef PG8_BAR
#undef PG8_SCHED
}
}
#define LAS __attribute__((address_space(3)))
typedef unsigned short bf16_t;
typedef short bf16x8 __attribute__((ext_vector_type(8)));
typedef float f32x4 __attribute__((ext_vector_type(4)));
typedef float f32x2 __attribute__((ext_vector_type(2)));
typedef unsigned u32x4 __attribute__((ext_vector_type(4)));
typedef unsigned u32x2 __attribute__((ext_vector_type(2)));

constexpr int D = 1024, NB = 8, SEQ = 2048, CTXL = 256, DFF = 2816;
constexpr int MX = NB * SEQ;
constexpr int MC = NB * CTXL;
constexpr int MT = MX + MC;
constexpr int NMOD = 9;
constexpr int NEV = 3072;
constexpr int NQKV = 1536;
constexpr float EPS = 1e-6f;
constexpr int LDS_BYTES = 147456;
constexpr int NTHREADS = 512;

constexpr size_t MiB = 1u << 20;
constexpr size_t SZ_WIN = (size_t)5632 * 1024 * 2, SZ_WOUT = (size_t)1024 * 2816 * 2;
constexpr size_t WS_WIN = 0;
constexpr size_t WS_WOUT = WS_WIN + 4 * SZ_WIN;
constexpr size_t WS_WEIN = WS_WOUT + 4 * SZ_WOUT;
constexpr size_t WS_WEOUT = WS_WEIN + (size_t)3072 * 1024 * 2;
constexpr size_t WS_WQKV = WS_WEOUT + (size_t)1024 * 1024 * 2;
constexpr size_t WS_WOOUT = WS_WQKV + (size_t)1536 * 1024 * 2;
constexpr size_t WS_MOD = WS_WOOUT + (size_t)1024 * 1024 * 2;
constexpr size_t WS_WG = WS_MOD + (size_t)2 * 9 * 9216 * 4;
constexpr size_t WS_ROPE = WS_WG + (size_t)16 * 1024 * 4;
constexpr size_t WS_GATES = WS_ROPE + 8192;
constexpr size_t WS_HC = WS_GATES + (size_t)MT * 16 * 4;
constexpr size_t WS_A0 = ((WS_HC + (size_t)MC * D * 4 + 255) / 256) * 256;
constexpr size_t WS_A1 = WS_A0 + (size_t)2 * MT * 512 * 4;
constexpr size_t WS_BIG = WS_A1 + (size_t)MT * D * 2;
constexpr size_t WS_END = WS_BIG + (size_t)MT * 3072 * 2;

struct Args {
    const float* x; const float* c; const float* ctx; const float* c_ctx; const float* ada_w; const float* ada_b;
    const float* ffn_w_in; const float* ffn_w_out; const float* even_w_in; const float* even_w_out;
    const float* mlstm_conv; const float* mlstm_gate_b; const float* mlstm_norm; const float* sgu_norm; const float* sgu_ws; const float* sgu_b;
    const float* odd_w_qkv; const float* odd_w_out; const float* attn_sink; const float* final_norm;
    float* out; unsigned char* ws; int ph_lo, ph_hi;
};

typedef const __attribute__((address_space(4))) Args* kargp;
__device__ __forceinline__ kargp kargs() { kargp p = (kargp)__builtin_amdgcn_kernarg_segment_ptr(); asm volatile("" : "+s"(p)); return p; }
#define KA(f) (kargs()->f)
typedef __bf16 bf16x2_t __attribute__((ext_vector_type(2)));
__device__ __forceinline__ unsigned pk2(float lo, float hi) { f32x2 v = {lo, hi}; bf16x2_t b = __builtin_convertvector(v, bf16x2_t); return __builtin_bit_cast(unsigned, b); }
__device__ __forceinline__ bf16_t f2bf(float f) { return (bf16_t)(pk2(f, 0.f) & 0xffffu); }
__device__ __forceinline__ float bf2f(bf16_t v) { return __uint_as_float(((unsigned)v) << 16); }
__device__ __forceinline__ float bflo(unsigned w) { return __uint_as_float(w << 16); }
__device__ __forceinline__ float bfhi(unsigned w) { return __uint_as_float(w & 0xffff0000u); }
__device__ __forceinline__ float silu_f(float v) { return v * __builtin_amdgcn_rcpf(1.f + __expf(-v)); }
__device__ __forceinline__ float sigmoid_f(float v) { return __builtin_amdgcn_rcpf(1.f + __expf(-v)); }
__device__ __forceinline__ float gelu_tanh(float v) {
    const float z = 0.7978845608028654f * (v + 0.044715f * v * v * v);
    const float t = 1.f - 2.f * __builtin_amdgcn_rcpf(1.f + __expf(2.f * z));
    return 0.5f * v * (1.f + t);
}
__device__ __forceinline__ float wave_sum(float v) {
#pragma unroll
    for (int o = 1; o < 64; o <<= 1) v += __shfl_xor(v, o);
    return v;
}
__device__ __forceinline__ float wave_max(float v) {
#pragma unroll
    for (int o = 1; o < 64; o <<= 1) v = fmaxf(v, __shfl_xor(v, o));
    return v;
}
__device__ __forceinline__ f32x4 mfma16(bf16x8 a, bf16x8 b, f32x4 c) { return __builtin_amdgcn_mfma_f32_16x16x32_bf16(a, b, c, 0, 0, 0); }
__device__ __forceinline__ bf16x8 ldsfrag(const LAS unsigned char* p) { return *(const LAS bf16x8*)p; }

namespace pg8 {
struct EpiSwiglu {
    static constexpr bool PERM = true, AFTER_DRAIN = false;
    bf16_t* O;
    __device__ __forceinline__ void operator()(const f32x4 (&acc)[2][2][4][2], const Unit& u, int wr, int wc, int fr, int fq) const {
        const int row0 = u.pm * BM + wr * 64 + fr, col0 = u.pn * 128 + wc * 32 + 8 * fq;
#pragma unroll
        for (int ai = 0; ai < 2; ++ai)
#pragma unroll
            for (int m = 0; m < 4; ++m) {
                bf16_t* rowp = O + (size_t)(row0 + ai * HALF + m * 16) * DFF + col0;
                const f32x4 g0 = acc[ai][0][m][0], g1 = acc[ai][0][m][1], u0 = acc[ai][1][m][0], u1 = acc[ai][1][m][1];
                u32x4 w;
                w.x = ::pk2(::silu_f(g0[0]) * u0[0], ::silu_f(g0[1]) * u0[1]); w.y = ::pk2(::silu_f(g0[2]) * u0[2], ::silu_f(g0[3]) * u0[3]);
                w.z = ::pk2(::silu_f(g1[0]) * u1[0], ::silu_f(g1[1]) * u1[1]); w.w = ::pk2(::silu_f(g1[2]) * u1[2], ::silu_f(g1[3]) * u1[3]);
                *(u32x4*)rowp = w;
            }
    }
};
struct EpiResid {
    static constexpr bool PERM = false, AFTER_DRAIN = false;
    const float* bx; const float* bc; float* ox; float* oc; const float* gate;
    float coef;
    __device__ __forceinline__ void operator()(const f32x4 (&acc)[2][2][4][2], const Unit& u, int wr, int wc, int fr, int fq) const {
        const bool isx = u.pm < 64;
        const int bi = isx ? (u.pm >> 3) : 8;
        const float* base = isx ? bx : bc - (size_t)MX * D;
        float* outp = isx ? ox : oc - (size_t)MX * D;
        const int row0 = u.pm * BM + wr * 64 + fr, col0 = u.pn * BM + wc * 32 + 4 * fq;
        const float* gp = gate + (size_t)bi * 9216 + col0;
#pragma unroll
        for (int bj = 0; bj < 2; ++bj)
#pragma unroll
            for (int n = 0; n < 2; ++n) {
                const f32x4 gv = *(const f32x4*)(gp + bj * HALF + n * 16) * coef;
#pragma unroll
                for (int ai = 0; ai < 2; ++ai)
#pragma unroll
                    for (int m = 0; m < 4; ++m) {
                        const size_t off = (size_t)(row0 + ai * HALF + m * 16) * D + col0 + bj * HALF + n * 16;
                        const f32x4 b = *(const f32x4*)(base + off);
                        *(f32x4*)(outp + off) = b + gv * acc[ai][bj][m][n];
                        if (m & 1) asm volatile("" ::: "memory");
                    }
            }
    }
};
struct EpiPlain {
    static constexpr bool PERM = true, AFTER_DRAIN = false;
    bf16_t* O; int ldc;
    __device__ __forceinline__ void operator()(const f32x4 (&acc)[2][2][4][2], const Unit& u, int wr, int wc, int fr, int fq) const {
        const int row0 = u.pm * BM + wr * 64 + fr, col0 = u.pn * BM + wc * 32 + 8 * fq;
#pragma unroll
        for (int ai = 0; ai < 2; ++ai)
#pragma unroll
            for (int m = 0; m < 4; ++m) {
                bf16_t* rowp = O + (size_t)(row0 + ai * HALF + m * 16) * ldc + col0;
#pragma unroll
                for (int bj = 0; bj < 2; ++bj) {
                    const f32x4 v0 = acc[ai][bj][m][0], v1 = acc[ai][bj][m][1];
                    u32x4 w; w.x = ::pk2(v0[0], v0[1]); w.y = ::pk2(v0[2], v0[3]); w.z = ::pk2(v1[0], v1[1]); w.w = ::pk2(v1[2], v1[3]);
                    *(u32x4*)(rowp + bj * HALF) = w;
                }
            }
    }
};
struct EpiQKV {
    static constexpr bool PERM = true, AFTER_DRAIN = false;
    bf16_t* O; const float* rope;
    __device__ __forceinline__ void operator()(const f32x4 (&acc)[2][2][4][2], const Unit& u, int wr, int wc, int fr, int fq) const {
        const int row0 = u.pm * BM + wr * 64 + fr;
        const bool isx = u.pm < 64;
#pragma unroll
        for (int bj = 0; bj < 2; ++bj) {
            const int col0 = u.pn * BM + bj * HALF + wc * 32 + 8 * fq;
            const bool dorope = isx && (col0 < 1280);
            const float qs = (col0 < 1024) ? 0.125f : 1.f;
            const int p0 = (col0 & 63) >> 1;
            const int f0 = p0 & 15;
#pragma unroll
            for (int ai = 0; ai < 2; ++ai)
#pragma unroll
                for (int m = 0; m < 4; ++m) {
                    const int row = row0 + ai * HALF + m * 16;
                    f32x4 v0 = acc[ai][bj][m][0] * qs, v1 = acc[ai][bj][m][1] * qs;
                    if (dorope) {
                        const int t = row & 2047;
                        const int pos = (p0 < 16) ? (t >> 6) : (t & 63);
                        const f32x4 cs0 = *(const f32x4*)(rope + (pos * 16 + f0) * 2), cs1 = *(const f32x4*)(rope + (pos * 16 + f0) * 2 + 4);
                        f32x4 r0, r1;
                        r0[0] = v0[0] * cs0[0] - v0[1] * cs0[1]; r0[1] = v0[0] * cs0[1] + v0[1] * cs0[0];
                        r0[2] = v0[2] * cs0[2] - v0[3] * cs0[3]; r0[3] = v0[2] * cs0[3] + v0[3] * cs0[2];
                        r1[0] = v1[0] * cs1[0] - v1[1] * cs1[1]; r1[1] = v1[0] * cs1[1] + v1[1] * cs1[0];
                        r1[2] = v1[2] * cs1[2] - v1[3] * cs1[3]; r1[3] = v1[2] * cs1[3] + v1[3] * cs1[2];
                        v0 = r0; v1 = r1;
                    }
                    u32x4 w; w.x = ::pk2(v0[0], v0[1]); w.y = ::pk2(v0[2], v0[3]); w.z = ::pk2(v1[0], v1[1]); w.w = ::pk2(v1[2], v1[3]);
                    *(u32x4*)(O + (size_t)row * NQKV + col0) = w;
                }
        }
    }
};
}

__device__ __forceinline__ void tr_item(const float* W, int ldw, int k0, int srccol0, bf16_t* WT, int K, int destrow0, LAS float* scr, int lane) {
#pragma unroll 8
    for (int i = 0; i < 32; ++i) { const int kk = 2 * i + (lane >> 5); scr[kk * 33 + (lane & 31)] = W[(size_t)(k0 + kk) * ldw + srccol0 + (lane & 31)]; }
    asm volatile("s_waitcnt lgkmcnt(0)" ::: "memory");
    const int c = lane & 7;
#pragma unroll
    for (int j = 0; j < 4; ++j) { const int n = (lane >> 3) + 8 * j; const LAS float* s = scr + (8 * c) * 33 + n;
        u32x4 o; o.x = pk2(s[0 * 33], s[1 * 33]); o.y = pk2(s[2 * 33], s[3 * 33]); o.z = pk2(s[4 * 33], s[5 * 33]); o.w = pk2(s[6 * 33], s[7 * 33]);
        *(u32x4*)(WT + (size_t)(destrow0 + n) * K + k0 + 8 * c) = o; }
    asm volatile("s_waitcnt lgkmcnt(0)" ::: "memory");
}

__device__ __forceinline__ void p0_phase(LAS unsigned char* lds) {
    int tid_ = threadIdx.x; asm volatile("" : "+v"(tid_)); const int tid = tid_, lane = tid & 63, wid = __builtin_amdgcn_readfirstlane(tid >> 6), G = gridDim.x;
    unsigned char* ws = KA(ws);
    {
        LAS float* s = (LAS float*)lds;
        LAS float* red = (LAS float*)(lds + 36864);
        for (int i = tid; i < 9 * 1024; i += NTHREADS) { const float v = (i < 8192) ? KA(c)[i] : KA(c_ctx)[i - 8192]; s[i] = v / (1.f + expf(-v)); }
        __syncthreads();
        float* mod = (float*)(ws + WS_MOD);
        for (int tile = blockIdx.x; tile < 288; tile += G) {
            const int l = tile / 144, cg = tile % 144, n = cg * 64 + lane, kg = wid;
            float acc[9];
#pragma unroll
            for (int bi = 0; bi < 9; ++bi) acc[bi] = 0.f;
            const float* wp = KA(ada_w) + ((size_t)l * 1024 + kg * 128) * 9216 + n;
#pragma unroll 4
            for (int kk = 0; kk < 128; ++kk) {
                const float w = wp[(size_t)kk * 9216];
#pragma unroll
                for (int bi = 0; bi < 9; ++bi) acc[bi] += s[bi * 1024 + kg * 128 + kk] * w;
            }
#pragma unroll
            for (int bi = 0; bi < 9; ++bi) red[(kg * 9 + bi) * 64 + lane] = acc[bi];
            __syncthreads();
            for (int i = tid; i < 576; i += NTHREADS) {
                const int bi = i >> 6, cc = i & 63; float sum = 0.f;
#pragma unroll
                for (int k2 = 0; k2 < 8; ++k2) sum += red[(k2 * 9 + bi) * 64 + cc];
                mod[((size_t)l * 9 + bi) * 9216 + cg * 64 + cc] = sum + KA(ada_b)[l * 9216 + cg * 64 + cc];
            }
            __syncthreads();
        }
    }
    {
        const int gt = blockIdx.x * NTHREADS + tid, GT = G * NTHREADS;
        float* wg = (float*)(ws + WS_WG);
        for (int i = gt; i < 16 * 1024; i += GT) { const int g = i >> 10, k = i & 1023; wg[i] = KA(even_w_in)[(size_t)k * 3088 + 2048 + g]; }
        float* rope = (float*)(ws + WS_ROPE);
        for (int i = gt; i < 64 * 16; i += GT) { const int pos = i >> 4, f = i & 15; const float inv = powf(10000.f, -(float)f / 16.f); const float ang = (float)pos * inv; rope[2 * i] = cosf(ang); rope[2 * i + 1] = sinf(ang); }
    }
    {
        LAS float* scr = (LAS float*)(lds + wid * 16384);
        const int gw = blockIdx.x * 8 + wid, NGW = G * 8;
        constexpr int I_IN = 16 * 176, I_OUT = 44 * 32, I_EIN = 16 * 96, I_SQ = 16 * 32, I_QKV = 16 * 48;
        constexpr int NITEMS = 4 * I_IN + 4 * I_OUT + I_EIN + I_SQ + I_QKV + I_SQ;
        for (int it = gw; it < NITEMS; it += NGW) {
            int r = it;
            if (r < 4 * I_IN) { const int mi = r / I_IN; r -= mi * I_IN; const int kb = r / 176, nb = r % 176; const int n0 = nb * 32;
                const int dest = (n0 < 2816) ? ((n0 >> 7) * 256 + (n0 & 127)) : ((((n0 - 2816) >> 7) * 256) + 128 + ((n0 - 2816) & 127));
                tr_item(KA(ffn_w_in) + (size_t)mi * 1024 * 5632, 5632, kb * 64, n0, (bf16_t*)(ws + WS_WIN + mi * SZ_WIN), 1024, dest, scr, lane); continue; }
            r -= 4 * I_IN;
            if (r < 4 * I_OUT) { const int mi = r / I_OUT; r -= mi * I_OUT; const int kb = r / 32, nb = r % 32;
                tr_item(KA(ffn_w_out) + (size_t)mi * 2816 * 1024, 1024, kb * 64, nb * 32, (bf16_t*)(ws + WS_WOUT + mi * SZ_WOUT), 2816, nb * 32, scr, lane); continue; }
            r -= 4 * I_OUT;
            if (r < I_EIN) { const int kb = r / 96, nb = r % 96; const int src = nb < 64 ? nb * 32 : 2064 + (nb - 64) * 32;
                tr_item(KA(even_w_in), 3088, kb * 64, src, (bf16_t*)(ws + WS_WEIN), 1024, nb * 32, scr, lane); continue; }
            r -= I_EIN;
            if (r < I_SQ) { const int kb = r / 32, nb = r % 32; tr_item(KA(even_w_out), 1024, kb * 64, nb * 32, (bf16_t*)(ws + WS_WEOUT), 1024, nb * 32, scr, lane); continue; }
            r -= I_SQ;
            if (r < I_QKV) { const int kb = r / 48, nb = r % 48; tr_item(KA(odd_w_qkv), 1536, kb * 64, nb * 32, (bf16_t*)(ws + WS_WQKV), 1024, nb * 32, scr, lane); continue; }
            r -= I_QKV;
            { const int kb = r / 32, nb = r % 32; tr_item(KA(odd_w_out), 1024, kb * 64, nb * 32, (bf16_t*)(ws + WS_WOOUT), 1024, nb * 32, scr, lane); }
        }
    }
}

template <bool GATES>
__device__ __forceinline__ void norm_phase(LAS unsigned char* lds, const float* hx, const float* hc, bf16_t* A0, const float* modl, int shift_i, int scale_i, int nrows,
                                           const float* wg, const float* gate_b, float* gates) {
    int tid_ = threadIdx.x; asm volatile("" : "+v"(tid_)); const int tid = tid_, lane = tid & 63, wid = __builtin_amdgcn_readfirstlane(tid >> 6), G = gridDim.x;
    LAS float* wgs = (LAS float*)lds;
    if (GATES) { for (int i = tid; i < 16 * 1024 / 4; i += NTHREADS) ((LAS f32x4*)wgs)[i] = ((const f32x4*)wg)[i]; __syncthreads(); }
    for (int R = blockIdx.x * 8 + wid; R < nrows; R += G * 8) {
        const bool isx = R < MX;
        const float* src = isx ? hx + (size_t)R * D : hc + (size_t)(R - MX) * D;
        const int bi = isx ? (R >> 11) : 8;
        const float* mb = modl + (size_t)bi * 9216;
        f32x4 v[4]; float ss = 0.f;
#pragma unroll
        for (int j = 0; j < 4; ++j) { v[j] = *(const f32x4*)(src + 256 * j + 4 * lane); ss += (v[j][0] * v[j][0] + v[j][1] * v[j][1]) + (v[j][2] * v[j][2] + v[j][3] * v[j][3]); }
        const float rstd = 1.0f / sqrtf(wave_sum(ss) * (1.f / D) + EPS);
#pragma unroll
        for (int j = 0; j < 4; ++j) {
            const f32x4 sc = *(const f32x4*)(mb + scale_i * 1024 + 256 * j + 4 * lane), sh = *(const f32x4*)(mb + shift_i * 1024 + 256 * j + 4 * lane);
            v[j] = v[j] * rstd * (sc + 1.f) + sh;
            u32x2 w; w.x = pk2(v[j][0], v[j][1]); w.y = pk2(v[j][2], v[j][3]);
            *(u32x2*)(A0 + (size_t)R * D + 256 * j + 4 * lane) = w;
        }
        if (GATES) {
            float mine = 0.f;
#pragma unroll 1
            for (int g = 0; g < 16; ++g) {
                float d = 0.f;
#pragma unroll
                for (int j = 0; j < 4; ++j) { const f32x4 w = *(const LAS f32x4*)(wgs + g * 1024 + 256 * j + 4 * lane); d += (v[j][0] * w[0] + v[j][1] * w[1]) + (v[j][2] * w[2] + v[j][3] * w[3]); }
                d = wave_sum(d);
                if (lane == g) mine = d;
            }
            if (lane < 16) gates[(size_t)R * 16 + lane] = mine + gate_b[lane];
        }
    }
    if (GATES) __syncthreads();
}

__device__ __forceinline__ void mlstm_phase(LAS unsigned char* lds, const bf16_t* P, const float* gates, const float* convw, float* Hdir) {
    int tid_ = threadIdx.x; asm volatile("" : "+v"(tid_)); const int tid = tid_, lane = tid & 63, wid = __builtin_amdgcn_readfirstlane(tid >> 6), r = lane & 15, q = lane >> 4;
    constexpr int LD = 136, LDB = LD * 2;
    constexpr int OFF_Q = 0, OFF_K = 34816, OFF_KT = 69632, OFF_VT = 104448, OFF_VW = 113152, OFF_CT = 121856, OFF_SC = 130560;
    LAS bf16_t* Qs = (LAS bf16_t*)(lds + OFF_Q); LAS bf16_t* Ks = (LAS bf16_t*)(lds + OFF_K); LAS bf16_t* Kt = (LAS bf16_t*)(lds + OFF_KT);
    LAS bf16_t* Vt = (LAS bf16_t*)(lds + OFF_VT); LAS bf16_t* Vw = (LAS bf16_t*)(lds + OFF_VW); LAS bf16_t* Ct = (LAS bf16_t*)(lds + OFF_CT);
    LAS float* sc = (LAS float*)(lds + OFF_SC);
    LAS float* rowf = sc; LAS float* dmb = sc + 128; LAS float* inter = sc + 256; LAS float* wl = sc + 384; LAS float* en = sc + 512; LAS float* qn = sc + 640; LAS float* nvec = sc + 768; LAS float* misc = sc + 896; LAS float* cw = sc + 1024;
    const int seg = tid & 15;
    for (int unit = blockIdx.x; unit < 256; unit += gridDim.x) {
        const int es = unit & 3, dir = (unit >> 2) & 1, h = (unit >> 3) & 3, b = unit >> 5;
        for (int i = tid; i < 768; i += NTHREADS) { const int qk = i / 384, j = (i % 384) >> 7, ch = i & 127; cw[i] = convw[j * 1024 + qk * 512 + h * 128 + ch]; }
        for (int i = tid; i < 32 * LD / 2; i += NTHREADS) ((LAS unsigned*)Ct)[i] = 0u;
        if (tid < 128) nvec[tid] = 0.f;
        f32x4 Cacc[2]; Cacc[0] = (f32x4){0.f, 0.f, 0.f, 0.f}; Cacc[1] = Cacc[0];
        float m_state = 0.f;
        __syncthreads();
        for (int ci = 0; ci < 18; ++ci) {
            int cc, sbase, T;
            if (ci < 2) { cc = dir ? 1 - ci : ci; sbase = MX + b * CTXL; T = CTXL; } else { cc = dir ? 17 - ci : ci - 2; sbase = b * SEQ; T = SEQ; }
            if (wid == 0) {
                float ig[2], bc[2];
#pragma unroll
                for (int hf = 0; hf < 2; ++hf) { const int l = lane + 64 * hf; const int R = sbase + cc * 128 + (dir ? 127 - l : l);
                    ig[hf] = gates[(size_t)R * 16 + dir * 8 + h]; const float fg = gates[(size_t)R * 16 + dir * 8 + 4 + h];
                    bc[hf] = fminf(fg, 0.f) - log1pf(expf(-fabsf(fg))); }
#pragma unroll
                for (int off = 1; off < 64; off <<= 1) { const float t0 = __shfl_up(bc[0], off), t1 = __shfl_up(bc[1], off); if (lane >= off) { bc[0] += t0; bc[1] += t1; } }
                bc[1] += __shfl(bc[0], 63);
                const float g = __shfl(bc[1], 63);
                const float d0 = ig[0] - bc[0], d1 = ig[1] - bc[1];
                float p0 = d0, p1 = d1;
#pragma unroll
                for (int off = 1; off < 64; off <<= 1) { const float t0 = __shfl_up(p0, off), t1 = __shfl_up(p1, off); if (lane >= off) { p0 = fmaxf(p0, t0); p1 = fmaxf(p1, t1); } }
                p1 = fmaxf(p1, __shfl(p0, 63));
                const float a0 = g + d0, a1 = g + d1;
                const float mloc = wave_max(fmaxf(a0, a1));
                const float m_new = fmaxf(g + m_state, mloc);
                const float dec = expf(g + m_state - m_new);
                const float mt0 = bc[0] + fmaxf(m_state, p0), mt1 = bc[1] + fmaxf(m_state, p1);
                rowf[lane] = bc[0] - mt0; rowf[lane + 64] = bc[1] - mt1;
                dmb[lane] = d0; dmb[lane + 64] = d1;
                inter[lane] = expf(bc[0] + m_state - mt0); inter[lane + 64] = expf(bc[1] + m_state - mt1);
                wl[lane] = expf(a0 - m_new); wl[lane + 64] = expf(a1 - m_new);
                en[lane] = expf(-mt0); en[lane + 64] = expf(-mt1);
                if (lane == 0) misc[0] = dec;
                m_state = m_new;
            }
#pragma unroll 1
            for (int it = 0; it < 4; ++it) {
                const int l = (tid + NTHREADS * it) >> 4;
                const int tin = cc * 128 + (dir ? 127 - l : l);
                const bf16_t* pr = P + (size_t)(sbase + tin) * NEV + h * 128 + seg * 8;
                const u32x4 z = (u32x4){0u, 0u, 0u, 0u};
                {
                    const u32x4 c0 = *(const u32x4*)pr; const u32x4 pv = tin > 0 ? *(const u32x4*)(pr - NEV) : z; const u32x4 nx = tin < T - 1 ? *(const u32x4*)(pr + NEV) : z;
                    float y[8];
#pragma unroll
                    for (int hf = 0; hf < 2; ++hf) {
                        const f32x4 w0 = *(const LAS f32x4*)(cw + 0 * 128 + seg * 8 + 4 * hf), w1 = *(const LAS f32x4*)(cw + 1 * 128 + seg * 8 + 4 * hf), w2v = *(const LAS f32x4*)(cw + 2 * 128 + seg * 8 + 4 * hf);
                        y[4 * hf + 0] = w0[0] * bflo(pv[2 * hf]) + w1[0] * bflo(c0[2 * hf]) + w2v[0] * bflo(nx[2 * hf]);
                        y[4 * hf + 1] = w0[1] * bfhi(pv[2 * hf]) + w1[1] * bfhi(c0[2 * hf]) + w2v[1] * bfhi(nx[2 * hf]);
                        y[4 * hf + 2] = w0[2] * bflo(pv[2 * hf + 1]) + w1[2] * bflo(c0[2 * hf + 1]) + w2v[2] * bflo(nx[2 * hf + 1]);
                        y[4 * hf + 3] = w0[3] * bfhi(pv[2 * hf + 1]) + w1[3] * bfhi(c0[2 * hf + 1]) + w2v[3] * bfhi(nx[2 * hf + 1]);
                    }
                    u32x4 o;
#pragma unroll
                    for (int w2 = 0; w2 < 4; ++w2) o[w2] = pk2(silu_f(y[2 * w2]), silu_f(y[2 * w2 + 1]));
                    *(LAS u32x4*)(Qs + l * LD + seg * 8) = o;
                }
                {
                    const bf16_t* pk = pr + 512;
                    const u32x4 c0 = *(const u32x4*)pk; const u32x4 pv = tin > 0 ? *(const u32x4*)(pk - NEV) : z; const u32x4 nx = tin < T - 1 ? *(const u32x4*)(pk + NEV) : z;
                    float y[8];
#pragma unroll
                    for (int hf = 0; hf < 2; ++hf) {
                        const f32x4 w0 = *(const LAS f32x4*)(cw + 3 * 128 + seg * 8 + 4 * hf), w1 = *(const LAS f32x4*)(cw + 4 * 128 + seg * 8 + 4 * hf), w2v = *(const LAS f32x4*)(cw + 5 * 128 + seg * 8 + 4 * hf);
                        y[4 * hf + 0] = w0[0] * bflo(pv[2 * hf]) + w1[0] * bflo(c0[2 * hf]) + w2v[0] * bflo(nx[2 * hf]);
                        y[4 * hf + 1] = w0[1] * bfhi(pv[2 * hf]) + w1[1] * bfhi(c0[2 * hf]) + w2v[1] * bfhi(nx[2 * hf]);
                        y[4 * hf + 2] = w0[2] * bflo(pv[2 * hf + 1]) + w1[2] * bflo(c0[2 * hf + 1]) + w2v[2] * bflo(nx[2 * hf + 1]);
                        y[4 * hf + 3] = w0[3] * bfhi(pv[2 * hf + 1]) + w1[3] * bfhi(c0[2 * hf + 1]) + w2v[3] * bfhi(nx[2 * hf + 1]);
                    }
                    u32x4 o;
#pragma unroll
                    for (int w2 = 0; w2 < 4; ++w2) { o[w2] = pk2(silu_f(y[2 * w2]) * 0.08838834764831845f, silu_f(y[2 * w2 + 1]) * 0.08838834764831845f);
                        Kt[(seg * 8 + 2 * w2) * LD + l] = (bf16_t)(o[w2] & 0xffffu); Kt[(seg * 8 + 2 * w2 + 1) * LD + l] = (bf16_t)(o[w2] >> 16); }
                    *(LAS u32x4*)(Ks + l * LD + seg * 8) = o;
                }
            }
            __syncthreads();
            const float dec = misc[0];
            {
                const int l = tid >> 2, sg = tid & 3;
                const int tin = cc * 128 + (dir ? 127 - l : l);
                const u32x4 vv = *(const u32x4*)(P + (size_t)(sbase + tin) * NEV + 1024 + h * 128 + es * 32 + sg * 8);
                const float w = wl[l];
#pragma unroll
                for (int w2 = 0; w2 < 4; ++w2) {
                    Vt[(sg * 8 + 2 * w2) * LD + l] = (bf16_t)(vv[w2] & 0xffffu); Vt[(sg * 8 + 2 * w2 + 1) * LD + l] = (bf16_t)(vv[w2] >> 16);
                    Vw[(sg * 8 + 2 * w2) * LD + l] = f2bf(bflo(vv[w2]) * w); Vw[(sg * 8 + 2 * w2 + 1) * LD + l] = f2bf(bfhi(vv[w2]) * w);
                }
            }
            f32x4 sacc[8];
            {
                bf16x8 af[4];
#pragma unroll
                for (int ks = 0; ks < 4; ++ks) af[ks] = ldsfrag(lds + OFF_Q + (16 * wid + r) * LDB + (32 * ks + 8 * q) * 2);
#pragma unroll
                for (int jb = 0; jb < 8; ++jb) {
                    sacc[jb] = (f32x4){0.f, 0.f, 0.f, 0.f};
                    if (jb <= wid) {
#pragma unroll
                        for (int ks = 0; ks < 4; ++ks) sacc[jb] = mfma16(af[ks], ldsfrag(lds + OFF_K + (16 * jb + r) * LDB + (32 * ks + 8 * q) * 2), sacc[jb]);
                    }
                }
            }
            {
                const int t = tid >> 2, part = tid & 3; float s = 0.f;
#pragma unroll
                for (int i = 0; i < 4; ++i) {
                    const u32x4 qv = *(const LAS u32x4*)(Qs + t * LD + part * 32 + i * 8);
                    const f32x4 n0 = *(const LAS f32x4*)(nvec + part * 32 + i * 8), n1 = *(const LAS f32x4*)(nvec + part * 32 + i * 8 + 4);
                    s += bflo(qv[0]) * n0[0] + bfhi(qv[0]) * n0[1] + bflo(qv[1]) * n0[2] + bfhi(qv[1]) * n0[3] + bflo(qv[2]) * n1[0] + bfhi(qv[2]) * n1[1] + bflo(qv[3]) * n1[2] + bfhi(qv[3]) * n1[3];
                }
                s += __shfl_xor(s, 1); s += __shfl_xor(s, 2);
                if (part == 0) qn[t] = s;
            }
            __syncthreads();
            LAS bf16_t* Ss = Ks;
            float rs[4] = {0.f, 0.f, 0.f, 0.f};
            {
                const f32x4 rf = *(const LAS f32x4*)(rowf + 16 * wid + 4 * q);
#pragma unroll
                for (int jb = 0; jb < 8; ++jb) {
                    if (jb <= wid) {
                        const int s = 16 * jb + r; const float dm = dmb[s];
#pragma unroll
                        for (int reg = 0; reg < 4; ++reg) { const int t = 16 * wid + 4 * q + reg;
                            const float v = (s <= t) ? sacc[jb][reg] * __expf(rf[reg] + dm) : 0.f;
                            rs[reg] += v; Ss[t * LD + s] = f2bf(v); }
                    } else if (jb == wid + 1 && !(wid & 1)) {
#pragma unroll
                        for (int reg = 0; reg < 4; ++reg) Ss[(16 * wid + 4 * q + reg) * LD + 16 * jb + r] = 0;
                    }
                }
#pragma unroll
                for (int reg = 0; reg < 4; ++reg) { rs[reg] += __shfl_xor(rs[reg], 1); rs[reg] += __shfl_xor(rs[reg], 2); rs[reg] += __shfl_xor(rs[reg], 4); rs[reg] += __shfl_xor(rs[reg], 8); }
            }
            {
                const int nks = (wid >> 1) + 1;
                const f32x4 it4 = *(const LAS f32x4*)(inter + 16 * wid + 4 * q), qn4 = *(const LAS f32x4*)(qn + 16 * wid + 4 * q), en4 = *(const LAS f32x4*)(en + 16 * wid + 4 * q);
                bf16x8 qf[4];
#pragma unroll
                for (int ks = 0; ks < 4; ++ks) qf[ks] = ldsfrag(lds + OFF_Q + (16 * wid + r) * LDB + (32 * ks + 8 * q) * 2);
#pragma unroll
                for (int nt = 0; nt < 2; ++nt) {
                    f32x4 a1 = (f32x4){0.f, 0.f, 0.f, 0.f}, a2 = a1;
#pragma unroll
                    for (int ks = 0; ks < 4; ++ks) {
                        if (ks < nks) a1 = mfma16(ldsfrag(lds + OFF_K + (16 * wid + r) * LDB + (32 * ks + 8 * q) * 2), ldsfrag(lds + OFF_VT + (16 * nt + r) * LDB + (32 * ks + 8 * q) * 2), a1);
                        a2 = mfma16(qf[ks], ldsfrag(lds + OFF_CT + (16 * nt + r) * LDB + (32 * ks + 8 * q) * 2), a2);
                    }
#pragma unroll
                    for (int reg = 0; reg < 4; ++reg) {
                        const int t = 16 * wid + 4 * q + reg;
                        const float den = rs[reg] + it4[reg] * qn4[reg];
                        const float hv = (a1[reg] + it4[reg] * a2[reg]) / fmaxf(fabsf(den), en4[reg]);
                        const int R = sbase + cc * 128 + (dir ? 127 - t : t);
                        Hdir[((size_t)dir * MT + R) * 512 + h * 128 + es * 32 + 16 * nt + r] = hv;
                    }
                }
            }
            {
                bf16x8 kf[4];
#pragma unroll
                for (int ks = 0; ks < 4; ++ks) kf[ks] = ldsfrag(lds + OFF_KT + (16 * wid + r) * LDB + (32 * ks + 8 * q) * 2);
#pragma unroll
                for (int nt = 0; nt < 2; ++nt) {
                    Cacc[nt] = Cacc[nt] * dec;
#pragma unroll
                    for (int ks = 0; ks < 4; ++ks) Cacc[nt] = mfma16(kf[ks], ldsfrag(lds + OFF_VW + (16 * nt + r) * LDB + (32 * ks + 8 * q) * 2), Cacc[nt]);
                }
            }
            float nnew;
            {
                const int d = tid >> 2, part = tid & 3; float s = 0.f;
#pragma unroll
                for (int i = 0; i < 4; ++i) {
                    const u32x4 kv = *(const LAS u32x4*)(Kt + d * LD + part * 32 + i * 8);
                    const f32x4 w0 = *(const LAS f32x4*)(wl + part * 32 + i * 8), w1 = *(const LAS f32x4*)(wl + part * 32 + i * 8 + 4);
                    s += bflo(kv[0]) * w0[0] + bfhi(kv[0]) * w0[1] + bflo(kv[1]) * w0[2] + bfhi(kv[1]) * w0[3] + bflo(kv[2]) * w1[0] + bfhi(kv[2]) * w1[1] + bflo(kv[3]) * w1[2] + bfhi(kv[3]) * w1[3];
                }
                s += __shfl_xor(s, 1); s += __shfl_xor(s, 2);
                nnew = dec * nvec[d] + s;
            }
            __syncthreads();
#pragma unroll
            for (int nt = 0; nt < 2; ++nt) { u32x2 w; w.x = pk2(Cacc[nt][0], Cacc[nt][1]); w.y = pk2(Cacc[nt][2], Cacc[nt][3]); *(LAS u32x2*)(Ct + (16 * nt + r) * LD + 16 * wid + 4 * q) = w; }
            if ((tid & 3) == 0) nvec[tid >> 2] = nnew;
        }
        __syncthreads();
    }
}

__device__ __forceinline__ void sgu_phase(LAS unsigned char* lds, const bf16_t* P, const float* sgu_norm, const float* sgu_ws, const float* sgu_b, bf16_t* A1) {
    int tid_ = threadIdx.x; asm volatile("" : "+v"(tid_)); const int tid = tid_, lane = tid & 63, wid = __builtin_amdgcn_readfirstlane(tid >> 6), r = lane & 15, q = lane >> 4;
    constexpr int LD = 136, LDB = LD * 2, OFF_W = 0, OFF_V = 34816, OFF_R = 69632;
    LAS bf16_t* Ws = (LAS bf16_t*)(lds + OFF_W); LAS bf16_t* Vt = (LAS bf16_t*)(lds + OFF_V); LAS float* rstd = (LAS float*)(lds + OFF_R);
    for (int unit = blockIdx.x; unit < 576; unit += gridDim.x) {
        const int g = unit & 3, n = (unit >> 2) % 18, b = unit / 72;
        const int rbase = n < 2 ? MX + b * CTXL + n * 128 : b * SEQ + (n - 2) * 128;
        {
            const int tok = tid >> 2, part = tid & 3; float ss = 0.f;
            const bf16_t* pv = P + (size_t)(rbase + tok) * NEV + 2560 + part * 128;
#pragma unroll 4
            for (int i = 0; i < 16; ++i) { const u32x4 w = *(const u32x4*)(pv + i * 8);
#pragma unroll
                for (int k = 0; k < 4; ++k) { const float a0 = gelu_tanh(bflo(w[k])), a1 = gelu_tanh(bfhi(w[k])); ss += a0 * a0 + a1 * a1; } }
            ss += __shfl_xor(ss, 1); ss += __shfl_xor(ss, 2);
            if (part == 0) rstd[tok] = 1.0f / sqrtf(ss * (1.f / 512.f) + EPS);
        }
#pragma unroll
        for (int it = 0; it < 4; ++it) { const int i = tid + NTHREADS * it; const int p = i >> 4, sg = i & 15;
            const float* wp = sgu_ws + ((size_t)g * 128 + p) * 128 + sg * 8; const f32x4 w0 = *(const f32x4*)wp, w1 = *(const f32x4*)(wp + 4);
            u32x4 o; o.x = pk2(w0[0], w0[1]); o.y = pk2(w0[2], w0[3]); o.z = pk2(w1[0], w1[1]); o.w = pk2(w1[2], w1[3]);
            *(LAS u32x4*)(Ws + p * LD + sg * 8) = o; }
        __syncthreads();
#pragma unroll
        for (int it = 0; it < 4; ++it) { const int i = tid + NTHREADS * it; const int tq = i >> 4, sg = i & 15;
            const u32x4 w = *(const u32x4*)(P + (size_t)(rbase + tq) * NEV + 2560 + g * 128 + sg * 8);
            const float rq = rstd[tq];
            const f32x4 g0 = *(const f32x4*)(sgu_norm + g * 128 + sg * 8), g1 = *(const f32x4*)(sgu_norm + g * 128 + sg * 8 + 4);
            Vt[(sg * 8 + 0) * LD + tq] = f2bf(gelu_tanh(bflo(w[0])) * rq * g0[0]); Vt[(sg * 8 + 1) * LD + tq] = f2bf(gelu_tanh(bfhi(w[0])) * rq * g0[1]);
            Vt[(sg * 8 + 2) * LD + tq] = f2bf(gelu_tanh(bflo(w[1])) * rq * g0[2]); Vt[(sg * 8 + 3) * LD + tq] = f2bf(gelu_tanh(bfhi(w[1])) * rq * g0[3]);
            Vt[(sg * 8 + 4) * LD + tq] = f2bf(gelu_tanh(bflo(w[2])) * rq * g1[0]); Vt[(sg * 8 + 5) * LD + tq] = f2bf(gelu_tanh(bfhi(w[2])) * rq * g1[1]);
            Vt[(sg * 8 + 6) * LD + tq] = f2bf(gelu_tanh(bflo(w[3])) * rq * g1[2]); Vt[(sg * 8 + 7) * LD + tq] = f2bf(gelu_tanh(bfhi(w[3])) * rq * g1[3]); }
        __syncthreads();
        {
            bf16x8 af[4];
#pragma unroll
            for (int ks = 0; ks < 4; ++ks) af[ks] = ldsfrag(lds + OFF_W + (16 * wid + r) * LDB + (32 * ks + 8 * q) * 2);
            const f32x4 sb4 = *(const f32x4*)(sgu_b + g * 128 + 16 * wid + 4 * q);
#pragma unroll
            for (int jb = 0; jb < 8; ++jb) {
                f32x4 acc = (f32x4){0.f, 0.f, 0.f, 0.f};
#pragma unroll
                for (int ks = 0; ks < 4; ++ks) acc = mfma16(af[ks], ldsfrag(lds + OFF_V + (16 * jb + r) * LDB + (32 * ks + 8 * q) * 2), acc);
#pragma unroll
                for (int reg = 0; reg < 4; ++reg) { const int p = 16 * wid + 4 * q + reg; const size_t R = (size_t)(rbase + p);
                    const float uu = gelu_tanh(bf2f(P[R * NEV + 2048 + g * 128 + 16 * jb + r]));
                    A1[R * D + 512 + g * 128 + 16 * jb + r] = f2bf(uu * (acc[reg] + sb4[reg])); }
            }
        }
        __syncthreads();
    }
}

__device__ __forceinline__ void combine_phase(const float* Hdir, const bf16_t* P, const float* mnorm, bf16_t* A1) {
    int tid_ = threadIdx.x; asm volatile("" : "+v"(tid_)); const int tid = tid_, lane = tid & 63, wid = __builtin_amdgcn_readfirstlane(tid >> 6);
    for (int R = blockIdx.x * 8 + wid; R < MT; R += gridDim.x * 8) {
        const int col = lane * 8;
        const float* p0 = Hdir + (size_t)R * 512 + col; const float* p1 = Hdir + ((size_t)MT + R) * 512 + col;
        const f32x4 a0 = *(const f32x4*)p0 + *(const f32x4*)p1, a1 = *(const f32x4*)(p0 + 4) + *(const f32x4*)(p1 + 4);
        float ss = (a0[0] * a0[0] + a0[1] * a0[1]) + (a0[2] * a0[2] + a0[3] * a0[3]) + (a1[0] * a1[0] + a1[1] * a1[1]) + (a1[2] * a1[2] + a1[3] * a1[3]);
        ss += __shfl_xor(ss, 1); ss += __shfl_xor(ss, 2); ss += __shfl_xor(ss, 4); ss += __shfl_xor(ss, 8);
        const float rstd = 1.0f / sqrtf(ss * (1.f / 128.f) + EPS);
        const f32x4 m0 = *(const f32x4*)(mnorm + col), m1 = *(const f32x4*)(mnorm + col + 4);
        const u32x4 ov = *(const u32x4*)(P + (size_t)R * NEV + 1536 + col);
        u32x4 w;
        w.x = pk2(sigmoid_f(bflo(ov[0])) * a0[0] * rstd * m0[0], sigmoid_f(bfhi(ov[0])) * a0[1] * rstd * m0[1]);
        w.y = pk2(sigmoid_f(bflo(ov[1])) * a0[2] * rstd * m0[2], sigmoid_f(bfhi(ov[1])) * a0[3] * rstd * m0[3]);
        w.z = pk2(sigmoid_f(bflo(ov[2])) * a1[0] * rstd * m1[0], sigmoid_f(bfhi(ov[2])) * a1[1] * rstd * m1[1]);
        w.w = pk2(sigmoid_f(bflo(ov[3])) * a1[2] * rstd * m1[2], sigmoid_f(bfhi(ov[3])) * a1[3] * rstd * m1[3]);
        *(u32x4*)(A1 + (size_t)R * D + col) = w;
    }
}

__device__ __forceinline__ void attn_phase(LAS unsigned char* lds, const bf16_t* QKV, const float* sink, bf16_t* A1) {
    int tid_ = threadIdx.x; asm volatile("" : "+v"(tid_)); const int tid = tid_, lane = tid & 63, wid = __builtin_amdgcn_readfirstlane(tid >> 6), r = lane & 15, q = lane >> 4;
    constexpr int LK = 72, LKB = LK * 2, OFF_K = 0, OFF_V = 9216, OFF_P = 18432, PSZ = 64 * LKB;
    LAS bf16_t* Ks = (LAS bf16_t*)(lds + OFF_K); LAS bf16_t* Vt = (LAS bf16_t*)(lds + OFF_V);
    LAS bf16_t* Ps = (LAS bf16_t*)(lds + OFF_P + wid * PSZ);
    const LAS unsigned char* Pb = lds + OFF_P + wid * PSZ;
    for (int unit = blockIdx.x; unit < 512; unit += gridDim.x) {
        const int hk = unit & 3, j = (unit >> 2) & 15, b = unit >> 6;
        const int g = wid >> 1, hq = hk * 4 + g, tok0 = (wid & 1) * 64;
        const int qrow0 = b * SEQ + j * 128 + tok0;
        bf16x8 qf[4][2];
#pragma unroll
        for (int mt = 0; mt < 4; ++mt)
#pragma unroll
            for (int ks = 0; ks < 2; ++ks) qf[mt][ks] = *(const bf16x8*)(QKV + (size_t)(qrow0 + 16 * mt + r) * NQKV + hq * 64 + 32 * ks + 8 * q);
        float mrun[4][4], lrun[4][4]; f32x4 oacc[4][4];
        const float sk = sink[hq];
#pragma unroll
        for (int mt = 0; mt < 4; ++mt)
#pragma unroll
            for (int i = 0; i < 4; ++i) { mrun[mt][i] = sk; lrun[mt][i] = 1.f; oacc[mt][i] = (f32x4){0.f, 0.f, 0.f, 0.f}; }
        for (int ti = 0; ti < 10; ++ti) {
            int krow0, kpos0; bool band;
            if (ti < 4) { krow0 = MX + b * CTXL + ti * 64; kpos0 = 0; band = false; }
            else { const int kb = j - 1 + ((ti - 4) >> 1); if (kb < 0 || kb > 15) continue; kpos0 = kb * 128 + ((ti - 4) & 1) * 64; krow0 = b * SEQ + kpos0; band = (kb != j); }
            __syncthreads();
            {
                const int key = tid >> 3, sg = tid & 7;
                const bf16_t* kp = QKV + (size_t)(krow0 + key) * NQKV + 1024 + hk * 64 + sg * 8;
                const u32x4 kv = *(const u32x4*)kp; const u32x4 vv = *(const u32x4*)(kp + 256);
                *(LAS u32x4*)(Ks + key * LK + sg * 8) = kv;
#pragma unroll
                for (int w2 = 0; w2 < 4; ++w2) { Vt[(sg * 8 + 2 * w2) * LK + key] = (bf16_t)(vv[w2] & 0xffffu); Vt[(sg * 8 + 2 * w2 + 1) * LK + key] = (bf16_t)(vv[w2] >> 16); }
            }
            __syncthreads();
#pragma unroll
            for (int mt = 0; mt < 4; ++mt) {
                f32x4 s[4];
#pragma unroll
                for (int nt = 0; nt < 4; ++nt) {
                    const bf16x8 k0 = ldsfrag(lds + OFF_K + (16 * nt + r) * LKB + (8 * q) * 2), k1 = ldsfrag(lds + OFF_K + (16 * nt + r) * LKB + (32 + 8 * q) * 2);
                    f32x4 a = (f32x4){0.f, 0.f, 0.f, 0.f}; a = mfma16(qf[mt][0], k0, a); a = mfma16(qf[mt][1], k1, a); s[nt] = a;
                }
                if (band) {
#pragma unroll
                    for (int nt = 0; nt < 4; ++nt)
#pragma unroll
                        for (int i = 0; i < 4; ++i) { const int qp = j * 128 + tok0 + 16 * mt + 4 * q + i, kp = kpos0 + 16 * nt + r; const int df = qp - kp;
                            if (df > 128 || df < -128) s[nt][i] = -1e30f; }
                }
#pragma unroll
                for (int i = 0; i < 4; ++i) {
                    float mx = fmaxf(fmaxf(s[0][i], s[1][i]), fmaxf(s[2][i], s[3][i]));
                    mx = fmaxf(mx, __shfl_xor(mx, 1)); mx = fmaxf(mx, __shfl_xor(mx, 2)); mx = fmaxf(mx, __shfl_xor(mx, 4)); mx = fmaxf(mx, __shfl_xor(mx, 8));
                    const float mn = fmaxf(mrun[mt][i], mx), alpha = __expf(mrun[mt][i] - mn);
                    float rsum = 0.f;
#pragma unroll
                    for (int nt = 0; nt < 4; ++nt) { const float p = __expf(s[nt][i] - mn); rsum += p; Ps[(16 * mt + 4 * q + i) * LK + 16 * nt + r] = f2bf(p); }
                    rsum += __shfl_xor(rsum, 1); rsum += __shfl_xor(rsum, 2); rsum += __shfl_xor(rsum, 4); rsum += __shfl_xor(rsum, 8);
                    lrun[mt][i] = lrun[mt][i] * alpha + rsum; mrun[mt][i] = mn;
#pragma unroll
                    for (int nt = 0; nt < 4; ++nt) oacc[mt][nt][i] *= alpha;
                }
                asm volatile("" ::: "memory");
            }
#pragma unroll
            for (int nt = 0; nt < 4; ++nt) {
                const bf16x8 v0 = ldsfrag(lds + OFF_V + (16 * nt + r) * LKB + (8 * q) * 2), v1 = ldsfrag(lds + OFF_V + (16 * nt + r) * LKB + (32 + 8 * q) * 2);
#pragma unroll
                for (int mt = 0; mt < 4; ++mt) {
                    oacc[mt][nt] = mfma16(ldsfrag(Pb + (16 * mt + r) * LKB + (8 * q) * 2), v0, oacc[mt][nt]);
                    oacc[mt][nt] = mfma16(ldsfrag(Pb + (16 * mt + r) * LKB + (32 + 8 * q) * 2), v1, oacc[mt][nt]);
                }
            }
        }
#pragma unroll
        for (int mt = 0; mt < 4; ++mt)
#pragma unroll
            for (int i = 0; i < 4; ++i) { const float inv = 1.f / lrun[mt][i]; const size_t R = (size_t)(qrow0 + 16 * mt + 4 * q + i);
#pragma unroll
                for (int nt = 0; nt < 4; ++nt) A1[R * D + hq * 64 + 16 * nt + r] = f2bf(oacc[mt][nt][i] * inv); }
    }
    __syncthreads();
}

__device__ __forceinline__ void final_phase(float* out, const float* fnorm) {
    int tid_ = threadIdx.x; asm volatile("" : "+v"(tid_)); const int tid = tid_, lane = tid & 63, wid = __builtin_amdgcn_readfirstlane(tid >> 6);
    for (int R = blockIdx.x * 8 + wid; R < MX; R += gridDim.x * 8) {
        float* src = out + (size_t)R * D;
        f32x4 v[4]; float ss = 0.f;
#pragma unroll
        for (int j = 0; j < 4; ++j) { v[j] = *(const f32x4*)(src + 256 * j + 4 * lane); ss += (v[j][0] * v[j][0] + v[j][1] * v[j][1]) + (v[j][2] * v[j][2] + v[j][3] * v[j][3]); }
        const float rstd = 1.0f / sqrtf(wave_sum(ss) * (1.f / D) + EPS);
#pragma unroll
        for (int j = 0; j < 4; ++j) { const f32x4 w = *(const f32x4*)(fnorm + 256 * j + 4 * lane); *(f32x4*)(src + 256 * j + 4 * lane) = v[j] * rstd * w; }
    }
}

#ifndef MK_SINGLE
#define MK_SINGLE 1
#endif
constexpr int NPHASES = 23;
#ifndef EN_ALL
#define EN_ALL 1
#endif
#ifndef EN_P0
#define EN_P0 EN_ALL
#endif
#ifndef EN_NORM
#define EN_NORM EN_ALL
#endif
#ifndef EN_GEMM
#define EN_GEMM (EN_ALL ? 15 : 0)
#endif
#ifndef EN_MLSTM
#define EN_MLSTM EN_ALL
#endif
#ifndef EN_SGU
#define EN_SGU EN_ALL
#endif
#ifndef EN_COMB
#define EN_COMB EN_ALL
#endif
#ifndef EN_ATTN
#define EN_ATTN EN_ALL
#endif
#ifndef EN_FINAL
#define EN_FINAL EN_ALL
#endif
__global__ void __launch_bounds__(NTHREADS, 2) fwd_kernel(Args a_unused) {
    extern __shared__ __attribute__((aligned(16))) unsigned char lds_raw[];
    LAS unsigned char* lds = (LAS unsigned char*)lds_raw;
    cg::grid_group grid = cg::this_grid();
    unsigned char* ws = KA(ws);
    const int G = gridDim.x, c = blockIdx.x;
    float* Hx = KA(out); float* Hc = (float*)(ws + WS_HC);
    bf16_t* A0 = (bf16_t*)(ws + WS_A0); bf16_t* A1 = (bf16_t*)(ws + WS_A1); bf16_t* BIG = (bf16_t*)(ws + WS_BIG);
    float* Hdir = (float*)(ws + WS_A0);
    const float* mod = (const float*)(ws + WS_MOD);
    float* gates = (float*)(ws + WS_GATES);
    const int lo = KA(ph_lo), hi = KA(ph_hi);
    enum { K_P0, K_NORM, K_NORMG, K_SWIGLU, K_RESID, K_PLAIN, K_QKV, K_MIX0, K_COMB, K_ATTN, K_FINAL };
    for (int ph = lo; ph < hi; ++ph) {
        const int layer = ph >= 12 ? 1 : 0;
        const int lp = ph >= 12 ? ph - 12 : ph - 1;
        const float* modl = mod + (size_t)layer * 9 * 9216;
        int kind = K_P0, M = MT, gi = 0, ffn = 0, Kd = 1024; float coef = 1.f;
        const bf16_t* Aop = A0; const bf16_t* Wop = nullptr;
        const float* bxp = Hx; const float* bcp = Hc;
        if (ph == 0) kind = K_P0;
        else if (ph == 22) kind = K_FINAL;
        else if (lp == 0) { kind = K_NORM; gi = 0; if (layer == 0) { bxp = KA(x); bcp = KA(ctx); } }
        else if (lp == 1) { kind = K_SWIGLU; ffn = layer * 2; }
        else if (lp == 2) { kind = K_RESID; Aop = BIG; Wop = (const bf16_t*)(ws + WS_WOUT + (size_t)(layer * 2) * SZ_WOUT); Kd = 2816; gi = 2; coef = 0.5f; if (layer == 0) { bxp = KA(x); bcp = KA(ctx); } }
        else if (layer == 0) {
            if (lp == 3) { kind = K_NORMG; gi = 3; }
            else if (lp == 4) kind = K_PLAIN;
            else if (lp == 5) kind = K_MIX0;
            else if (lp == 6) kind = K_COMB;
            else if (lp == 7) { kind = K_RESID; Aop = A1; Wop = (const bf16_t*)(ws + WS_WEOUT); gi = 5; }
            else if (lp == 8) { kind = K_NORM; gi = 6; }
            else if (lp == 9) { kind = K_SWIGLU; ffn = 1; }
            else { kind = K_RESID; Aop = BIG; Wop = (const bf16_t*)(ws + WS_WOUT + SZ_WOUT); Kd = 2816; gi = 8; coef = 0.5f; }
        } else {
            if (lp == 3) { kind = K_NORM; gi = 3; }
            else if (lp == 4) kind = K_QKV;
            else if (lp == 5) kind = K_ATTN;
            else if (lp == 6) { kind = K_RESID; Aop = A1; Wop = (const bf16_t*)(ws + WS_WOOUT); gi = 5; M = MX; }
            else if (lp == 7) { kind = K_NORM; gi = 6; M = MX; }
            else if (lp == 8) { kind = K_SWIGLU; ffn = 3; M = MX; }
            else { kind = K_RESID; Aop = BIG; Wop = (const bf16_t*)(ws + WS_WOUT + 3 * SZ_WOUT); Kd = 2816; gi = 8; coef = 0.5f; M = MX; }
        }
        if (kind == K_P0) { if (EN_P0) p0_phase(lds); }
        else if (kind == K_NORM) { if (EN_NORM) norm_phase<false>(lds, bxp, bcp, A0, modl, gi, gi + 1, M, nullptr, nullptr, nullptr); }
        else if (kind == K_NORMG) { if (EN_NORM) norm_phase<true>(lds, Hx, Hc, A0, modl, gi, gi + 1, M, (const float*)(ws + WS_WG), KA(mlstm_gate_b), gates); }
        else if (kind == K_SWIGLU) { if (EN_GEMM & 1) { pg8::Gemm g{A0, (const bf16_t*)(ws + WS_WIN + (size_t)ffn * SZ_WIN), M, 5632, 1024}; pg8::StaticOrder S; S.init(M, 5632, G, c); pg8::EpiSwiglu E{BIG};
            pg8::gemm_phase<pg8::EpiSwiglu, pg8::StaticOrder, true, true>(lds, g, S, E); } }
        else if (kind == K_RESID) { if (EN_GEMM & 2) { pg8::Gemm g{Aop, Wop, M, 1024, Kd}; pg8::StaticOrder S; S.init(M, 1024, G, c); pg8::EpiResid E{bxp, bcp, Hx, Hc, modl + gi * 1024, coef};
            pg8::gemm_phase<pg8::EpiResid, pg8::StaticOrder, true, true>(lds, g, S, E); } }
        else if (kind == K_PLAIN) { if (EN_GEMM & 4) { pg8::Gemm g{A0, (const bf16_t*)(ws + WS_WEIN), MT, NEV, 1024}; pg8::StaticOrder S; S.init(MT, NEV, G, c); pg8::EpiPlain E{BIG, NEV};
            pg8::gemm_phase<pg8::EpiPlain, pg8::StaticOrder, true, true>(lds, g, S, E); } }
        else if (kind == K_QKV) { if (EN_GEMM & 8) { pg8::Gemm g{A0, (const bf16_t*)(ws + WS_WQKV), MT, NQKV, 1024}; pg8::StaticOrder S; S.init(MT, NQKV, G, c); pg8::EpiQKV E{BIG, (const float*)(ws + WS_ROPE)};
            pg8::gemm_phase<pg8::EpiQKV, pg8::StaticOrder, true, true>(lds, g, S, E); } }
        else if (kind == K_MIX0) { if (EN_MLSTM) mlstm_phase(lds, BIG, gates, KA(mlstm_conv), Hdir); if (EN_SGU) sgu_phase(lds, BIG, KA(sgu_norm), KA(sgu_ws), KA(sgu_b), A1); }
        else if (kind == K_COMB) { if (EN_COMB) combine_phase(Hdir, BIG, KA(mlstm_norm), A1); }
        else if (kind == K_ATTN) { if (EN_ATTN) attn_phase(lds, BIG, KA(attn_sink), A1); }
        else { if (EN_FINAL) final_phase(Hx, KA(final_norm)); }
        if (ph + 1 < hi) {
            __syncthreads();
            if (threadIdx.x < 64) { __builtin_amdgcn_fence(__ATOMIC_RELEASE, "agent"); asm volatile("s_waitcnt vmcnt(0)" ::: "memory"); }
            grid.sync();
            if (threadIdx.x < 64) { __builtin_amdgcn_fence(__ATOMIC_ACQUIRE, "agent"); asm volatile("s_waitcnt vmcnt(0)" ::: "memory"); }
            __syncthreads();
        }
    }
}

extern "C" void kernel_launch(void* const* d_in, const int* in_sizes, int n_in, void* d_out, int out_size, void* d_ws, size_t ws_size, hipStream_t stream) {
    static int grid = 0;
    if (grid == 0) {
        if (n_in != 20 || out_size != MX * D || ws_size < WS_END) { fprintf(stderr, "kernel_launch: unexpected problem (n_in %d out %d ws %zu need %zu)\n", n_in, out_size, ws_size, (size_t)WS_END); grid = -1; return; }
        int dev = 0, cus = 0, per_cu = 0;
        hipGetDevice(&dev);
        hipDeviceGetAttribute(&cus, hipDeviceAttributeMultiprocessorCount, dev);
        hipFuncSetAttribute((const void*)fwd_kernel, hipFuncAttributeMaxDynamicSharedMemorySize, LDS_BYTES);
        hipOccupancyMaxActiveBlocksPerMultiprocessor(&per_cu, (const void*)fwd_kernel, NTHREADS, LDS_BYTES);
        if (per_cu < 1) { fprintf(stderr, "kernel_launch: occupancy query says %d blocks per CU\n", per_cu); grid = -1; return; }
        grid = cus;
    }
    if (grid < 0) return;
    Args a{};
#ifdef DBG_MEMSET
    hipMemsetAsync(d_ws, 0, WS_END, stream); hipMemsetAsync(d_out, 0, (size_t)out_size * 4, stream);
#endif
    a.x = (const float*)d_in[0]; a.c = (const float*)d_in[1]; a.ctx = (const float*)d_in[2]; a.c_ctx = (const float*)d_in[3]; a.ada_w = (const float*)d_in[4]; a.ada_b = (const float*)d_in[5];
    a.ffn_w_in = (const float*)d_in[6]; a.ffn_w_out = (const float*)d_in[7]; a.even_w_in = (const float*)d_in[8]; a.even_w_out = (const float*)d_in[9];
    a.mlstm_conv = (const float*)d_in[10]; a.mlstm_gate_b = (const float*)d_in[11]; a.mlstm_norm = (const float*)d_in[12]; a.sgu_norm = (const float*)d_in[13]; a.sgu_ws = (const float*)d_in[14]; a.sgu_b = (const float*)d_in[15];
    a.odd_w_qkv = (const float*)d_in[16]; a.odd_w_out = (const float*)d_in[17]; a.attn_sink = (const float*)d_in[18]; a.final_norm = (const float*)d_in[19];
    a.out = (float*)d_out; a.ws = (unsigned char*)d_ws;
#if MK_SINGLE
    a.ph_lo = 0; a.ph_hi = NPHASES;
    { void* args[] = {&a}; hipError_t e = hipLaunchCooperativeKernel((const void*)fwd_kernel, dim3(grid), dim3(NTHREADS), args, LDS_BYTES, stream);
      if (e != hipSuccess) fprintf(stderr, "cooperative launch failed: %s\n", hipGetErrorString(e)); }
#else
    for (int p = 0; p < NPHASES; ++p) { a.ph_lo = p; a.ph_hi = p + 1; void* args[] = {&a};
        hipError_t e = hipLaunchCooperativeKernel((const void*)fwd_kernel, dim3(grid), dim3(NTHREADS), args, LDS_BYTES, stream);
        if (e != hipSuccess) { fprintf(stderr, "launch %d failed: %s\n", p, hipGetErrorString(e)); break; } }
#endif
}
```

```cpp
#include <hip/hip_runtime.h>
#include <hip/hip_cooperative_groups.h>
#include <cstdio>
#include <cstdint>
namespace cg = cooperative_groups;
namespace pg8 {
#define PG8_LAS __attribute__((address_space(3)))
typedef unsigned short bf16_t;
typedef short bf16x8 __attribute__((ext_vector_type(8)));
typedef float f32x4 __attribute__((ext_vector_type(4)));
typedef unsigned u32x4 __attribute__((ext_vector_type(4)));
constexpr int BM = 256, BK = 64, HALF = 128, HTB = HALF * BK * 2  , STAGE_BYTES = 8 * HTB, NXCD = 8, WGM = 8;

__host__ __device__ __forceinline__ int lds_byte(int r, int c) { const int st = (r >> 4) * 2 + (c >> 5), rr = r & 15, cc = c & 31, ob = rr * 64 + cc * 2; return st * 1024 + (ob ^ (((ob >> 9) & 1) << 5)); }
__host__ __device__ __forceinline__ void stage_rc(int b, int& R, int& C) { const int st = b / 1024, sb = b % 1024, swz = sb ^ (((sb >> 9) & 1) << 5); R = (st >> 1) * 16 + swz / 64; C = (st & 1) * 32 + (swz % 64) / 2; }
__host__ __device__ __forceinline__ int perm32(int rho) { const int n = rho >> 4, i = rho & 15; return 8 * (i >> 2) + 4 * n + (i & 3); }

struct Unit { int pm, pn; };
struct Gemm { const bf16_t* A; const bf16_t* Bt; int M, N, K; };

struct StaticOrder {
    int nM, nN, nwg, G, c;
    __host__ __device__ void init(int M, int N, int G_, int c_) { nM = M / BM; nN = N / BM; nwg = nM * nN; G = G_; c = c_; }
    __host__ __device__ bool next(int i, Unit& u) const {
        const long L = (long)i * G + c; if (L >= nwg) return false;
        int wgid = (int)L; { const int q = nwg / NXCD, r = nwg % NXCD, xcd = wgid % NXCD, off = wgid / NXCD; wgid = (xcd < r ? xcd * (q + 1) : r * (q + 1) + (xcd - r) * q) + off; }
        const int nig = WGM * nN, gid = wgid / nig, fm = gid * WGM, gsz = (nM - fm) < WGM ? (nM - fm) : WGM;
        u.pm = fm + ((wgid % nig) % gsz); u.pn = (wgid % nig) / gsz; return true;
    }
    __device__ __forceinline__ void a_ready(const Unit&) const {}
    __device__ __forceinline__ void done(const Unit&) const {}
};

__device__ __forceinline__ unsigned cvt_pk_bf16(float lo, float hi) { unsigned r; asm volatile("v_cvt_pk_bf16_f32 %0, %1, %2" : "=v"(r) : "v"(lo), "v"(hi)); return r; }
typedef float f32x2 __attribute__((ext_vector_type(2)));
template <class Epi, class Sched, bool ALIGN_EPI = false, bool SP2 = false>
__device__ __forceinline__ void gemm_phase(PG8_LAS unsigned char* lds, const Gemm g, const Sched& S, const Epi& E) {
    int tid_ = threadIdx.x; asm volatile("" : "+v"(tid_)); const int tid = tid_, wid = __builtin_amdgcn_readfirstlane(tid >> 6), lane = tid & 63, wr = wid >> 2, wc = wid & 3, fr = lane & 15, fq = lane >> 4;
    const int K = g.K, nt = K / BK;
    unsigned voffA[2], voffB[2];
#pragma unroll
    for (int i = 0; i < 2; ++i) { int R, C; stage_rc(tid * 16 + i * 8192, R, C); const int Rb = Epi::PERM ? ((R & ~31) + perm32(R & 31)) : R;
        voffA[i] = (unsigned)(R * K + C) * 2u; voffB[i] = (unsigned)(Rb * K + C) * 2u; }
    const size_t kstep = (size_t)(BK * 2);
    const size_t hstep = (size_t)HALF * K * 2;
    const size_t tstep = 2 * hstep;
    const unsigned ldsw = (unsigned)wid * 1024u;
    const int aoff = lds_byte(wr * 64 + fr, fq * 8), boff = lds_byte(wc * 32 + fr, fq * 8);
#define PG8_SA(b, h) (((b) * 2 + (h)) * HTB)
#define PG8_SB(b, h) ((4 + (b) * 2 + (h)) * HTB)
#define PG8_STAGE(bufoff, gbase, voff) do { _Pragma("unroll") for (int _i = 0; _i < 2; ++_i) \
        __builtin_amdgcn_global_load_lds((const unsigned*)((const char*)(gbase) + (voff)[_i]), (PG8_LAS unsigned*)(lds + (bufoff) + ldsw + _i * 8192), 16, 0, 0); } while (0)
#define PG8_LDA(dst, b, h) do { _Pragma("unroll") for (int m = 0; m < 4; ++m) _Pragma("unroll") for (int k = 0; k < 2; ++k) dst[m][k] = *(const PG8_LAS bf16x8*)(lds + PG8_SA(b, h) + aoff + m * 2048 + k * 1024); } while (0)
#define PG8_LDB(dst, b, h) do { _Pragma("unroll") for (int n = 0; n < 2; ++n) _Pragma("unroll") for (int k = 0; k < 2; ++k) dst[n][k] = *(const PG8_LAS bf16x8*)(lds + PG8_SB(b, h) + boff + n * 2048 + k * 1024); } while (0)
#define PG8_MMA(ai, bj, At, Bt) do { __builtin_amdgcn_s_setprio(1); _Pragma("unroll") for (int m = 0; m < 4; ++m) _Pragma("unroll") for (int n = 0; n < 2; ++n) _Pragma("unroll") for (int k = 0; k < 2; ++k) \
        acc[ai][bj][m][n] = __builtin_amdgcn_mfma_f32_16x16x32_bf16(Bt[n][k], At[m][k], acc[ai][bj][m][n], 0, 0, 0); __builtin_amdgcn_s_setprio(0); } while (0)
#define PG8_WAIT_V(n) asm volatile("s_waitcnt vmcnt(" #n ")" ::: "memory")
#define PG8_WAIT_L(n) asm volatile("s_waitcnt lgkmcnt(" #n ")" ::: "memory")
#define PG8_BAR __builtin_amdgcn_s_barrier()
#define PG8_SCHED __builtin_amdgcn_sched_barrier(0)
    Unit cur, nxt; int ui = 0;
    if (!S.next(0, cur)) return;
    f32x4 acc[2][2][4][2];
#pragma unroll
    for (int a = 0; a < 2; ++a)
#pragma unroll
        for (int b = 0; b < 2; ++b)
#pragma unroll
            for (int m = 0; m < 4; ++m)
#pragma unroll
                for (int n = 0; n < 2; ++n) acc[a][b][m][n] = (f32x4){0.f, 0.f, 0.f, 0.f};
    bf16x8 At[4][2], B0[2][2], B1[2][2];
    const char* cA = (const char*)g.A + (size_t)cur.pm * tstep; const char* cB = (const char*)g.Bt + (size_t)cur.pn * tstep;
    S.a_ready(cur);
    if constexpr (SP2) {
        PG8_STAGE(PG8_SB(0, 0), cB, voffB); PG8_STAGE(PG8_SB(0, 1), cB + hstep, voffB); PG8_STAGE(PG8_SA(0, 0), cA, voffA); PG8_STAGE(PG8_SA(0, 1), cA + hstep, voffA);
        if (wr == 1) PG8_BAR;
        PG8_WAIT_V(2); PG8_BAR;
        PG8_STAGE(PG8_SB(1, 0), cB + kstep, voffB); PG8_STAGE(PG8_SA(1, 0), cA + kstep, voffA); PG8_STAGE(PG8_SB(1, 1), cB + hstep + kstep, voffB);
        PG8_WAIT_V(6); PG8_BAR;
    } else {
        PG8_STAGE(PG8_SB(0, 0), cB, voffB); PG8_STAGE(PG8_SA(0, 0), cA, voffA); PG8_STAGE(PG8_SB(0, 1), cB + hstep, voffB); PG8_STAGE(PG8_SA(0, 1), cA + hstep, voffA);
        if (wr == 1) PG8_BAR;
        PG8_WAIT_V(4); PG8_BAR;
        PG8_STAGE(PG8_SB(1, 0), cB + kstep, voffB); PG8_STAGE(PG8_SA(1, 0), cA + kstep, voffA); PG8_STAGE(PG8_SB(1, 1), cB + hstep + kstep, voffB);
        PG8_WAIT_V(6); PG8_BAR;
    }
    for (;;) {
        const bool has_next = S.next(ui + 1, nxt);
        const char* nA = has_next ? (const char*)g.A + (size_t)nxt.pm * tstep : cA; const char* nB = has_next ? (const char*)g.Bt + (size_t)nxt.pn * tstep : cB;
        for (int t = 0; t < nt; t += 2) {
            const bool last = (t == nt - 2);
            const char* a1 = cA + (size_t)(t + 1) * kstep;
            const char* a2 = last ? nA : cA + (size_t)(t + 2) * kstep; const char* b2 = last ? nB : cB + (size_t)(t + 2) * kstep;
            const char* a3 = a2 + kstep; const char* b3 = b2 + kstep;
            if (last && has_next) S.a_ready(nxt);
            if constexpr (SP2) {
            PG8_LDB(B0, 0, 0); PG8_LDB(B1, 0, 1); PG8_SCHED; PG8_LDA(At, 0, 0); PG8_STAGE(PG8_SA(1, 1), a1 + hstep, voffA);
            PG8_WAIT_V(8); PG8_WAIT_L(0); PG8_BAR; PG8_MMA(0, 0, At, B0); PG8_MMA(0, 1, At, B1); PG8_BAR; PG8_SCHED;
            PG8_LDA(At, 0, 1); PG8_STAGE(PG8_SB(0, 0), b2, voffB); PG8_STAGE(PG8_SB(0, 1), b2 + hstep, voffB); PG8_STAGE(PG8_SA(0, 0), a2, voffA);
            PG8_WAIT_V(8); PG8_WAIT_L(0); PG8_BAR; PG8_MMA(1, 0, At, B0); PG8_MMA(1, 1, At, B1); PG8_BAR; PG8_SCHED;
            PG8_LDB(B0, 1, 0); PG8_LDB(B1, 1, 1); PG8_SCHED; PG8_LDA(At, 1, 0); PG8_STAGE(PG8_SA(0, 1), a2 + hstep, voffA);
            PG8_WAIT_V(8); PG8_WAIT_L(0); PG8_BAR; PG8_MMA(0, 0, At, B0); PG8_MMA(0, 1, At, B1); PG8_BAR; PG8_SCHED;
            PG8_LDA(At, 1, 1); PG8_STAGE(PG8_SB(1, 0), b3, voffB); PG8_STAGE(PG8_SB(1, 1), b3 + hstep, voffB); PG8_STAGE(PG8_SA(1, 0), a3, voffA);
            PG8_WAIT_V(8); PG8_WAIT_L(0); PG8_BAR; PG8_MMA(1, 0, At, B0); PG8_MMA(1, 1, At, B1); PG8_BAR; PG8_SCHED;
            } else {
            PG8_LDB(B0, 0, 0); PG8_SCHED; PG8_LDA(At, 0, 0); PG8_STAGE(PG8_SA(1, 1), a1 + hstep, voffA);
            PG8_WAIT_L(8); PG8_BAR; PG8_WAIT_L(0); PG8_MMA(0, 0, At, B0); PG8_BAR; PG8_SCHED;
            PG8_LDB(B1, 0, 1); PG8_STAGE(PG8_SB(0, 0), b2, voffB);
            PG8_BAR; PG8_WAIT_L(0); PG8_MMA(0, 1, At, B1); PG8_BAR;
            PG8_LDA(At, 0, 1); PG8_STAGE(PG8_SA(0, 0), a2, voffA);
            PG8_BAR; PG8_WAIT_L(0); PG8_MMA(1, 0, At, B0); PG8_BAR; PG8_SCHED;
            PG8_STAGE(PG8_SB(0, 1), b2 + hstep, voffB);
            PG8_WAIT_V(6); PG8_BAR; PG8_MMA(1, 1, At, B1); PG8_BAR;
            PG8_LDB(B0, 1, 0); PG8_SCHED; PG8_LDA(At, 1, 0); PG8_STAGE(PG8_SA(0, 1), a2 + hstep, voffA);
            PG8_WAIT_L(8); PG8_BAR; PG8_WAIT_L(0); PG8_MMA(0, 0, At, B0); PG8_BAR; PG8_SCHED;
            PG8_LDB(B1, 1, 1); PG8_STAGE(PG8_SB(1, 0), b3, voffB);
            PG8_BAR; PG8_WAIT_L(0); PG8_MMA(0, 1, At, B1); PG8_BAR;
            PG8_LDA(At, 1, 1); PG8_STAGE(PG8_SA(1, 0), a3, voffA);
            PG8_BAR; PG8_WAIT_L(0); PG8_MMA(1, 0, At, B0); PG8_BAR; PG8_SCHED;
            PG8_STAGE(PG8_SB(1, 1), b3 + hstep, voffB);
            PG8_WAIT_V(6); PG8_BAR; PG8_MMA(1, 1, At, B1); PG8_BAR;
            }
        }
        if constexpr (ALIGN_EPI) { if (wr == 0) PG8_BAR; }
        if constexpr (!Epi::AFTER_DRAIN) { E(acc, cur, wr, wc, fr, fq); S.done(cur); }
        if (!has_next) break;
#pragma unroll
        for (int a = 0; a < 2; ++a)
#pragma unroll
            for (int b = 0; b < 2; ++b)
#pragma unroll
                for (int m = 0; m < 4; ++m)
#pragma unroll
                    for (int n = 0; n < 2; ++n) acc[a][b][m][n] = (f32x4){0.f, 0.f, 0.f, 0.f};
        cur = nxt; cA = nA; cB = nB; ++ui;
        if constexpr (ALIGN_EPI) { if (wr == 1) PG8_BAR; }
    }
    PG8_WAIT_V(0);
    if constexpr (!ALIGN_EPI) { if (wr == 0) PG8_BAR; }
    PG8_BAR;
    if constexpr (Epi::AFTER_DRAIN) { E.fused(acc, cur, wr, wc, fr, fq, lds, wid, lane); S.done(cur); }
#undef PG8_SA
#undef PG8_SB
#undef PG8_STAGE
#undef PG8_LDA
#undef PG8_LDB
#undef PG8_MMA
#undef PG8_WAIT_V
#undef PG8_WAIT_L
#undef PG8_BAR
#undef PG8_SCHED
}
}
#define LAS __attribute__((address_space(3)))
typedef unsigned short bf16_t;
typedef short bf16x8 __attribute__((ext_vector_type(8)));
typedef float f32x4 __attribute__((ext_vector_type(4)));
typedef float f32x2 __attribute__((ext_vector_type(2)));
typedef unsigned u32x4 __attribute__((ext_vector_type(4)));
typedef unsigned u32x2 __attribute__((ext_vector_type(2)));

constexpr int D = 1024, NB = 8, SEQ = 2048, CTXL = 256, DFF = 2816;
constexpr int MX = NB * SEQ;
constexpr int MC = NB * CTXL;
constexpr int MT = MX + MC;
constexpr int NMOD = 9;
constexpr int NEV = 3072;
constexpr int NQKV = 1536;
constexpr float EPS = 1e-6f;
constexpr int LDS_BYTES = 147456;
constexpr int NTHREADS = 512;

constexpr size_t MiB = 1u << 20;
constexpr size_t SZ_WIN = (size_t)5632 * 1024 * 2, SZ_WOUT = (size_t)1024 * 2816 * 2;
constexpr size_t WS_WIN = 0;
constexpr size_t WS_WOUT = WS_WIN + 4 * SZ_WIN;
constexpr size_t WS_WEIN = WS_WOUT + 4 * SZ_WOUT;
constexpr size_t WS_WEOUT = WS_WEIN + (size_t)3072 * 1024 * 2;
constexpr size_t WS_WQKV = WS_WEOUT + (size_t)1024 * 1024 * 2;
constexpr size_t WS_WOOUT = WS_WQKV + (size_t)1536 * 1024 * 2;
constexpr size_t WS_MOD = WS_WOOUT + (size_t)1024 * 1024 * 2;
constexpr size_t WS_WG = WS_MOD + (size_t)2 * 9 * 9216 * 4;
constexpr size_t WS_ROPE = WS_WG + (size_t)16 * 1024 * 4;
constexpr size_t WS_GATES = WS_ROPE + 8192;
constexpr size_t WS_HC = WS_GATES + (size_t)MT * 16 * 4;
constexpr size_t WS_A0 = ((WS_HC + (size_t)MC * D * 4 + 255) / 256) * 256;
constexpr size_t WS_A1 = WS_A0 + (size_t)2 * MT * 512 * 4;
constexpr size_t WS_BIG = WS_A1 + (size_t)MT * D * 2;
constexpr size_t WS_CTL = WS_BIG + (size_t)MT * 3072 * 2;
constexpr size_t CTL_BYTES = 16384;
constexpr size_t WS_END = WS_CTL + CTL_BYTES;

struct Args {
    const float* x; const float* c; const float* ctx; const float* c_ctx; const float* ada_w; const float* ada_b;
    const float* ffn_w_in; const float* ffn_w_out; const float* even_w_in; const float* even_w_out;
    const float* mlstm_conv; const float* mlstm_gate_b; const float* mlstm_norm; const float* sgu_norm; const float* sgu_ws; const float* sgu_b;
    const float* odd_w_qkv; const float* odd_w_out; const float* attn_sink; const float* final_norm;
    float* out; unsigned char* ws; int ph_lo, ph_hi;
};

typedef const __attribute__((address_space(4))) Args* kargp;
__device__ __forceinline__ kargp kargs() { kargp p = (kargp)__builtin_amdgcn_kernarg_segment_ptr(); asm volatile("" : "+s"(p)); return p; }
#define KA(f) (kargs()->f)
typedef __bf16 bf16x2_t __attribute__((ext_vector_type(2)));
__device__ __forceinline__ unsigned pk2(float lo, float hi) { f32x2 v = {lo, hi}; bf16x2_t b = __builtin_convertvector(v, bf16x2_t); return __builtin_bit_cast(unsigned, b); }
__device__ __forceinline__ bf16_t f2bf(float f) { return (bf16_t)(pk2(f, 0.f) & 0xffffu); }
__device__ __forceinline__ float bf2f(bf16_t v) { return __uint_as_float(((unsigned)v) << 16); }
__device__ __forceinline__ float bflo(unsigned w) { return __uint_as_float(w << 16); }
__device__ __forceinline__ float bfhi(unsigned w) { return __uint_as_float(w & 0xffff0000u); }
__device__ __forceinline__ float silu_f(float v) { return v * __builtin_amdgcn_rcpf(1.f + __expf(-v)); }
__device__ __forceinline__ float sigmoid_f(float v) { return __builtin_amdgcn_rcpf(1.f + __expf(-v)); }
__device__ __forceinline__ float gelu_tanh(float v) {
    const float z = 0.7978845608028654f * (v + 0.044715f * v * v * v);
    const float t = 1.f - 2.f * __builtin_amdgcn_rcpf(1.f + __expf(2.f * z));
    return 0.5f * v * (1.f + t);
}
__device__ __forceinline__ float wave_sum(float v) {
#pragma unroll
    for (int o = 1; o < 64; o <<= 1) v += __shfl_xor(v, o);
    return v;
}
__device__ __forceinline__ float wave_max(float v) {
#pragma unroll
    for (int o = 1; o < 64; o <<= 1) v = fmaxf(v, __shfl_xor(v, o));
    return v;
}
__device__ __forceinline__ f32x4 mfma16(bf16x8 a, bf16x8 b, f32x4 c) { return __builtin_amdgcn_mfma_f32_16x16x32_bf16(a, b, c, 0, 0, 0); }
__device__ __forceinline__ bf16x8 ldsfrag(const LAS unsigned char* p) { return *(const LAS bf16x8*)p; }

namespace pg8 {
struct EpiSwiglu {
    static constexpr bool PERM = true, AFTER_DRAIN = false;
    bf16_t* O;
    __device__ __forceinline__ void operator()(const f32x4 (&acc)[2][2][4][2], const Unit& u, int wr, int wc, int fr, int fq) const {
        const int row0 = u.pm * BM + wr * 64 + fr, col0 = u.pn * 128 + wc * 32 + 8 * fq;
#pragma unroll
        for (int ai = 0; ai < 2; ++ai)
#pragma unroll
            for (int m = 0; m < 4; ++m) {
                bf16_t* rowp = O + (size_t)(row0 + ai * HALF + m * 16) * DFF + col0;
                const f32x4 g0 = acc[ai][0][m][0], g1 = acc[ai][0][m][1], u0 = acc[ai][1][m][0], u1 = acc[ai][1][m][1];
                u32x4 w;
                w.x = ::pk2(::silu_f(g0[0]) * u0[0], ::silu_f(g0[1]) * u0[1]); w.y = ::pk2(::silu_f(g0[2]) * u0[2], ::silu_f(g0[3]) * u0[3]);
                w.z = ::pk2(::silu_f(g1[0]) * u1[0], ::silu_f(g1[1]) * u1[1]); w.w = ::pk2(::silu_f(g1[2]) * u1[2], ::silu_f(g1[3]) * u1[3]);
                *(u32x4*)rowp = w;
            }
    }
};
struct EpiResid {
    static constexpr bool PERM = false, AFTER_DRAIN = false;
    const float* bx; const float* bc; float* ox; float* oc; const float* gate;
    float coef;
    __device__ __forceinline__ void operator()(const f32x4 (&acc)[2][2][4][2], const Unit& u, int wr, int wc, int fr, int fq) const {
        const bool isx = u.pm < 64;
        const int bi = isx ? (u.pm >> 3) : 8;
        const float* base = isx ? bx : bc - (size_t)MX * D;
        float* outp = isx ? ox : oc - (size_t)MX * D;
        const int row0 = u.pm * BM + wr * 64 + fr, col0 = u.pn * BM + wc * 32 + 4 * fq;
        const float* gp = gate + (size_t)bi * 9216 + col0;
#pragma unroll
        for (int bj = 0; bj < 2; ++bj)
#pragma unroll
            for (int n = 0; n < 2; ++n) {
                const f32x4 gv = *(const f32x4*)(gp + bj * HALF + n * 16) * coef;
#pragma unroll
                for (int ai = 0; ai < 2; ++ai)
#pragma unroll
                    for (int m = 0; m < 4; ++m) {
                        const size_t off = (size_t)(row0 + ai * HALF + m * 16) * D + col0 + bj * HALF + n * 16;
                        const f32x4 b = *(const f32x4*)(base + off);
                        *(f32x4*)(outp + off) = b + gv * acc[ai][bj][m][n];
                        if (m & 1) asm volatile("" ::: "memory");
                    }
            }
    }
};
struct EpiPlain {
    static constexpr bool PERM = true, AFTER_DRAIN = false;
    bf16_t* O; int ldc;
    __device__ __forceinline__ void operator()(const f32x4 (&acc)[2][2][4][2], const Unit& u, int wr, int wc, int fr, int fq) const {
        const int row0 = u.pm * BM + wr * 64 + fr, col0 = u.pn * BM + wc * 32 + 8 * fq;
#pragma unroll
        for (int ai = 0; ai < 2; ++ai)
#pragma unroll
            for (int m = 0; m < 4; ++m) {
                bf16_t* rowp = O + (size_t)(row0 + ai * HALF + m * 16) * ldc + col0;
#pragma unroll
                for (int bj = 0; bj < 2; ++bj) {
                    const f32x4 v0 = acc[ai][bj][m][0], v1 = acc[ai][bj][m][1];
                    u32x4 w; w.x = ::pk2(v0[0], v0[1]); w.y = ::pk2(v0[2], v0[3]); w.z = ::pk2(v1[0], v1[1]); w.w = ::pk2(v1[2], v1[3]);
                    *(u32x4*)(rowp + bj * HALF) = w;
                }
            }
    }
};
struct EpiQKV {
    static constexpr bool PERM = true, AFTER_DRAIN = false;
    bf16_t* O; const float* rope;
    __device__ __forceinline__ void operator()(const f32x4 (&acc)[2][2][4][2], const Unit& u, int wr, int wc, int fr, int fq) const {
        const int row0 = u.pm * BM + wr * 64 + fr;
        const bool isx = u.pm < 64;
#pragma unroll
        for (int bj = 0; bj < 2; ++bj) {
            const int col0 = u.pn * BM + bj * HALF + wc * 32 + 8 * fq;
            const bool dorope = isx && (col0 < 1280);
            const float qs = (col0 < 1024) ? 0.125f : 1.f;
            const int p0 = (col0 & 63) >> 1;
            const int f0 = p0 & 15;
#pragma unroll
            for (int ai = 0; ai < 2; ++ai)
#pragma unroll
                for (int m = 0; m < 4; ++m) {
                    const int row = row0 + ai * HALF + m * 16;
                    f32x4 v0 = acc[ai][bj][m][0] * qs, v1 = acc[ai][bj][m][1] * qs;
                    if (dorope) {
                        const int t = row & 2047;
                        const int pos = (p0 < 16) ? (t >> 6) : (t & 63);
                        const f32x4 cs0 = *(const f32x4*)(rope + (pos * 16 + f0) * 2), cs1 = *(const f32x4*)(rope + (pos * 16 + f0) * 2 + 4);
                        f32x4 r0, r1;
                        r0[0] = v0[0] * cs0[0] - v0[1] * cs0[1]; r0[1] = v0[0] * cs0[1] + v0[1] * cs0[0];
                        r0[2] = v0[2] * cs0[2] - v0[3] * cs0[3]; r0[3] = v0[2] * cs0[3] + v0[3] * cs0[2];
                        r1[0] = v1[0] * cs1[0] - v1[1] * cs1[1]; r1[1] = v1[0] * cs1[1] + v1[1] * cs1[0];
                        r1[2] = v1[2] * cs1[2] - v1[3] * cs1[3]; r1[3] = v1[2] * cs1[3] + v1[3] * cs1[2];
                        v0 = r0; v1 = r1;
                    }
                    u32x4 w; w.x = ::pk2(v0[0], v0[1]); w.y = ::pk2(v0[2], v0[3]); w.z = ::pk2(v1[0], v1[1]); w.w = ::pk2(v1[2], v1[3]);
                    *(u32x4*)(O + (size_t)row * NQKV + col0) = w;
                }
        }
    }
};
}

__device__ __forceinline__ void tr_item(const float* W, int ldw, int k0, int srccol0, bf16_t* WT, int K, int destrow0, LAS float* scr, int lane) {
#pragma unroll 8
    for (int i = 0; i < 32; ++i) { const int kk = 2 * i + (lane >> 5); scr[kk * 33 + (lane & 31)] = W[(size_t)(k0 + kk) * ldw + srccol0 + (lane & 31)]; }
    asm volatile("s_waitcnt lgkmcnt(0)" ::: "memory");
    const int c = lane & 7;
#pragma unroll
    for (int j = 0; j < 4; ++j) { const int n = (lane >> 3) + 8 * j; const LAS float* s = scr + (8 * c) * 33 + n;
        u32x4 o; o.x = pk2(s[0 * 33], s[1 * 33]); o.y = pk2(s[2 * 33], s[3 * 33]); o.z = pk2(s[4 * 33], s[5 * 33]); o.w = pk2(s[6 * 33], s[7 * 33]);
        *(u32x4*)(WT + (size_t)(destrow0 + n) * K + k0 + 8 * c) = o; }
    asm volatile("s_waitcnt lgkmcnt(0)" ::: "memory");
}

__device__ __forceinline__ void p0_phase(LAS unsigned char* lds) {
    int tid_ = threadIdx.x; asm volatile("" : "+v"(tid_)); const int tid = tid_, lane = tid & 63, wid = __builtin_amdgcn_readfirstlane(tid >> 6), G = gridDim.x;
    unsigned char* ws = KA(ws);
    {
        LAS float* s = (LAS float*)lds;
        LAS float* red = (LAS float*)(lds + 36864);
        for (int i = tid; i < 9 * 1024; i += NTHREADS) { const float v = (i < 8192) ? KA(c)[i] : KA(c_ctx)[i - 8192]; s[i] = v / (1.f + expf(-v)); }
        __syncthreads();
        float* mod = (float*)(ws + WS_MOD);
        for (int tile = blockIdx.x; tile < 288; tile += G) {
            const int l = tile / 144, cg = tile % 144, n = cg * 64 + lane, kg = wid;
            float acc[9];
#pragma unroll
            for (int bi = 0; bi < 9; ++bi) acc[bi] = 0.f;
            const float* wp = KA(ada_w) + ((size_t)l * 1024 + kg * 128) * 9216 + n;
#pragma unroll 4
            for (int kk = 0; kk < 128; ++kk) {
                const float w = wp[(size_t)kk * 9216];
#pragma unroll
                for (int bi = 0; bi < 9; ++bi) acc[bi] += s[bi * 1024 + kg * 128 + kk] * w;
            }
#pragma unroll
            for (int bi = 0; bi < 9; ++bi) red[(kg * 9 + bi) * 64 + lane] = acc[bi];
            __syncthreads();
            for (int i = tid; i < 576; i += NTHREADS) {
                const int bi = i >> 6, cc = i & 63; float sum = 0.f;
#pragma unroll
                for (int k2 = 0; k2 < 8; ++k2) sum += red[(k2 * 9 + bi) * 64 + cc];
                mod[((size_t)l * 9 + bi) * 9216 + cg * 64 + cc] = sum + KA(ada_b)[l * 9216 + cg * 64 + cc];
            }
            __syncthreads();
        }
    }
    {
        const int gt = blockIdx.x * NTHREADS + tid, GT = G * NTHREADS;
        float* wg = (float*)(ws + WS_WG);
        for (int i = gt; i < 16 * 1024; i += GT) { const int g = i >> 10, k = i & 1023; wg[i] = KA(even_w_in)[(size_t)k * 3088 + 2048 + g]; }
        float* rope = (float*)(ws + WS_ROPE);
        for (int i = gt; i < 64 * 16; i += GT) { const int pos = i >> 4, f = i & 15; const float inv = powf(10000.f, -(float)f / 16.f); const float ang = (float)pos * inv; rope[2 * i] = cosf(ang); rope[2 * i + 1] = sinf(ang); }
    }
    {
        LAS float* scr = (LAS float*)(lds + wid * 16384);
        const int gw = blockIdx.x * 8 + wid, NGW = G * 8;
        constexpr int I_IN = 16 * 176, I_OUT = 44 * 32, I_EIN = 16 * 96, I_SQ = 16 * 32, I_QKV = 16 * 48;
        constexpr int NITEMS = 4 * I_IN + 4 * I_OUT + I_EIN + I_SQ + I_QKV + I_SQ;
        for (int it = gw; it < NITEMS; it += NGW) {
            int r = it;
            if (r < 4 * I_IN) { const int mi = r / I_IN; r -= mi * I_IN; const int kb = r / 176, nb = r % 176; const int n0 = nb * 32;
                const int dest = (n0 < 2816) ? ((n0 >> 7) * 256 + (n0 & 127)) : ((((n0 - 2816) >> 7) * 256) + 128 + ((n0 - 2816) & 127));
                tr_item(KA(ffn_w_in) + (size_t)mi * 1024 * 5632, 5632, kb * 64, n0, (bf16_t*)(ws + WS_WIN + mi * SZ_WIN), 1024, dest, scr, lane); continue; }
            r -= 4 * I_IN;
            if (r < 4 * I_OUT) { const int mi = r / I_OUT; r -= mi * I_OUT; const int kb = r / 32, nb = r % 32;
                tr_item(KA(ffn_w_out) + (size_t)mi * 2816 * 1024, 1024, kb * 64, nb * 32, (bf16_t*)(ws + WS_WOUT + mi * SZ_WOUT), 2816, nb * 32, scr, lane); continue; }
            r -= 4 * I_OUT;
            if (r < I_EIN) { const int kb = r / 96, nb = r % 96; const int src = nb < 64 ? nb * 32 : 2064 + (nb - 64) * 32;
                tr_item(KA(even_w_in), 3088, kb * 64, src, (bf16_t*)(ws + WS_WEIN), 1024, nb * 32, scr, lane); continue; }
            r -= I_EIN;
            if (r < I_SQ) { const int kb = r / 32, nb = r % 32; tr_item(KA(even_w_out), 1024, kb * 64, nb * 32, (bf16_t*)(ws + WS_WEOUT), 1024, nb * 32, scr, lane); continue; }
            r -= I_SQ;
            if (r < I_QKV) { const int kb = r / 48, nb = r % 48; tr_item(KA(odd_w_qkv), 1536, kb * 64, nb * 32, (bf16_t*)(ws + WS_WQKV), 1024, nb * 32, scr, lane); continue; }
            r -= I_QKV;
            { const int kb = r / 32, nb = r % 32; tr_item(KA(odd_w_out), 1024, kb * 64, nb * 32, (bf16_t*)(ws + WS_WOOUT), 1024, nb * 32, scr, lane); }
        }
    }
}

template <bool GATES>
__device__ __forceinline__ void norm_phase(LAS unsigned char* lds, const float* hx, const float* hc, bf16_t* A0, const float* modl, int shift_i, int scale_i, int nrows,
                                           const float* wg, const float* gate_b, float* gates) {
    int tid_ = threadIdx.x; asm volatile("" : "+v"(tid_)); const int tid = tid_, lane = tid & 63, wid = __builtin_amdgcn_readfirstlane(tid >> 6), G = gridDim.x;
    LAS float* wgs = (LAS float*)lds;
    if (GATES) { for (int i = tid; i < 16 * 1024 / 4; i += NTHREADS) ((LAS f32x4*)wgs)[i] = ((const f32x4*)wg)[i]; __syncthreads(); }
    for (int R = blockIdx.x * 8 + wid; R < nrows; R += G * 8) {
        const bool isx = R < MX;
        const float* src = isx ? hx + (size_t)R * D : hc + (size_t)(R - MX) * D;
        const int bi = isx ? (R >> 11) : 8;
        const float* mb = modl + (size_t)bi * 9216;
        f32x4 v[4]; float ss = 0.f;
#pragma unroll
        for (int j = 0; j < 4; ++j) { v[j] = *(const f32x4*)(src + 256 * j + 4 * lane); ss += (v[j][0] * v[j][0] + v[j][1] * v[j][1]) + (v[j][2] * v[j][2] + v[j][3] * v[j][3]); }
        const float rstd = 1.0f / sqrtf(wave_sum(ss) * (1.f / D) + EPS);
#pragma unroll
        for (int j = 0; j < 4; ++j) {
            const f32x4 sc = *(const f32x4*)(mb + scale_i * 1024 + 256 * j + 4 * lane), sh = *(const f32x4*)(mb + shift_i * 1024 + 256 * j + 4 * lane);
            v[j] = v[j] * rstd * (sc + 1.f) + sh;
            u32x2 w; w.x = pk2(v[j][0], v[j][1]); w.y = pk2(v[j][2], v[j][3]);
            *(u32x2*)(A0 + (size_t)R * D + 256 * j + 4 * lane) = w;
        }
        if (GATES) {
            float mine = 0.f;
#pragma unroll 1
            for (int g = 0; g < 16; ++g) {
                float d = 0.f;
#pragma unroll
                for (int j = 0; j < 4; ++j) { const f32x4 w = *(const LAS f32x4*)(wgs + g * 1024 + 256 * j + 4 * lane); d += (v[j][0] * w[0] + v[j][1] * w[1]) + (v[j][2] * w[2] + v[j][3] * w[3]); }
                d = wave_sum(d);
                if (lane == g) mine = d;
            }
            if (lane < 16) gates[(size_t)R * 16 + lane] = mine + gate_b[lane];
        }
    }
    if (GATES) __syncthreads();
}

__device__ __forceinline__ void mlstm_phase(LAS unsigned char* lds, const bf16_t* P, const float* gates, const float* convw, float* Hdir) {
    int tid_ = threadIdx.x; asm volatile("" : "+v"(tid_)); const int tid = tid_, lane = tid & 63, wid = __builtin_amdgcn_readfirstlane(tid >> 6), r = lane & 15, q = lane >> 4;
    constexpr int LD = 136, LDB = LD * 2;
    constexpr int OFF_Q = 0, OFF_K = 34816, OFF_KT = 69632, OFF_VT = 104448, OFF_VW = 113152, OFF_CT = 121856, OFF_SC = 130560;
    LAS bf16_t* Qs = (LAS bf16_t*)(lds + OFF_Q); LAS bf16_t* Ks = (LAS bf16_t*)(lds + OFF_K); LAS bf16_t* Kt = (LAS bf16_t*)(lds + OFF_KT);
    LAS bf16_t* Vt = (LAS bf16_t*)(lds + OFF_VT); LAS bf16_t* Vw = (LAS bf16_t*)(lds + OFF_VW); LAS bf16_t* Ct = (LAS bf16_t*)(lds + OFF_CT);
    LAS float* sc = (LAS float*)(lds + OFF_SC);
    LAS float* rowf = sc; LAS float* dmb = sc + 128; LAS float* inter = sc + 256; LAS float* wl = sc + 384; LAS float* en = sc + 512; LAS float* qn = sc + 640; LAS float* nvec = sc + 768; LAS float* misc = sc + 896; LAS float* cw = sc + 1024;
    const int seg = tid & 15;
    for (int unit = blockIdx.x; unit < 256; unit += gridDim.x) {
        const int es = unit & 3, dir = (unit >> 2) & 1, h = (unit >> 3) & 3, b = unit >> 5;
        for (int i = tid; i < 768; i += NTHREADS) { const int qk = i / 384, j = (i % 384) >> 7, ch = i & 127; cw[i] = convw[j * 1024 + qk * 512 + h * 128 + ch]; }
        for (int i = tid; i < 32 * LD / 2; i += NTHREADS) ((LAS unsigned*)Ct)[i] = 0u;
        if (tid < 128) nvec[tid] = 0.f;
        f32x4 Cacc[2]; Cacc[0] = (f32x4){0.f, 0.f, 0.f, 0.f}; Cacc[1] = Cacc[0];
        float m_state = 0.f;
        __syncthreads();
        for (int ci = 0; ci < 18; ++ci) {
            int cc, sbase, T;
            if (ci < 2) { cc = dir ? 1 - ci : ci; sbase = MX + b * CTXL; T = CTXL; } else { cc = dir ? 17 - ci : ci - 2; sbase = b * SEQ; T = SEQ; }
            if (wid == 0) {
                float ig[2], bc[2];
#pragma unroll
                for (int hf = 0; hf < 2; ++hf) { const int l = lane + 64 * hf; const int R = sbase + cc * 128 + (dir ? 127 - l : l);
                    ig[hf] = gates[(size_t)R * 16 + dir * 8 + h]; const float fg = gates[(size_t)R * 16 + dir * 8 + 4 + h];
                    bc[hf] = fminf(fg, 0.f) - log1pf(expf(-fabsf(fg))); }
#pragma unroll
                for (int off = 1; off < 64; off <<= 1) { const float t0 = __shfl_up(bc[0], off), t1 = __shfl_up(bc[1], off); if (lane >= off) { bc[0] += t0; bc[1] += t1; } }
                bc[1] += __shfl(bc[0], 63);
                const float g = __shfl(bc[1], 63);
                const float d0 = ig[0] - bc[0], d1 = ig[1] - bc[1];
                float p0 = d0, p1 = d1;
#pragma unroll
                for (int off = 1; off < 64; off <<= 1) { const float t0 = __shfl_up(p0, off), t1 = __shfl_up(p1, off); if (lane >= off) { p0 = fmaxf(p0, t0); p1 = fmaxf(p1, t1); } }
                p1 = fmaxf(p1, __shfl(p0, 63));
                const float a0 = g + d0, a1 = g + d1;
                const float mloc = wave_max(fmaxf(a0, a1));
                const float m_new = fmaxf(g + m_state, mloc);
                const float dec = expf(g + m_state - m_new);
                const float mt0 = bc[0] + fmaxf(m_state, p0), mt1 = bc[1] + fmaxf(m_state, p1);
                rowf[lane] = bc[0] - mt0; rowf[lane + 64] = bc[1] - mt1;
                dmb[lane] = d0; dmb[lane + 64] = d1;
                inter[lane] = expf(bc[0] + m_state - mt0); inter[lane + 64] = expf(bc[1] + m_state - mt1);
                wl[lane] = expf(a0 - m_new); wl[lane + 64] = expf(a1 - m_new);
                en[lane] = expf(-mt0); en[lane + 64] = expf(-mt1);
                if (lane == 0) misc[0] = dec;
                m_state = m_new;
            }
#pragma unroll 1
            for (int it = 0; it < 4; ++it) {
                const int l = (tid + NTHREADS * it) >> 4;
                const int tin = cc * 128 + (dir ? 127 - l : l);
                const bf16_t* pr = P + (size_t)(sbase + tin) * NEV + h * 128 + seg * 8;
                const u32x4 z = (u32x4){0u, 0u, 0u, 0u};
                {
                    const u32x4 c0 = *(const u32x4*)pr; const u32x4 pv = tin > 0 ? *(const u32x4*)(pr - NEV) : z; const u32x4 nx = tin < T - 1 ? *(const u32x4*)(pr + NEV) : z;
                    float y[8];
#pragma unroll
                    for (int hf = 0; hf < 2; ++hf) {
                        const f32x4 w0 = *(const LAS f32x4*)(cw + 0 * 128 + seg * 8 + 4 * hf), w1 = *(const LAS f32x4*)(cw + 1 * 128 + seg * 8 + 4 * hf), w2v = *(const LAS f32x4*)(cw + 2 * 128 + seg * 8 + 4 * hf);
                        y[4 * hf + 0] = w0[0] * bflo(pv[2 * hf]) + w1[0] * bflo(c0[2 * hf]) + w2v[0] * bflo(nx[2 * hf]);
                        y[4 * hf + 1] = w0[1] * bfhi(pv[2 * hf]) + w1[1] * bfhi(c0[2 * hf]) + w2v[1] * bfhi(nx[2 * hf]);
                        y[4 * hf + 2] = w0[2] * bflo(pv[2 * hf + 1]) + w1[2] * bflo(c0[2 * hf + 1]) + w2v[2] * bflo(nx[2 * hf + 1]);
                        y[4 * hf + 3] = w0[3] * bfhi(pv[2 * hf + 1]) + w1[3] * bfhi(c0[2 * hf + 1]) + w2v[3] * bfhi(nx[2 * hf + 1]);
                    }
                    u32x4 o;
#pragma unroll
                    for (int w2 = 0; w2 < 4; ++w2) o[w2] = pk2(silu_f(y[2 * w2]), silu_f(y[2 * w2 + 1]));
                    *(LAS u32x4*)(Qs + l * LD + seg * 8) = o;
                }
                {
                    const bf16_t* pk = pr + 512;
                    const u32x4 c0 = *(const u32x4*)pk; const u32x4 pv = tin > 0 ? *(const u32x4*)(pk - NEV) : z; const u32x4 nx = tin < T - 1 ? *(const u32x4*)(pk + NEV) : z;
                    float y[8];
#pragma unroll
                    for (int hf = 0; hf < 2; ++hf) {
                        const f32x4 w0 = *(const LAS f32x4*)(cw + 3 * 128 + seg * 8 + 4 * hf), w1 = *(const LAS f32x4*)(cw + 4 * 128 + seg * 8 + 4 * hf), w2v = *(const LAS f32x4*)(cw + 5 * 128 + seg * 8 + 4 * hf);
                        y[4 * hf + 0] = w0[0] * bflo(pv[2 * hf]) + w1[0] * bflo(c0[2 * hf]) + w2v[0] * bflo(nx[2 * hf]);
                        y[4 * hf + 1] = w0[1] * bfhi(pv[2 * hf]) + w1[1] * bfhi(c0[2 * hf]) + w2v[1] * bfhi(nx[2 * hf]);
                        y[4 * hf + 2] = w0[2] * bflo(pv[2 * hf + 1]) + w1[2] * bflo(c0[2 * hf + 1]) + w2v[2] * bflo(nx[2 * hf + 1]);
                        y[4 * hf + 3] = w0[3] * bfhi(pv[2 * hf + 1]) + w1[3] * bfhi(c0[2 * hf + 1]) + w2v[3] * bfhi(nx[2 * hf + 1]);
                    }
                    u32x4 o;
#pragma unroll
                    for (int w2 = 0; w2 < 4; ++w2) { o[w2] = pk2(silu_f(y[2 * w2]) * 0.08838834764831845f, silu_f(y[2 * w2 + 1]) * 0.08838834764831845f);
                        Kt[(seg * 8 + 2 * w2) * LD + l] = (bf16_t)(o[w2] & 0xffffu); Kt[(seg * 8 + 2 * w2 + 1) * LD + l] = (bf16_t)(o[w2] >> 16); }
                    *(LAS u32x4*)(Ks + l * LD + seg * 8) = o;
                }
            }
            __syncthreads();
            const float dec = misc[0];
            {
                const int l = tid >> 2, sg = tid & 3;
                const int tin = cc * 128 + (dir ? 127 - l : l);
                const u32x4 vv = *(const u32x4*)(P + (size_t)(sbase + tin) * NEV + 1024 + h * 128 + es * 32 + sg * 8);
                const float w = wl[l];
#pragma unroll
                for (int w2 = 0; w2 < 4; ++w2) {
                    Vt[(sg * 8 + 2 * w2) * LD + l] = (bf16_t)(vv[w2] & 0xffffu); Vt[(sg * 8 + 2 * w2 + 1) * LD + l] = (bf16_t)(vv[w2] >> 16);
                    Vw[(sg * 8 + 2 * w2) * LD + l] = f2bf(bflo(vv[w2]) * w); Vw[(sg * 8 + 2 * w2 + 1) * LD + l] = f2bf(bfhi(vv[w2]) * w);
                }
            }
            f32x4 sacc[8];
            {
                bf16x8 af[4];
#pragma unroll
                for (int ks = 0; ks < 4; ++ks) af[ks] = ldsfrag(lds + OFF_Q + (16 * wid + r) * LDB + (32 * ks + 8 * q) * 2);
#pragma unroll
                for (int jb = 0; jb < 8; ++jb) {
                    sacc[jb] = (f32x4){0.f, 0.f, 0.f, 0.f};
                    if (jb <= wid) {
#pragma unroll
                        for (int ks = 0; ks < 4; ++ks) sacc[jb] = mfma16(af[ks], ldsfrag(lds + OFF_K + (16 * jb + r) * LDB + (32 * ks + 8 * q) * 2), sacc[jb]);
                    }
                }
            }
            {
                const int t = tid >> 2, part = tid & 3; float s = 0.f;
#pragma unroll
                for (int i = 0; i < 4; ++i) {
                    const u32x4 qv = *(const LAS u32x4*)(Qs + t * LD + part * 32 + i * 8);
                    const f32x4 n0 = *(const LAS f32x4*)(nvec + part * 32 + i * 8), n1 = *(const LAS f32x4*)(nvec + part * 32 + i * 8 + 4);
                    s += bflo(qv[0]) * n0[0] + bfhi(qv[0]) * n0[1] + bflo(qv[1]) * n0[2] + bfhi(qv[1]) * n0[3] + bflo(qv[2]) * n1[0] + bfhi(qv[2]) * n1[1] + bflo(qv[3]) * n1[2] + bfhi(qv[3]) * n1[3];
                }
                s += __shfl_xor(s, 1); s += __shfl_xor(s, 2);
                if (part == 0) qn[t] = s;
            }
            __syncthreads();
            LAS bf16_t* Ss = Ks;
            float rs[4] = {0.f, 0.f, 0.f, 0.f};
            {
                const f32x4 rf = *(const LAS f32x4*)(rowf + 16 * wid + 4 * q);
#pragma unroll
                for (int jb = 0; jb < 8; ++jb) {
                    if (jb <= wid) {
                        const int s = 16 * jb + r; const float dm = dmb[s];
#pragma unroll
                        for (int reg = 0; reg < 4; ++reg) { const int t = 16 * wid + 4 * q + reg;
                            const float v = (s <= t) ? sacc[jb][reg] * __expf(rf[reg] + dm) : 0.f;
                            rs[reg] += v; Ss[t * LD + s] = f2bf(v); }
                    } else if (jb == wid + 1 && !(wid & 1)) {
#pragma unroll
                        for (int reg = 0; reg < 4; ++reg) Ss[(16 * wid + 4 * q + reg) * LD + 16 * jb + r] = 0;
                    }
                }
#pragma unroll
                for (int reg = 0; reg < 4; ++reg) { rs[reg] += __shfl_xor(rs[reg], 1); rs[reg] += __shfl_xor(rs[reg], 2); rs[reg] += __shfl_xor(rs[reg], 4); rs[reg] += __shfl_xor(rs[reg], 8); }
            }
            {
                const int nks = (wid >> 1) + 1;
                const f32x4 it4 = *(const LAS f32x4*)(inter + 16 * wid + 4 * q), qn4 = *(const LAS f32x4*)(qn + 16 * wid + 4 * q), en4 = *(const LAS f32x4*)(en + 16 * wid + 4 * q);
                bf16x8 qf[4];
#pragma unroll
                for (int ks = 0; ks < 4; ++ks) qf[ks] = ldsfrag(lds + OFF_Q + (16 * wid + r) * LDB + (32 * ks + 8 * q) * 2);
#pragma unroll
                for (int nt = 0; nt < 2; ++nt) {
                    f32x4 a1 = (f32x4){0.f, 0.f, 0.f, 0.f}, a2 = a1;
#pragma unroll
                    for (int ks = 0; ks < 4; ++ks) {
                        if (ks < nks) a1 = mfma16(ldsfrag(lds + OFF_K + (16 * wid + r) * LDB + (32 * ks + 8 * q) * 2), ldsfrag(lds + OFF_VT + (16 * nt + r) * LDB + (32 * ks + 8 * q) * 2), a1);
                        a2 = mfma16(qf[ks], ldsfrag(lds + OFF_CT + (16 * nt + r) * LDB + (32 * ks + 8 * q) * 2), a2);
                    }
#pragma unroll
                    for (int reg = 0; reg < 4; ++reg) {
                        const int t = 16 * wid + 4 * q + reg;
                        const float den = rs[reg] + it4[reg] * qn4[reg];
                        const float hv = (a1[reg] + it4[reg] * a2[reg]) / fmaxf(fabsf(den), en4[reg]);
                        const int R = sbase + cc * 128 + (dir ? 127 - t : t);
                        Hdir[((size_t)dir * MT + R) * 512 + h * 128 + es * 32 + 16 * nt + r] = hv;
                    }
                }
            }
            {
                bf16x8 kf[4];
#pragma unroll
                for (int ks = 0; ks < 4; ++ks) kf[ks] = ldsfrag(lds + OFF_KT + (16 * wid + r) * LDB + (32 * ks + 8 * q) * 2);
#pragma unroll
                for (int nt = 0; nt < 2; ++nt) {
                    Cacc[nt] = Cacc[nt] * dec;
#pragma unroll
                    for (int ks = 0; ks < 4; ++ks) Cacc[nt] = mfma16(kf[ks], ldsfrag(lds + OFF_VW + (16 * nt + r) * LDB + (32 * ks + 8 * q) * 2), Cacc[nt]);
                }
            }
            float nnew;
            {
                const int d = tid >> 2, part = tid & 3; float s = 0.f;
#pragma unroll
                for (int i = 0; i < 4; ++i) {
                    const u32x4 kv = *(const LAS u32x4*)(Kt + d * LD + part * 32 + i * 8);
                    const f32x4 w0 = *(const LAS f32x4*)(wl + part * 32 + i * 8), w1 = *(const LAS f32x4*)(wl + part * 32 + i * 8 + 4);
                    s += bflo(kv[0]) * w0[0] + bfhi(kv[0]) * w0[1] + bflo(kv[1]) * w0[2] + bfhi(kv[1]) * w0[3] + bflo(kv[2]) * w1[0] + bfhi(kv[2]) * w1[1] + bflo(kv[3]) * w1[2] + bfhi(kv[3]) * w1[3];
                }
                s += __shfl_xor(s, 1); s += __shfl_xor(s, 2);
                nnew = dec * nvec[d] + s;
            }
            __syncthreads();
#pragma unroll
            for (int nt = 0; nt < 2; ++nt) { u32x2 w; w.x = pk2(Cacc[nt][0], Cacc[nt][1]); w.y = pk2(Cacc[nt][2], Cacc[nt][3]); *(LAS u32x2*)(Ct + (16 * nt + r) * LD + 16 * wid + 4 * q) = w; }
            if ((tid & 3) == 0) nvec[tid >> 2] = nnew;
        }
        __syncthreads();
    }
}

__device__ __forceinline__ void sgu_phase(LAS unsigned char* lds, const bf16_t* P, const float* sgu_norm, const float* sgu_ws, const float* sgu_b, bf16_t* A1) {
    int tid_ = threadIdx.x; asm volatile("" : "+v"(tid_)); const int tid = tid_, lane = tid & 63, wid = __builtin_amdgcn_readfirstlane(tid >> 6), r = lane & 15, q = lane >> 4;
    constexpr int LD = 136, LDB = LD * 2, OFF_W = 0, OFF_V = 34816, OFF_R = 69632;
    LAS bf16_t* Ws = (LAS bf16_t*)(lds + OFF_W); LAS bf16_t* Vt = (LAS bf16_t*)(lds + OFF_V); LAS float* rstd = (LAS float*)(lds + OFF_R);
    for (int unit = blockIdx.x; unit < 576; unit += gridDim.x) {
        const int g = unit & 3, n = (unit >> 2) % 18, b = unit / 72;
        const int rbase = n < 2 ? MX + b * CTXL + n * 128 : b * SEQ + (n - 2) * 128;
        {
            const int tok = tid >> 2, part = tid & 3; float ss = 0.f;
            const bf16_t* pv = P + (size_t)(rbase + tok) * NEV + 2560 + part * 128;
#pragma unroll 4
            for (int i = 0; i < 16; ++i) { const u32x4 w = *(const u32x4*)(pv + i * 8);
#pragma unroll
                for (int k = 0; k < 4; ++k) { const float a0 = gelu_tanh(bflo(w[k])), a1 = gelu_tanh(bfhi(w[k])); ss += a0 * a0 + a1 * a1; } }
            ss += __shfl_xor(ss, 1); ss += __shfl_xor(ss, 2);
            if (part == 0) rstd[tok] = 1.0f / sqrtf(ss * (1.f / 512.f) + EPS);
        }
#pragma unroll
        for (int it = 0; it < 4; ++it) { const int i = tid + NTHREADS * it; const int p = i >> 4, sg = i & 15;
            const float* wp = sgu_ws + ((size_t)g * 128 + p) * 128 + sg * 8; const f32x4 w0 = *(const f32x4*)wp, w1 = *(const f32x4*)(wp + 4);
            u32x4 o; o.x = pk2(w0[0], w0[1]); o.y = pk2(w0[2], w0[3]); o.z = pk2(w1[0], w1[1]); o.w = pk2(w1[2], w1[3]);
            *(LAS u32x4*)(Ws + p * LD + sg * 8) = o; }
        __syncthreads();
#pragma unroll
        for (int it = 0; it < 4; ++it) { const int i = tid + NTHREADS * it; const int tq = i >> 4, sg = i & 15;
            const u32x4 w = *(const u32x4*)(P + (size_t)(rbase + tq) * NEV + 2560 + g * 128 + sg * 8);
            const float rq = rstd[tq];
            const f32x4 g0 = *(const f32x4*)(sgu_norm + g * 128 + sg * 8), g1 = *(const f32x4*)(sgu_norm + g * 128 + sg * 8 + 4);
            Vt[(sg * 8 + 0) * LD + tq] = f2bf(gelu_tanh(bflo(w[0])) * rq * g0[0]); Vt[(sg * 8 + 1) * LD + tq] = f2bf(gelu_tanh(bfhi(w[0])) * rq * g0[1]);
            Vt[(sg * 8 + 2) * LD + tq] = f2bf(gelu_tanh(bflo(w[1])) * rq * g0[2]); Vt[(sg * 8 + 3) * LD + tq] = f2bf(gelu_tanh(bfhi(w[1])) * rq * g0[3]);
            Vt[(sg * 8 + 4) * LD + tq] = f2bf(gelu_tanh(bflo(w[2])) * rq * g1[0]); Vt[(sg * 8 + 5) * LD + tq] = f2bf(gelu_tanh(bfhi(w[2])) * rq * g1[1]);
            Vt[(sg * 8 + 6) * LD + tq] = f2bf(gelu_tanh(bflo(w[3])) * rq * g1[2]); Vt[(sg * 8 + 7) * LD + tq] = f2bf(gelu_tanh(bfhi(w[3])) * rq * g1[3]); }
        __syncthreads();
        {
            bf16x8 af[4];
#pragma unroll
            for (int ks = 0; ks < 4; ++ks) af[ks] = ldsfrag(lds + OFF_W + (16 * wid + r) * LDB + (32 * ks + 8 * q) * 2);
            const f32x4 sb4 = *(const f32x4*)(sgu_b + g * 128 + 16 * wid + 4 * q);
#pragma unroll
            for (int jb = 0; jb < 8; ++jb) {
                f32x4 acc = (f32x4){0.f, 0.f, 0.f, 0.f};
#pragma unroll
                for (int ks = 0; ks < 4; ++ks) acc = mfma16(af[ks], ldsfrag(lds + OFF_V + (16 * jb + r) * LDB + (32 * ks + 8 * q) * 2), acc);
#pragma unroll
                for (int reg = 0; reg < 4; ++reg) { const int p = 16 * wid + 4 * q + reg; const size_t R = (size_t)(rbase + p);
                    const float uu = gelu_tanh(bf2f(P[R * NEV + 2048 + g * 128 + 16 * jb + r]));
                    A1[R * D + 512 + g * 128 + 16 * jb + r] = f2bf(uu * (acc[reg] + sb4[reg])); }
            }
        }
        __syncthreads();
    }
}

__device__ __forceinline__ void combine_phase(const float* Hdir, const bf16_t* P, const float* mnorm, bf16_t* A1) {
    int tid_ = threadIdx.x; asm volatile("" : "+v"(tid_)); const int tid = tid_, lane = tid & 63, wid = __builtin_amdgcn_readfirstlane(tid >> 6);
    for (int R = blockIdx.x * 8 + wid; R < MT; R += gridDim.x * 8) {
        const int col = lane * 8;
        const float* p0 = Hdir + (size_t)R * 512 + col; const float* p1 = Hdir + ((size_t)MT + R) * 512 + col;
        const f32x4 a0 = *(const f32x4*)p0 + *(const f32x4*)p1, a1 = *(const f32x4*)(p0 + 4) + *(const f32x4*)(p1 + 4);
        float ss = (a0[0] * a0[0] + a0[1] * a0[1]) + (a0[2] * a0[2] + a0[3] * a0[3]) + (a1[0] * a1[0] + a1[1] * a1[1]) + (a1[2] * a1[2] + a1[3] * a1[3]);
        ss += __shfl_xor(ss, 1); ss += __shfl_xor(ss, 2); ss += __shfl_xor(ss, 4); ss += __shfl_xor(ss, 8);
        const float rstd = 1.0f / sqrtf(ss * (1.f / 128.f) + EPS);
        const f32x4 m0 = *(const f32x4*)(mnorm + col), m1 = *(const f32x4*)(mnorm + col + 4);
        const u32x4 ov = *(const u32x4*)(P + (size_t)R * NEV + 1536 + col);
        u32x4 w;
        w.x = pk2(sigmoid_f(bflo(ov[0])) * a0[0] * rstd * m0[0], sigmoid_f(bfhi(ov[0])) * a0[1] * rstd * m0[1]);
        w.y = pk2(sigmoid_f(bflo(ov[1])) * a0[2] * rstd * m0[2], sigmoid_f(bfhi(ov[1])) * a0[3] * rstd * m0[3]);
        w.z = pk2(sigmoid_f(bflo(ov[2])) * a1[0] * rstd * m1[0], sigmoid_f(bfhi(ov[2])) * a1[1] * rstd * m1[1]);
        w.w = pk2(sigmoid_f(bflo(ov[3])) * a1[2] * rstd * m1[2], sigmoid_f(bfhi(ov[3])) * a1[3] * rstd * m1[3]);
        *(u32x4*)(A1 + (size_t)R * D + col) = w;
    }
}

__device__ __forceinline__ void attn_phase(LAS unsigned char* lds, const bf16_t* QKV, const float* sink, bf16_t* A1) {
    int tid_ = threadIdx.x; asm volatile("" : "+v"(tid_)); const int tid = tid_, lane = tid & 63, wid = __builtin_amdgcn_readfirstlane(tid >> 6), r = lane & 15, q = lane >> 4;
    constexpr int LK = 72, LKB = LK * 2, OFF_K = 0, OFF_V = 9216, OFF_P = 18432, PSZ = 64 * LKB;
    LAS bf16_t* Ks = (LAS bf16_t*)(lds + OFF_K); LAS bf16_t* Vt = (LAS bf16_t*)(lds + OFF_V);
    LAS bf16_t* Ps = (LAS bf16_t*)(lds + OFF_P + wid * PSZ);
    const LAS unsigned char* Pb = lds + OFF_P + wid * PSZ;
    for (int unit = blockIdx.x; unit < 512; unit += gridDim.x) {
        const int hk = unit & 3, j = (unit >> 2) & 15, b = unit >> 6;
        const int g = wid >> 1, hq = hk * 4 + g, tok0 = (wid & 1) * 64;
        const int qrow0 = b * SEQ + j * 128 + tok0;
        bf16x8 qf[4][2];
#pragma unroll
        for (int mt = 0; mt < 4; ++mt)
#pragma unroll
            for (int ks = 0; ks < 2; ++ks) qf[mt][ks] = *(const bf16x8*)(QKV + (size_t)(qrow0 + 16 * mt + r) * NQKV + hq * 64 + 32 * ks + 8 * q);
        float mrun[4][4], lrun[4][4]; f32x4 oacc[4][4];
        const float sk = sink[hq];
#pragma unroll
        for (int mt = 0; mt < 4; ++mt)
#pragma unroll
            for (int i = 0; i < 4; ++i) { mrun[mt][i] = sk; lrun[mt][i] = 1.f; oacc[mt][i] = (f32x4){0.f, 0.f, 0.f, 0.f}; }
        for (int ti = 0; ti < 10; ++ti) {
            int krow0, kpos0; bool band;
            if (ti < 4) { krow0 = MX + b * CTXL + ti * 64; kpos0 = 0; band = false; }
            else { const int kb = j - 1 + ((ti - 4) >> 1); if (kb < 0 || kb > 15) continue; kpos0 = kb * 128 + ((ti - 4) & 1) * 64; krow0 = b * SEQ + kpos0; band = (kb != j); }
            __syncthreads();
            {
                const int key = tid >> 3, sg = tid & 7;
                const bf16_t* kp = QKV + (size_t)(krow0 + key) * NQKV + 1024 + hk * 64 + sg * 8;
                const u32x4 kv = *(const u32x4*)kp; const u32x4 vv = *(const u32x4*)(kp + 256);
                *(LAS u32x4*)(Ks + key * LK + sg * 8) = kv;
#pragma unroll
                for (int w2 = 0; w2 < 4; ++w2) { Vt[(sg * 8 + 2 * w2) * LK + key] = (bf16_t)(vv[w2] & 0xffffu); Vt[(sg * 8 + 2 * w2 + 1) * LK + key] = (bf16_t)(vv[w2] >> 16); }
            }
            __syncthreads();
#pragma unroll
            for (int mt = 0; mt < 4; ++mt) {
                f32x4 s[4];
#pragma unroll
                for (int nt = 0; nt < 4; ++nt) {
                    const bf16x8 k0 = ldsfrag(lds + OFF_K + (16 * nt + r) * LKB + (8 * q) * 2), k1 = ldsfrag(lds + OFF_K + (16 * nt + r) * LKB + (32 + 8 * q) * 2);
                    f32x4 a = (f32x4){0.f, 0.f, 0.f, 0.f}; a = mfma16(qf[mt][0], k0, a); a = mfma16(qf[mt][1], k1, a); s[nt] = a;
                }
                if (band) {
#pragma unroll
                    for (int nt = 0; nt < 4; ++nt)
#pragma unroll
                        for (int i = 0; i < 4; ++i) { const int qp = j * 128 + tok0 + 16 * mt + 4 * q + i, kp = kpos0 + 16 * nt + r; const int df = qp - kp;
                            if (df > 128 || df < -128) s[nt][i] = -1e30f; }
                }
#pragma unroll
                for (int i = 0; i < 4; ++i) {
                    float mx = fmaxf(fmaxf(s[0][i], s[1][i]), fmaxf(s[2][i], s[3][i]));
                    mx = fmaxf(mx, __shfl_xor(mx, 1)); mx = fmaxf(mx, __shfl_xor(mx, 2)); mx = fmaxf(mx, __shfl_xor(mx, 4)); mx = fmaxf(mx, __shfl_xor(mx, 8));
                    const float mn = fmaxf(mrun[mt][i], mx), alpha = __expf(mrun[mt][i] - mn);
                    float rsum = 0.f;
#pragma unroll
                    for (int nt = 0; nt < 4; ++nt) { const float p = __expf(s[nt][i] - mn); rsum += p; Ps[(16 * mt + 4 * q + i) * LK + 16 * nt + r] = f2bf(p); }
                    rsum += __shfl_xor(rsum, 1); rsum += __shfl_xor(rsum, 2); rsum += __shfl_xor(rsum, 4); rsum += __shfl_xor(rsum, 8);
                    lrun[mt][i] = lrun[mt][i] * alpha + rsum; mrun[mt][i] = mn;
#pragma unroll
                    for (int nt = 0; nt < 4; ++nt) oacc[mt][nt][i] *= alpha;
                }
                asm volatile("" ::: "memory");
            }
#pragma unroll
            for (int nt = 0; nt < 4; ++nt) {
                const bf16x8 v0 = ldsfrag(lds + OFF_V + (16 * nt + r) * LKB + (8 * q) * 2), v1 = ldsfrag(lds + OFF_V + (16 * nt + r) * LKB + (32 + 8 * q) * 2);
#pragma unroll
                for (int mt = 0; mt < 4; ++mt) {
                    oacc[mt][nt] = mfma16(ldsfrag(Pb + (16 * mt + r) * LKB + (8 * q) * 2), v0, oacc[mt][nt]);
                    oacc[mt][nt] = mfma16(ldsfrag(Pb + (16 * mt + r) * LKB + (32 + 8 * q) * 2), v1, oacc[mt][nt]);
                }
            }
        }
#pragma unroll
        for (int mt = 0; mt < 4; ++mt)
#pragma unroll
            for (int i = 0; i < 4; ++i) { const float inv = 1.f / lrun[mt][i]; const size_t R = (size_t)(qrow0 + 16 * mt + 4 * q + i);
#pragma unroll
                for (int nt = 0; nt < 4; ++nt) A1[R * D + hq * 64 + 16 * nt + r] = f2bf(oacc[mt][nt][i] * inv); }
    }
    __syncthreads();
}

__device__ __forceinline__ void final_phase(float* out, const float* fnorm) {
    int tid_ = threadIdx.x; asm volatile("" : "+v"(tid_)); const int tid = tid_, lane = tid & 63, wid = __builtin_amdgcn_readfirstlane(tid >> 6);
    for (int R = blockIdx.x * 8 + wid; R < MX; R += gridDim.x * 8) {
        float* src = out + (size_t)R * D;
        f32x4 v[4]; float ss = 0.f;
#pragma unroll
        for (int j = 0; j < 4; ++j) { v[j] = *(const f32x4*)(src + 256 * j + 4 * lane); ss += (v[j][0] * v[j][0] + v[j][1] * v[j][1]) + (v[j][2] * v[j][2] + v[j][3] * v[j][3]); }
        const float rstd = 1.0f / sqrtf(wave_sum(ss) * (1.f / D) + EPS);
#pragma unroll
        for (int j = 0; j < 4; ++j) { const f32x4 w = *(const f32x4*)(fnorm + 256 * j + 4 * lane); *(f32x4*)(src + 256 * j + 4 * lane) = v[j] * rstd * w; }
    }
}

#define GAS __attribute__((address_space(1)))
typedef GAS unsigned gu32;
#define RLX_AGENT __ATOMIC_RELAXED, __HIP_MEMORY_SCOPE_AGENT
#define XB_TMO      128
#define XB_XCNT(j)  (256  + 64 * (j))
#define XB_XSUB(j)  (1280 + 64 * (j))
#define XB_XGEN(j)  (2304 + 64 * (j))
#define XB_TOP      3328
#define XB_TOPGEN   3392
#define XCD_BAR_WORDS 3456
#define XB_SPIN_CAP (1u << 18)

__device__ __forceinline__ unsigned xb_ld(unsigned* p)              { return __hip_atomic_load(p, __ATOMIC_RELAXED, __HIP_MEMORY_SCOPE_AGENT); }
__device__ __forceinline__ unsigned xb_add(unsigned* p, unsigned v) { return __hip_atomic_fetch_add(p, v, __ATOMIC_RELAXED, __HIP_MEMORY_SCOPE_AGENT); }
__device__ __forceinline__ unsigned xb_xcc_id() { return (unsigned)__builtin_amdgcn_s_getreg((3 << 11) | 20) & 0xFu; }
#define XB_SPIN(cond, bar) do { unsigned _sp = 0; while (cond) { __builtin_amdgcn_s_sleep(1); \
    if ((++_sp & 255u) == 0u) { if (xb_ld(&(bar)[XB_TMO])) break; if (_sp > XB_SPIN_CAP) { atomicAdd(&(bar)[XB_TMO], 1u); break; } } } } while (0)

struct XcdBarrier {
    unsigned* bar; unsigned x;
    volatile LAS unsigned* st;
};

__device__ __forceinline__ XcdBarrier xcd_barrier_post(unsigned* bar, volatile LAS unsigned* st) {
    XcdBarrier b; b.bar = bar; b.x = xb_xcc_id(); b.st = st;
    if (threadIdx.x == 0) (void)xb_add(&bar[XB_XCNT(b.x)], 1u);
    return b;
}
__device__ __forceinline__ void xcd_barrier_complete(unsigned* bar, unsigned x, unsigned& nloc, unsigned& nx) {
    const unsigned G = gridDim.x * gridDim.y * gridDim.z;
    unsigned sum, cnt, mine, sp = 0u;
    for (;;) {
        sum = 0u; cnt = 0u; mine = 0u;
#pragma unroll
        for (unsigned j = 0; j < 16; ++j) { const unsigned c = xb_ld(&bar[XB_XCNT(j)]); sum += c; cnt += (c > 0u) ? 1u : 0u; mine = (j == x) ? c : mine; }
        if (sum == G) break;
        __builtin_amdgcn_s_sleep(1);
        if ((++sp & 255u) == 0u) { if (xb_ld(&bar[XB_TMO])) break; if (sp > XB_SPIN_CAP) { atomicAdd(&bar[XB_TMO], 1u); break; } }
    }
    nloc = mine > 0u ? mine : 1u; nx = cnt > 0u ? cnt : 1u;
}

__device__ __forceinline__ void xcd_barrier(const XcdBarrier& b) {
    asm volatile("s_waitcnt vmcnt(0)" ::: "memory");
    __syncthreads();
    if (threadIdx.x == 0) {
        unsigned* bar = b.bar;
        __builtin_amdgcn_s_waitcnt(0);
        unsigned nloc = b.st[0], nx = b.st[1];
        if (nloc == 0u) { xcd_barrier_complete(bar, b.x, nloc, nx); b.st[0] = nloc; b.st[1] = nx; }
        const unsigned old = xb_add(&bar[XB_XSUB(b.x)], 1u);
        const unsigned gen = old / nloc;
        if (old + 1u == (gen + 1u) * nloc) {
            __builtin_amdgcn_fence(__ATOMIC_RELEASE, "agent");
            asm volatile("s_waitcnt vmcnt(0)" ::: "memory");
            const unsigned og = xb_add(&bar[XB_TOP], 1u);
            const unsigned tg = og / nx;
            if (og + 1u == (tg + 1u) * nx) xb_add(&bar[XB_TOPGEN], 1u);
            else XB_SPIN(xb_ld(&bar[XB_TOPGEN]) == tg, bar);
            __builtin_amdgcn_fence(__ATOMIC_ACQUIRE, "agent");
            xb_add(&bar[XB_XGEN(b.x)], 1u);
            asm volatile("s_waitcnt vmcnt(0)" ::: "memory");
        } else {
            XB_SPIN(xb_ld(&bar[XB_XGEN(b.x)]) == gen, bar);
            __builtin_amdgcn_fence(__ATOMIC_ACQUIRE, "agent");
            asm volatile("s_waitcnt vmcnt(0)" ::: "memory");
        }
    }
    __syncthreads();
}

#ifndef MK_SINGLE
#define MK_SINGLE 1
#endif
constexpr int NPHASES = 23;
#ifndef REP_MASK
#define REP_MASK 0
#endif
#ifndef NSYNC_REP
#define NSYNC_REP 1
#endif
#ifndef EN_ALL
#define EN_ALL 1
#endif
#ifndef EN_P0
#define EN_P0 EN_ALL
#endif
#ifndef EN_NORM
#define EN_NORM EN_ALL
#endif
#ifndef EN_GEMM
#define EN_GEMM (EN_ALL ? 15 : 0)
#endif
#ifndef EN_MLSTM
#define EN_MLSTM EN_ALL
#endif
#ifndef EN_SGU
#define EN_SGU EN_ALL
#endif
#ifndef EN_COMB
#define EN_COMB EN_ALL
#endif
#ifndef EN_ATTN
#define EN_ATTN EN_ALL
#endif
#ifndef EN_FINAL
#define EN_FINAL EN_ALL
#endif
__global__ void __launch_bounds__(NTHREADS, 2) fwd_kernel(Args a_unused) {
    extern __shared__ __attribute__((aligned(16))) unsigned char lds_raw[];
    LAS unsigned char* lds = (LAS unsigned char*)lds_raw;
    cg::grid_group grid = cg::this_grid();
    unsigned char* ws = KA(ws);
    const int G = gridDim.x, c = blockIdx.x;
    float* Hx = KA(out); float* Hc = (float*)(ws + WS_HC);
    bf16_t* A0 = (bf16_t*)(ws + WS_A0); bf16_t* A1 = (bf16_t*)(ws + WS_A1); bf16_t* BIG = (bf16_t*)(ws + WS_BIG);
    float* Hdir = (float*)(ws + WS_A0);
    const float* mod = (const float*)(ws + WS_MOD);
    float* gates = (float*)(ws + WS_GATES);
    const int lo = KA(ph_lo), hi = KA(ph_hi);
    volatile LAS unsigned* barst = (volatile LAS unsigned*)(lds + LDS_BYTES - 16);
    if (threadIdx.x < 2) barst[threadIdx.x] = 0u;
    __syncthreads();
    XcdBarrier bar = xcd_barrier_post((unsigned*)(ws + WS_CTL), barst);
    enum { K_P0, K_NORM, K_NORMG, K_SWIGLU, K_RESID, K_PLAIN, K_QKV, K_MIX0, K_COMB, K_ATTN, K_FINAL };
    for (int ph = lo; ph < hi; ++ph) {
        const int layer = ph >= 12 ? 1 : 0;
        const int lp = ph >= 12 ? ph - 12 : ph - 1;
        const float* modl = mod + (size_t)layer * 9 * 9216;
        int kind = K_P0, M = MT, gi = 0, ffn = 0, Kd = 1024; float coef = 1.f;
        const bf16_t* Aop = A0; const bf16_t* Wop = nullptr;
        const float* bxp = Hx; const float* bcp = Hc;
        if (ph == 0) kind = K_P0;
        else if (ph == 22) kind = K_FINAL;
        else if (lp == 0) { kind = K_NORM; gi = 0; if (layer == 0) { bxp = KA(x); bcp = KA(ctx); } }
        else if (lp == 1) { kind = K_SWIGLU; ffn = layer * 2; }
        else if (lp == 2) { kind = K_RESID; Aop = BIG; Wop = (const bf16_t*)(ws + WS_WOUT + (size_t)(layer * 2) * SZ_WOUT); Kd = 2816; gi = 2; coef = 0.5f; if (layer == 0) { bxp = KA(x); bcp = KA(ctx); } }
        else if (layer == 0) {
            if (lp == 3) { kind = K_NORMG; gi = 3; }
            else if (lp == 4) kind = K_PLAIN;
            else if (lp == 5) kind = K_MIX0;
            else if (lp == 6) kind = K_COMB;
            else if (lp == 7) { kind = K_RESID; Aop = A1; Wop = (const bf16_t*)(ws + WS_WEOUT); gi = 5; }
            else if (lp == 8) { kind = K_NORM; gi = 6; }
            else if (lp == 9) { kind = K_SWIGLU; ffn = 1; }
            else { kind = K_RESID; Aop = BIG; Wop = (const bf16_t*)(ws + WS_WOUT + SZ_WOUT); Kd = 2816; gi = 8; coef = 0.5f; }
        } else {
            if (lp == 3) { kind = K_NORM; gi = 3; }
            else if (lp == 4) kind = K_QKV;
            else if (lp == 5) kind = K_ATTN;
            else if (lp == 6) { kind = K_RESID; Aop = A1; Wop = (const bf16_t*)(ws + WS_WOOUT); gi = 5; M = MX; }
            else if (lp == 7) { kind = K_NORM; gi = 6; M = MX; }
            else if (lp == 8) { kind = K_SWIGLU; ffn = 3; M = MX; }
            else { kind = K_RESID; Aop = BIG; Wop = (const bf16_t*)(ws + WS_WOUT + 3 * SZ_WOUT); Kd = 2816; gi = 8; coef = 0.5f; M = MX; }
        }
        const int nrep = ((REP_MASK >> kind) & 1) ? 2 : 1;
        for (int rep = 0; rep < nrep; ++rep) {
        if (rep == 1) { if (kind == K_RESID) { bxp = Hx; bcp = Hc; coef = 0.f; } __syncthreads(); }
        if (kind == K_P0) { if (EN_P0) p0_phase(lds); }
        else if (kind == K_NORM) { if (EN_NORM) norm_phase<false>(lds, bxp, bcp, A0, modl, gi, gi + 1, M, nullptr, nullptr, nullptr); }
        else if (kind == K_NORMG) { if (EN_NORM) norm_phase<true>(lds, Hx, Hc, A0, modl, gi, gi + 1, M, (const float*)(ws + WS_WG), KA(mlstm_gate_b), gates); }
        else if (kind == K_SWIGLU) { if (EN_GEMM & 1) { pg8::Gemm g{A0, (const bf16_t*)(ws + WS_WIN + (size_t)ffn * SZ_WIN), M, 5632, 1024}; pg8::StaticOrder S; S.init(M, 5632, G, c); pg8::EpiSwiglu E{BIG};
            pg8::gemm_phase<pg8::EpiSwiglu, pg8::StaticOrder, true, true>(lds, g, S, E); } }
        else if (kind == K_RESID) { if (EN_GEMM & 2) { pg8::Gemm g{Aop, Wop, M, 1024, Kd}; pg8::StaticOrder S; S.init(M, 1024, G, c); pg8::EpiResid E{bxp, bcp, Hx, Hc, modl + gi * 1024, coef};
            pg8::gemm_phase<pg8::EpiResid, pg8::StaticOrder, true, true>(lds, g, S, E); } }
        else if (kind == K_PLAIN) { if (EN_GEMM & 4) { pg8::Gemm g{A0, (const bf16_t*)(ws + WS_WEIN), MT, NEV, 1024}; pg8::StaticOrder S; S.init(MT, NEV, G, c); pg8::EpiPlain E{BIG, NEV};
            pg8::gemm_phase<pg8::EpiPlain, pg8::StaticOrder, true, true>(lds, g, S, E); } }
        else if (kind == K_QKV) { if (EN_GEMM & 8) { pg8::Gemm g{A0, (const bf16_t*)(ws + WS_WQKV), MT, NQKV, 1024}; pg8::StaticOrder S; S.init(MT, NQKV, G, c); pg8::EpiQKV E{BIG, (const float*)(ws + WS_ROPE)};
            pg8::gemm_phase<pg8::EpiQKV, pg8::StaticOrder, true, true>(lds, g, S, E); } }
        else if (kind == K_MIX0) { if (EN_MLSTM && (rep == 0 || !(REP_MASK & 0x10000))) mlstm_phase(lds, BIG, gates, KA(mlstm_conv), Hdir); if (EN_SGU && (rep == 0 || (REP_MASK & 0x10000))) sgu_phase(lds, BIG, KA(sgu_norm), KA(sgu_ws), KA(sgu_b), A1); }
        else if (kind == K_COMB) { if (EN_COMB) combine_phase(Hdir, BIG, KA(mlstm_norm), A1); }
        else if (kind == K_ATTN) { if (EN_ATTN) attn_phase(lds, BIG, KA(attn_sink), A1); }
        else { if (EN_FINAL) final_phase(Hx, KA(final_norm)); }
        }
        if (ph + 1 < hi) {
            if (ph == 0) {
                __syncthreads();
                if (threadIdx.x < 64) { __builtin_amdgcn_fence(__ATOMIC_RELEASE, "agent"); asm volatile("s_waitcnt vmcnt(0)" ::: "memory"); }
                grid.sync();
                if (threadIdx.x < 64) { __builtin_amdgcn_fence(__ATOMIC_ACQUIRE, "agent"); asm volatile("s_waitcnt vmcnt(0)" ::: "memory"); }
                __syncthreads();
            } else {
                for (int srep = 0; srep < NSYNC_REP; ++srep) xcd_barrier(bar);
            }
        }
    }
}

extern "C" void kernel_launch(void* const* d_in, const int* in_sizes, int n_in, void* d_out, int out_size, void* d_ws, size_t ws_size, hipStream_t stream) {
    static int grid = 0;
    if (grid == 0) {
        if (n_in != 20 || out_size != MX * D || ws_size < WS_END) { fprintf(stderr, "kernel_launch: unexpected problem (n_in %d out %d ws %zu need %zu)\n", n_in, out_size, ws_size, (size_t)WS_END); grid = -1; return; }
        int dev = 0, cus = 0, per_cu = 0;
        hipGetDevice(&dev);
        hipDeviceGetAttribute(&cus, hipDeviceAttributeMultiprocessorCount, dev);
        hipFuncSetAttribute((const void*)fwd_kernel, hipFuncAttributeMaxDynamicSharedMemorySize, LDS_BYTES);
        hipOccupancyMaxActiveBlocksPerMultiprocessor(&per_cu, (const void*)fwd_kernel, NTHREADS, LDS_BYTES);
        if (per_cu < 1) { fprintf(stderr, "kernel_launch: occupancy query says %d blocks per CU\n", per_cu); grid = -1; return; }
        grid = cus;
    }
    if (grid < 0) return;
    if (hipMemsetAsync((char*)d_ws + WS_CTL, 0, CTL_BYTES, stream) != hipSuccess) { fprintf(stderr, "kernel_launch: memset failed\n"); return; }
    Args a{};
#ifdef DBG_MEMSET
    hipMemsetAsync(d_ws, 0, WS_END, stream); hipMemsetAsync(d_out, 0, (size_t)out_size * 4, stream);
#endif
    a.x = (const float*)d_in[0]; a.c = (const float*)d_in[1]; a.ctx = (const float*)d_in[2]; a.c_ctx = (const float*)d_in[3]; a.ada_w = (const float*)d_in[4]; a.ada_b = (const float*)d_in[5];
    a.ffn_w_in = (const float*)d_in[6]; a.ffn_w_out = (const float*)d_in[7]; a.even_w_in = (const float*)d_in[8]; a.even_w_out = (const float*)d_in[9];
    a.mlstm_conv = (const float*)d_in[10]; a.mlstm_gate_b = (const float*)d_in[11]; a.mlstm_norm = (const float*)d_in[12]; a.sgu_norm = (const float*)d_in[13]; a.sgu_ws = (const float*)d_in[14]; a.sgu_b = (const float*)d_in[15];
    a.odd_w_qkv = (const float*)d_in[16]; a.odd_w_out = (const float*)d_in[17]; a.attn_sink = (const float*)d_in[18]; a.final_norm = (const float*)d_in[19];
    a.out = (float*)d_out; a.ws = (unsigned char*)d_ws;
#if MK_SINGLE
    a.ph_lo = 0; a.ph_hi = NPHASES;
    { void* args[] = {&a}; hipError_t e = hipLaunchCooperativeKernel((const void*)fwd_kernel, dim3(grid), dim3(NTHREADS), args, LDS_BYTES, stream);
      if (e != hipSuccess) fprintf(stderr, "cooperative launch failed: %s\n", hipGetErrorString(e)); }
#else
    for (int p = 0; p < NPHASES; ++p) { a.ph_lo = p; a.ph_hi = p + 1; void* args[] = {&a};
        hipError_t e = hipLaunchCooperativeKernel((const void*)fwd_kernel, dim3(grid), dim3(NTHREADS), args, LDS_BYTES, stream);
        if (e != hipSuccess) { fprintf(stderr, "launch %d failed: %s\n", p, hipGetErrorString(e)); break; } }
#endif
}
```

```cpp
#include <hip/hip_runtime.h>
#include <hip/hip_cooperative_groups.h>
#include <cstdio>
#include <cstdint>
namespace cg = cooperative_groups;
namespace pg8 {
#define PG8_LAS __attribute__((address_space(3)))
typedef unsigned short bf16_t;
typedef short bf16x8 __attribute__((ext_vector_type(8)));
typedef float f32x4 __attribute__((ext_vector_type(4)));
typedef unsigned u32x4 __attribute__((ext_vector_type(4)));
constexpr int BM = 256, BK = 64, HALF = 128, HTB = HALF * BK * 2  , STAGE_BYTES = 8 * HTB, NXCD = 8, WGM = 8;

__host__ __device__ __forceinline__ int lds_byte(int r, int c) { const int st = (r >> 4) * 2 + (c >> 5), rr = r & 15, cc = c & 31, ob = rr * 64 + cc * 2; return st * 1024 + (ob ^ (((ob >> 9) & 1) << 5)); }
__host__ __device__ __forceinline__ void stage_rc(int b, int& R, int& C) { const int st = b / 1024, sb = b % 1024, swz = sb ^ (((sb >> 9) & 1) << 5); R = (st >> 1) * 16 + swz / 64; C = (st & 1) * 32 + (swz % 64) / 2; }
__host__ __device__ __forceinline__ int perm32(int rho) { const int n = rho >> 4, i = rho & 15; return 8 * (i >> 2) + 4 * n + (i & 3); }

struct Unit { int pm, pn; };
struct Gemm { const bf16_t* A; const bf16_t* Bt; int M, N, K; };

struct StaticOrder {
    int nM, nN, nwg, G, c;
    __host__ __device__ void init(int M, int N, int G_, int c_) { nM = M / BM; nN = N / BM; nwg = nM * nN; G = G_; c = c_; }
    __host__ __device__ bool next(int i, Unit& u) const {
        const long L = (long)i * G + c; if (L >= nwg) return false;
        int wgid = (int)L; { const int q = nwg / NXCD, r = nwg % NXCD, xcd = wgid % NXCD, off = wgid / NXCD; wgid = (xcd < r ? xcd * (q + 1) : r * (q + 1) + (xcd - r) * q) + off; }
        const int nig = WGM * nN, gid = wgid / nig, fm = gid * WGM, gsz = (nM - fm) < WGM ? (nM - fm) : WGM;
        u.pm = fm + ((wgid % nig) % gsz); u.pn = (wgid % nig) / gsz; return true;
    }
    __device__ __forceinline__ void a_ready(const Unit&) const {}
    __device__ __forceinline__ void done(const Unit&) const {}
};

__device__ __forceinline__ unsigned cvt_pk_bf16(float lo, float hi) { unsigned r; asm volatile("v_cvt_pk_bf16_f32 %0, %1, %2" : "=v"(r) : "v"(lo), "v"(hi)); return r; }
typedef float f32x2 __attribute__((ext_vector_type(2)));
template <class Epi, class Sched, bool ALIGN_EPI = false, bool SP2 = false>
__device__ __forceinline__ void gemm_phase(PG8_LAS unsigned char* lds, const Gemm g, const Sched& S, const Epi& E) {
    int tid_ = threadIdx.x; asm volatile("" : "+v"(tid_)); const int tid = tid_, wid = __builtin_amdgcn_readfirstlane(tid >> 6), lane = tid & 63, wr = wid >> 2, wc = wid & 3, fr = lane & 15, fq = lane >> 4;
    const int K = g.K, nt = K / BK;
    unsigned voffA[2], voffB[2];
#pragma unroll
    for (int i = 0; i < 2; ++i) { int R, C; stage_rc(tid * 16 + i * 8192, R, C); const int Rb = Epi::PERM ? ((R & ~31) + perm32(R & 31)) : R;
        voffA[i] = (unsigned)(R * K + C) * 2u; voffB[i] = (unsigned)(Rb * K + C) * 2u; }
    const size_t kstep = (size_t)(BK * 2);
    const size_t hstep = (size_t)HALF * K * 2;
    const size_t tstep = 2 * hstep;
    const unsigned ldsw = (unsigned)wid * 1024u;
    const int aoff = lds_byte(wr * 64 + fr, fq * 8), boff = lds_byte(wc * 32 + fr, fq * 8);
#define PG8_SA(b, h) (((b) * 2 + (h)) * HTB)
#define PG8_SB(b, h) ((4 + (b) * 2 + (h)) * HTB)
#define PG8_STAGE(bufoff, gbase, voff) do { _Pragma("unroll") for (int _i = 0; _i < 2; ++_i) \
        __builtin_amdgcn_global_load_lds((const unsigned*)((const char*)(gbase) + (voff)[_i]), (PG8_LAS unsigned*)(lds + (bufoff) + ldsw + _i * 8192), 16, 0, 0); } while (0)
#define PG8_LDA(dst, b, h) do { _Pragma("unroll") for (int m = 0; m < 4; ++m) _Pragma("unroll") for (int k = 0; k < 2; ++k) dst[m][k] = *(const PG8_LAS bf16x8*)(lds + PG8_SA(b, h) + aoff + m * 2048 + k * 1024); } while (0)
#define PG8_LDB(dst, b, h) do { _Pragma("unroll") for (int n = 0; n < 2; ++n) _Pragma("unroll") for (int k = 0; k < 2; ++k) dst[n][k] = *(const PG8_LAS bf16x8*)(lds + PG8_SB(b, h) + boff + n * 2048 + k * 1024); } while (0)
#define PG8_MMA(ai, bj, At, Bt) do { __builtin_amdgcn_s_setprio(1); _Pragma("unroll") for (int m = 0; m < 4; ++m) _Pragma("unroll") for (int n = 0; n < 2; ++n) _Pragma("unroll") for (int k = 0; k < 2; ++k) \
        acc[ai][bj][m][n] = __builtin_amdgcn_mfma_f32_16x16x32_bf16(Bt[n][k], At[m][k], acc[ai][bj][m][n], 0, 0, 0); __builtin_amdgcn_s_setprio(0); } while (0)
#define PG8_WAIT_V(n) asm volatile("s_waitcnt vmcnt(" #n ")" ::: "memory")
#define PG8_WAIT_L(n) asm volatile("s_waitcnt lgkmcnt(" #n ")" ::: "memory")
#define PG8_BAR __builtin_amdgcn_s_barrier()
#define PG8_SCHED __builtin_amdgcn_sched_barrier(0)
    Unit cur, nxt; int ui = 0;
    if (!S.next(0, cur)) return;
    f32x4 acc[2][2][4][2];
#pragma unroll
    for (int a = 0; a < 2; ++a)
#pragma unroll
        for (int b = 0; b < 2; ++b)
#pragma unroll
            for (int m = 0; m < 4; ++m)
#pragma unroll
                for (int n = 0; n < 2; ++n) acc[a][b][m][n] = (f32x4){0.f, 0.f, 0.f, 0.f};
    bf16x8 At[4][2], B0[2][2], B1[2][2];
    const char* cA = (const char*)g.A + (size_t)cur.pm * tstep; const char* cB = (const char*)g.Bt + (size_t)cur.pn * tstep;
    S.a_ready(cur);
    if constexpr (SP2) {
        PG8_STAGE(PG8_SB(0, 0), cB, voffB); PG8_STAGE(PG8_SB(0, 1), cB + hstep, voffB); PG8_STAGE(PG8_SA(0, 0), cA, voffA); PG8_STAGE(PG8_SA(0, 1), cA + hstep, voffA);
        if (wr == 1) PG8_BAR;
        PG8_WAIT_V(2); PG8_BAR;
        PG8_STAGE(PG8_SB(1, 0), cB + kstep, voffB); PG8_STAGE(PG8_SA(1, 0), cA + kstep, voffA); PG8_STAGE(PG8_SB(1, 1), cB + hstep + kstep, voffB);
        PG8_WAIT_V(6); PG8_BAR;
    } else {
        PG8_STAGE(PG8_SB(0, 0), cB, voffB); PG8_STAGE(PG8_SA(0, 0), cA, voffA); PG8_STAGE(PG8_SB(0, 1), cB + hstep, voffB); PG8_STAGE(PG8_SA(0, 1), cA + hstep, voffA);
        if (wr == 1) PG8_BAR;
        PG8_WAIT_V(4); PG8_BAR;
        PG8_STAGE(PG8_SB(1, 0), cB + kstep, voffB); PG8_STAGE(PG8_SA(1, 0), cA + kstep, voffA); PG8_STAGE(PG8_SB(1, 1), cB + hstep + kstep, voffB);
        PG8_WAIT_V(6); PG8_BAR;
    }
    for (;;) {
        const bool has_next = S.next(ui + 1, nxt);
        const char* nA = has_next ? (const char*)g.A + (size_t)nxt.pm * tstep : cA; const char* nB = has_next ? (const char*)g.Bt + (size_t)nxt.pn * tstep : cB;
        for (int t = 0; t < nt; t += 2) {
            const bool last = (t == nt - 2);
            const char* a1 = cA + (size_t)(t + 1) * kstep;
            const char* a2 = last ? nA : cA + (size_t)(t + 2) * kstep; const char* b2 = last ? nB : cB + (size_t)(t + 2) * kstep;
            const char* a3 = a2 + kstep; const char* b3 = b2 + kstep;
            if (last && has_next) S.a_ready(nxt);
            if constexpr (SP2) {
            PG8_LDB(B0, 0, 0); PG8_LDB(B1, 0, 1); PG8_SCHED; PG8_LDA(At, 0, 0); PG8_STAGE(PG8_SA(1, 1), a1 + hstep, voffA);
            PG8_WAIT_V(8); PG8_WAIT_L(0); PG8_BAR; PG8_MMA(0, 0, At, B0); PG8_MMA(0, 1, At, B1); PG8_BAR; PG8_SCHED;
            PG8_LDA(At, 0, 1); PG8_STAGE(PG8_SB(0, 0), b2, voffB); PG8_STAGE(PG8_SB(0, 1), b2 + hstep, voffB); PG8_STAGE(PG8_SA(0, 0), a2, voffA);
            PG8_WAIT_V(8); PG8_WAIT_L(0); PG8_BAR; PG8_MMA(1, 0, At, B0); PG8_MMA(1, 1, At, B1); PG8_BAR; PG8_SCHED;
            PG8_LDB(B0, 1, 0); PG8_LDB(B1, 1, 1); PG8_SCHED; PG8_LDA(At, 1, 0); PG8_STAGE(PG8_SA(0, 1), a2 + hstep, voffA);
            PG8_WAIT_V(8); PG8_WAIT_L(0); PG8_BAR; PG8_MMA(0, 0, At, B0); PG8_MMA(0, 1, At, B1); PG8_BAR; PG8_SCHED;
            PG8_LDA(At, 1, 1); PG8_STAGE(PG8_SB(1, 0), b3, voffB); PG8_STAGE(PG8_SB(1, 1), b3 + hstep, voffB); PG8_STAGE(PG8_SA(1, 0), a3, voffA);
            PG8_WAIT_V(8); PG8_WAIT_L(0); PG8_BAR; PG8_MMA(1, 0, At, B0); PG8_MMA(1, 1, At, B1); PG8_BAR; PG8_SCHED;
            } else {
            PG8_LDB(B0, 0, 0); PG8_SCHED; PG8_LDA(At, 0, 0); PG8_STAGE(PG8_SA(1, 1), a1 + hstep, voffA);
            PG8_WAIT_L(8); PG8_BAR; PG8_WAIT_L(0); PG8_MMA(0, 0, At, B0); PG8_BAR; PG8_SCHED;
            PG8_LDB(B1, 0, 1); PG8_STAGE(PG8_SB(0, 0), b2, voffB);
            PG8_BAR; PG8_WAIT_L(0); PG8_MMA(0, 1, At, B1); PG8_BAR;
            PG8_LDA(At, 0, 1); PG8_STAGE(PG8_SA(0, 0), a2, voffA);
            PG8_BAR; PG8_WAIT_L(0); PG8_MMA(1, 0, At, B0); PG8_BAR; PG8_SCHED;
            PG8_STAGE(PG8_SB(0, 1), b2 + hstep, voffB);
            PG8_WAIT_V(6); PG8_BAR; PG8_MMA(1, 1, At, B1); PG8_BAR;
            PG8_LDB(B0, 1, 0); PG8_SCHED; PG8_LDA(At, 1, 0); PG8_STAGE(PG8_SA(0, 1), a2 + hstep, voffA);
            PG8_WAIT_L(8); PG8_BAR; PG8_WAIT_L(0); PG8_MMA(0, 0, At, B0); PG8_BAR; PG8_SCHED;
            PG8_LDB(B1, 1, 1); PG8_STAGE(PG8_SB(1, 0), b3, voffB);
            PG8_BAR; PG8_WAIT_L(0); PG8_MMA(0, 1, At, B1); PG8_BAR;
            PG8_LDA(At, 1, 1); PG8_STAGE(PG8_SA(1, 0), a3, voffA);
            PG8_BAR; PG8_WAIT_L(0); PG8_MMA(1, 0, At, B0); PG8_BAR; PG8_SCHED;
            PG8_STAGE(PG8_SB(1, 1), b3 + hstep, voffB);
            PG8_WAIT_V(6); PG8_BAR; PG8_MMA(1, 1, At, B1); PG8_BAR;
            }
        }
        if constexpr (ALIGN_EPI) { if (wr == 0) PG8_BAR; }
        if constexpr (!Epi::AFTER_DRAIN) { E(acc, cur, wr, wc, fr, fq); S.done(cur); }
        if (!has_next) break;
#pragma unroll
        for (int a = 0; a < 2; ++a)
#pragma unroll
            for (int b = 0; b < 2; ++b)
#pragma unroll
                for (int m = 0; m < 4; ++m)
#pragma unroll
                    for (int n = 0; n < 2; ++n) acc[a][b][m][n] = (f32x4){0.f, 0.f, 0.f, 0.f};
        cur = nxt; cA = nA; cB = nB; ++ui;
        if constexpr (ALIGN_EPI) { if (wr == 1) PG8_BAR; }
    }
    PG8_WAIT_V(0);
    if constexpr (!ALIGN_EPI) { if (wr == 0) PG8_BAR; }
    PG8_BAR;
    if constexpr (Epi::AFTER_DRAIN) { E.fused(acc, cur, wr, wc, fr, fq, lds, wid, lane); S.done(cur); }
#undef PG8_SA
#undef PG8_SB
#undef PG8_STAGE
#undef PG8_LDA
#undef PG8_LDB
#undef PG8_MMA
#undef PG8_WAIT_V
#undef PG8_WAIT_L
#undef PG8_BAR
#undef PG8_SCHED
}
}
#define LAS __attribute__((address_space(3)))
typedef unsigned short bf16_t;
typedef short bf16x8 __attribute__((ext_vector_type(8)));
typedef float f32x4 __attribute__((ext_vector_type(4)));
typedef float f32x2 __attribute__((ext_vector_type(2)));
typedef unsigned u32x4 __attribute__((ext_vector_type(4)));
typedef unsigned u32x2 __attribute__((ext_vector_type(2)));

constexpr int D = 1024, NB = 8, SEQ = 2048, CTXL = 256, DFF = 2816;
constexpr int MX = NB * SEQ;
constexpr int MC = NB * CTXL;
constexpr int MT = MX + MC;
constexpr int NMOD = 9;
constexpr int NEV = 3072;
constexpr int NQKV = 1536;
constexpr float EPS = 1e-6f;
constexpr int LDS_BYTES = 147456;
constexpr int NTHREADS = 512;

constexpr size_t MiB = 1u << 20;
constexpr size_t SZ_WIN = (size_t)5632 * 1024 * 2, SZ_WOUT = (size_t)1024 * 2816 * 2;
constexpr size_t WS_WIN = 0;
constexpr size_t WS_WOUT = WS_WIN + 4 * SZ_WIN;
constexpr size_t WS_WEIN = WS_WOUT + 4 * SZ_WOUT;
constexpr size_t WS_WEOUT = WS_WEIN + (size_t)3072 * 1024 * 2;
constexpr size_t WS_WQKV = WS_WEOUT + (size_t)1024 * 1024 * 2;
constexpr size_t WS_WOOUT = WS_WQKV + (size_t)1536 * 1024 * 2;
constexpr size_t WS_MOD = WS_WOOUT + (size_t)1024 * 1024 * 2;
constexpr size_t WS_WG = WS_MOD + (size_t)2 * 9 * 9216 * 4;
constexpr size_t WS_ROPE = WS_WG + (size_t)16 * 1024 * 4;
constexpr size_t WS_GATES = WS_ROPE + 8192;
constexpr size_t WS_HC = WS_GATES + (size_t)MT * 16 * 4;
constexpr size_t WS_A0 = ((WS_HC + (size_t)MC * D * 4 + 255) / 256) * 256;
constexpr size_t WS_QC = WS_A0 + (size_t)MT * D * 2;
constexpr size_t WS_KC = WS_QC + (size_t)MT * 512 * 2;
constexpr size_t WS_KCT = WS_KC + (size_t)MT * 512 * 2;
constexpr size_t WS_A1 = WS_KCT + (size_t)576 * 128 * 128 * 2;
constexpr size_t WS_BIG = WS_A1 + (size_t)MT * D * 2;
constexpr size_t WS_CTL = WS_BIG + (size_t)MT * 3072 * 2;
constexpr size_t CTL_BYTES = 16384;
constexpr size_t WS_END = WS_CTL + CTL_BYTES;

struct Args {
    const float* x; const float* c; const float* ctx; const float* c_ctx; const float* ada_w; const float* ada_b;
    const float* ffn_w_in; const float* ffn_w_out; const float* even_w_in; const float* even_w_out;
    const float* mlstm_conv; const float* mlstm_gate_b; const float* mlstm_norm; const float* sgu_norm; const float* sgu_ws; const float* sgu_b;
    const float* odd_w_qkv; const float* odd_w_out; const float* attn_sink; const float* final_norm;
    float* out; unsigned char* ws; int ph_lo, ph_hi;
};

typedef const __attribute__((address_space(4))) Args* kargp;
__device__ __forceinline__ kargp kargs() { kargp p = (kargp)__builtin_amdgcn_kernarg_segment_ptr(); asm volatile("" : "+s"(p)); return p; }
#define KA(f) (kargs()->f)
typedef __bf16 bf16x2_t __attribute__((ext_vector_type(2)));
__device__ __forceinline__ unsigned pk2(float lo, float hi) { f32x2 v = {lo, hi}; bf16x2_t b = __builtin_convertvector(v, bf16x2_t); return __builtin_bit_cast(unsigned, b); }
__device__ __forceinline__ bf16_t f2bf(float f) { return (bf16_t)(pk2(f, 0.f) & 0xffffu); }
__device__ __forceinline__ float bf2f(bf16_t v) { return __uint_as_float(((unsigned)v) << 16); }
__device__ __forceinline__ float bflo(unsigned w) { return __uint_as_float(w << 16); }
__device__ __forceinline__ float bfhi(unsigned w) { return __uint_as_float(w & 0xffff0000u); }
__device__ __forceinline__ float silu_f(float v) { return v * __builtin_amdgcn_rcpf(1.f + __expf(-v)); }
__device__ __forceinline__ float sigmoid_f(float v) { return __builtin_amdgcn_rcpf(1.f + __expf(-v)); }
__device__ __forceinline__ float gelu_tanh(float v) {
    const float z = 0.7978845608028654f * (v + 0.044715f * v * v * v);
    const float t = 1.f - 2.f * __builtin_amdgcn_rcpf(1.f + __expf(2.f * z));
    return 0.5f * v * (1.f + t);
}
__device__ __forceinline__ float wave_sum(float v) {
#pragma unroll
    for (int o = 1; o < 64; o <<= 1) v += __shfl_xor(v, o);
    return v;
}
__device__ __forceinline__ float wave_max(float v) {
#pragma unroll
    for (int o = 1; o < 64; o <<= 1) v = fmaxf(v, __shfl_xor(v, o));
    return v;
}
__device__ __forceinline__ f32x4 mfma16(bf16x8 a, bf16x8 b, f32x4 c) { return __builtin_amdgcn_mfma_f32_16x16x32_bf16(a, b, c, 0, 0, 0); }
__device__ __forceinline__ bf16x8 ldsfrag(const LAS unsigned char* p) { return *(const LAS bf16x8*)p; }

namespace pg8 {
struct EpiSwiglu {
    static constexpr bool PERM = true, AFTER_DRAIN = false;
    bf16_t* O;
    __device__ __forceinline__ void operator()(const f32x4 (&acc)[2][2][4][2], const Unit& u, int wr, int wc, int fr, int fq) const {
        const int row0 = u.pm * BM + wr * 64 + fr, col0 = u.pn * 128 + wc * 32 + 8 * fq;
#pragma unroll
        for (int ai = 0; ai < 2; ++ai)
#pragma unroll
            for (int m = 0; m < 4; ++m) {
                bf16_t* rowp = O + (size_t)(row0 + ai * HALF + m * 16) * DFF + col0;
                const f32x4 g0 = acc[ai][0][m][0], g1 = acc[ai][0][m][1], u0 = acc[ai][1][m][0], u1 = acc[ai][1][m][1];
                u32x4 w;
                w.x = ::pk2(::silu_f(g0[0]) * u0[0], ::silu_f(g0[1]) * u0[1]); w.y = ::pk2(::silu_f(g0[2]) * u0[2], ::silu_f(g0[3]) * u0[3]);
                w.z = ::pk2(::silu_f(g1[0]) * u1[0], ::silu_f(g1[1]) * u1[1]); w.w = ::pk2(::silu_f(g1[2]) * u1[2], ::silu_f(g1[3]) * u1[3]);
                *(u32x4*)rowp = w;
            }
    }
};
struct EpiResid {
    static constexpr bool PERM = false, AFTER_DRAIN = false;
    const float* bx; const float* bc; float* ox; float* oc; const float* gate;
    float coef;
    __device__ __forceinline__ void operator()(const f32x4 (&acc)[2][2][4][2], const Unit& u, int wr, int wc, int fr, int fq) const {
        const bool isx = u.pm < 64;
        const int bi = isx ? (u.pm >> 3) : 8;
        const float* base = isx ? bx : bc - (size_t)MX * D;
        float* outp = isx ? ox : oc - (size_t)MX * D;
        const int row0 = u.pm * BM + wr * 64 + fr, col0 = u.pn * BM + wc * 32 + 4 * fq;
        const float* gp = gate + (size_t)bi * 9216 + col0;
#pragma unroll
        for (int bj = 0; bj < 2; ++bj)
#pragma unroll
            for (int n = 0; n < 2; ++n) {
                const f32x4 gv = *(const f32x4*)(gp + bj * HALF + n * 16) * coef;
#pragma unroll
                for (int ai = 0; ai < 2; ++ai)
#pragma unroll
                    for (int m = 0; m < 4; ++m) {
                        const size_t off = (size_t)(row0 + ai * HALF + m * 16) * D + col0 + bj * HALF + n * 16;
                        const f32x4 b = *(const f32x4*)(base + off);
                        *(f32x4*)(outp + off) = b + gv * acc[ai][bj][m][n];
                        if (m & 1) asm volatile("" ::: "memory");
                    }
            }
    }
};
struct EpiPlain {
    static constexpr bool PERM = true, AFTER_DRAIN = false;
    bf16_t* O; int ldc;
    __device__ __forceinline__ void operator()(const f32x4 (&acc)[2][2][4][2], const Unit& u, int wr, int wc, int fr, int fq) const {
        const int row0 = u.pm * BM + wr * 64 + fr, col0 = u.pn * BM + wc * 32 + 8 * fq;
#pragma unroll
        for (int ai = 0; ai < 2; ++ai)
#pragma unroll
            for (int m = 0; m < 4; ++m) {
                bf16_t* rowp = O + (size_t)(row0 + ai * HALF + m * 16) * ldc + col0;
#pragma unroll
                for (int bj = 0; bj < 2; ++bj) {
                    const f32x4 v0 = acc[ai][bj][m][0], v1 = acc[ai][bj][m][1];
                    u32x4 w; w.x = ::pk2(v0[0], v0[1]); w.y = ::pk2(v0[2], v0[3]); w.z = ::pk2(v1[0], v1[1]); w.w = ::pk2(v1[2], v1[3]);
                    *(u32x4*)(rowp + bj * HALF) = w;
                }
            }
    }
};
struct EpiQKV {
    static constexpr bool PERM = true, AFTER_DRAIN = false;
    bf16_t* O; const float* rope;
    __device__ __forceinline__ void operator()(const f32x4 (&acc)[2][2][4][2], const Unit& u, int wr, int wc, int fr, int fq) const {
        const int row0 = u.pm * BM + wr * 64 + fr;
        const bool isx = u.pm < 64;
#pragma unroll
        for (int bj = 0; bj < 2; ++bj) {
            const int col0 = u.pn * BM + bj * HALF + wc * 32 + 8 * fq;
            const bool dorope = isx && (col0 < 1280);
            const float qs = (col0 < 1024) ? 0.125f : 1.f;
            const int p0 = (col0 & 63) >> 1;
            const int f0 = p0 & 15;
#pragma unroll
            for (int ai = 0; ai < 2; ++ai)
#pragma unroll
                for (int m = 0; m < 4; ++m) {
                    const int row = row0 + ai * HALF + m * 16;
                    f32x4 v0 = acc[ai][bj][m][0] * qs, v1 = acc[ai][bj][m][1] * qs;
                    if (dorope) {
                        const int t = row & 2047;
                        const int pos = (p0 < 16) ? (t >> 6) : (t & 63);
                        const f32x4 cs0 = *(const f32x4*)(rope + (pos * 16 + f0) * 2), cs1 = *(const f32x4*)(rope + (pos * 16 + f0) * 2 + 4);
                        f32x4 r0, r1;
                        r0[0] = v0[0] * cs0[0] - v0[1] * cs0[1]; r0[1] = v0[0] * cs0[1] + v0[1] * cs0[0];
                        r0[2] = v0[2] * cs0[2] - v0[3] * cs0[3]; r0[3] = v0[2] * cs0[3] + v0[3] * cs0[2];
                        r1[0] = v1[0] * cs1[0] - v1[1] * cs1[1]; r1[1] = v1[0] * cs1[1] + v1[1] * cs1[0];
                        r1[2] = v1[2] * cs1[2] - v1[3] * cs1[3]; r1[3] = v1[2] * cs1[3] + v1[3] * cs1[2];
                        v0 = r0; v1 = r1;
                    }
                    u32x4 w; w.x = ::pk2(v0[0], v0[1]); w.y = ::pk2(v0[2], v0[3]); w.z = ::pk2(v1[0], v1[1]); w.w = ::pk2(v1[2], v1[3]);
                    *(u32x4*)(O + (size_t)row * NQKV + col0) = w;
                }
        }
    }
};
}

__device__ __forceinline__ void tr_item(const float* W, int ldw, int k0, int srccol0, bf16_t* WT, int K, int destrow0, LAS float* scr, int lane) {
#pragma unroll 8
    for (int i = 0; i < 32; ++i) { const int kk = 2 * i + (lane >> 5); scr[kk * 33 + (lane & 31)] = W[(size_t)(k0 + kk) * ldw + srccol0 + (lane & 31)]; }
    asm volatile("s_waitcnt lgkmcnt(0)" ::: "memory");
    const int c = lane & 7;
#pragma unroll
    for (int j = 0; j < 4; ++j) { const int n = (lane >> 3) + 8 * j; const LAS float* s = scr + (8 * c) * 33 + n;
        u32x4 o; o.x = pk2(s[0 * 33], s[1 * 33]); o.y = pk2(s[2 * 33], s[3 * 33]); o.z = pk2(s[4 * 33], s[5 * 33]); o.w = pk2(s[6 * 33], s[7 * 33]);
        *(u32x4*)(WT + (size_t)(destrow0 + n) * K + k0 + 8 * c) = o; }
    asm volatile("s_waitcnt lgkmcnt(0)" ::: "memory");
}

__device__ __forceinline__ void p0_phase(LAS unsigned char* lds) {
    int tid_ = threadIdx.x; asm volatile("" : "+v"(tid_)); const int tid = tid_, lane = tid & 63, wid = __builtin_amdgcn_readfirstlane(tid >> 6), G = gridDim.x;
    unsigned char* ws = KA(ws);
    {
        LAS float* s = (LAS float*)lds;
        LAS float* red = (LAS float*)(lds + 36864);
        for (int i = tid; i < 9 * 1024; i += NTHREADS) { const float v = (i < 8192) ? KA(c)[i] : KA(c_ctx)[i - 8192]; s[i] = v / (1.f + expf(-v)); }
        __syncthreads();
        float* mod = (float*)(ws + WS_MOD);
        for (int tile = blockIdx.x; tile < 288; tile += G) {
            const int l = tile / 144, cg = tile % 144, n = cg * 64 + lane, kg = wid;
            float acc[9];
#pragma unroll
            for (int bi = 0; bi < 9; ++bi) acc[bi] = 0.f;
            const float* wp = KA(ada_w) + ((size_t)l * 1024 + kg * 128) * 9216 + n;
#pragma unroll 4
            for (int kk = 0; kk < 128; ++kk) {
                const float w = wp[(size_t)kk * 9216];
#pragma unroll
                for (int bi = 0; bi < 9; ++bi) acc[bi] += s[bi * 1024 + kg * 128 + kk] * w;
            }
#pragma unroll
            for (int bi = 0; bi < 9; ++bi) red[(kg * 9 + bi) * 64 + lane] = acc[bi];
            __syncthreads();
            for (int i = tid; i < 576; i += NTHREADS) {
                const int bi = i >> 6, cc = i & 63; float sum = 0.f;
#pragma unroll
                for (int k2 = 0; k2 < 8; ++k2) sum += red[(k2 * 9 + bi) * 64 + cc];
                mod[((size_t)l * 9 + bi) * 9216 + cg * 64 + cc] = sum + KA(ada_b)[l * 9216 + cg * 64 + cc];
            }
            __syncthreads();
        }
    }
    {
        const int gt = blockIdx.x * NTHREADS + tid, GT = G * NTHREADS;
        float* wg = (float*)(ws + WS_WG);
        for (int i = gt; i < 16 * 1024; i += GT) { const int g = i >> 10, k = i & 1023; wg[i] = KA(even_w_in)[(size_t)k * 3088 + 2048 + g]; }
        float* rope = (float*)(ws + WS_ROPE);
        for (int i = gt; i < 64 * 16; i += GT) { const int pos = i >> 4, f = i & 15; const float inv = powf(10000.f, -(float)f / 16.f); const float ang = (float)pos * inv; rope[2 * i] = cosf(ang); rope[2 * i + 1] = sinf(ang); }
    }
    {
        LAS float* scr = (LAS float*)(lds + wid * 16384);
        const int gw = blockIdx.x * 8 + wid, NGW = G * 8;
        constexpr int I_IN = 16 * 176, I_OUT = 44 * 32, I_EIN = 16 * 96, I_SQ = 16 * 32, I_QKV = 16 * 48;
        constexpr int NITEMS = 4 * I_IN + 4 * I_OUT + I_EIN + I_SQ + I_QKV + I_SQ;
        for (int it = gw; it < NITEMS; it += NGW) {
            int r = it;
            if (r < 4 * I_IN) { const int mi = r / I_IN; r -= mi * I_IN; const int kb = r / 176, nb = r % 176; const int n0 = nb * 32;
                const int dest = (n0 < 2816) ? ((n0 >> 7) * 256 + (n0 & 127)) : ((((n0 - 2816) >> 7) * 256) + 128 + ((n0 - 2816) & 127));
                tr_item(KA(ffn_w_in) + (size_t)mi * 1024 * 5632, 5632, kb * 64, n0, (bf16_t*)(ws + WS_WIN + mi * SZ_WIN), 1024, dest, scr, lane); continue; }
            r -= 4 * I_IN;
            if (r < 4 * I_OUT) { const int mi = r / I_OUT; r -= mi * I_OUT; const int kb = r / 32, nb = r % 32;
                tr_item(KA(ffn_w_out) + (size_t)mi * 2816 * 1024, 1024, kb * 64, nb * 32, (bf16_t*)(ws + WS_WOUT + mi * SZ_WOUT), 2816, nb * 32, scr, lane); continue; }
            r -= 4 * I_OUT;
            if (r < I_EIN) { const int kb = r / 96, nb = r % 96; const int src = nb < 64 ? nb * 32 : 2064 + (nb - 64) * 32;
                tr_item(KA(even_w_in), 3088, kb * 64, src, (bf16_t*)(ws + WS_WEIN), 1024, nb * 32, scr, lane); continue; }
            r -= I_EIN;
            if (r < I_SQ) { const int kb = r / 32, nb = r % 32; tr_item(KA(even_w_out), 1024, kb * 64, nb * 32, (bf16_t*)(ws + WS_WEOUT), 1024, nb * 32, scr, lane); continue; }
            r -= I_SQ;
            if (r < I_QKV) { const int kb = r / 48, nb = r % 48; tr_item(KA(odd_w_qkv), 1536, kb * 64, nb * 32, (bf16_t*)(ws + WS_WQKV), 1024, nb * 32, scr, lane); continue; }
            r -= I_QKV;
            { const int kb = r / 32, nb = r % 32; tr_item(KA(odd_w_out), 1024, kb * 64, nb * 32, (bf16_t*)(ws + WS_WOOUT), 1024, nb * 32, scr, lane); }
        }
    }
}

template <bool GATES>
__device__ __forceinline__ void norm_phase(LAS unsigned char* lds, const float* hx, const float* hc, bf16_t* A0, const float* modl, int shift_i, int scale_i, int nrows,
                                           const float* wg, const float* gate_b, float* gates) {
    int tid_ = threadIdx.x; asm volatile("" : "+v"(tid_)); const int tid = tid_, lane = tid & 63, wid = __builtin_amdgcn_readfirstlane(tid >> 6), G = gridDim.x;
    LAS float* wgs = (LAS float*)lds;
    if (GATES) { for (int i = tid; i < 16 * 1024 / 4; i += NTHREADS) ((LAS f32x4*)wgs)[i] = ((const f32x4*)wg)[i]; __syncthreads(); }
    for (int R = blockIdx.x * 8 + wid; R < nrows; R += G * 8) {
        const bool isx = R < MX;
        const float* src = isx ? hx + (size_t)R * D : hc + (size_t)(R - MX) * D;
        const int bi = isx ? (R >> 11) : 8;
        const float* mb = modl + (size_t)bi * 9216;
        f32x4 v[4]; float ss = 0.f;
#pragma unroll
        for (int j = 0; j < 4; ++j) { v[j] = *(const f32x4*)(src + 256 * j + 4 * lane); ss += (v[j][0] * v[j][0] + v[j][1] * v[j][1]) + (v[j][2] * v[j][2] + v[j][3] * v[j][3]); }
        const float rstd = 1.0f / sqrtf(wave_sum(ss) * (1.f / D) + EPS);
#pragma unroll
        for (int j = 0; j < 4; ++j) {
            const f32x4 sc = *(const f32x4*)(mb + scale_i * 1024 + 256 * j + 4 * lane), sh = *(const f32x4*)(mb + shift_i * 1024 + 256 * j + 4 * lane);
            v[j] = v[j] * rstd * (sc + 1.f) + sh;
            u32x2 w; w.x = pk2(v[j][0], v[j][1]); w.y = pk2(v[j][2], v[j][3]);
            *(u32x2*)(A0 + (size_t)R * D + 256 * j + 4 * lane) = w;
        }
        if (GATES) {
            float mine = 0.f;
#pragma unroll 1
            for (int g = 0; g < 16; ++g) {
                float d = 0.f;
#pragma unroll
                for (int j = 0; j < 4; ++j) { const f32x4 w = *(const LAS f32x4*)(wgs + g * 1024 + 256 * j + 4 * lane); d += (v[j][0] * w[0] + v[j][1] * w[1]) + (v[j][2] * w[2] + v[j][3] * w[3]); }
                d = wave_sum(d);
                if (lane == g) mine = d;
            }
            if (lane < 16) gates[(size_t)R * 16 + lane] = mine + gate_b[lane];
        }
    }
    if (GATES) __syncthreads();
}

__device__ __forceinline__ void qkprep_phase(LAS unsigned char* lds, const bf16_t* P, const float* convw, bf16_t* Qc, bf16_t* Kc, bf16_t* KcT) {
    int tid_ = threadIdx.x; asm volatile("" : "+v"(tid_)); const int tid = tid_;
    constexpr int LD = 136;
    LAS bf16_t* Tt = (LAS bf16_t*)lds;
    LAS float* cw = (LAS float*)(lds + 34816);
    const int seg = tid & 15;
    for (int unit = blockIdx.x; unit < 576; unit += gridDim.x) {
        const int h = unit & 3, gc = unit >> 2, n = gc % 18, b = gc / 18;
        const int sbase = n < 2 ? MX + b * CTXL : b * SEQ, T = n < 2 ? CTXL : SEQ, t0 = n < 2 ? n * 128 : (n - 2) * 128;
        for (int i = tid; i < 768; i += NTHREADS) { const int qk = i / 384, j = (i % 384) >> 7, ch = i & 127; cw[i] = convw[j * 1024 + qk * 512 + h * 128 + ch]; }
        __syncthreads();
#pragma unroll 1
        for (int it = 0; it < 4; ++it) {
            const int l = (tid + NTHREADS * it) >> 4;
            const int tin = t0 + l;
            const size_t R = (size_t)(sbase + tin);
            const bf16_t* pr = P + R * NEV + h * 128 + seg * 8;
            const u32x4 z = (u32x4){0u, 0u, 0u, 0u};
#pragma unroll
            for (int qk = 0; qk < 2; ++qk) {
                const bf16_t* pp = pr + qk * 512;
                const u32x4 c0 = *(const u32x4*)pp; const u32x4 pv = tin > 0 ? *(const u32x4*)(pp - NEV) : z; const u32x4 nx = tin < T - 1 ? *(const u32x4*)(pp + NEV) : z;
                float y[8];
#pragma unroll
                for (int hf = 0; hf < 2; ++hf) {
                    const f32x4 w0 = *(const LAS f32x4*)(cw + (qk * 3 + 0) * 128 + seg * 8 + 4 * hf), w1 = *(const LAS f32x4*)(cw + (qk * 3 + 1) * 128 + seg * 8 + 4 * hf), w2v = *(const LAS f32x4*)(cw + (qk * 3 + 2) * 128 + seg * 8 + 4 * hf);
                    y[4 * hf + 0] = w0[0] * bflo(pv[2 * hf]) + w1[0] * bflo(c0[2 * hf]) + w2v[0] * bflo(nx[2 * hf]);
                    y[4 * hf + 1] = w0[1] * bfhi(pv[2 * hf]) + w1[1] * bfhi(c0[2 * hf]) + w2v[1] * bfhi(nx[2 * hf]);
                    y[4 * hf + 2] = w0[2] * bflo(pv[2 * hf + 1]) + w1[2] * bflo(c0[2 * hf + 1]) + w2v[2] * bflo(nx[2 * hf + 1]);
                    y[4 * hf + 3] = w0[3] * bfhi(pv[2 * hf + 1]) + w1[3] * bfhi(c0[2 * hf + 1]) + w2v[3] * bfhi(nx[2 * hf + 1]);
                }
                const float scl = qk ? 0.08838834764831845f : 1.f;
                u32x4 o;
#pragma unroll
                for (int w2 = 0; w2 < 4; ++w2) o[w2] = pk2(silu_f(y[2 * w2]) * scl, silu_f(y[2 * w2 + 1]) * scl);
                *(u32x4*)((qk ? Kc : Qc) + R * 512 + h * 128 + seg * 8) = o;
                if (qk) {
#pragma unroll
                    for (int w2 = 0; w2 < 4; ++w2) { Tt[(seg * 8 + 2 * w2) * LD + l] = (bf16_t)(o[w2] & 0xffffu); Tt[(seg * 8 + 2 * w2 + 1) * LD + l] = (bf16_t)(o[w2] >> 16); }
                }
            }
        }
        __syncthreads();
#pragma unroll
        for (int it = 0; it < 4; ++it) { const int i = tid + NTHREADS * it; const int d = i >> 4, sg = i & 15;
            *(u32x4*)(KcT + ((size_t)unit * 128 + d) * 128 + sg * 8) = *(const LAS u32x4*)(Tt + d * LD + sg * 8); }
        __syncthreads();
    }
}

__device__ __forceinline__ void mlstm_phase(LAS unsigned char* lds, const bf16_t* P, const float* gates, const bf16_t* Qc, const bf16_t* Kc, const bf16_t* KcT, bf16_t* Hdir) {
    int tid_ = threadIdx.x; asm volatile("" : "+v"(tid_)); const int tid = tid_, lane = tid & 63, wid = __builtin_amdgcn_readfirstlane(tid >> 6), r = lane & 15, q = lane >> 4;
    constexpr int LD = 136, LDB = LD * 2;
    constexpr int OFF_Q = 0, OFF_K = 34816, OFF_KT = 69632, OFF_VT = 104448, OFF_VW = 113152, OFF_CT = 121856, OFF_SC = 130560;
    LAS bf16_t* Qs = (LAS bf16_t*)(lds + OFF_Q); LAS bf16_t* Ks = (LAS bf16_t*)(lds + OFF_K); LAS bf16_t* Kt = (LAS bf16_t*)(lds + OFF_KT);
    LAS bf16_t* Vt = (LAS bf16_t*)(lds + OFF_VT); LAS bf16_t* Vw = (LAS bf16_t*)(lds + OFF_VW); LAS bf16_t* Ct = (LAS bf16_t*)(lds + OFF_CT);
    LAS float* sc = (LAS float*)(lds + OFF_SC);
    LAS float* rowf = sc; LAS float* dmb = sc + 128; LAS float* inter = sc + 256; LAS float* wl = sc + 384; LAS float* en = sc + 512; LAS float* qn = sc + 640; LAS float* nvec = sc + 768; LAS float* misc = sc + 896;
    for (int unit = blockIdx.x; unit < 256; unit += gridDim.x) {
        const int es = unit & 3, dir = (unit >> 2) & 1, h = (unit >> 3) & 3, b = unit >> 5;
        for (int i = tid; i < 32 * LD / 2; i += NTHREADS) ((LAS unsigned*)Ct)[i] = 0u;
        if (tid < 128) nvec[tid] = 0.f;
        f32x4 Cacc[2]; Cacc[0] = (f32x4){0.f, 0.f, 0.f, 0.f}; Cacc[1] = Cacc[0];
        float m_state = 0.f;
        u32x4 pq[4], pvv; float pgi[2], pgf[2];
        const unsigned voffq = (unsigned)(((tid >> 4) * 512 + (tid & 15) * 8) * 2), vofft = (unsigned)(((tid >> 4) * 128 + (tid & 15) * 8) * 2);
#define MLSTM_CHUNK_INFO(ci_, n_, gc_, rb_) do { if ((ci_) < 2) n_ = dir ? 1 - (ci_) : (ci_); else n_ = dir ? 19 - (ci_) : (ci_); gc_ = b * 18 + n_; rb_ = n_ < 2 ? MX + b * CTXL + n_ * 128 : b * SEQ + (n_ - 2) * 128; } while (0)
#define MLSTM_PREFETCH(ci_) do { int n2, gc2, rb2; MLSTM_CHUNK_INFO(ci_, n2, gc2, rb2); \
            const bf16_t* qg = Qc + (size_t)rb2 * 512 + h * 128; (void)gc2; \
            _Pragma("unroll") for (int it = 0; it < 4; ++it) { \
                pq[it] = *(const u32x4*)((const char*)(qg + it * 16384) + voffq); } \
            pvv = *(const u32x4*)(P + (size_t)(rb2 + (tid >> 2)) * NEV + 1024 + h * 128 + es * 32 + (tid & 3) * 8); \
            if (wid == 0) { _Pragma("unroll") for (int hf = 0; hf < 2; ++hf) { const int l = lane + 64 * hf; const int R = rb2 + (dir ? 127 - l : l); \
                pgi[hf] = gates[(size_t)R * 16 + dir * 8 + h]; pgf[hf] = gates[(size_t)R * 16 + dir * 8 + 4 + h]; } } } while (0)
        MLSTM_PREFETCH(0);
        __syncthreads();
        for (int ci = 0; ci < 18; ++ci) {
            int wc_ = wid, dc_ = dir; asm volatile("" : "+s"(wc_), "+s"(dc_)); const int widc = wc_, dirc = dc_;
            int n, gc, rbase;
            MLSTM_CHUNK_INFO(ci, n, gc, rbase);
            if (wid == 0) {
                float ig[2], bc[2];
#pragma unroll
                for (int hf = 0; hf < 2; ++hf) { ig[hf] = pgi[hf]; const float fg = pgf[hf];
                    bc[hf] = fminf(fg, 0.f) - log1pf(expf(-fabsf(fg))); }
#pragma unroll
                for (int off = 1; off < 64; off <<= 1) { const float t0 = __shfl_up(bc[0], off), t1 = __shfl_up(bc[1], off); if (lane >= off) { bc[0] += t0; bc[1] += t1; } }
                bc[1] += __shfl(bc[0], 63);
                const float g = __shfl(bc[1], 63);
                const float d0 = ig[0] - bc[0], d1 = ig[1] - bc[1];
                float p0 = d0, p1 = d1;
#pragma unroll
                for (int off = 1; off < 64; off <<= 1) { const float t0 = __shfl_up(p0, off), t1 = __shfl_up(p1, off); if (lane >= off) { p0 = fmaxf(p0, t0); p1 = fmaxf(p1, t1); } }
                p1 = fmaxf(p1, __shfl(p0, 63));
                const float a0 = g + d0, a1 = g + d1;
                const float mloc = wave_max(fmaxf(a0, a1));
                const float m_new = fmaxf(g + m_state, mloc);
                const float dec = expf(g + m_state - m_new);
                const float mt0 = bc[0] + fmaxf(m_state, p0), mt1 = bc[1] + fmaxf(m_state, p1);
                const int i0 = dir ? 127 - lane : lane, i1 = dir ? 63 - lane : lane + 64;
                rowf[i0] = bc[0] - mt0; rowf[i1] = bc[1] - mt1;
                dmb[i0] = d0; dmb[i1] = d1;
                inter[i0] = expf(bc[0] + m_state - mt0); inter[i1] = expf(bc[1] + m_state - mt1);
                wl[i0] = expf(a0 - m_new); wl[i1] = expf(a1 - m_new);
                en[i0] = expf(-mt0); en[i1] = expf(-mt1);
                if (lane == 0) misc[0] = dec;
                m_state = m_new;
            }
            u32x4 pk[4], pt[4];
            { const bf16_t* kg = Kc + (size_t)rbase * 512 + h * 128; const bf16_t* tg = KcT + (size_t)(gc * 4 + h) * 128 * 128;
#pragma unroll
              for (int it = 0; it < 4; ++it) pk[it] = *(const u32x4*)((const char*)(kg + it * 16384) + voffq);
#pragma unroll
              for (int it = 0; it < 4; ++it) pt[it] = *(const u32x4*)((const char*)(tg + it * 4096) + vofft); }
#pragma unroll
            for (int it = 0; it < 4; ++it) { const int i = tid + NTHREADS * it; const int row = i >> 4, sg = i & 15; *(LAS u32x4*)(Qs + row * LD + sg * 8) = pq[it]; }
#pragma unroll
            for (int it = 0; it < 4; ++it) { const int i = tid + NTHREADS * it; const int row = i >> 4, sg = i & 15; *(LAS u32x4*)(Ks + row * LD + sg * 8) = pk[it]; }
            __syncthreads();
            const float dec = misc[0];
            {
                const int t = tid >> 2, sg = tid & 3;
                const u32x4 vv = pvv;
                const float w = wl[t];
#pragma unroll
                for (int w2 = 0; w2 < 4; ++w2) {
                    Vt[(sg * 8 + 2 * w2) * LD + t] = (bf16_t)(vv[w2] & 0xffffu); Vt[(sg * 8 + 2 * w2 + 1) * LD + t] = (bf16_t)(vv[w2] >> 16);
                    Vw[(sg * 8 + 2 * w2) * LD + t] = f2bf(bflo(vv[w2]) * w); Vw[(sg * 8 + 2 * w2 + 1) * LD + t] = f2bf(bfhi(vv[w2]) * w);
                }
            }
            f32x4 sacc[8];
            {
                bf16x8 af[4];
#pragma unroll
                for (int ks = 0; ks < 4; ++ks) af[ks] = ldsfrag(lds + OFF_Q + (16 * wid + r) * LDB + (32 * ks + 8 * q) * 2);
#pragma unroll
                for (int jb = 0; jb < 8; ++jb) {
                    sacc[jb] = (f32x4){0.f, 0.f, 0.f, 0.f};
                    if (dirc ? (jb >= widc) : (jb <= widc)) {
#pragma unroll
                        for (int ks = 0; ks < 4; ++ks) sacc[jb] = mfma16(af[ks], ldsfrag(lds + OFF_K + (16 * jb + r) * LDB + (32 * ks + 8 * q) * 2), sacc[jb]);
                    }
                }
            }
            {
                const int t = tid >> 2, part = tid & 3; float s = 0.f;
#pragma unroll
                for (int i = 0; i < 4; ++i) {
                    const u32x4 qv = *(const LAS u32x4*)(Qs + t * LD + part * 32 + i * 8);
                    const f32x4 n0 = *(const LAS f32x4*)(nvec + part * 32 + i * 8), n1 = *(const LAS f32x4*)(nvec + part * 32 + i * 8 + 4);
                    s += bflo(qv[0]) * n0[0] + bfhi(qv[0]) * n0[1] + bflo(qv[1]) * n0[2] + bfhi(qv[1]) * n0[3] + bflo(qv[2]) * n1[0] + bfhi(qv[2]) * n1[1] + bflo(qv[3]) * n1[2] + bfhi(qv[3]) * n1[3];
                }
                s += __shfl_xor(s, 1); s += __shfl_xor(s, 2);
                if (part == 0) qn[t] = s;
            }
#pragma unroll
            for (int it = 0; it < 4; ++it) { const int i = tid + NTHREADS * it; *(LAS u32x4*)(Kt + (i >> 4) * LD + (i & 15) * 8) = pt[it]; }
            __syncthreads();
            LAS bf16_t* Ss = Ks;
            float rs[4] = {0.f, 0.f, 0.f, 0.f};
            {
                const f32x4 rf = *(const LAS f32x4*)(rowf + 16 * wid + 4 * q);
                const int zb = dirc ? ((widc & 1) ? widc - 1 : -1) : ((widc & 1) ? -1 : widc + 1);
#pragma unroll
                for (int jb = 0; jb < 8; ++jb) {
                    if (dirc ? (jb >= widc) : (jb <= widc)) {
                        const int s = 16 * jb + r; const float dm = dmb[s];
#pragma unroll
                        for (int reg = 0; reg < 4; ++reg) { const int t = 16 * wid + 4 * q + reg;
                            const bool ok = dirc ? (s >= t) : (s <= t);
                            const float v = ok ? sacc[jb][reg] * __expf(rf[reg] + dm) : 0.f;
                            rs[reg] += v; Ss[t * LD + s] = f2bf(v); }
                    } else if (jb == zb) {
#pragma unroll
                        for (int reg = 0; reg < 4; ++reg) Ss[(16 * wid + 4 * q + reg) * LD + 16 * jb + r] = 0;
                    }
                }
#pragma unroll
                for (int reg = 0; reg < 4; ++reg) { rs[reg] += __shfl_xor(rs[reg], 1); rs[reg] += __shfl_xor(rs[reg], 2); rs[reg] += __shfl_xor(rs[reg], 4); rs[reg] += __shfl_xor(rs[reg], 8); }
            }
            {
                const int kh = widc >> 1;
                const f32x4 it4 = *(const LAS f32x4*)(inter + 16 * wid + 4 * q), qn4 = *(const LAS f32x4*)(qn + 16 * wid + 4 * q), en4 = *(const LAS f32x4*)(en + 16 * wid + 4 * q);
                bf16x8 qf[4];
#pragma unroll
                for (int ks = 0; ks < 4; ++ks) qf[ks] = ldsfrag(lds + OFF_Q + (16 * wid + r) * LDB + (32 * ks + 8 * q) * 2);
#pragma unroll
                for (int nt = 0; nt < 2; ++nt) {
                    f32x4 a1 = (f32x4){0.f, 0.f, 0.f, 0.f}, a2 = a1;
#pragma unroll
                    for (int ks = 0; ks < 4; ++ks) {
                        if (dirc ? (ks >= kh) : (ks <= kh)) a1 = mfma16(ldsfrag(lds + OFF_K + (16 * wid + r) * LDB + (32 * ks + 8 * q) * 2), ldsfrag(lds + OFF_VT + (16 * nt + r) * LDB + (32 * ks + 8 * q) * 2), a1);
                        a2 = mfma16(qf[ks], ldsfrag(lds + OFF_CT + (16 * nt + r) * LDB + (32 * ks + 8 * q) * 2), a2);
                    }
#pragma unroll
                    for (int reg = 0; reg < 4; ++reg) {
                        const int t = 16 * wid + 4 * q + reg;
                        const float den = rs[reg] + it4[reg] * qn4[reg];
                        const float hv = (a1[reg] + it4[reg] * a2[reg]) / fmaxf(fabsf(den), en4[reg]);
                        Hdir[((size_t)dir * MT + rbase + t) * 512 + h * 128 + es * 32 + 16 * nt + r] = f2bf(hv);
                    }
                }
            }
            asm volatile("" ::: "memory");
            if (ci + 1 < 18) MLSTM_PREFETCH(ci + 1);
            asm volatile("" ::: "memory");
            {
                bf16x8 kf[4];
#pragma unroll
                for (int ks = 0; ks < 4; ++ks) kf[ks] = ldsfrag(lds + OFF_KT + (16 * wid + r) * LDB + (32 * ks + 8 * q) * 2);
#pragma unroll
                for (int nt = 0; nt < 2; ++nt) {
                    Cacc[nt] = Cacc[nt] * dec;
#pragma unroll
                    for (int ks = 0; ks < 4; ++ks) Cacc[nt] = mfma16(kf[ks], ldsfrag(lds + OFF_VW + (16 * nt + r) * LDB + (32 * ks + 8 * q) * 2), Cacc[nt]);
                }
            }
            float nnew;
            {
                const int d = tid >> 2, part = tid & 3; float s = 0.f;
#pragma unroll
                for (int i = 0; i < 4; ++i) {
                    const u32x4 kv = *(const LAS u32x4*)(Kt + d * LD + part * 32 + i * 8);
                    const f32x4 w0 = *(const LAS f32x4*)(wl + part * 32 + i * 8), w1 = *(const LAS f32x4*)(wl + part * 32 + i * 8 + 4);
                    s += bflo(kv[0]) * w0[0] + bfhi(kv[0]) * w0[1] + bflo(kv[1]) * w0[2] + bfhi(kv[1]) * w0[3] + bflo(kv[2]) * w1[0] + bfhi(kv[2]) * w1[1] + bflo(kv[3]) * w1[2] + bfhi(kv[3]) * w1[3];
                }
                s += __shfl_xor(s, 1); s += __shfl_xor(s, 2);
                nnew = dec * nvec[d] + s;
            }
            __syncthreads();
#pragma unroll
            for (int nt = 0; nt < 2; ++nt) { u32x2 w; w.x = pk2(Cacc[nt][0], Cacc[nt][1]); w.y = pk2(Cacc[nt][2], Cacc[nt][3]); *(LAS u32x2*)(Ct + (16 * nt + r) * LD + 16 * wid + 4 * q) = w; }
            if ((tid & 3) == 0) nvec[tid >> 2] = nnew;
        }
        __syncthreads();
    }
}

__device__ __forceinline__ void sgu_phase(LAS unsigned char* lds, const bf16_t* P, const float* sgu_norm, const float* sgu_ws, const float* sgu_b, bf16_t* A1) {
    int tid_ = threadIdx.x; asm volatile("" : "+v"(tid_)); const int tid = tid_, lane = tid & 63, wid = __builtin_amdgcn_readfirstlane(tid >> 6), r = lane & 15, q = lane >> 4;
    constexpr int LD = 136, LDB = LD * 2, OFF_W = 0, OFF_V = 34816, OFF_R = 69632;
    LAS bf16_t* Ws = (LAS bf16_t*)(lds + OFF_W); LAS bf16_t* Vt = (LAS bf16_t*)(lds + OFF_V); LAS float* rstd = (LAS float*)(lds + OFF_R);
    for (int unit = blockIdx.x; unit < 576; unit += gridDim.x) {
        const int g = unit & 3, n = (unit >> 2) % 18, b = unit / 72;
        const int rbase = n < 2 ? MX + b * CTXL + n * 128 : b * SEQ + (n - 2) * 128;
        {
            const int tok = tid >> 2, part = tid & 3; float ss = 0.f;
            const bf16_t* pv = P + (size_t)(rbase + tok) * NEV + 2560 + part * 128;
#pragma unroll 4
            for (int i = 0; i < 16; ++i) { const u32x4 w = *(const u32x4*)(pv + i * 8);
#pragma unroll
                for (int k = 0; k < 4; ++k) { const float a0 = gelu_tanh(bflo(w[k])), a1 = gelu_tanh(bfhi(w[k])); ss += a0 * a0 + a1 * a1; } }
            ss += __shfl_xor(ss, 1); ss += __shfl_xor(ss, 2);
            if (part == 0) rstd[tok] = 1.0f / sqrtf(ss * (1.f / 512.f) + EPS);
        }
#pragma unroll
        for (int it = 0; it < 4; ++it) { const int i = tid + NTHREADS * it; const int p = i >> 4, sg = i & 15;
            const float* wp = sgu_ws + ((size_t)g * 128 + p) * 128 + sg * 8; const f32x4 w0 = *(const f32x4*)wp, w1 = *(const f32x4*)(wp + 4);
            u32x4 o; o.x = pk2(w0[0], w0[1]); o.y = pk2(w0[2], w0[3]); o.z = pk2(w1[0], w1[1]); o.w = pk2(w1[2], w1[3]);
            *(LAS u32x4*)(Ws + p * LD + sg * 8) = o; }
        __syncthreads();
#pragma unroll
        for (int it = 0; it < 4; ++it) { const int i = tid + NTHREADS * it; const int tq = i >> 4, sg = i & 15;
            const u32x4 w = *(const u32x4*)(P + (size_t)(rbase + tq) * NEV + 2560 + g * 128 + sg * 8);
            const float rq = rstd[tq];
            const f32x4 g0 = *(const f32x4*)(sgu_norm + g * 128 + sg * 8), g1 = *(const f32x4*)(sgu_norm + g * 128 + sg * 8 + 4);
            Vt[(sg * 8 + 0) * LD + tq] = f2bf(gelu_tanh(bflo(w[0])) * rq * g0[0]); Vt[(sg * 8 + 1) * LD + tq] = f2bf(gelu_tanh(bfhi(w[0])) * rq * g0[1]);
            Vt[(sg * 8 + 2) * LD + tq] = f2bf(gelu_tanh(bflo(w[1])) * rq * g0[2]); Vt[(sg * 8 + 3) * LD + tq] = f2bf(gelu_tanh(bfhi(w[1])) * rq * g0[3]);
            Vt[(sg * 8 + 4) * LD + tq] = f2bf(gelu_tanh(bflo(w[2])) * rq * g1[0]); Vt[(sg * 8 + 5) * LD + tq] = f2bf(gelu_tanh(bfhi(w[2])) * rq * g1[1]);
            Vt[(sg * 8 + 6) * LD + tq] = f2bf(gelu_tanh(bflo(w[3])) * rq * g1[2]); Vt[(sg * 8 + 7) * LD + tq] = f2bf(gelu_tanh(bfhi(w[3])) * rq * g1[3]); }
        __syncthreads();
        {
            bf16x8 af[4];
#pragma unroll
            for (int ks = 0; ks < 4; ++ks) af[ks] = ldsfrag(lds + OFF_W + (16 * wid + r) * LDB + (32 * ks + 8 * q) * 2);
            const f32x4 sb4 = *(const f32x4*)(sgu_b + g * 128 + 16 * wid + 4 * q);
#pragma unroll
            for (int jb = 0; jb < 8; ++jb) {
                f32x4 acc = (f32x4){0.f, 0.f, 0.f, 0.f};
#pragma unroll
                for (int ks = 0; ks < 4; ++ks) acc = mfma16(af[ks], ldsfrag(lds + OFF_V + (16 * jb + r) * LDB + (32 * ks + 8 * q) * 2), acc);
#pragma unroll
                for (int reg = 0; reg < 4; ++reg) { const int p = 16 * wid + 4 * q + reg; const size_t R = (size_t)(rbase + p);
                    const float uu = gelu_tanh(bf2f(P[R * NEV + 2048 + g * 128 + 16 * jb + r]));
                    A1[R * D + 512 + g * 128 + 16 * jb + r] = f2bf(uu * (acc[reg] + sb4[reg])); }
            }
        }
        __syncthreads();
    }
}

__device__ __forceinline__ void combine_phase(const bf16_t* Hdir, const bf16_t* P, const float* mnorm, bf16_t* A1) {
    int tid_ = threadIdx.x; asm volatile("" : "+v"(tid_)); const int tid = tid_, lane = tid & 63, wid = __builtin_amdgcn_readfirstlane(tid >> 6);
    for (int R = blockIdx.x * 8 + wid; R < MT; R += gridDim.x * 8) {
        const int col = lane * 8;
        const u32x4 h0 = *(const u32x4*)(Hdir + (size_t)R * 512 + col), h1 = *(const u32x4*)(Hdir + ((size_t)MT + R) * 512 + col);
        float a[8];
#pragma unroll
        for (int k = 0; k < 4; ++k) { a[2 * k] = bflo(h0[k]) + bflo(h1[k]); a[2 * k + 1] = bfhi(h0[k]) + bfhi(h1[k]); }
        float ss = 0.f;
#pragma unroll
        for (int k = 0; k < 8; ++k) ss += a[k] * a[k];
        ss += __shfl_xor(ss, 1); ss += __shfl_xor(ss, 2); ss += __shfl_xor(ss, 4); ss += __shfl_xor(ss, 8);
        const float rstd = 1.0f / sqrtf(ss * (1.f / 128.f) + EPS);
        const f32x4 m0 = *(const f32x4*)(mnorm + col), m1 = *(const f32x4*)(mnorm + col + 4);
        const u32x4 ov = *(const u32x4*)(P + (size_t)R * NEV + 1536 + col);
        u32x4 w;
        w.x = pk2(sigmoid_f(bflo(ov[0])) * a[0] * rstd * m0[0], sigmoid_f(bfhi(ov[0])) * a[1] * rstd * m0[1]);
        w.y = pk2(sigmoid_f(bflo(ov[1])) * a[2] * rstd * m0[2], sigmoid_f(bfhi(ov[1])) * a[3] * rstd * m0[3]);
        w.z = pk2(sigmoid_f(bflo(ov[2])) * a[4] * rstd * m1[0], sigmoid_f(bfhi(ov[2])) * a[5] * rstd * m1[1]);
        w.w = pk2(sigmoid_f(bflo(ov[3])) * a[6] * rstd * m1[2], sigmoid_f(bfhi(ov[3])) * a[7] * rstd * m1[3]);
        *(u32x4*)(A1 + (size_t)R * D + col) = w;
    }
}

__device__ __forceinline__ void attn_phase(LAS unsigned char* lds, const bf16_t* QKV, const float* sink, bf16_t* A1) {
    int tid_ = threadIdx.x; asm volatile("" : "+v"(tid_)); const int tid = tid_, lane = tid & 63, wid = __builtin_amdgcn_readfirstlane(tid >> 6), r = lane & 15, q = lane >> 4;
    constexpr int LK = 72, LKB = LK * 2, OFF_K = 0, OFF_V = 9216, OFF_P = 18432, PSZ = 64 * LKB;
    LAS bf16_t* Ks = (LAS bf16_t*)(lds + OFF_K); LAS bf16_t* Vt = (LAS bf16_t*)(lds + OFF_V);
    LAS bf16_t* Ps = (LAS bf16_t*)(lds + OFF_P + wid * PSZ);
    const LAS unsigned char* Pb = lds + OFF_P + wid * PSZ;
    for (int unit = blockIdx.x; unit < 512; unit += gridDim.x) {
        const int hk = unit & 3, j = (unit >> 2) & 15, b = unit >> 6;
        const int g = wid >> 1, hq = hk * 4 + g, tok0 = (wid & 1) * 64;
        const int qrow0 = b * SEQ + j * 128 + tok0;
        bf16x8 qf[4][2];
#pragma unroll
        for (int mt = 0; mt < 4; ++mt)
#pragma unroll
            for (int ks = 0; ks < 2; ++ks) qf[mt][ks] = *(const bf16x8*)(QKV + (size_t)(qrow0 + 16 * mt + r) * NQKV + hq * 64 + 32 * ks + 8 * q);
        float mrun[4][4], lrun[4][4]; f32x4 oacc[4][4];
        const float sk = sink[hq];
#pragma unroll
        for (int mt = 0; mt < 4; ++mt)
#pragma unroll
            for (int i = 0; i < 4; ++i) { mrun[mt][i] = sk; lrun[mt][i] = 1.f; oacc[mt][i] = (f32x4){0.f, 0.f, 0.f, 0.f}; }
        for (int ti = 0; ti < 10; ++ti) {
            int krow0, kpos0; bool band;
            if (ti < 4) { krow0 = MX + b * CTXL + ti * 64; kpos0 = 0; band = false; }
            else { const int kb = j - 1 + ((ti - 4) >> 1); if (kb < 0 || kb > 15) continue; kpos0 = kb * 128 + ((ti - 4) & 1) * 64; krow0 = b * SEQ + kpos0; band = (kb != j); }
            __syncthreads();
            {
                const int key = tid >> 3, sg = tid & 7;
                const bf16_t* kp = QKV + (size_t)(krow0 + key) * NQKV + 1024 + hk * 64 + sg * 8;
                const u32x4 kv = *(const u32x4*)kp; const u32x4 vv = *(const u32x4*)(kp + 256);
                *(LAS u32x4*)(Ks + key * LK + sg * 8) = kv;
#pragma unroll
                for (int w2 = 0; w2 < 4; ++w2) { Vt[(sg * 8 + 2 * w2) * LK + key] = (bf16_t)(vv[w2] & 0xffffu); Vt[(sg * 8 + 2 * w2 + 1) * LK + key] = (bf16_t)(vv[w2] >> 16); }
            }
            __syncthreads();
#pragma unroll
            for (int mt = 0; mt < 4; ++mt) {
                f32x4 s[4];
#pragma unroll
                for (int nt = 0; nt < 4; ++nt) {
                    const bf16x8 k0 = ldsfrag(lds + OFF_K + (16 * nt + r) * LKB + (8 * q) * 2), k1 = ldsfrag(lds + OFF_K + (16 * nt + r) * LKB + (32 + 8 * q) * 2);
                    f32x4 a = (f32x4){0.f, 0.f, 0.f, 0.f}; a = mfma16(qf[mt][0], k0, a); a = mfma16(qf[mt][1], k1, a); s[nt] = a;
                }
                if (band) {
#pragma unroll
                    for (int nt = 0; nt < 4; ++nt)
#pragma unroll
                        for (int i = 0; i < 4; ++i) { const int qp = j * 128 + tok0 + 16 * mt + 4 * q + i, kp = kpos0 + 16 * nt + r; const int df = qp - kp;
                            if (df > 128 || df < -128) s[nt][i] = -1e30f; }
                }
#pragma unroll
                for (int i = 0; i < 4; ++i) {
                    float mx = fmaxf(fmaxf(s[0][i], s[1][i]), fmaxf(s[2][i], s[3][i]));
                    mx = fmaxf(mx, __shfl_xor(mx, 1)); mx = fmaxf(mx, __shfl_xor(mx, 2)); mx = fmaxf(mx, __shfl_xor(mx, 4)); mx = fmaxf(mx, __shfl_xor(mx, 8));
                    const float mn = fmaxf(mrun[mt][i], mx), alpha = __expf(mrun[mt][i] - mn);
                    float rsum = 0.f;
#pragma unroll
                    for (int nt = 0; nt < 4; ++nt) { const float p = __expf(s[nt][i] - mn); rsum += p; Ps[(16 * mt + 4 * q + i) * LK + 16 * nt + r] = f2bf(p); }
                    rsum += __shfl_xor(rsum, 1); rsum += __shfl_xor(rsum, 2); rsum += __shfl_xor(rsum, 4); rsum += __shfl_xor(rsum, 8);
                    lrun[mt][i] = lrun[mt][i] * alpha + rsum; mrun[mt][i] = mn;
#pragma unroll
                    for (int nt = 0; nt < 4; ++nt) oacc[mt][nt][i] *= alpha;
                }
                asm volatile("" ::: "memory");
            }
#pragma unroll
            for (int nt = 0; nt < 4; ++nt) {
                const bf16x8 v0 = ldsfrag(lds + OFF_V + (16 * nt + r) * LKB + (8 * q) * 2), v1 = ldsfrag(lds + OFF_V + (16 * nt + r) * LKB + (32 + 8 * q) * 2);
#pragma unroll
                for (int mt = 0; mt < 4; ++mt) {
                    oacc[mt][nt] = mfma16(ldsfrag(Pb + (16 * mt + r) * LKB + (8 * q) * 2), v0, oacc[mt][nt]);
                    oacc[mt][nt] = mfma16(ldsfrag(Pb + (16 * mt + r) * LKB + (32 + 8 * q) * 2), v1, oacc[mt][nt]);
                }
            }
        }
#pragma unroll
        for (int mt = 0; mt < 4; ++mt)
#pragma unroll
            for (int i = 0; i < 4; ++i) { const float inv = 1.f / lrun[mt][i]; const size_t R = (size_t)(qrow0 + 16 * mt + 4 * q + i);
#pragma unroll
                for (int nt = 0; nt < 4; ++nt) A1[R * D + hq * 64 + 16 * nt + r] = f2bf(oacc[mt][nt][i] * inv); }
    }
    __syncthreads();
}

__device__ __forceinline__ void final_phase(float* out, const float* fnorm) {
    int tid_ = threadIdx.x; asm volatile("" : "+v"(tid_)); const int tid = tid_, lane = tid & 63, wid = __builtin_amdgcn_readfirstlane(tid >> 6);
    for (int R = blockIdx.x * 8 + wid; R < MX; R += gridDim.x * 8) {
        float* src = out + (size_t)R * D;
        f32x4 v[4]; float ss = 0.f;
#pragma unroll
        for (int j = 0; j < 4; ++j) { v[j] = *(const f32x4*)(src + 256 * j + 4 * lane); ss += (v[j][0] * v[j][0] + v[j][1] * v[j][1]) + (v[j][2] * v[j][2] + v[j][3] * v[j][3]); }
        const float rstd = 1.0f / sqrtf(wave_sum(ss) * (1.f / D) + EPS);
#pragma unroll
        for (int j = 0; j < 4; ++j) { const f32x4 w = *(const f32x4*)(fnorm + 256 * j + 4 * lane); *(f32x4*)(src + 256 * j + 4 * lane) = v[j] * rstd * w; }
    }
}

#define GAS __attribute__((address_space(1)))
typedef GAS unsigned gu32;
#define RLX_AGENT __ATOMIC_RELAXED, __HIP_MEMORY_SCOPE_AGENT
#define XB_TMO      128
#define XB_XCNT(j)  (256  + 64 * (j))
#define XB_XSUB(j)  (1280 + 64 * (j))
#define XB_XGEN(j)  (2304 + 64 * (j))
#define XB_TOP      3328
#define XB_TOPGEN   3392
#define XCD_BAR_WORDS 3456
#define XB_SPIN_CAP (1u << 18)

__device__ __forceinline__ unsigned xb_ld(unsigned* p)              { return __hip_atomic_load(p, __ATOMIC_RELAXED, __HIP_MEMORY_SCOPE_AGENT); }
__device__ __forceinline__ unsigned xb_add(unsigned* p, unsigned v) { return __hip_atomic_fetch_add(p, v, __ATOMIC_RELAXED, __HIP_MEMORY_SCOPE_AGENT); }
__device__ __forceinline__ unsigned xb_xcc_id() { return (unsigned)__builtin_amdgcn_s_getreg((3 << 11) | 20) & 0xFu; }
#define XB_SPIN(cond, bar) do { unsigned _sp = 0; while (cond) { __builtin_amdgcn_s_sleep(1); \
    if ((++_sp & 255u) == 0u) { if (xb_ld(&(bar)[XB_TMO])) break; if (_sp > XB_SPIN_CAP) { atomicAdd(&(bar)[XB_TMO], 1u); break; } } } } while (0)

struct XcdBarrier {
    unsigned* bar; unsigned x;
    volatile LAS unsigned* st;
};

__device__ __forceinline__ XcdBarrier xcd_barrier_post(unsigned* bar, volatile LAS unsigned* st) {
    XcdBarrier b; b.bar = bar; b.x = xb_xcc_id(); b.st = st;
    if (threadIdx.x == 0) (void)xb_add(&bar[XB_XCNT(b.x)], 1u);
    return b;
}
__device__ __forceinline__ void xcd_barrier_complete(unsigned* bar, unsigned x, unsigned& nloc, unsigned& nx) {
    const unsigned G = gridDim.x * gridDim.y * gridDim.z;
    unsigned sum, cnt, mine, sp = 0u;
    for (;;) {
        sum = 0u; cnt = 0u;
#pragma unroll 1
        for (unsigned j = 0; j < 16; ++j) { const unsigned c = xb_ld(&bar[XB_XCNT(j)]); sum += c; cnt += (c > 0u) ? 1u : 0u; }
        mine = xb_ld(&bar[XB_XCNT(x)]);
        if (sum == G) break;
        __builtin_amdgcn_s_sleep(1);
        if ((++sp & 255u) == 0u) { if (xb_ld(&bar[XB_TMO])) break; if (sp > XB_SPIN_CAP) { atomicAdd(&bar[XB_TMO], 1u); break; } }
    }
    nloc = mine > 0u ? mine : 1u; nx = cnt > 0u ? cnt : 1u;
}

__device__ __forceinline__ void xcd_barrier(const XcdBarrier& b) {
    asm volatile("s_waitcnt vmcnt(0)" ::: "memory");
    __syncthreads();
    if (threadIdx.x == 0) {
        unsigned* bar = b.bar;
        __builtin_amdgcn_s_waitcnt(0);
        unsigned nloc = b.st[0], nx = b.st[1];
        if (nloc == 0u) { xcd_barrier_complete(bar, b.x, nloc, nx); b.st[0] = nloc; b.st[1] = nx; }
        const unsigned old = xb_add(&bar[XB_XSUB(b.x)], 1u);
        const unsigned gen = old / nloc;
        if (old + 1u == (gen + 1u) * nloc) {
            __builtin_amdgcn_fence(__ATOMIC_RELEASE, "agent");
            asm volatile("s_waitcnt vmcnt(0)" ::: "memory");
            const unsigned og = xb_add(&bar[XB_TOP], 1u);
            const unsigned tg = og / nx;
            if (og + 1u == (tg + 1u) * nx) xb_add(&bar[XB_TOPGEN], 1u);
            else XB_SPIN(xb_ld(&bar[XB_TOPGEN]) == tg, bar);
            __builtin_amdgcn_fence(__ATOMIC_ACQUIRE, "agent");
            xb_add(&bar[XB_XGEN(b.x)], 1u);
            asm volatile("s_waitcnt vmcnt(0)" ::: "memory");
        } else {
            XB_SPIN(xb_ld(&bar[XB_XGEN(b.x)]) == gen, bar);
            __builtin_amdgcn_fence(__ATOMIC_ACQUIRE, "agent");
            asm volatile("s_waitcnt vmcnt(0)" ::: "memory");
        }
    }
    __syncthreads();
}

#ifndef MK_SINGLE
#define MK_SINGLE 1
#endif
constexpr int NPHASES = 24;
#ifndef EN_PREP
#define EN_PREP 1
#endif
#ifndef REP_MASK
#define REP_MASK 0
#endif
#ifndef USE_CG_FIRST
#define USE_CG_FIRST 0
#endif
#ifndef NSYNC_REP
#define NSYNC_REP 1
#endif
#ifndef EN_ALL
#define EN_ALL 1
#endif
#ifndef EN_P0
#define EN_P0 EN_ALL
#endif
#ifndef EN_NORM
#define EN_NORM EN_ALL
#endif
#ifndef EN_GEMM
#define EN_GEMM (EN_ALL ? 15 : 0)
#endif
#ifndef EN_MLSTM
#define EN_MLSTM EN_ALL
#endif
#ifndef EN_SGU
#define EN_SGU EN_ALL
#endif
#ifndef EN_COMB
#define EN_COMB EN_ALL
#endif
#ifndef EN_ATTN
#define EN_ATTN EN_ALL
#endif
#ifndef EN_FINAL
#define EN_FINAL EN_ALL
#endif
__global__ void __launch_bounds__(NTHREADS, 2) fwd_kernel(Args a_unused) {
    extern __shared__ __attribute__((aligned(16))) unsigned char lds_raw[];
    LAS unsigned char* lds = (LAS unsigned char*)lds_raw;
    cg::grid_group grid = cg::this_grid();
    unsigned char* ws = KA(ws);
    const int G = gridDim.x, c = blockIdx.x;
    float* Hx = KA(out); float* Hc = (float*)(ws + WS_HC);
    bf16_t* A0 = (bf16_t*)(ws + WS_A0); bf16_t* A1 = (bf16_t*)(ws + WS_A1); bf16_t* BIG = (bf16_t*)(ws + WS_BIG);
    bf16_t* Hdir = (bf16_t*)(ws + WS_A0);
    const float* mod = (const float*)(ws + WS_MOD);
    float* gates = (float*)(ws + WS_GATES);
    const int lo = KA(ph_lo), hi = KA(ph_hi);
    volatile LAS unsigned* barst = (volatile LAS unsigned*)(lds + LDS_BYTES - 16);
    if (threadIdx.x < 2) barst[threadIdx.x] = 0u;
    __syncthreads();
    XcdBarrier bar = xcd_barrier_post((unsigned*)(ws + WS_CTL), barst);
    enum { K_P0, K_NORM, K_NORMG, K_SWIGLU, K_RESID, K_PLAIN, K_QKV, K_MIX0, K_COMB, K_ATTN, K_FINAL, K_PREP };
    for (int ph = lo; ph < hi; ++ph) {
        const int layer = ph >= 13 ? 1 : 0;
        const int lp = ph >= 13 ? ph - 13 : ph - 1;
        const float* modl = mod + (size_t)layer * 9 * 9216;
        int kind = K_P0, M = MT, gi = 0, ffn = 0, Kd = 1024; float coef = 1.f;
        const bf16_t* Aop = A0; const bf16_t* Wop = nullptr;
        const float* bxp = Hx; const float* bcp = Hc;
        if (ph == 0) kind = K_P0;
        else if (ph == 23) kind = K_FINAL;
        else if (lp == 0) { kind = K_NORM; gi = 0; if (layer == 0) { bxp = KA(x); bcp = KA(ctx); } }
        else if (lp == 1) { kind = K_SWIGLU; ffn = layer * 2; }
        else if (lp == 2) { kind = K_RESID; Aop = BIG; Wop = (const bf16_t*)(ws + WS_WOUT + (size_t)(layer * 2) * SZ_WOUT); Kd = 2816; gi = 2; coef = 0.5f; if (layer == 0) { bxp = KA(x); bcp = KA(ctx); } }
        else if (layer == 0) {
            if (lp == 3) { kind = K_NORMG; gi = 3; }
            else if (lp == 4) kind = K_PLAIN;
            else if (lp == 5) kind = K_PREP;
            else if (lp == 6) kind = K_MIX0;
            else if (lp == 7) kind = K_COMB;
            else if (lp == 8) { kind = K_RESID; Aop = A1; Wop = (const bf16_t*)(ws + WS_WEOUT); gi = 5; }
            else if (lp == 9) { kind = K_NORM; gi = 6; }
            else if (lp == 10) { kind = K_SWIGLU; ffn = 1; }
            else { kind = K_RESID; Aop = BIG; Wop = (const bf16_t*)(ws + WS_WOUT + SZ_WOUT); Kd = 2816; gi = 8; coef = 0.5f; }
        } else {
            if (lp == 3) { kind = K_NORM; gi = 3; }
            else if (lp == 4) kind = K_QKV;
            else if (lp == 5) kind = K_ATTN;
            else if (lp == 6) { kind = K_RESID; Aop = A1; Wop = (const bf16_t*)(ws + WS_WOOUT); gi = 5; M = MX; }
            else if (lp == 7) { kind = K_NORM; gi = 6; M = MX; }
            else if (lp == 8) { kind = K_SWIGLU; ffn = 3; M = MX; }
            else { kind = K_RESID; Aop = BIG; Wop = (const bf16_t*)(ws + WS_WOUT + 3 * SZ_WOUT); Kd = 2816; gi = 8; coef = 0.5f; M = MX; }
        }
        const int nrep = ((REP_MASK >> kind) & 1) ? 2 : 1;
        for (int rep = 0; rep < nrep; ++rep) {
        if (rep == 1) { if (kind == K_RESID) { bxp = Hx; bcp = Hc; coef = 0.f; } __syncthreads(); }
        if (kind == K_P0) { if (EN_P0) p0_phase(lds); }
        else if (kind == K_NORM) { if (EN_NORM) norm_phase<false>(lds, bxp, bcp, A0, modl, gi, gi + 1, M, nullptr, nullptr, nullptr); }
        else if (kind == K_NORMG) { if (EN_NORM) norm_phase<true>(lds, Hx, Hc, A0, modl, gi, gi + 1, M, (const float*)(ws + WS_WG), KA(mlstm_gate_b), gates); }
        else if (kind == K_SWIGLU) { if (EN_GEMM & 1) { pg8::Gemm g{A0, (const bf16_t*)(ws + WS_WIN + (size_t)ffn * SZ_WIN), M, 5632, 1024}; pg8::StaticOrder S; S.init(M, 5632, G, c); pg8::EpiSwiglu E{BIG};
            pg8::gemm_phase<pg8::EpiSwiglu, pg8::StaticOrder, true, true>(lds, g, S, E); } }
        else if (kind == K_RESID) { if (EN_GEMM & 2) { pg8::Gemm g{Aop, Wop, M, 1024, Kd}; pg8::StaticOrder S; S.init(M, 1024, G, c); pg8::EpiResid E{bxp, bcp, Hx, Hc, modl + gi * 1024, coef};
            pg8::gemm_phase<pg8::EpiResid, pg8::StaticOrder, true, true>(lds, g, S, E); } }
        else if (kind == K_PLAIN) { if (EN_GEMM & 4) { pg8::Gemm g{A0, (const bf16_t*)(ws + WS_WEIN), MT, NEV, 1024}; pg8::StaticOrder S; S.init(MT, NEV, G, c); pg8::EpiPlain E{BIG, NEV};
            pg8::gemm_phase<pg8::EpiPlain, pg8::StaticOrder, true, true>(lds, g, S, E); } }
        else if (kind == K_QKV) { if (EN_GEMM & 8) { pg8::Gemm g{A0, (const bf16_t*)(ws + WS_WQKV), MT, NQKV, 1024}; pg8::StaticOrder S; S.init(MT, NQKV, G, c); pg8::EpiQKV E{BIG, (const float*)(ws + WS_ROPE)};
            pg8::gemm_phase<pg8::EpiQKV, pg8::StaticOrder, true, true>(lds, g, S, E); } }
        else if (kind == K_PREP) { if (EN_MLSTM && EN_PREP) qkprep_phase(lds, BIG, KA(mlstm_conv), (bf16_t*)(ws + WS_QC), (bf16_t*)(ws + WS_KC), (bf16_t*)(ws + WS_KCT)); if (EN_SGU) sgu_phase(lds, BIG, KA(sgu_norm), KA(sgu_ws), KA(sgu_b), A1); }
        else if (kind == K_MIX0) { if (EN_MLSTM) mlstm_phase(lds, BIG, gates, (const bf16_t*)(ws + WS_QC), (const bf16_t*)(ws + WS_KC), (const bf16_t*)(ws + WS_KCT), Hdir); }
        else if (kind == K_COMB) { if (EN_COMB) combine_phase(Hdir, BIG, KA(mlstm_norm), A1); }
        else if (kind == K_ATTN) { if (EN_ATTN) attn_phase(lds, BIG, KA(attn_sink), A1); }
        else { if (EN_FINAL) final_phase(Hx, KA(final_norm)); }
        }
        if (ph + 1 < hi) {
            if (ph == 0 && USE_CG_FIRST) {
                __syncthreads();
                if (threadIdx.x < 64) { __builtin_amdgcn_fence(__ATOMIC_RELEASE, "agent"); asm volatile("s_waitcnt vmcnt(0)" ::: "memory"); }
                grid.sync();
                if (threadIdx.x < 64) { __builtin_amdgcn_fence(__ATOMIC_ACQUIRE, "agent"); asm volatile("s_waitcnt vmcnt(0)" ::: "memory"); }
                __syncthreads();
            } else {
                for (int srep = 0; srep < NSYNC_REP; ++srep) xcd_barrier(bar);
            }
        }
    }
}

extern "C" void kernel_launch(void* const* d_in, const int* in_sizes, int n_in, void* d_out, int out_size, void* d_ws, size_t ws_size, hipStream_t stream) {
    static int grid = 0;
    if (grid == 0) {
        if (n_in != 20 || out_size != MX * D || ws_size < WS_END) { fprintf(stderr, "kernel_launch: unexpected problem (n_in %d out %d ws %zu need %zu)\n", n_in, out_size, ws_size, (size_t)WS_END); grid = -1; return; }
        int dev = 0, cus = 0, per_cu = 0;
        hipGetDevice(&dev);
        hipDeviceGetAttribute(&cus, hipDeviceAttributeMultiprocessorCount, dev);
        hipFuncSetAttribute((const void*)fwd_kernel, hipFuncAttributeMaxDynamicSharedMemorySize, LDS_BYTES);
        hipOccupancyMaxActiveBlocksPerMultiprocessor(&per_cu, (const void*)fwd_kernel, NTHREADS, LDS_BYTES);
        if (per_cu < 1) { fprintf(stderr, "kernel_launch: occupancy query says %d blocks per CU\n", per_cu); grid = -1; return; }
        grid = cus;
    }
    if (grid < 0) return;
    if (hipMemsetAsync((char*)d_ws + WS_CTL, 0, CTL_BYTES, stream) != hipSuccess) { fprintf(stderr, "kernel_launch: memset failed\n"); return; }
    Args a{};
#ifdef DBG_MEMSET
    hipMemsetAsync(d_ws, 0, WS_END, stream); hipMemsetAsync(d_out, 0, (size_t)out_size * 4, stream);
#endif
    a.x = (const float*)d_in[0]; a.c = (const float*)d_in[1]; a.ctx = (const float*)d_in[2]; a.c_ctx = (const float*)d_in[3]; a.ada_w = (const float*)d_in[4]; a.ada_b = (const float*)d_in[5];
    a.ffn_w_in = (const float*)d_in[6]; a.ffn_w_out = (const float*)d_in[7]; a.even_w_in = (const float*)d_in[8]; a.even_w_out = (const float*)d_in[9];
    a.mlstm_conv = (const float*)d_in[10]; a.mlstm_gate_b = (const float*)d_in[11]; a.mlstm_norm = (const float*)d_in[12]; a.sgu_norm = (const float*)d_in[13]; a.sgu_ws = (const float*)d_in[14]; a.sgu_b = (const float*)d_in[15];
    a.odd_w_qkv = (const float*)d_in[16]; a.odd_w_out = (const float*)d_in[17]; a.attn_sink = (const float*)d_in[18]; a.final_norm = (const float*)d_in[19];
    a.out = (float*)d_out; a.ws = (unsigned char*)d_ws;
#if MK_SINGLE
    a.ph_lo = 0; a.ph_hi = NPHASES;
    { void* args[] = {&a}; hipError_t e = hipLaunchCooperativeKernel((const void*)fwd_kernel, dim3(grid), dim3(NTHREADS), args, LDS_BYTES, stream);
      if (e != hipSuccess) fprintf(stderr, "cooperative launch failed: %s\n", hipGetErrorString(e)); }
#else
    for (int p = 0; p < NPHASES; ++p) { a.ph_lo = p; a.ph_hi = p + 1; void* args[] = {&a};
        hipError_t e = hipLaunchCooperativeKernel((const void*)fwd_kernel, dim3(grid), dim3(NTHREADS), args, LDS_BYTES, stream);
        if (e != hipSuccess) { fprintf(stderr, "launch %d failed: %s\n", p, hipGetErrorString(e)); break; } }
#endif
}
```

```cpp
#include <hip/hip_runtime.h>
#include <hip/hip_cooperative_groups.h>
#include <cstdio>
#include <cstdint>
namespace cg = cooperative_groups;
namespace pg8 {
#define PG8_LAS __attribute__((address_space(3)))
typedef unsigned short bf16_t;
typedef short bf16x8 __attribute__((ext_vector_type(8)));
typedef float f32x4 __attribute__((ext_vector_type(4)));
typedef unsigned u32x4 __attribute__((ext_vector_type(4)));
constexpr int BM = 256, BK = 64, HALF = 128, HTB = HALF * BK * 2  , STAGE_BYTES = 8 * HTB, NXCD = 8, WGM = 8;

__host__ __device__ __forceinline__ int lds_byte(int r, int c) { const int st = (r >> 4) * 2 + (c >> 5), rr = r & 15, cc = c & 31, ob = rr * 64 + cc * 2; return st * 1024 + (ob ^ (((ob >> 9) & 1) << 5)); }
__host__ __device__ __forceinline__ void stage_rc(int b, int& R, int& C) { const int st = b / 1024, sb = b % 1024, swz = sb ^ (((sb >> 9) & 1) << 5); R = (st >> 1) * 16 + swz / 64; C = (st & 1) * 32 + (swz % 64) / 2; }
__host__ __device__ __forceinline__ int perm32(int rho) { const int n = rho >> 4, i = rho & 15; return 8 * (i >> 2) + 4 * n + (i & 3); }

struct Unit { int pm, pn, k0, nt; };
struct Gemm { const bf16_t* A; const bf16_t* Bt; int M, N, K; };

struct StaticOrder {
    int nM, nN, nwg, G, c, ntf;
    __host__ __device__ void init(int M, int N, int G_, int c_, int K_) { nM = M / BM; nN = N / BM; nwg = nM * nN; G = G_; c = c_; ntf = K_ / BK; }
    __host__ __device__ __forceinline__ bool next(int i, Unit& u) const {
        const long L = (long)i * G + c; if (L >= nwg) return false;
        int wgid = (int)L; { const int q = nwg / NXCD, r = nwg % NXCD, xcd = wgid % NXCD, off = wgid / NXCD; wgid = (xcd < r ? xcd * (q + 1) : r * (q + 1) + (xcd - r) * q) + off; }
        const int nig = WGM * nN, gid = wgid / nig, fm = gid * WGM, gsz = (nM - fm) < WGM ? (nM - fm) : WGM;
        u.pm = fm + ((wgid % nig) % gsz); u.pn = (wgid % nig) / gsz; u.k0 = 0; u.nt = ntf; return true;
    }
    __device__ __forceinline__ void a_ready(const Unit&) const {}
    __device__ __forceinline__ void done(const Unit&) const {}
};

struct SplitCtxOrder {
    int nN, G, c, ntf, nctx;
    __host__ __device__ void init(int N, int G_, int c_, int K_, int nctx_) { nN = N / BM; G = G_; c = c_; ntf = K_ / BK; nctx = nctx_; }
    __host__ __device__ __forceinline__ bool next(int i, Unit& u) const {
        const int L = i * G + c, nwg = 64 * nN;
        if (L >= nwg + nctx) return false;
        int wgid = L < nwg ? L : 0; { const int q = nwg / NXCD, xcd = wgid % NXCD, off = wgid / NXCD; wgid = xcd * q + off; }
        const int nig = WGM * nN, gid = wgid / nig, fm = gid * WGM;
        const int pm0 = fm + ((wgid % nig) % WGM), pn0 = (wgid % nig) / WGM;
        const int L2 = L - nwg, tt = L2 >> 1;
        const bool ctxu = L >= nwg;
        Unit r;
        r.pm = ctxu ? 64 + tt / nN : pm0; r.pn = ctxu ? tt % nN : pn0; r.nt = ctxu ? ntf / 2 : ntf; r.k0 = ctxu ? (L2 & 1) * (ntf / 2) * BK : 0;
        u = r; return true;
    }
    __device__ __forceinline__ void a_ready(const Unit&) const {}
    __device__ __forceinline__ void done(const Unit&) const {}
};

__device__ __forceinline__ unsigned cvt_pk_bf16(float lo, float hi) { unsigned r; asm volatile("v_cvt_pk_bf16_f32 %0, %1, %2" : "=v"(r) : "v"(lo), "v"(hi)); return r; }
typedef float f32x2 __attribute__((ext_vector_type(2)));
template <class Epi, class Sched, bool ALIGN_EPI = false, bool SP2 = false>
__device__ __forceinline__ void gemm_phase(PG8_LAS unsigned char* lds, const Gemm g, const Sched& S, const Epi& E) {
    int tid_ = threadIdx.x; asm volatile("" : "+v"(tid_)); const int tid = tid_, wid = __builtin_amdgcn_readfirstlane(tid >> 6), lane = tid & 63, wr = wid >> 2, wc = wid & 3, fr = lane & 15, fq = lane >> 4;
    const int K = g.K;
    unsigned voffA[2], voffB[2];
#pragma unroll
    for (int i = 0; i < 2; ++i) { int R, C; stage_rc(tid * 16 + i * 8192, R, C); const int Rb = Epi::PERM ? ((R & ~31) + perm32(R & 31)) : R;
        voffA[i] = (unsigned)(R * K + C) * 2u; voffB[i] = (unsigned)(Rb * K + C) * 2u; }
    const size_t kstep = (size_t)(BK * 2);
    const size_t hstep = (size_t)HALF * K * 2;
    const size_t tstep = 2 * hstep;
    const unsigned ldsw = (unsigned)wid * 1024u;
    const int aoff = lds_byte(wr * 64 + fr, fq * 8), boff = lds_byte(wc * 32 + fr, fq * 8);
#define PG8_SA(b, h) (((b) * 2 + (h)) * HTB)
#define PG8_SB(b, h) ((4 + (b) * 2 + (h)) * HTB)
#define PG8_STAGE(bufoff, gbase, voff) do { _Pragma("unroll") for (int _i = 0; _i < 2; ++_i) \
        __builtin_amdgcn_global_load_lds((const unsigned*)((const char*)(gbase) + (voff)[_i]), (PG8_LAS unsigned*)(lds + (bufoff) + ldsw + _i * 8192), 16, 0, 0); } while (0)
#define PG8_LDA(dst, b, h) do { _Pragma("unroll") for (int m = 0; m < 4; ++m) _Pragma("unroll") for (int k = 0; k < 2; ++k) dst[m][k] = *(const PG8_LAS bf16x8*)(lds + PG8_SA(b, h) + aoff + m * 2048 + k * 1024); } while (0)
#define PG8_LDB(dst, b, h) do { _Pragma("unroll") for (int n = 0; n < 2; ++n) _Pragma("unroll") for (int k = 0; k < 2; ++k) dst[n][k] = *(const PG8_LAS bf16x8*)(lds + PG8_SB(b, h) + boff + n * 2048 + k * 1024); } while (0)
#define PG8_MMA(ai, bj, At, Bt) do { __builtin_amdgcn_s_setprio(1); _Pragma("unroll") for (int m = 0; m < 4; ++m) _Pragma("unroll") for (int n = 0; n < 2; ++n) _Pragma("unroll") for (int k = 0; k < 2; ++k) \
        acc[ai][bj][m][n] = __builtin_amdgcn_mfma_f32_16x16x32_bf16(Bt[n][k], At[m][k], acc[ai][bj][m][n], 0, 0, 0); __builtin_amdgcn_s_setprio(0); } while (0)
#define PG8_WAIT_V(n) asm volatile("s_waitcnt vmcnt(" #n ")" ::: "memory")
#define PG8_WAIT_L(n) asm volatile("s_waitcnt lgkmcnt(" #n ")" ::: "memory")
#define PG8_BAR __builtin_amdgcn_s_barrier()
#define PG8_SCHED __builtin_amdgcn_sched_barrier(0)
    Unit cur, nxt; int ui = 0;
    if (!S.next(0, cur)) return;
    f32x4 acc[2][2][4][2];
#pragma unroll
    for (int a = 0; a < 2; ++a)
#pragma unroll
        for (int b = 0; b < 2; ++b)
#pragma unroll
            for (int m = 0; m < 4; ++m)
#pragma unroll
                for (int n = 0; n < 2; ++n) acc[a][b][m][n] = (f32x4){0.f, 0.f, 0.f, 0.f};
    bf16x8 At[4][2], B0[2][2], B1[2][2];
    const char* cA = (const char*)g.A + (size_t)cur.pm * tstep + (size_t)cur.k0 * 2; const char* cB = (const char*)g.Bt + (size_t)cur.pn * tstep + (size_t)cur.k0 * 2;
    S.a_ready(cur);
    if constexpr (SP2) {
        PG8_STAGE(PG8_SB(0, 0), cB, voffB); PG8_STAGE(PG8_SB(0, 1), cB + hstep, voffB); PG8_STAGE(PG8_SA(0, 0), cA, voffA); PG8_STAGE(PG8_SA(0, 1), cA + hstep, voffA);
        if (wr == 1) PG8_BAR;
        PG8_WAIT_V(2); PG8_BAR;
        PG8_STAGE(PG8_SB(1, 0), cB + kstep, voffB); PG8_STAGE(PG8_SA(1, 0), cA + kstep, voffA); PG8_STAGE(PG8_SB(1, 1), cB + hstep + kstep, voffB);
        PG8_WAIT_V(6); PG8_BAR;
    } else {
        PG8_STAGE(PG8_SB(0, 0), cB, voffB); PG8_STAGE(PG8_SA(0, 0), cA, voffA); PG8_STAGE(PG8_SB(0, 1), cB + hstep, voffB); PG8_STAGE(PG8_SA(0, 1), cA + hstep, voffA);
        if (wr == 1) PG8_BAR;
        PG8_WAIT_V(4); PG8_BAR;
        PG8_STAGE(PG8_SB(1, 0), cB + kstep, voffB); PG8_STAGE(PG8_SA(1, 0), cA + kstep, voffA); PG8_STAGE(PG8_SB(1, 1), cB + hstep + kstep, voffB);
        PG8_WAIT_V(6); PG8_BAR;
    }
    for (;;) {
        const bool has_next = S.next(ui + 1, nxt);
        const char* nA = has_next ? (const char*)g.A + (size_t)nxt.pm * tstep + (size_t)nxt.k0 * 2 : cA; const char* nB = has_next ? (const char*)g.Bt + (size_t)nxt.pn * tstep + (size_t)nxt.k0 * 2 : cB;
        const int nt = cur.nt;
        for (int t = 0; t < nt; t += 2) {
            const bool last = (t == nt - 2);
            const char* a1 = cA + (size_t)(t + 1) * kstep;
            const char* a2 = last ? nA : cA + (size_t)(t + 2) * kstep; const char* b2 = last ? nB : cB + (size_t)(t + 2) * kstep;
            const char* a3 = a2 + kstep; const char* b3 = b2 + kstep;
            if (last && has_next) S.a_ready(nxt);
            if constexpr (SP2) {
            PG8_LDB(B0, 0, 0); PG8_LDB(B1, 0, 1); PG8_SCHED; PG8_LDA(At, 0, 0); PG8_STAGE(PG8_SA(1, 1), a1 + hstep, voffA);
            PG8_WAIT_V(8); PG8_WAIT_L(0); PG8_BAR; PG8_MMA(0, 0, At, B0); PG8_MMA(0, 1, At, B1); PG8_BAR; PG8_SCHED;
            PG8_LDA(At, 0, 1); PG8_STAGE(PG8_SB(0, 0), b2, voffB); PG8_STAGE(PG8_SB(0, 1), b2 + hstep, voffB); PG8_STAGE(PG8_SA(0, 0), a2, voffA);
            PG8_WAIT_V(8); PG8_WAIT_L(0); PG8_BAR; PG8_MMA(1, 0, At, B0); PG8_MMA(1, 1, At, B1); PG8_BAR; PG8_SCHED;
            PG8_LDB(B0, 1, 0); PG8_LDB(B1, 1, 1); PG8_SCHED; PG8_LDA(At, 1, 0); PG8_STAGE(PG8_SA(0, 1), a2 + hstep, voffA);
            PG8_WAIT_V(8); PG8_WAIT_L(0); PG8_BAR; PG8_MMA(0, 0, At, B0); PG8_MMA(0, 1, At, B1); PG8_BAR; PG8_SCHED;
            PG8_LDA(At, 1, 1); PG8_STAGE(PG8_SB(1, 0), b3, voffB); PG8_STAGE(PG8_SB(1, 1), b3 + hstep, voffB); PG8_STAGE(PG8_SA(1, 0), a3, voffA);
            PG8_WAIT_V(8); PG8_WAIT_L(0); PG8_BAR; PG8_MMA(1, 0, At, B0); PG8_MMA(1, 1, At, B1); PG8_BAR; PG8_SCHED;
            } else {
            PG8_LDB(B0, 0, 0); PG8_SCHED; PG8_LDA(At, 0, 0); PG8_STAGE(PG8_SA(1, 1), a1 + hstep, voffA);
            PG8_WAIT_L(8); PG8_BAR; PG8_WAIT_L(0); PG8_MMA(0, 0, At, B0); PG8_BAR; PG8_SCHED;
            PG8_LDB(B1, 0, 1); PG8_STAGE(PG8_SB(0, 0), b2, voffB);
            PG8_BAR; PG8_WAIT_L(0); PG8_MMA(0, 1, At, B1); PG8_BAR;
            PG8_LDA(At, 0, 1); PG8_STAGE(PG8_SA(0, 0), a2, voffA);
            PG8_BAR; PG8_WAIT_L(0); PG8_MMA(1, 0, At, B0); PG8_BAR; PG8_SCHED;
            PG8_STAGE(PG8_SB(0, 1), b2 + hstep, voffB);
            PG8_WAIT_V(6); PG8_BAR; PG8_MMA(1, 1, At, B1); PG8_BAR;
            PG8_LDB(B0, 1, 0); PG8_SCHED; PG8_LDA(At, 1, 0); PG8_STAGE(PG8_SA(0, 1), a2 + hstep, voffA);
            PG8_WAIT_L(8); PG8_BAR; PG8_WAIT_L(0); PG8_MMA(0, 0, At, B0); PG8_BAR; PG8_SCHED;
            PG8_LDB(B1, 1, 1); PG8_STAGE(PG8_SB(1, 0), b3, voffB);
            PG8_BAR; PG8_WAIT_L(0); PG8_MMA(0, 1, At, B1); PG8_BAR;
            PG8_LDA(At, 1, 1); PG8_STAGE(PG8_SA(1, 0), a3, voffA);
            PG8_BAR; PG8_WAIT_L(0); PG8_MMA(1, 0, At, B0); PG8_BAR; PG8_SCHED;
            PG8_STAGE(PG8_SB(1, 1), b3 + hstep, voffB);
            PG8_WAIT_V(6); PG8_BAR; PG8_MMA(1, 1, At, B1); PG8_BAR;
            }
        }
        if constexpr (ALIGN_EPI) { if (wr == 0) PG8_BAR; }
        if constexpr (!Epi::AFTER_DRAIN) { E(acc, cur, wr, wc, fr, fq); S.done(cur); }
        if (!has_next) break;
#pragma unroll
        for (int a = 0; a < 2; ++a)
#pragma unroll
            for (int b = 0; b < 2; ++b)
#pragma unroll
                for (int m = 0; m < 4; ++m)
#pragma unroll
                    for (int n = 0; n < 2; ++n) acc[a][b][m][n] = (f32x4){0.f, 0.f, 0.f, 0.f};
        cur = nxt; cA = nA; cB = nB; ++ui;
        if constexpr (ALIGN_EPI) { if (wr == 1) PG8_BAR; }
    }
    PG8_WAIT_V(0);
    if constexpr (!ALIGN_EPI) { if (wr == 0) PG8_BAR; }
    PG8_BAR;
    if constexpr (Epi::AFTER_DRAIN) { E.fused(acc, cur, wr, wc, fr, fq, lds, wid, lane); S.done(cur); }
#undef PG8_SA
#undef PG8_SB
#undef PG8_STAGE
#undef PG8_LDA
#undef PG8_LDB
#undef PG8_MMA
#undef PG8_WAIT_V
#undef PG8_WAIT_L
#undef PG8_BAR
#undef PG8_SCHED
}
}
#define LAS __attribute__((address_space(3)))
typedef unsigned short bf16_t;
typedef short bf16x8 __attribute__((ext_vector_type(8)));
typedef float f32x4 __attribute__((ext_vector_type(4)));
typedef float f32x2 __attribute__((ext_vector_type(2)));
typedef unsigned u32x4 __attribute__((ext_vector_type(4)));
typedef unsigned u32x2 __attribute__((ext_vector_type(2)));

constexpr int D = 1024, NB = 8, SEQ = 2048, CTXL = 256, DFF = 2816;
constexpr int MX = NB * SEQ;
constexpr int MC = NB * CTXL;
constexpr int MT = MX + MC;
constexpr int NMOD = 9;
constexpr int NEV = 3072;
constexpr int NQKV = 1536;
constexpr float EPS = 1e-6f;
constexpr int LDS_BYTES = 147456;
constexpr int NTHREADS = 512;

constexpr size_t MiB = 1u << 20;
constexpr size_t SZ_WIN = (size_t)5632 * 1024 * 2, SZ_WOUT = (size_t)1024 * 2816 * 2;
constexpr size_t WS_WIN = 0;
constexpr size_t WS_WOUT = WS_WIN + 4 * SZ_WIN;
constexpr size_t WS_WEIN = WS_WOUT + 4 * SZ_WOUT;
constexpr size_t WS_WEOUT = WS_WEIN + (size_t)3072 * 1024 * 2;
constexpr size_t WS_WQKV = WS_WEOUT + (size_t)1024 * 1024 * 2;
constexpr size_t WS_WOOUT = WS_WQKV + (size_t)1536 * 1024 * 2;
constexpr size_t WS_MOD = WS_WOOUT + (size_t)1024 * 1024 * 2;
constexpr size_t WS_WG = WS_MOD + (size_t)2 * 9 * 9216 * 4;
constexpr size_t WS_ROPE = WS_WG + (size_t)16 * 1024 * 4;
constexpr size_t WS_GATES = WS_ROPE + 8192;
constexpr size_t WS_HC = WS_GATES + (size_t)MT * 16 * 4;
constexpr size_t WS_A0 = ((WS_HC + (size_t)MC * D * 4 + 255) / 256) * 256;
constexpr size_t WS_QC = WS_A0 + (size_t)MT * D * 2;
constexpr size_t WS_KC = WS_QC + (size_t)MT * 512 * 2;
constexpr size_t WS_KCT = WS_KC + (size_t)MT * 512 * 2;
constexpr size_t WS_A1 = WS_KCT + (size_t)576 * 128 * 128 * 2;
constexpr size_t WS_BIG = WS_A1 + (size_t)MT * D * 2;
constexpr size_t WS_CTL = WS_BIG + (size_t)MT * 3072 * 2;
constexpr size_t CTL_BYTES = 16384;
constexpr size_t WS_PC = WS_CTL + CTL_BYTES;
constexpr size_t WS_END = WS_PC + (size_t)MC * D * 4;

struct Args {
    const float* x; const float* c; const float* ctx; const float* c_ctx; const float* ada_w; const float* ada_b;
    const float* ffn_w_in; const float* ffn_w_out; const float* even_w_in; const float* even_w_out;
    const float* mlstm_conv; const float* mlstm_gate_b; const float* mlstm_norm; const float* sgu_norm; const float* sgu_ws; const float* sgu_b;
    const float* odd_w_qkv; const float* odd_w_out; const float* attn_sink; const float* final_norm;
    float* out; unsigned char* ws; int ph_lo, ph_hi;
};

typedef const __attribute__((address_space(4))) Args* kargp;
__device__ __forceinline__ kargp kargs() { kargp p = (kargp)__builtin_amdgcn_kernarg_segment_ptr(); asm volatile("" : "+s"(p)); return p; }
#define KA(f) (kargs()->f)
typedef __bf16 bf16x2_t __attribute__((ext_vector_type(2)));
__device__ __forceinline__ unsigned pk2(float lo, float hi) { f32x2 v = {lo, hi}; bf16x2_t b = __builtin_convertvector(v, bf16x2_t); return __builtin_bit_cast(unsigned, b); }
__device__ __forceinline__ bf16_t f2bf(float f) { return (bf16_t)(pk2(f, 0.f) & 0xffffu); }
__device__ __forceinline__ float bf2f(bf16_t v) { return __uint_as_float(((unsigned)v) << 16); }
__device__ __forceinline__ float bflo(unsigned w) { return __uint_as_float(w << 16); }
__device__ __forceinline__ float bfhi(unsigned w) { return __uint_as_float(w & 0xffff0000u); }
__device__ __forceinline__ float silu_f(float v) { return v * __builtin_amdgcn_rcpf(1.f + __expf(-v)); }
__device__ __forceinline__ float sigmoid_f(float v) { return __builtin_amdgcn_rcpf(1.f + __expf(-v)); }
__device__ __forceinline__ float gelu_tanh(float v) {
    const float z = 0.7978845608028654f * (v + 0.044715f * v * v * v);
    const float t = 1.f - 2.f * __builtin_amdgcn_rcpf(1.f + __expf(2.f * z));
    return 0.5f * v * (1.f + t);
}
__device__ __forceinline__ float wave_sum(float v) {
#pragma unroll
    for (int o = 1; o < 64; o <<= 1) v += __shfl_xor(v, o);
    return v;
}
__device__ __forceinline__ float wave_max(float v) {
#pragma unroll
    for (int o = 1; o < 64; o <<= 1) v = fmaxf(v, __shfl_xor(v, o));
    return v;
}
__device__ __forceinline__ f32x4 mfma16(bf16x8 a, bf16x8 b, f32x4 c) { return __builtin_amdgcn_mfma_f32_16x16x32_bf16(a, b, c, 0, 0, 0); }
__device__ __forceinline__ bf16x8 ldsfrag(const LAS unsigned char* p) { return *(const LAS bf16x8*)p; }

namespace pg8 {
struct EpiSwiglu {
    static constexpr bool PERM = true, AFTER_DRAIN = false;
    bf16_t* O;
    __device__ __forceinline__ void operator()(const f32x4 (&acc)[2][2][4][2], const Unit& u, int wr, int wc, int fr, int fq) const {
        const int row0 = u.pm * BM + wr * 64 + fr, col0 = u.pn * 128 + wc * 32 + 8 * fq;
#pragma unroll
        for (int ai = 0; ai < 2; ++ai)
#pragma unroll
            for (int m = 0; m < 4; ++m) {
                bf16_t* rowp = O + (size_t)(row0 + ai * HALF + m * 16) * DFF + col0;
                const f32x4 g0 = acc[ai][0][m][0], g1 = acc[ai][0][m][1], u0 = acc[ai][1][m][0], u1 = acc[ai][1][m][1];
                u32x4 w;
                w.x = ::pk2(::silu_f(g0[0]) * u0[0], ::silu_f(g0[1]) * u0[1]); w.y = ::pk2(::silu_f(g0[2]) * u0[2], ::silu_f(g0[3]) * u0[3]);
                w.z = ::pk2(::silu_f(g1[0]) * u1[0], ::silu_f(g1[1]) * u1[1]); w.w = ::pk2(::silu_f(g1[2]) * u1[2], ::silu_f(g1[3]) * u1[3]);
                *(u32x4*)rowp = w;
            }
    }
};
struct EpiResid {
    static constexpr bool PERM = false, AFTER_DRAIN = false;
    const float* bx; const float* bc; float* ox; float* oc; float* pc; const float* gate;
    float coef;
    __device__ __forceinline__ void operator()(const f32x4 (&acc)[2][2][4][2], const Unit& u, int wr, int wc, int fr, int fq) const {
        const bool isx = u.pm < 64; const bool split = u.k0 != 0;
        const int bi = isx ? (u.pm >> 3) : 8;
        const float* base = isx ? bx : bc - (size_t)MX * D;
        float* outp = isx ? ox : oc - (size_t)MX * D;
        const int row0 = u.pm * BM + wr * 64 + fr, col0 = u.pn * BM + wc * 32 + 4 * fq;
        const float* gp = gate + (size_t)bi * 9216 + col0;
#pragma unroll
        for (int bj = 0; bj < 2; ++bj)
#pragma unroll
            for (int n = 0; n < 2; ++n) {
                const f32x4 gv = *(const f32x4*)(gp + bj * HALF + n * 16) * coef;
#pragma unroll
                for (int ai = 0; ai < 2; ++ai)
#pragma unroll
                    for (int m = 0; m < 4; ++m) {
                        const size_t off = (size_t)(row0 + ai * HALF + m * 16) * D + col0 + bj * HALF + n * 16;
                        const f32x4 pv = gv * acc[ai][bj][m][n];
                        if (split) {
                            *(f32x4*)(pc + off - (size_t)MX * D) = pv;
                        } else {
                            const f32x4 b = *(const f32x4*)(base + off);
                            *(f32x4*)(outp + off) = b + pv;
                        }
                        if (m & 1) asm volatile("" ::: "memory");
                    }
            }
    }
};
struct EpiPlain {
    static constexpr bool PERM = true, AFTER_DRAIN = false;
    bf16_t* O; int ldc;
    __device__ __forceinline__ void operator()(const f32x4 (&acc)[2][2][4][2], const Unit& u, int wr, int wc, int fr, int fq) const {
        const int row0 = u.pm * BM + wr * 64 + fr, col0 = u.pn * BM + wc * 32 + 8 * fq;
#pragma unroll
        for (int ai = 0; ai < 2; ++ai)
#pragma unroll
            for (int m = 0; m < 4; ++m) {
                bf16_t* rowp = O + (size_t)(row0 + ai * HALF + m * 16) * ldc + col0;
#pragma unroll
                for (int bj = 0; bj < 2; ++bj) {
                    const f32x4 v0 = acc[ai][bj][m][0], v1 = acc[ai][bj][m][1];
                    u32x4 w; w.x = ::pk2(v0[0], v0[1]); w.y = ::pk2(v0[2], v0[3]); w.z = ::pk2(v1[0], v1[1]); w.w = ::pk2(v1[2], v1[3]);
                    *(u32x4*)(rowp + bj * HALF) = w;
                }
            }
    }
};
struct EpiQKV {
    static constexpr bool PERM = true, AFTER_DRAIN = false;
    bf16_t* O; const float* rope;
    __device__ __forceinline__ void operator()(const f32x4 (&acc)[2][2][4][2], const Unit& u, int wr, int wc, int fr, int fq) const {
        const int row0 = u.pm * BM + wr * 64 + fr;
        const bool isx = u.pm < 64;
#pragma unroll
        for (int bj = 0; bj < 2; ++bj) {
            const int col0 = u.pn * BM + bj * HALF + wc * 32 + 8 * fq;
            const bool dorope = isx && (col0 < 1280);
            const float qs = (col0 < 1024) ? 0.125f : 1.f;
            const int p0 = (col0 & 63) >> 1;
            const int f0 = p0 & 15;
#pragma unroll
            for (int ai = 0; ai < 2; ++ai)
#pragma unroll
                for (int m = 0; m < 4; ++m) {
                    const int row = row0 + ai * HALF + m * 16;
                    f32x4 v0 = acc[ai][bj][m][0] * qs, v1 = acc[ai][bj][m][1] * qs;
                    if (dorope) {
                        const int t = row & 2047;
                        const int pos = (p0 < 16) ? (t >> 6) : (t & 63);
                        const f32x4 cs0 = *(const f32x4*)(rope + (pos * 16 + f0) * 2), cs1 = *(const f32x4*)(rope + (pos * 16 + f0) * 2 + 4);
                        f32x4 r0, r1;
                        r0[0] = v0[0] * cs0[0] - v0[1] * cs0[1]; r0[1] = v0[0] * cs0[1] + v0[1] * cs0[0];
                        r0[2] = v0[2] * cs0[2] - v0[3] * cs0[3]; r0[3] = v0[2] * cs0[3] + v0[3] * cs0[2];
                        r1[0] = v1[0] * cs1[0] - v1[1] * cs1[1]; r1[1] = v1[0] * cs1[1] + v1[1] * cs1[0];
                        r1[2] = v1[2] * cs1[2] - v1[3] * cs1[3]; r1[3] = v1[2] * cs1[3] + v1[3] * cs1[2];
                        v0 = r0; v1 = r1;
                    }
                    u32x4 w; w.x = ::pk2(v0[0], v0[1]); w.y = ::pk2(v0[2], v0[3]); w.z = ::pk2(v1[0], v1[1]); w.w = ::pk2(v1[2], v1[3]);
                    *(u32x4*)(O + (size_t)row * NQKV + col0) = w;
                }
        }
    }
};
}

__device__ __forceinline__ void tr_item(const float* W, int ldw, int k0, int srccol0, bf16_t* WT, int K, int destrow0, LAS float* scr, int lane) {
#pragma unroll 8
    for (int i = 0; i < 32; ++i) { const int kk = 2 * i + (lane >> 5); scr[kk * 33 + (lane & 31)] = W[(size_t)(k0 + kk) * ldw + srccol0 + (lane & 31)]; }
    asm volatile("s_waitcnt lgkmcnt(0)" ::: "memory");
    const int c = lane & 7;
#pragma unroll
    for (int j = 0; j < 4; ++j) { const int n = (lane >> 3) + 8 * j; const LAS float* s = scr + (8 * c) * 33 + n;
        u32x4 o; o.x = pk2(s[0 * 33], s[1 * 33]); o.y = pk2(s[2 * 33], s[3 * 33]); o.z = pk2(s[4 * 33], s[5 * 33]); o.w = pk2(s[6 * 33], s[7 * 33]);
        *(u32x4*)(WT + (size_t)(destrow0 + n) * K + k0 + 8 * c) = o; }
    asm volatile("s_waitcnt lgkmcnt(0)" ::: "memory");
}

__device__ __forceinline__ void p0_phase(LAS unsigned char* lds) {
    int tid_ = threadIdx.x; asm volatile("" : "+v"(tid_)); const int tid = tid_, lane = tid & 63, wid = __builtin_amdgcn_readfirstlane(tid >> 6), G = gridDim.x;
    unsigned char* ws = KA(ws);
    {
        LAS float* s = (LAS float*)lds;
        LAS float* red = (LAS float*)(lds + 36864);
        for (int i = tid; i < 9 * 1024; i += NTHREADS) { const float v = (i < 8192) ? KA(c)[i] : KA(c_ctx)[i - 8192]; s[i] = v / (1.f + expf(-v)); }
        __syncthreads();
        float* mod = (float*)(ws + WS_MOD);
        for (int tile = blockIdx.x; tile < 288; tile += G) {
            const int l = tile / 144, cg = tile % 144, n = cg * 64 + lane, kg = wid;
            float acc[9];
#pragma unroll
            for (int bi = 0; bi < 9; ++bi) acc[bi] = 0.f;
            const float* wp = KA(ada_w) + ((size_t)l * 1024 + kg * 128) * 9216 + n;
#pragma unroll 4
            for (int kk = 0; kk < 128; ++kk) {
                const float w = wp[(size_t)kk * 9216];
#pragma unroll
                for (int bi = 0; bi < 9; ++bi) acc[bi] += s[bi * 1024 + kg * 128 + kk] * w;
            }
#pragma unroll
            for (int bi = 0; bi < 9; ++bi) red[(kg * 9 + bi) * 64 + lane] = acc[bi];
            __syncthreads();
            for (int i = tid; i < 576; i += NTHREADS) {
                const int bi = i >> 6, cc = i & 63; float sum = 0.f;
#pragma unroll
                for (int k2 = 0; k2 < 8; ++k2) sum += red[(k2 * 9 + bi) * 64 + cc];
                mod[((size_t)l * 9 + bi) * 9216 + cg * 64 + cc] = sum + KA(ada_b)[l * 9216 + cg * 64 + cc];
            }
            __syncthreads();
        }
    }
    {
        const int gt = blockIdx.x * NTHREADS + tid, GT = G * NTHREADS;
        float* wg = (float*)(ws + WS_WG);
        for (int i = gt; i < 16 * 1024; i += GT) { const int g = i >> 10, k = i & 1023; wg[i] = KA(even_w_in)[(size_t)k * 3088 + 2048 + g]; }
        float* rope = (float*)(ws + WS_ROPE);
        for (int i = gt; i < 64 * 16; i += GT) { const int pos = i >> 4, f = i & 15; const float inv = powf(10000.f, -(float)f / 16.f); const float ang = (float)pos * inv; rope[2 * i] = cosf(ang); rope[2 * i + 1] = sinf(ang); }
    }
    {
        LAS float* scr = (LAS float*)(lds + wid * 16384);
        const int gw = blockIdx.x * 8 + wid, NGW = G * 8;
        constexpr int I_IN = 16 * 176, I_OUT = 44 * 32, I_EIN = 16 * 96, I_SQ = 16 * 32, I_QKV = 16 * 48;
        constexpr int NITEMS = 4 * I_IN + 4 * I_OUT + I_EIN + I_SQ + I_QKV + I_SQ;
        for (int it = gw; it < NITEMS; it += NGW) {
            int r = it;
            if (r < 4 * I_IN) { const int mi = r / I_IN; r -= mi * I_IN; const int kb = r / 176, nb = r % 176; const int n0 = nb * 32;
                const int dest = (n0 < 2816) ? ((n0 >> 7) * 256 + (n0 & 127)) : ((((n0 - 2816) >> 7) * 256) + 128 + ((n0 - 2816) & 127));
                tr_item(KA(ffn_w_in) + (size_t)mi * 1024 * 5632, 5632, kb * 64, n0, (bf16_t*)(ws + WS_WIN + mi * SZ_WIN), 1024, dest, scr, lane); continue; }
            r -= 4 * I_IN;
            if (r < 4 * I_OUT) { const int mi = r / I_OUT; r -= mi * I_OUT; const int kb = r / 32, nb = r % 32;
                tr_item(KA(ffn_w_out) + (size_t)mi * 2816 * 1024, 1024, kb * 64, nb * 32, (bf16_t*)(ws + WS_WOUT + mi * SZ_WOUT), 2816, nb * 32, scr, lane); continue; }
            r -= 4 * I_OUT;
            if (r < I_EIN) { const int kb = r / 96, nb = r % 96; const int src = nb < 64 ? nb * 32 : 2064 + (nb - 64) * 32;
                tr_item(KA(even_w_in), 3088, kb * 64, src, (bf16_t*)(ws + WS_WEIN), 1024, nb * 32, scr, lane); continue; }
            r -= I_EIN;
            if (r < I_SQ) { const int kb = r / 32, nb = r % 32; tr_item(KA(even_w_out), 1024, kb * 64, nb * 32, (bf16_t*)(ws + WS_WEOUT), 1024, nb * 32, scr, lane); continue; }
            r -= I_SQ;
            if (r < I_QKV) { const int kb = r / 48, nb = r % 48; tr_item(KA(odd_w_qkv), 1536, kb * 64, nb * 32, (bf16_t*)(ws + WS_WQKV), 1024, nb * 32, scr, lane); continue; }
            r -= I_QKV;
            { const int kb = r / 32, nb = r % 32; tr_item(KA(odd_w_out), 1024, kb * 64, nb * 32, (bf16_t*)(ws + WS_WOOUT), 1024, nb * 32, scr, lane); }
        }
    }
}

template <bool GATES>
__device__ __forceinline__ void norm_phase(LAS unsigned char* lds, const float* hx, const float* hc, bf16_t* A0, const float* modl, int shift_i, int scale_i, int nrows,
                                           const float* wg, const float* gate_b, float* gates, float* copy_c) {
    int tid_ = threadIdx.x; asm volatile("" : "+v"(tid_)); const int tid = tid_, lane = tid & 63, wid = __builtin_amdgcn_readfirstlane(tid >> 6), G = gridDim.x;
    LAS float* wgs = (LAS float*)lds;
    if (GATES) { for (int i = tid; i < 16 * 1024 / 4; i += NTHREADS) ((LAS f32x4*)wgs)[i] = ((const f32x4*)wg)[i]; __syncthreads(); }
    for (int R = blockIdx.x * 8 + wid; R < nrows; R += G * 8) {
        const bool isx = R < MX;
        const float* src = isx ? hx + (size_t)R * D : hc + (size_t)(R - MX) * D;
        const int bi = isx ? (R >> 11) : 8;
        const float* mb = modl + (size_t)bi * 9216;
        f32x4 v[4]; float ss = 0.f;
#pragma unroll
        for (int j = 0; j < 4; ++j) { v[j] = *(const f32x4*)(src + 256 * j + 4 * lane);
            if (copy_c && !isx) { v[j] += *(const f32x4*)(copy_c + (size_t)(R - MX) * D + 256 * j + 4 * lane); *(f32x4*)((float*)hc + (size_t)(R - MX) * D + 256 * j + 4 * lane) = v[j]; }
            ss += (v[j][0] * v[j][0] + v[j][1] * v[j][1]) + (v[j][2] * v[j][2] + v[j][3] * v[j][3]); }
        const float rstd = 1.0f / sqrtf(wave_sum(ss) * (1.f / D) + EPS);
#pragma unroll
        for (int j = 0; j < 4; ++j) {
            const f32x4 sc = *(const f32x4*)(mb + scale_i * 1024 + 256 * j + 4 * lane), sh = *(const f32x4*)(mb + shift_i * 1024 + 256 * j + 4 * lane);
            v[j] = v[j] * rstd * (sc + 1.f) + sh;
            u32x2 w; w.x = pk2(v[j][0], v[j][1]); w.y = pk2(v[j][2], v[j][3]);
            *(u32x2*)(A0 + (size_t)R * D + 256 * j + 4 * lane) = w;
        }
        if (GATES) {
            float mine = 0.f;
#pragma unroll 1
            for (int g = 0; g < 16; ++g) {
                float d = 0.f;
#pragma unroll
                for (int j = 0; j < 4; ++j) { const f32x4 w = *(const LAS f32x4*)(wgs + g * 1024 + 256 * j + 4 * lane); d += (v[j][0] * w[0] + v[j][1] * w[1]) + (v[j][2] * w[2] + v[j][3] * w[3]); }
                d = wave_sum(d);
                if (lane == g) mine = d;
            }
            if (lane < 16) gates[(size_t)R * 16 + lane] = mine + gate_b[lane];
        }
    }
    if (GATES) __syncthreads();
}

__device__ __forceinline__ void qkprep_phase(LAS unsigned char* lds, const bf16_t* P, const float* convw, bf16_t* Qc, bf16_t* Kc, bf16_t* KcT) {
    int tid_ = threadIdx.x; asm volatile("" : "+v"(tid_)); const int tid = tid_;
    constexpr int LD = 136;
    LAS bf16_t* Tt = (LAS bf16_t*)lds;
    LAS float* cw = (LAS float*)(lds + 34816);
    const int seg = tid & 15;
    for (int unit = blockIdx.x; unit < 576; unit += gridDim.x) {
        const int h = unit & 3, gc = unit >> 2, n = gc % 18, b = gc / 18;
        const int sbase = n < 2 ? MX + b * CTXL : b * SEQ, T = n < 2 ? CTXL : SEQ, t0 = n < 2 ? n * 128 : (n - 2) * 128;
        for (int i = tid; i < 768; i += NTHREADS) { const int qk = i / 384, j = (i % 384) >> 7, ch = i & 127; cw[i] = convw[j * 1024 + qk * 512 + h * 128 + ch]; }
        __syncthreads();
#pragma unroll 1
        for (int it = 0; it < 4; ++it) {
            const int l = (tid + NTHREADS * it) >> 4;
            const int tin = t0 + l;
            const size_t R = (size_t)(sbase + tin);
            const bf16_t* pr = P + R * NEV + h * 128 + seg * 8;
            const u32x4 z = (u32x4){0u, 0u, 0u, 0u};
#pragma unroll
            for (int qk = 0; qk < 2; ++qk) {
                const bf16_t* pp = pr + qk * 512;
                const u32x4 c0 = *(const u32x4*)pp; const u32x4 pv = tin > 0 ? *(const u32x4*)(pp - NEV) : z; const u32x4 nx = tin < T - 1 ? *(const u32x4*)(pp + NEV) : z;
                float y[8];
#pragma unroll
                for (int hf = 0; hf < 2; ++hf) {
                    const f32x4 w0 = *(const LAS f32x4*)(cw + (qk * 3 + 0) * 128 + seg * 8 + 4 * hf), w1 = *(const LAS f32x4*)(cw + (qk * 3 + 1) * 128 + seg * 8 + 4 * hf), w2v = *(const LAS f32x4*)(cw + (qk * 3 + 2) * 128 + seg * 8 + 4 * hf);
                    y[4 * hf + 0] = w0[0] * bflo(pv[2 * hf]) + w1[0] * bflo(c0[2 * hf]) + w2v[0] * bflo(nx[2 * hf]);
                    y[4 * hf + 1] = w0[1] * bfhi(pv[2 * hf]) + w1[1] * bfhi(c0[2 * hf]) + w2v[1] * bfhi(nx[2 * hf]);
                    y[4 * hf + 2] = w0[2] * bflo(pv[2 * hf + 1]) + w1[2] * bflo(c0[2 * hf + 1]) + w2v[2] * bflo(nx[2 * hf + 1]);
                    y[4 * hf + 3] = w0[3] * bfhi(pv[2 * hf + 1]) + w1[3] * bfhi(c0[2 * hf + 1]) + w2v[3] * bfhi(nx[2 * hf + 1]);
                }
                const float scl = qk ? 0.08838834764831845f : 1.f;
                u32x4 o;
#pragma unroll
                for (int w2 = 0; w2 < 4; ++w2) o[w2] = pk2(silu_f(y[2 * w2]) * scl, silu_f(y[2 * w2 + 1]) * scl);
                *(u32x4*)((qk ? Kc : Qc) + R * 512 + h * 128 + seg * 8) = o;
                if (qk) {
#pragma unroll
                    for (int w2 = 0; w2 < 4; ++w2) { Tt[(seg * 8 + 2 * w2) * LD + l] = (bf16_t)(o[w2] & 0xffffu); Tt[(seg * 8 + 2 * w2 + 1) * LD + l] = (bf16_t)(o[w2] >> 16); }
                }
            }
        }
        __syncthreads();
#pragma unroll
        for (int it = 0; it < 4; ++it) { const int i = tid + NTHREADS * it; const int d = i >> 4, sg = i & 15;
            *(u32x4*)(KcT + ((size_t)unit * 128 + d) * 128 + sg * 8) = *(const LAS u32x4*)(Tt + d * LD + sg * 8); }
        __syncthreads();
    }
}

__device__ __forceinline__ void mlstm_phase(LAS unsigned char* lds, const bf16_t* P, const float* gates, const bf16_t* Qc, const bf16_t* Kc, const bf16_t* KcT, bf16_t* Hdir) {
    int tid_ = threadIdx.x; asm volatile("" : "+v"(tid_)); const int tid = tid_, lane = tid & 63, wid = __builtin_amdgcn_readfirstlane(tid >> 6), r = lane & 15, q = lane >> 4;
    constexpr int LD = 136, LDB = LD * 2;
    constexpr int OFF_Q = 0, OFF_K = 34816, OFF_KT = 69632, OFF_VT = 104448, OFF_VW = 113152, OFF_CT = 121856, OFF_SC = 130560;
    LAS bf16_t* Qs = (LAS bf16_t*)(lds + OFF_Q); LAS bf16_t* Ks = (LAS bf16_t*)(lds + OFF_K); LAS bf16_t* Kt = (LAS bf16_t*)(lds + OFF_KT);
    LAS bf16_t* Vt = (LAS bf16_t*)(lds + OFF_VT); LAS bf16_t* Vw = (LAS bf16_t*)(lds + OFF_VW); LAS bf16_t* Ct = (LAS bf16_t*)(lds + OFF_CT);
    LAS float* sc = (LAS float*)(lds + OFF_SC);
    LAS float* rowf = sc; LAS float* dmb = sc + 128; LAS float* inter = sc + 256; LAS float* wl = sc + 384; LAS float* en = sc + 512; LAS float* qn = sc + 640; LAS float* nvec = sc + 768; LAS float* misc = sc + 896;
    for (int unit = blockIdx.x; unit < 256; unit += gridDim.x) {
        const int es = unit & 3, dir = (unit >> 2) & 1, h = (unit >> 3) & 3, b = unit >> 5;
        for (int i = tid; i < 32 * LD / 2; i += NTHREADS) ((LAS unsigned*)Ct)[i] = 0u;
        if (tid < 128) nvec[tid] = 0.f;
        f32x4 Cacc[2]; Cacc[0] = (f32x4){0.f, 0.f, 0.f, 0.f}; Cacc[1] = Cacc[0];
        float m_state = 0.f;
        u32x4 pq[4], pvv; float pgi[2], pgf[2];
        const unsigned voffq = (unsigned)(((tid >> 4) * 512 + (tid & 15) * 8) * 2), vofft = (unsigned)(((tid >> 4) * 128 + (tid & 15) * 8) * 2);
#define MLSTM_CHUNK_INFO(ci_, n_, gc_, rb_) do { if ((ci_) < 2) n_ = dir ? 1 - (ci_) : (ci_); else n_ = dir ? 19 - (ci_) : (ci_); gc_ = b * 18 + n_; rb_ = n_ < 2 ? MX + b * CTXL + n_ * 128 : b * SEQ + (n_ - 2) * 128; } while (0)
#define MLSTM_PREFETCH(ci_) do { int n2, gc2, rb2; MLSTM_CHUNK_INFO(ci_, n2, gc2, rb2); \
            const bf16_t* qg = Qc + (size_t)rb2 * 512 + h * 128; (void)gc2; \
            _Pragma("unroll") for (int it = 0; it < 4; ++it) { \
                pq[it] = *(const u32x4*)((const char*)(qg + it * 16384) + voffq); } \
            pvv = *(const u32x4*)(P + (size_t)(rb2 + (tid >> 2)) * NEV + 1024 + h * 128 + es * 32 + (tid & 3) * 8); \
            if (wid == 0) { _Pragma("unroll") for (int hf = 0; hf < 2; ++hf) { const int l = lane + 64 * hf; const int R = rb2 + (dir ? 127 - l : l); \
                pgi[hf] = gates[(size_t)R * 16 + dir * 8 + h]; pgf[hf] = gates[(size_t)R * 16 + dir * 8 + 4 + h]; } } } while (0)
        MLSTM_PREFETCH(0);
        __syncthreads();
        for (int ci = 0; ci < 18; ++ci) {
            int wc_ = wid, dc_ = dir; asm volatile("" : "+s"(wc_), "+s"(dc_)); const int widc = wc_, dirc = dc_;
            int n, gc, rbase;
            MLSTM_CHUNK_INFO(ci, n, gc, rbase);
            if (wid == 0) {
                float ig[2], bc[2];
#pragma unroll
                for (int hf = 0; hf < 2; ++hf) { ig[hf] = pgi[hf]; const float fg = pgf[hf];
                    bc[hf] = fminf(fg, 0.f) - log1pf(expf(-fabsf(fg))); }
#pragma unroll
                for (int off = 1; off < 64; off <<= 1) { const float t0 = __shfl_up(bc[0], off), t1 = __shfl_up(bc[1], off); if (lane >= off) { bc[0] += t0; bc[1] += t1; } }
                bc[1] += __shfl(bc[0], 63);
                const float g = __shfl(bc[1], 63);
                const float d0 = ig[0] - bc[0], d1 = ig[1] - bc[1];
                float p0 = d0, p1 = d1;
#pragma unroll
                for (int off = 1; off < 64; off <<= 1) { const float t0 = __shfl_up(p0, off), t1 = __shfl_up(p1, off); if (lane >= off) { p0 = fmaxf(p0, t0); p1 = fmaxf(p1, t1); } }
                p1 = fmaxf(p1, __shfl(p0, 63));
                const float a0 = g + d0, a1 = g + d1;
                const float mloc = wave_max(fmaxf(a0, a1));
                const float m_new = fmaxf(g + m_state, mloc);
                const float dec = expf(g + m_state - m_new);
                const float mt0 = bc[0] + fmaxf(m_state, p0), mt1 = bc[1] + fmaxf(m_state, p1);
                const int i0 = dir ? 127 - lane : lane, i1 = dir ? 63 - lane : lane + 64;
                rowf[i0] = bc[0] - mt0; rowf[i1] = bc[1] - mt1;
                dmb[i0] = d0; dmb[i1] = d1;
                inter[i0] = expf(bc[0] + m_state - mt0); inter[i1] = expf(bc[1] + m_state - mt1);
                wl[i0] = expf(a0 - m_new); wl[i1] = expf(a1 - m_new);
                en[i0] = expf(-mt0); en[i1] = expf(-mt1);
                if (lane == 0) misc[0] = dec;
                m_state = m_new;
            }
            u32x4 pk[4], pt[4];
            { const bf16_t* kg = Kc + (size_t)rbase * 512 + h * 128; const bf16_t* tg = KcT + (size_t)(gc * 4 + h) * 128 * 128;
#pragma unroll
              for (int it = 0; it < 4; ++it) pk[it] = *(const u32x4*)((const char*)(kg + it * 16384) + voffq);
#pragma unroll
              for (int it = 0; it < 4; ++it) pt[it] = *(const u32x4*)((const char*)(tg + it * 4096) + vofft); }
#pragma unroll
            for (int it = 0; it < 4; ++it) { const int i = tid + NTHREADS * it; const int row = i >> 4, sg = i & 15; *(LAS u32x4*)(Qs + row * LD + sg * 8) = pq[it]; }
#pragma unroll
            for (int it = 0; it < 4; ++it) { const int i = tid + NTHREADS * it; const int row = i >> 4, sg = i & 15; *(LAS u32x4*)(Ks + row * LD + sg * 8) = pk[it]; }
            __syncthreads();
            const float dec = misc[0];
            {
                const int t = tid >> 2, sg = tid & 3;
                const u32x4 vv = pvv;
                const float w = wl[t];
#pragma unroll
                for (int w2 = 0; w2 < 4; ++w2) {
                    Vt[(sg * 8 + 2 * w2) * LD + t] = (bf16_t)(vv[w2] & 0xffffu); Vt[(sg * 8 + 2 * w2 + 1) * LD + t] = (bf16_t)(vv[w2] >> 16);
                    Vw[(sg * 8 + 2 * w2) * LD + t] = f2bf(bflo(vv[w2]) * w); Vw[(sg * 8 + 2 * w2 + 1) * LD + t] = f2bf(bfhi(vv[w2]) * w);
                }
            }
            f32x4 sacc[8];
            {
                bf16x8 af[4];
#pragma unroll
                for (int ks = 0; ks < 4; ++ks) af[ks] = ldsfrag(lds + OFF_Q + (16 * wid + r) * LDB + (32 * ks + 8 * q) * 2);
#pragma unroll
                for (int jb = 0; jb < 8; ++jb) {
                    sacc[jb] = (f32x4){0.f, 0.f, 0.f, 0.f};
                    if (dirc ? (jb >= widc) : (jb <= widc)) {
#pragma unroll
                        for (int ks = 0; ks < 4; ++ks) sacc[jb] = mfma16(af[ks], ldsfrag(lds + OFF_K + (16 * jb + r) * LDB + (32 * ks + 8 * q) * 2), sacc[jb]);
                    }
                }
            }
            {
                const int t = tid >> 2, part = tid & 3; float s = 0.f;
#pragma unroll
                for (int i = 0; i < 4; ++i) {
                    const u32x4 qv = *(const LAS u32x4*)(Qs + t * LD + part * 32 + i * 8);
                    const f32x4 n0 = *(const LAS f32x4*)(nvec + part * 32 + i * 8), n1 = *(const LAS f32x4*)(nvec + part * 32 + i * 8 + 4);
                    s += bflo(qv[0]) * n0[0] + bfhi(qv[0]) * n0[1] + bflo(qv[1]) * n0[2] + bfhi(qv[1]) * n0[3] + bflo(qv[2]) * n1[0] + bfhi(qv[2]) * n1[1] + bflo(qv[3]) * n1[2] + bfhi(qv[3]) * n1[3];
                }
                s += __shfl_xor(s, 1); s += __shfl_xor(s, 2);
                if (part == 0) qn[t] = s;
            }
#pragma unroll
            for (int it = 0; it < 4; ++it) { const int i = tid + NTHREADS * it; *(LAS u32x4*)(Kt + (i >> 4) * LD + (i & 15) * 8) = pt[it]; }
            __syncthreads();
            LAS bf16_t* Ss = Ks;
            float rs[4] = {0.f, 0.f, 0.f, 0.f};
            {
                const f32x4 rf = *(const LAS f32x4*)(rowf + 16 * wid + 4 * q);
                const int zb = dirc ? ((widc & 1) ? widc - 1 : -1) : ((widc & 1) ? -1 : widc + 1);
#pragma unroll
                for (int jb = 0; jb < 8; ++jb) {
                    if (dirc ? (jb >= widc) : (jb <= widc)) {
                        const int s = 16 * jb + r; const float dm = dmb[s];
#pragma unroll
                        for (int reg = 0; reg < 4; ++reg) { const int t = 16 * wid + 4 * q + reg;
                            const bool ok = dirc ? (s >= t) : (s <= t);
                            const float v = ok ? sacc[jb][reg] * __expf(rf[reg] + dm) : 0.f;
                            rs[reg] += v; Ss[t * LD + s] = f2bf(v); }
                    } else if (jb == zb) {
#pragma unroll
                        for (int reg = 0; reg < 4; ++reg) Ss[(16 * wid + 4 * q + reg) * LD + 16 * jb + r] = 0;
                    }
                }
#pragma unroll
                for (int reg = 0; reg < 4; ++reg) { rs[reg] += __shfl_xor(rs[reg], 1); rs[reg] += __shfl_xor(rs[reg], 2); rs[reg] += __shfl_xor(rs[reg], 4); rs[reg] += __shfl_xor(rs[reg], 8); }
            }
            {
                const int kh = widc >> 1;
                const f32x4 it4 = *(const LAS f32x4*)(inter + 16 * wid + 4 * q), qn4 = *(const LAS f32x4*)(qn + 16 * wid + 4 * q), en4 = *(const LAS f32x4*)(en + 16 * wid + 4 * q);
                bf16x8 qf[4];
#pragma unroll
                for (int ks = 0; ks < 4; ++ks) qf[ks] = ldsfrag(lds + OFF_Q + (16 * wid + r) * LDB + (32 * ks + 8 * q) * 2);
#pragma unroll
                for (int nt = 0; nt < 2; ++nt) {
                    f32x4 a1 = (f32x4){0.f, 0.f, 0.f, 0.f}, a2 = a1;
#pragma unroll
                    for (int ks = 0; ks < 4; ++ks) {
                        if (dirc ? (ks >= kh) : (ks <= kh)) a1 = mfma16(ldsfrag(lds + OFF_K + (16 * wid + r) * LDB + (32 * ks + 8 * q) * 2), ldsfrag(lds + OFF_VT + (16 * nt + r) * LDB + (32 * ks + 8 * q) * 2), a1);
                        a2 = mfma16(qf[ks], ldsfrag(lds + OFF_CT + (16 * nt + r) * LDB + (32 * ks + 8 * q) * 2), a2);
                    }
#pragma unroll
                    for (int reg = 0; reg < 4; ++reg) {
                        const int t = 16 * wid + 4 * q + reg;
                        const float den = rs[reg] + it4[reg] * qn4[reg];
                        const float hv = (a1[reg] + it4[reg] * a2[reg]) / fmaxf(fabsf(den), en4[reg]);
                        Hdir[((size_t)dir * MT + rbase + t) * 512 + h * 128 + es * 32 + 16 * nt + r] = f2bf(hv);
                    }
                }
            }
            asm volatile("" ::: "memory");
            if (ci + 1 < 18) MLSTM_PREFETCH(ci + 1);
            asm volatile("" ::: "memory");
            {
                bf16x8 kf[4];
#pragma unroll
                for (int ks = 0; ks < 4; ++ks) kf[ks] = ldsfrag(lds + OFF_KT + (16 * wid + r) * LDB + (32 * ks + 8 * q) * 2);
#pragma unroll
                for (int nt = 0; nt < 2; ++nt) {
                    Cacc[nt] = Cacc[nt] * dec;
#pragma unroll
                    for (int ks = 0; ks < 4; ++ks) Cacc[nt] = mfma16(kf[ks], ldsfrag(lds + OFF_VW + (16 * nt + r) * LDB + (32 * ks + 8 * q) * 2), Cacc[nt]);
                }
            }
            float nnew;
            {
                const int d = tid >> 2, part = tid & 3; float s = 0.f;
#pragma unroll
                for (int i = 0; i < 4; ++i) {
                    const u32x4 kv = *(const LAS u32x4*)(Kt + d * LD + part * 32 + i * 8);
                    const f32x4 w0 = *(const LAS f32x4*)(wl + part * 32 + i * 8), w1 = *(const LAS f32x4*)(wl + part * 32 + i * 8 + 4);
                    s += bflo(kv[0]) * w0[0] + bfhi(kv[0]) * w0[1] + bflo(kv[1]) * w0[2] + bfhi(kv[1]) * w0[3] + bflo(kv[2]) * w1[0] + bfhi(kv[2]) * w1[1] + bflo(kv[3]) * w1[2] + bfhi(kv[3]) * w1[3];
                }
                s += __shfl_xor(s, 1); s += __shfl_xor(s, 2);
                nnew = dec * nvec[d] + s;
            }
            __syncthreads();
#pragma unroll
            for (int nt = 0; nt < 2; ++nt) { u32x2 w; w.x = pk2(Cacc[nt][0], Cacc[nt][1]); w.y = pk2(Cacc[nt][2], Cacc[nt][3]); *(LAS u32x2*)(Ct + (16 * nt + r) * LD + 16 * wid + 4 * q) = w; }
            if ((tid & 3) == 0) nvec[tid >> 2] = nnew;
        }
        __syncthreads();
    }
}

__device__ __forceinline__ void sgu_phase(LAS unsigned char* lds, const bf16_t* P, const float* sgu_norm, const float* sgu_ws, const float* sgu_b, bf16_t* A1) {
    int tid_ = threadIdx.x; asm volatile("" : "+v"(tid_)); const int tid = tid_, lane = tid & 63, wid = __builtin_amdgcn_readfirstlane(tid >> 6), r = lane & 15, q = lane >> 4;
    constexpr int LD = 136, LDB = LD * 2, OFF_W = 0, OFF_V = 34816, OFF_R = 69632;
    LAS bf16_t* Ws = (LAS bf16_t*)(lds + OFF_W); LAS bf16_t* Vt = (LAS bf16_t*)(lds + OFF_V); LAS float* rstd = (LAS float*)(lds + OFF_R);
    for (int unit = blockIdx.x; unit < 576; unit += gridDim.x) {
        const int g = unit & 3, n = (unit >> 2) % 18, b = unit / 72;
        const int rbase = n < 2 ? MX + b * CTXL + n * 128 : b * SEQ + (n - 2) * 128;
        {
            const int tok = tid >> 2, part = tid & 3; float ss = 0.f;
            const bf16_t* pv = P + (size_t)(rbase + tok) * NEV + 2560 + part * 128;
#pragma unroll 4
            for (int i = 0; i < 16; ++i) { const u32x4 w = *(const u32x4*)(pv + i * 8);
#pragma unroll
                for (int k = 0; k < 4; ++k) { const float a0 = gelu_tanh(bflo(w[k])), a1 = gelu_tanh(bfhi(w[k])); ss += a0 * a0 + a1 * a1; } }
            ss += __shfl_xor(ss, 1); ss += __shfl_xor(ss, 2);
            if (part == 0) rstd[tok] = 1.0f / sqrtf(ss * (1.f / 512.f) + EPS);
        }
#pragma unroll
        for (int it = 0; it < 4; ++it) { const int i = tid + NTHREADS * it; const int p = i >> 4, sg = i & 15;
            const float* wp = sgu_ws + ((size_t)g * 128 + p) * 128 + sg * 8; const f32x4 w0 = *(const f32x4*)wp, w1 = *(const f32x4*)(wp + 4);
            u32x4 o; o.x = pk2(w0[0], w0[1]); o.y = pk2(w0[2], w0[3]); o.z = pk2(w1[0], w1[1]); o.w = pk2(w1[2], w1[3]);
            *(LAS u32x4*)(Ws + p * LD + sg * 8) = o; }
        __syncthreads();
#pragma unroll
        for (int it = 0; it < 4; ++it) { const int i = tid + NTHREADS * it; const int tq = i >> 4, sg = i & 15;
            const u32x4 w = *(const u32x4*)(P + (size_t)(rbase + tq) * NEV + 2560 + g * 128 + sg * 8);
            const float rq = rstd[tq];
            const f32x4 g0 = *(const f32x4*)(sgu_norm + g * 128 + sg * 8), g1 = *(const f32x4*)(sgu_norm + g * 128 + sg * 8 + 4);
            Vt[(sg * 8 + 0) * LD + tq] = f2bf(gelu_tanh(bflo(w[0])) * rq * g0[0]); Vt[(sg * 8 + 1) * LD + tq] = f2bf(gelu_tanh(bfhi(w[0])) * rq * g0[1]);
            Vt[(sg * 8 + 2) * LD + tq] = f2bf(gelu_tanh(bflo(w[1])) * rq * g0[2]); Vt[(sg * 8 + 3) * LD + tq] = f2bf(gelu_tanh(bfhi(w[1])) * rq * g0[3]);
            Vt[(sg * 8 + 4) * LD + tq] = f2bf(gelu_tanh(bflo(w[2])) * rq * g1[0]); Vt[(sg * 8 + 5) * LD + tq] = f2bf(gelu_tanh(bfhi(w[2])) * rq * g1[1]);
            Vt[(sg * 8 + 6) * LD + tq] = f2bf(gelu_tanh(bflo(w[3])) * rq * g1[2]); Vt[(sg * 8 + 7) * LD + tq] = f2bf(gelu_tanh(bfhi(w[3])) * rq * g1[3]); }
        __syncthreads();
        {
            bf16x8 af[4];
#pragma unroll
            for (int ks = 0; ks < 4; ++ks) af[ks] = ldsfrag(lds + OFF_W + (16 * wid + r) * LDB + (32 * ks + 8 * q) * 2);
            const f32x4 sb4 = *(const f32x4*)(sgu_b + g * 128 + 16 * wid + 4 * q);
#pragma unroll
            for (int jb = 0; jb < 8; ++jb) {
                f32x4 acc = (f32x4){0.f, 0.f, 0.f, 0.f};
#pragma unroll
                for (int ks = 0; ks < 4; ++ks) acc = mfma16(af[ks], ldsfrag(lds + OFF_V + (16 * jb + r) * LDB + (32 * ks + 8 * q) * 2), acc);
#pragma unroll
                for (int reg = 0; reg < 4; ++reg) { const int p = 16 * wid + 4 * q + reg; const size_t R = (size_t)(rbase + p);
                    const float uu = gelu_tanh(bf2f(P[R * NEV + 2048 + g * 128 + 16 * jb + r]));
                    A1[R * D + 512 + g * 128 + 16 * jb + r] = f2bf(uu * (acc[reg] + sb4[reg])); }
            }
        }
        __syncthreads();
    }
}

__device__ __forceinline__ void combine_phase(const bf16_t* Hdir, const bf16_t* P, const float* mnorm, bf16_t* A1) {
    int tid_ = threadIdx.x; asm volatile("" : "+v"(tid_)); const int tid = tid_, lane = tid & 63, wid = __builtin_amdgcn_readfirstlane(tid >> 6);
    for (int R = blockIdx.x * 8 + wid; R < MT; R += gridDim.x * 8) {
        const int col = lane * 8;
        const u32x4 h0 = *(const u32x4*)(Hdir + (size_t)R * 512 + col), h1 = *(const u32x4*)(Hdir + ((size_t)MT + R) * 512 + col);
        float a[8];
#pragma unroll
        for (int k = 0; k < 4; ++k) { a[2 * k] = bflo(h0[k]) + bflo(h1[k]); a[2 * k + 1] = bfhi(h0[k]) + bfhi(h1[k]); }
        float ss = 0.f;
#pragma unroll
        for (int k = 0; k < 8; ++k) ss += a[k] * a[k];
        ss += __shfl_xor(ss, 1); ss += __shfl_xor(ss, 2); ss += __shfl_xor(ss, 4); ss += __shfl_xor(ss, 8);
        const float rstd = 1.0f / sqrtf(ss * (1.f / 128.f) + EPS);
        const f32x4 m0 = *(const f32x4*)(mnorm + col), m1 = *(const f32x4*)(mnorm + col + 4);
        const u32x4 ov = *(const u32x4*)(P + (size_t)R * NEV + 1536 + col);
        u32x4 w;
        w.x = pk2(sigmoid_f(bflo(ov[0])) * a[0] * rstd * m0[0], sigmoid_f(bfhi(ov[0])) * a[1] * rstd * m0[1]);
        w.y = pk2(sigmoid_f(bflo(ov[1])) * a[2] * rstd * m0[2], sigmoid_f(bfhi(ov[1])) * a[3] * rstd * m0[3]);
        w.z = pk2(sigmoid_f(bflo(ov[2])) * a[4] * rstd * m1[0], sigmoid_f(bfhi(ov[2])) * a[5] * rstd * m1[1]);
        w.w = pk2(sigmoid_f(bflo(ov[3])) * a[6] * rstd * m1[2], sigmoid_f(bfhi(ov[3])) * a[7] * rstd * m1[3]);
        *(u32x4*)(A1 + (size_t)R * D + col) = w;
    }
}

__device__ __forceinline__ void attn_phase(LAS unsigned char* lds, const bf16_t* QKV, const float* sink, bf16_t* A1) {
    int tid_ = threadIdx.x; asm volatile("" : "+v"(tid_)); const int tid = tid_, lane = tid & 63, wid = __builtin_amdgcn_readfirstlane(tid >> 6), r = lane & 15, q = lane >> 4;
    constexpr int LK = 72, LKB = LK * 2, OFF_K = 0, OFF_V = 9216, OFF_P = 18432, PSZ = 64 * LKB;
    LAS bf16_t* Ks = (LAS bf16_t*)(lds + OFF_K); LAS bf16_t* Vt = (LAS bf16_t*)(lds + OFF_V);
    LAS bf16_t* Ps = (LAS bf16_t*)(lds + OFF_P + wid * PSZ);
    const LAS unsigned char* Pb = lds + OFF_P + wid * PSZ;
    for (int unit = blockIdx.x; unit < 512; unit += gridDim.x) {
        const int hk = unit & 3, j = (unit >> 2) & 15, b = unit >> 6;
        const int g = wid >> 1, hq = hk * 4 + g, tok0 = (wid & 1) * 64;
        const int qrow0 = b * SEQ + j * 128 + tok0;
        bf16x8 qf[4][2];
#pragma unroll
        for (int mt = 0; mt < 4; ++mt)
#pragma unroll
            for (int ks = 0; ks < 2; ++ks) qf[mt][ks] = *(const bf16x8*)(QKV + (size_t)(qrow0 + 16 * mt + r) * NQKV + hq * 64 + 32 * ks + 8 * q);
        float mrun[4][4], lrun[4][4]; f32x4 oacc[4][4];
        const float sk = sink[hq];
#pragma unroll
        for (int mt = 0; mt < 4; ++mt)
#pragma unroll
            for (int i = 0; i < 4; ++i) { mrun[mt][i] = sk; lrun[mt][i] = 1.f; oacc[mt][i] = (f32x4){0.f, 0.f, 0.f, 0.f}; }
        for (int ti = 0; ti < 10; ++ti) {
            int krow0, kpos0; bool band;
            if (ti < 4) { krow0 = MX + b * CTXL + ti * 64; kpos0 = 0; band = false; }
            else { const int kb = j - 1 + ((ti - 4) >> 1); if (kb < 0 || kb > 15) continue; kpos0 = kb * 128 + ((ti - 4) & 1) * 64; krow0 = b * SEQ + kpos0; band = (kb != j); }
            __syncthreads();
            {
                const int key = tid >> 3, sg = tid & 7;
                const bf16_t* kp = QKV + (size_t)(krow0 + key) * NQKV + 1024 + hk * 64 + sg * 8;
                const u32x4 kv = *(const u32x4*)kp; const u32x4 vv = *(const u32x4*)(kp + 256);
                *(LAS u32x4*)(Ks + key * LK + sg * 8) = kv;
#pragma unroll
                for (int w2 = 0; w2 < 4; ++w2) { Vt[(sg * 8 + 2 * w2) * LK + key] = (bf16_t)(vv[w2] & 0xffffu); Vt[(sg * 8 + 2 * w2 + 1) * LK + key] = (bf16_t)(vv[w2] >> 16); }
            }
            __syncthreads();
#pragma unroll
            for (int mt = 0; mt < 4; ++mt) {
                f32x4 s[4];
#pragma unroll
                for (int nt = 0; nt < 4; ++nt) {
                    const bf16x8 k0 = ldsfrag(lds + OFF_K + (16 * nt + r) * LKB + (8 * q) * 2), k1 = ldsfrag(lds + OFF_K + (16 * nt + r) * LKB + (32 + 8 * q) * 2);
                    f32x4 a = (f32x4){0.f, 0.f, 0.f, 0.f}; a = mfma16(qf[mt][0], k0, a); a = mfma16(qf[mt][1], k1, a); s[nt] = a;
                }
                if (band) {
#pragma unroll
                    for (int nt = 0; nt < 4; ++nt)
#pragma unroll
                        for (int i = 0; i < 4; ++i) { const int qp = j * 128 + tok0 + 16 * mt + 4 * q + i, kp = kpos0 + 16 * nt + r; const int df = qp - kp;
                            if (df > 128 || df < -128) s[nt][i] = -1e30f; }
                }
#pragma unroll
                for (int i = 0; i < 4; ++i) {
                    float mx = fmaxf(fmaxf(s[0][i], s[1][i]), fmaxf(s[2][i], s[3][i]));
                    mx = fmaxf(mx, __shfl_xor(mx, 1)); mx = fmaxf(mx, __shfl_xor(mx, 2)); mx = fmaxf(mx, __shfl_xor(mx, 4)); mx = fmaxf(mx, __shfl_xor(mx, 8));
                    const float mn = fmaxf(mrun[mt][i], mx), alpha = __expf(mrun[mt][i] - mn);
                    float rsum = 0.f;
#pragma unroll
                    for (int nt = 0; nt < 4; ++nt) { const float p = __expf(s[nt][i] - mn); rsum += p; Ps[(16 * mt + 4 * q + i) * LK + 16 * nt + r] = f2bf(p); }
                    rsum += __shfl_xor(rsum, 1); rsum += __shfl_xor(rsum, 2); rsum += __shfl_xor(rsum, 4); rsum += __shfl_xor(rsum, 8);
                    lrun[mt][i] = lrun[mt][i] * alpha + rsum; mrun[mt][i] = mn;
#pragma unroll
                    for (int nt = 0; nt < 4; ++nt) oacc[mt][nt][i] *= alpha;
                }
                asm volatile("" ::: "memory");
            }
#pragma unroll
            for (int nt = 0; nt < 4; ++nt) {
                const bf16x8 v0 = ldsfrag(lds + OFF_V + (16 * nt + r) * LKB + (8 * q) * 2), v1 = ldsfrag(lds + OFF_V + (16 * nt + r) * LKB + (32 + 8 * q) * 2);
#pragma unroll
                for (int mt = 0; mt < 4; ++mt) {
                    oacc[mt][nt] = mfma16(ldsfrag(Pb + (16 * mt + r) * LKB + (8 * q) * 2), v0, oacc[mt][nt]);
                    oacc[mt][nt] = mfma16(ldsfrag(Pb + (16 * mt + r) * LKB + (32 + 8 * q) * 2), v1, oacc[mt][nt]);
                }
            }
        }
#pragma unroll
        for (int mt = 0; mt < 4; ++mt)
#pragma unroll
            for (int i = 0; i < 4; ++i) { const float inv = 1.f / lrun[mt][i]; const size_t R = (size_t)(qrow0 + 16 * mt + 4 * q + i);
#pragma unroll
                for (int nt = 0; nt < 4; ++nt) A1[R * D + hq * 64 + 16 * nt + r] = f2bf(oacc[mt][nt][i] * inv); }
    }
    __syncthreads();
}

__device__ __forceinline__ void final_phase(float* out, const float* fnorm) {
    int tid_ = threadIdx.x; asm volatile("" : "+v"(tid_)); const int tid = tid_, lane = tid & 63, wid = __builtin_amdgcn_readfirstlane(tid >> 6);
    for (int R = blockIdx.x * 8 + wid; R < MX; R += gridDim.x * 8) {
        float* src = out + (size_t)R * D;
        f32x4 v[4]; float ss = 0.f;
#pragma unroll
        for (int j = 0; j < 4; ++j) { v[j] = *(const f32x4*)(src + 256 * j + 4 * lane); ss += (v[j][0] * v[j][0] + v[j][1] * v[j][1]) + (v[j][2] * v[j][2] + v[j][3] * v[j][3]); }
        const float rstd = 1.0f / sqrtf(wave_sum(ss) * (1.f / D) + EPS);
#pragma unroll
        for (int j = 0; j < 4; ++j) { const f32x4 w = *(const f32x4*)(fnorm + 256 * j + 4 * lane); *(f32x4*)(src + 256 * j + 4 * lane) = v[j] * rstd * w; }
    }
}

#define GAS __attribute__((address_space(1)))
typedef GAS unsigned gu32;
#define RLX_AGENT __ATOMIC_RELAXED, __HIP_MEMORY_SCOPE_AGENT
#define XB_TMO      128
#define XB_XCNT(j)  (256  + 64 * (j))
#define XB_XSUB(j)  (1280 + 64 * (j))
#define XB_XGEN(j)  (2304 + 64 * (j))
#define XB_TOP      3328
#define XB_TOPGEN   3392
#define XCD_BAR_WORDS 3456
#define XB_SPIN_CAP (1u << 18)

__device__ __forceinline__ unsigned xb_ld(unsigned* p)              { return __hip_atomic_load(p, __ATOMIC_RELAXED, __HIP_MEMORY_SCOPE_AGENT); }
__device__ __forceinline__ unsigned xb_add(unsigned* p, unsigned v) { return __hip_atomic_fetch_add(p, v, __ATOMIC_RELAXED, __HIP_MEMORY_SCOPE_AGENT); }
__device__ __forceinline__ unsigned xb_xcc_id() { return (unsigned)__builtin_amdgcn_s_getreg((3 << 11) | 20) & 0xFu; }
#define XB_SPIN(cond, bar) do { unsigned _sp = 0; while (cond) { __builtin_amdgcn_s_sleep(1); \
    if ((++_sp & 255u) == 0u) { if (xb_ld(&(bar)[XB_TMO])) break; if (_sp > XB_SPIN_CAP) { atomicAdd(&(bar)[XB_TMO], 1u); break; } } } } while (0)

struct XcdBarrier {
    unsigned* bar; unsigned x;
    volatile LAS unsigned* st;
};

__device__ __forceinline__ XcdBarrier xcd_barrier_post(unsigned* bar, volatile LAS unsigned* st) {
    XcdBarrier b; b.bar = bar; b.x = xb_xcc_id(); b.st = st;
    if (threadIdx.x == 0) (void)xb_add(&bar[XB_XCNT(b.x)], 1u);
    return b;
}
__device__ __forceinline__ void xcd_barrier_complete(unsigned* bar, unsigned x, unsigned& nloc, unsigned& nx) {
    const unsigned G = gridDim.x * gridDim.y * gridDim.z;
    unsigned sum, cnt, mine, sp = 0u;
    for (;;) {
        sum = 0u; cnt = 0u;
#pragma unroll 1
        for (unsigned j = 0; j < 16; ++j) { const unsigned c = xb_ld(&bar[XB_XCNT(j)]); sum += c; cnt += (c > 0u) ? 1u : 0u; }
        mine = xb_ld(&bar[XB_XCNT(x)]);
        if (sum == G) break;
        __builtin_amdgcn_s_sleep(1);
        if ((++sp & 255u) == 0u) { if (xb_ld(&bar[XB_TMO])) break; if (sp > XB_SPIN_CAP) { atomicAdd(&bar[XB_TMO], 1u); break; } }
    }
    nloc = mine > 0u ? mine : 1u; nx = cnt > 0u ? cnt : 1u;
}

__device__ __forceinline__ void xcd_barrier(const XcdBarrier& b) {
    asm volatile("s_waitcnt vmcnt(0)" ::: "memory");
    __syncthreads();
    if (threadIdx.x == 0) {
        unsigned* bar = b.bar;
        __builtin_amdgcn_s_waitcnt(0);
        unsigned nloc = b.st[0], nx = b.st[1];
        if (nloc == 0u) { xcd_barrier_complete(bar, b.x, nloc, nx); b.st[0] = nloc; b.st[1] = nx; }
        const unsigned old = xb_add(&bar[XB_XSUB(b.x)], 1u);
        const unsigned gen = old / nloc;
        if (old + 1u == (gen + 1u) * nloc) {
            __builtin_amdgcn_fence(__ATOMIC_RELEASE, "agent");
            asm volatile("s_waitcnt vmcnt(0)" ::: "memory");
            const unsigned og = xb_add(&bar[XB_TOP], 1u);
            const unsigned tg = og / nx;
            if (og + 1u == (tg + 1u) * nx) xb_add(&bar[XB_TOPGEN], 1u);
            else XB_SPIN(xb_ld(&bar[XB_TOPGEN]) == tg, bar);
            __builtin_amdgcn_fence(__ATOMIC_ACQUIRE, "agent");
            xb_add(&bar[XB_XGEN(b.x)], 1u);
            asm volatile("s_waitcnt vmcnt(0)" ::: "memory");
        } else {
            XB_SPIN(xb_ld(&bar[XB_XGEN(b.x)]) == gen, bar);
            __builtin_amdgcn_fence(__ATOMIC_ACQUIRE, "agent");
            asm volatile("s_waitcnt vmcnt(0)" ::: "memory");
        }
    }
    __syncthreads();
}

#ifndef MK_SINGLE
#define MK_SINGLE 1
#endif
constexpr int NPHASES = 24;
#ifndef EN_PREP
#define EN_PREP 1
#endif
#ifndef REP_MASK
#define REP_MASK 0
#endif
#ifndef USE_CG_FIRST
#define USE_CG_FIRST 0
#endif
#ifndef NSYNC_REP
#define NSYNC_REP 1
#endif
#ifndef EN_ALL
#define EN_ALL 1
#endif
#ifndef EN_P0
#define EN_P0 EN_ALL
#endif
#ifndef EN_NORM
#define EN_NORM EN_ALL
#endif
#ifndef EN_GEMM
#define EN_GEMM (EN_ALL ? 15 : 0)
#endif
#ifndef EN_MLSTM
#define EN_MLSTM EN_ALL
#endif
#ifndef EN_SGU
#define EN_SGU EN_ALL
#endif
#ifndef EN_COMB
#define EN_COMB EN_ALL
#endif
#ifndef EN_ATTN
#define EN_ATTN EN_ALL
#endif
#ifndef EN_FINAL
#define EN_FINAL EN_ALL
#endif
__global__ void __launch_bounds__(NTHREADS, 2) fwd_kernel(Args a_unused) {
    extern __shared__ __attribute__((aligned(16))) unsigned char lds_raw[];
    LAS unsigned char* lds = (LAS unsigned char*)lds_raw;
    cg::grid_group grid = cg::this_grid();
    unsigned char* ws = KA(ws);
    const int G = gridDim.x, c = blockIdx.x;
    float* Hx = KA(out); float* Hc = (float*)(ws + WS_HC);
    bf16_t* A0 = (bf16_t*)(ws + WS_A0); bf16_t* A1 = (bf16_t*)(ws + WS_A1); bf16_t* BIG = (bf16_t*)(ws + WS_BIG);
    bf16_t* Hdir = (bf16_t*)(ws + WS_A0);
    const float* mod = (const float*)(ws + WS_MOD);
    float* gates = (float*)(ws + WS_GATES);
    const int lo = KA(ph_lo), hi = KA(ph_hi);
    volatile LAS unsigned* barst = (volatile LAS unsigned*)(lds + LDS_BYTES - 16);
    if (threadIdx.x < 2) barst[threadIdx.x] = 0u;
    __syncthreads();
    XcdBarrier bar = xcd_barrier_post((unsigned*)(ws + WS_CTL), barst);
    enum { K_P0, K_NORM, K_NORMG, K_SWIGLU, K_RESID, K_PLAIN, K_QKV, K_MIX0, K_COMB, K_ATTN, K_FINAL, K_PREP };
    for (int ph = lo; ph < hi; ++ph) {
        const int layer = ph >= 13 ? 1 : 0;
        const int lp = ph >= 13 ? ph - 13 : ph - 1;
        const float* modl = mod + (size_t)layer * 9 * 9216;
        int kind = K_P0, M = MT, gi = 0, ffn = 0, Kd = 1024; float coef = 1.f;
        const bf16_t* Aop = A0; const bf16_t* Wop = nullptr;
        const float* bxp = Hx; const float* bcp = Hc;
        if (ph == 0) kind = K_P0;
        else if (ph == 23) kind = K_FINAL;
        else if (lp == 0) { kind = K_NORM; gi = 0; if (layer == 0) { bxp = KA(x); bcp = KA(ctx); } }
        else if (lp == 1) { kind = K_SWIGLU; ffn = layer * 2; }
        else if (lp == 2) { kind = K_RESID; Aop = BIG; Wop = (const bf16_t*)(ws + WS_WOUT + (size_t)(layer * 2) * SZ_WOUT); Kd = 2816; gi = 2; coef = 0.5f; if (layer == 0) { bxp = KA(x); bcp = KA(ctx); } }
        else if (layer == 0) {
            if (lp == 3) { kind = K_NORMG; gi = 3; }
            else if (lp == 4) kind = K_PLAIN;
            else if (lp == 5) kind = K_PREP;
            else if (lp == 6) kind = K_MIX0;
            else if (lp == 7) kind = K_COMB;
            else if (lp == 8) { kind = K_RESID; Aop = A1; Wop = (const bf16_t*)(ws + WS_WEOUT); gi = 5; }
            else if (lp == 9) { kind = K_NORM; gi = 6; }
            else if (lp == 10) { kind = K_SWIGLU; ffn = 1; }
            else { kind = K_RESID; Aop = BIG; Wop = (const bf16_t*)(ws + WS_WOUT + SZ_WOUT); Kd = 2816; gi = 8; coef = 0.5f; }
        } else {
            if (lp == 3) { kind = K_NORM; gi = 3; }
            else if (lp == 4) kind = K_QKV;
            else if (lp == 5) kind = K_ATTN;
            else if (lp == 6) { kind = K_RESID; Aop = A1; Wop = (const bf16_t*)(ws + WS_WOOUT); gi = 5; M = MX; }
            else if (lp == 7) { kind = K_NORM; gi = 6; M = MX; }
            else if (lp == 8) { kind = K_SWIGLU; ffn = 3; M = MX; }
            else { kind = K_RESID; Aop = BIG; Wop = (const bf16_t*)(ws + WS_WOUT + 3 * SZ_WOUT); Kd = 2816; gi = 8; coef = 0.5f; M = MX; }
        }
        const int nrep = ((REP_MASK >> kind) & 1) ? 2 : 1;
        for (int rep = 0; rep < nrep; ++rep) {
        if (rep == 1) { if (kind == K_RESID) { bxp = Hx; bcp = Hc; coef = 0.f; } __syncthreads(); }
        if (kind == K_P0) { if (EN_P0) p0_phase(lds); }
        else if (kind == K_NORM) { if (EN_NORM) norm_phase<false>(lds, bxp, bcp, A0, modl, gi, gi + 1, M, nullptr, nullptr, nullptr, (ph > 1 && M == MT) ? (float*)(ws + WS_PC) : nullptr); }
        else if (kind == K_NORMG) { if (EN_NORM) norm_phase<true>(lds, Hx, Hc, A0, modl, gi, gi + 1, M, (const float*)(ws + WS_WG), KA(mlstm_gate_b), gates, (float*)(ws + WS_PC)); }
        else if (kind == K_SWIGLU) { if (EN_GEMM & 1) { pg8::Gemm g{A0, (const bf16_t*)(ws + WS_WIN + (size_t)ffn * SZ_WIN), M, 5632, 1024}; pg8::StaticOrder S; S.init(M, 5632, G, c, 1024); pg8::EpiSwiglu E{BIG};
            pg8::gemm_phase<pg8::EpiSwiglu, pg8::StaticOrder, true, true>(lds, g, S, E); } }
        else if (kind == K_RESID) { if (EN_GEMM & 2) { pg8::Gemm g{Aop, Wop, M, 1024, Kd}; pg8::SplitCtxOrder S; S.init(1024, G, c, Kd, M == MT ? 64 : 0); pg8::EpiResid E{bxp, bcp, Hx, Hc, (float*)(ws + WS_PC), modl + gi * 1024, coef};
            pg8::gemm_phase<pg8::EpiResid, pg8::SplitCtxOrder, true, true>(lds, g, S, E); } }
        else if (kind == K_PLAIN) { if (EN_GEMM & 4) { pg8::Gemm g{A0, (const bf16_t*)(ws + WS_WEIN), MT, NEV, 1024}; pg8::StaticOrder S; S.init(MT, NEV, G, c, 1024); pg8::EpiPlain E{BIG, NEV};
            pg8::gemm_phase<pg8::EpiPlain, pg8::StaticOrder, true, true>(lds, g, S, E); } }
        else if (kind == K_QKV) { if (EN_GEMM & 8) { pg8::Gemm g{A0, (const bf16_t*)(ws + WS_WQKV), MT, NQKV, 1024}; pg8::StaticOrder S; S.init(MT, NQKV, G, c, 1024); pg8::EpiQKV E{BIG, (const float*)(ws + WS_ROPE)};
            pg8::gemm_phase<pg8::EpiQKV, pg8::StaticOrder, true, true>(lds, g, S, E); } }
        else if (kind == K_PREP) { if (EN_MLSTM && EN_PREP) qkprep_phase(lds, BIG, KA(mlstm_conv), (bf16_t*)(ws + WS_QC), (bf16_t*)(ws + WS_KC), (bf16_t*)(ws + WS_KCT)); if (EN_SGU) sgu_phase(lds, BIG, KA(sgu_norm), KA(sgu_ws), KA(sgu_b), A1); }
        else if (kind == K_MIX0) { if (EN_MLSTM) mlstm_phase(lds, BIG, gates, (const bf16_t*)(ws + WS_QC), (const bf16_t*)(ws + WS_KC), (const bf16_t*)(ws + WS_KCT), Hdir); }
        else if (kind == K_COMB) { if (EN_COMB) combine_phase(Hdir, BIG, KA(mlstm_norm), A1); }
        else if (kind == K_ATTN) { if (EN_ATTN) attn_phase(lds, BIG, KA(attn_sink), A1); }
        else { if (EN_FINAL) final_phase(Hx, KA(final_norm)); }
        }
        if (ph + 1 < hi) {
            if (ph == 0 && USE_CG_FIRST) {
                __syncthreads();
                if (threadIdx.x < 64) { __builtin_amdgcn_fence(__ATOMIC_RELEASE, "agent"); asm volatile("s_waitcnt vmcnt(0)" ::: "memory"); }
                grid.sync();
                if (threadIdx.x < 64) { __builtin_amdgcn_fence(__ATOMIC_ACQUIRE, "agent"); asm volatile("s_waitcnt vmcnt(0)" ::: "memory"); }
                __syncthreads();
            } else {
                for (int srep = 0; srep < NSYNC_REP; ++srep) xcd_barrier(bar);
            }
        }
    }
}

extern "C" void kernel_launch(void* const* d_in, const int* in_sizes, int n_in, void* d_out, int out_size, void* d_ws, size_t ws_size, hipStream_t stream) {
    static int grid = 0;
    if (grid == 0) {
        if (n_in != 20 || out_size != MX * D || ws_size < WS_END) { fprintf(stderr, "kernel_launch: unexpected problem (n_in %d out %d ws %zu need %zu)\n", n_in, out_size, ws_size, (size_t)WS_END); grid = -1; return; }
        int dev = 0, cus = 0, per_cu = 0;
        hipGetDevice(&dev);
        hipDeviceGetAttribute(&cus, hipDeviceAttributeMultiprocessorCount, dev);
        hipFuncSetAttribute((const void*)fwd_kernel, hipFuncAttributeMaxDynamicSharedMemorySize, LDS_BYTES);
        hipOccupancyMaxActiveBlocksPerMultiprocessor(&per_cu, (const void*)fwd_kernel, NTHREADS, LDS_BYTES);
        if (per_cu < 1) { fprintf(stderr, "kernel_launch: occupancy query says %d blocks per CU\n", per_cu); grid = -1; return; }
        grid = cus;
    }
    if (grid < 0) return;
    if (hipMemsetAsync((char*)d_ws + WS_CTL, 0, CTL_BYTES, stream) != hipSuccess) { fprintf(stderr, "kernel_launch: memset failed\n"); return; }
    Args a{};
#ifdef DBG_MEMSET
    hipMemsetAsync(d_ws, 0, WS_END, stream); hipMemsetAsync(d_out, 0, (size_t)out_size * 4, stream);
#endif
    a.x = (const float*)d_in[0]; a.c = (const float*)d_in[1]; a.ctx = (const float*)d_in[2]; a.c_ctx = (const float*)d_in[3]; a.ada_w = (const float*)d_in[4]; a.ada_b = (const float*)d_in[5];
    a.ffn_w_in = (const float*)d_in[6]; a.ffn_w_out = (const float*)d_in[7]; a.even_w_in = (const float*)d_in[8]; a.even_w_out = (const float*)d_in[9];
    a.mlstm_conv = (const float*)d_in[10]; a.mlstm_gate_b = (const float*)d_in[11]; a.mlstm_norm = (const float*)d_in[12]; a.sgu_norm = (const float*)d_in[13]; a.sgu_ws = (const float*)d_in[14]; a.sgu_b = (const float*)d_in[15];
    a.odd_w_qkv = (const float*)d_in[16]; a.odd_w_out = (const float*)d_in[17]; a.attn_sink = (const float*)d_in[18]; a.final_norm = (const float*)d_in[19];
    a.out = (float*)d_out; a.ws = (unsigned char*)d_ws;
#if MK_SINGLE
    a.ph_lo = 0; a.ph_hi = NPHASES;
    { void* args[] = {&a}; hipError_t e = hipLaunchCooperativeKernel((const void*)fwd_kernel, dim3(grid), dim3(NTHREADS), args, LDS_BYTES, stream);
      if (e != hipSuccess) fprintf(stderr, "cooperative launch failed: %s\n", hipGetErrorString(e)); }
#else
    for (int p = 0; p < NPHASES; ++p) { a.ph_lo = p; a.ph_hi = p + 1; void* args[] = {&a};
        hipError_t e = hipLaunchCooperativeKernel((const void*)fwd_kernel, dim3(grid), dim3(NTHREADS), args, LDS_BYTES, stream);
        if (e != hipSuccess) { fprintf(stderr, "launch %d failed: %s\n", p, hipGetErrorString(e)); break; } }
#endif
}
```

```cpp
#include <hip/hip_runtime.h>
#include <hip/hip_cooperative_groups.h>
#include <cstdio>
#include <cstdint>
namespace cg = cooperative_groups;
namespace pg8 {
#define PG8_LAS __attribute__((address_space(3)))
typedef unsigned short bf16_t;
typedef short bf16x8 __attribute__((ext_vector_type(8)));
typedef float f32x4 __attribute__((ext_vector_type(4)));
typedef unsigned u32x4 __attribute__((ext_vector_type(4)));
constexpr int BM = 256, BK = 64, HALF = 128, HTB = HALF * BK * 2  , STAGE_BYTES = 8 * HTB, NXCD = 8, WGM = 8;

__host__ __device__ __forceinline__ int lds_byte(int r, int c) { const int st = (r >> 4) * 2 + (c >> 5), rr = r & 15, cc = c & 31, ob = rr * 64 + cc * 2; return st * 1024 + (ob ^ (((ob >> 9) & 1) << 5)); }
__host__ __device__ __forceinline__ void stage_rc(int b, int& R, int& C) { const int st = b / 1024, sb = b % 1024, swz = sb ^ (((sb >> 9) & 1) << 5); R = (st >> 1) * 16 + swz / 64; C = (st & 1) * 32 + (swz % 64) / 2; }
__host__ __device__ __forceinline__ int perm32(int rho) { const int n = rho >> 4, i = rho & 15; return 8 * (i >> 2) + 4 * n + (i & 3); }

struct Unit { int pm, pn, k0, nt; };
struct Gemm { const bf16_t* A; const bf16_t* Bt; int M, N, K; };

struct StaticOrder {
    int nM, nN, nwg, G, c, ntf;
    __host__ __device__ void init(int M, int N, int G_, int c_, int K_) { nM = M / BM; nN = N / BM; nwg = nM * nN; G = G_; c = c_; ntf = K_ / BK; }
    __host__ __device__ __forceinline__ bool next(int i, Unit& u) const {
        const long L = (long)i * G + c; if (L >= nwg) return false;
        int wgid = (int)L; { const int q = nwg / NXCD, r = nwg % NXCD, xcd = wgid % NXCD, off = wgid / NXCD; wgid = (xcd < r ? xcd * (q + 1) : r * (q + 1) + (xcd - r) * q) + off; }
        const int nig = WGM * nN, gid = wgid / nig, fm = gid * WGM, gsz = (nM - fm) < WGM ? (nM - fm) : WGM;
        u.pm = fm + ((wgid % nig) % gsz); u.pn = (wgid % nig) / gsz; u.k0 = 0; u.nt = ntf; return true;
    }
    __device__ __forceinline__ void a_ready(const Unit&) const {}
    __device__ __forceinline__ void done(const Unit&) const {}
};

struct SplitCtxOrder {
    int nN, G, c, ntf, nctx;
    __host__ __device__ void init(int N, int G_, int c_, int K_, int nctx_) { nN = N / BM; G = G_; c = c_; ntf = K_ / BK; nctx = nctx_; }
    __host__ __device__ __forceinline__ bool next(int i, Unit& u) const {
        const int L = i * G + c, nwg = 64 * nN;
        if (L >= nwg + nctx) return false;
        int wgid = L < nwg ? L : 0; { const int q = nwg / NXCD, xcd = wgid % NXCD, off = wgid / NXCD; wgid = xcd * q + off; }
        const int nig = WGM * nN, gid = wgid / nig, fm = gid * WGM;
        const int pm0 = fm + ((wgid % nig) % WGM), pn0 = (wgid % nig) / WGM;
        const int L2 = L - nwg, tt = L2 >> 1;
        const bool ctxu = L >= nwg;
        Unit r;
        r.pm = ctxu ? 64 + tt / nN : pm0; r.pn = ctxu ? tt % nN : pn0; r.nt = ctxu ? ntf / 2 : ntf; r.k0 = ctxu ? (L2 & 1) * (ntf / 2) * BK : 0;
        u = r; return true;
    }
    __device__ __forceinline__ void a_ready(const Unit&) const {}
    __device__ __forceinline__ void done(const Unit&) const {}
};

__device__ __forceinline__ unsigned cvt_pk_bf16(float lo, float hi) { unsigned r; asm volatile("v_cvt_pk_bf16_f32 %0, %1, %2" : "=v"(r) : "v"(lo), "v"(hi)); return r; }
typedef float f32x2 __attribute__((ext_vector_type(2)));
template <class Epi, class Sched, bool ALIGN_EPI = false, bool SP2 = false>
__device__ __forceinline__ void gemm_phase(PG8_LAS unsigned char* lds, const Gemm g, const Sched& S, const Epi& E) {
    int tid_ = threadIdx.x; asm volatile("" : "+v"(tid_)); const int tid = tid_, wid = __builtin_amdgcn_readfirstlane(tid >> 6), lane = tid & 63, wr = wid >> 2, wc = wid & 3, fr = lane & 15, fq = lane >> 4;
    const int K = g.K;
    unsigned voffA[2], voffB[2];
#pragma unroll
    for (int i = 0; i < 2; ++i) { int R, C; stage_rc(tid * 16 + i * 8192, R, C); const int Rb = Epi::PERM ? ((R & ~31) + perm32(R & 31)) : R;
        voffA[i] = (unsigned)(R * K + C) * 2u; voffB[i] = (unsigned)(Rb * K + C) * 2u; }
    const size_t kstep = (size_t)(BK * 2);
    const size_t hstep = (size_t)HALF * K * 2;
    const size_t tstep = 2 * hstep;
    const unsigned ldsw = (unsigned)wid * 1024u;
    const int aoff = lds_byte(wr * 64 + fr, fq * 8), boff = lds_byte(wc * 32 + fr, fq * 8);
#define PG8_SA(b, h) (((b) * 2 + (h)) * HTB)
#define PG8_SB(b, h) ((4 + (b) * 2 + (h)) * HTB)
#define PG8_STAGE(bufoff, gbase, voff) do { _Pragma("unroll") for (int _i = 0; _i < 2; ++_i) \
        __builtin_amdgcn_global_load_lds((const unsigned*)((const char*)(gbase) + (voff)[_i]), (PG8_LAS unsigned*)(lds + (bufoff) + ldsw + _i * 8192), 16, 0, 0); } while (0)
#define PG8_LDA(dst, b, h) do { _Pragma("unroll") for (int m = 0; m < 4; ++m) _Pragma("unroll") for (int k = 0; k < 2; ++k) dst[m][k] = *(const PG8_LAS bf16x8*)(lds + PG8_SA(b, h) + aoff + m * 2048 + k * 1024); } while (0)
#define PG8_LDB(dst, b, h) do { _Pragma("unroll") for (int n = 0; n < 2; ++n) _Pragma("unroll") for (int k = 0; k < 2; ++k) dst[n][k] = *(const PG8_LAS bf16x8*)(lds + PG8_SB(b, h) + boff + n * 2048 + k * 1024); } while (0)
#define PG8_MMA(ai, bj, At, Bt) do { __builtin_amdgcn_s_setprio(1); _Pragma("unroll") for (int m = 0; m < 4; ++m) _Pragma("unroll") for (int n = 0; n < 2; ++n) _Pragma("unroll") for (int k = 0; k < 2; ++k) \
        acc[ai][bj][m][n] = __builtin_amdgcn_mfma_f32_16x16x32_bf16(Bt[n][k], At[m][k], acc[ai][bj][m][n], 0, 0, 0); __builtin_amdgcn_s_setprio(0); } while (0)
#define PG8_WAIT_V(n) asm volatile("s_waitcnt vmcnt(" #n ")" ::: "memory")
#define PG8_WAIT_L(n) asm volatile("s_waitcnt lgkmcnt(" #n ")" ::: "memory")
#define PG8_BAR __builtin_amdgcn_s_barrier()
#define PG8_SCHED __builtin_amdgcn_sched_barrier(0)
    Unit cur, nxt; int ui = 0;
    if (!S.next(0, cur)) return;
    f32x4 acc[2][2][4][2];
#pragma unroll
    for (int a = 0; a < 2; ++a)
#pragma unroll
        for (int b = 0; b < 2; ++b)
#pragma unroll
            for (int m = 0; m < 4; ++m)
#pragma unroll
                for (int n = 0; n < 2; ++n) acc[a][b][m][n] = (f32x4){0.f, 0.f, 0.f, 0.f};
    bf16x8 At[4][2], B0[2][2], B1[2][2];
    const char* cA = (const char*)g.A + (size_t)cur.pm * tstep + (size_t)cur.k0 * 2; const char* cB = (const char*)g.Bt + (size_t)cur.pn * tstep + (size_t)cur.k0 * 2;
    S.a_ready(cur);
    if constexpr (SP2) {
        PG8_STAGE(PG8_SB(0, 0), cB, voffB); PG8_STAGE(PG8_SB(0, 1), cB + hstep, voffB); PG8_STAGE(PG8_SA(0, 0), cA, voffA); PG8_STAGE(PG8_SA(0, 1), cA + hstep, voffA);
        if (wr == 1) PG8_BAR;
        PG8_WAIT_V(2); PG8_BAR;
        PG8_STAGE(PG8_SB(1, 0), cB + kstep, voffB); PG8_STAGE(PG8_SA(1, 0), cA + kstep, voffA); PG8_STAGE(PG8_SB(1, 1), cB + hstep + kstep, voffB);
        PG8_WAIT_V(6); PG8_BAR;
    } else {
        PG8_STAGE(PG8_SB(0, 0), cB, voffB); PG8_STAGE(PG8_SA(0, 0), cA, voffA); PG8_STAGE(PG8_SB(0, 1), cB + hstep, voffB); PG8_STAGE(PG8_SA(0, 1), cA + hstep, voffA);
        if (wr == 1) PG8_BAR;
        PG8_WAIT_V(4); PG8_BAR;
        PG8_STAGE(PG8_SB(1, 0), cB + kstep, voffB); PG8_STAGE(PG8_SA(1, 0), cA + kstep, voffA); PG8_STAGE(PG8_SB(1, 1), cB + hstep + kstep, voffB);
        PG8_WAIT_V(6); PG8_BAR;
    }
    for (;;) {
        const bool has_next = S.next(ui + 1, nxt);
        const char* nA = has_next ? (const char*)g.A + (size_t)nxt.pm * tstep + (size_t)nxt.k0 * 2 : cA; const char* nB = has_next ? (const char*)g.Bt + (size_t)nxt.pn * tstep + (size_t)nxt.k0 * 2 : cB;
        const int nt = cur.nt;
        for (int t = 0; t < nt; t += 2) {
            const bool last = (t == nt - 2);
            const char* a1 = cA + (size_t)(t + 1) * kstep;
            const char* a2 = last ? nA : cA + (size_t)(t + 2) * kstep; const char* b2 = last ? nB : cB + (size_t)(t + 2) * kstep;
            const char* a3 = a2 + kstep; const char* b3 = b2 + kstep;
            if (last && has_next) S.a_ready(nxt);
            if constexpr (SP2) {
            PG8_LDB(B0, 0, 0); PG8_LDB(B1, 0, 1); PG8_SCHED; PG8_LDA(At, 0, 0); PG8_STAGE(PG8_SA(1, 1), a1 + hstep, voffA);
            PG8_WAIT_V(8); PG8_WAIT_L(0); PG8_BAR; PG8_MMA(0, 0, At, B0); PG8_MMA(0, 1, At, B1); PG8_BAR; PG8_SCHED;
            PG8_LDA(At, 0, 1); PG8_STAGE(PG8_SB(0, 0), b2, voffB); PG8_STAGE(PG8_SB(0, 1), b2 + hstep, voffB); PG8_STAGE(PG8_SA(0, 0), a2, voffA);
            PG8_WAIT_V(8); PG8_WAIT_L(0); PG8_BAR; PG8_MMA(1, 0, At, B0); PG8_MMA(1, 1, At, B1); PG8_BAR; PG8_SCHED;
            PG8_LDB(B0, 1, 0); PG8_LDB(B1, 1, 1); PG8_SCHED; PG8_LDA(At, 1, 0); PG8_STAGE(PG8_SA(0, 1), a2 + hstep, voffA);
            PG8_WAIT_V(8); PG8_WAIT_L(0); PG8_BAR; PG8_MMA(0, 0, At, B0); PG8_MMA(0, 1, At, B1); PG8_BAR; PG8_SCHED;
            PG8_LDA(At, 1, 1); PG8_STAGE(PG8_SB(1, 0), b3, voffB); PG8_STAGE(PG8_SB(1, 1), b3 + hstep, voffB); PG8_STAGE(PG8_SA(1, 0), a3, voffA);
            PG8_WAIT_V(8); PG8_WAIT_L(0); PG8_BAR; PG8_MMA(1, 0, At, B0); PG8_MMA(1, 1, At, B1); PG8_BAR; PG8_SCHED;
            } else {
            PG8_LDB(B0, 0, 0); PG8_SCHED; PG8_LDA(At, 0, 0); PG8_STAGE(PG8_SA(1, 1), a1 + hstep, voffA);
            PG8_WAIT_L(8); PG8_BAR; PG8_WAIT_L(0); PG8_MMA(0, 0, At, B0); PG8_BAR; PG8_SCHED;
            PG8_LDB(B1, 0, 1); PG8_STAGE(PG8_SB(0, 0), b2, voffB);
            PG8_BAR; PG8_WAIT_L(0); PG8_MMA(0, 1, At, B1); PG8_BAR;
            PG8_LDA(At, 0, 1); PG8_STAGE(PG8_SA(0, 0), a2, voffA);
            PG8_BAR; PG8_WAIT_L(0); PG8_MMA(1, 0, At, B0); PG8_BAR; PG8_SCHED;
            PG8_STAGE(PG8_SB(0, 1), b2 + hstep, voffB);
            PG8_WAIT_V(6); PG8_BAR; PG8_MMA(1, 1, At, B1); PG8_BAR;
            PG8_LDB(B0, 1, 0); PG8_SCHED; PG8_LDA(At, 1, 0); PG8_STAGE(PG8_SA(0, 1), a2 + hstep, voffA);
            PG8_WAIT_L(8); PG8_BAR; PG8_WAIT_L(0); PG8_MMA(0, 0, At, B0); PG8_BAR; PG8_SCHED;
            PG8_LDB(B1, 1, 1); PG8_STAGE(PG8_SB(1, 0), b3, voffB);
            PG8_BAR; PG8_WAIT_L(0); PG8_MMA(0, 1, At, B1); PG8_BAR;
            PG8_LDA(At, 1, 1); PG8_STAGE(PG8_SA(1, 0), a3, voffA);
            PG8_BAR; PG8_WAIT_L(0); PG8_MMA(1, 0, At, B0); PG8_BAR; PG8_SCHED;
            PG8_STAGE(PG8_SB(1, 1), b3 + hstep, voffB);
            PG8_WAIT_V(6); PG8_BAR; PG8_MMA(1, 1, At, B1); PG8_BAR;
            }
        }
        if constexpr (ALIGN_EPI) { if (wr == 0) PG8_BAR; }
        if constexpr (!Epi::AFTER_DRAIN) { E(acc, cur, wr, wc, fr, fq); S.done(cur); }
        if (!has_next) break;
#pragma unroll
        for (int a = 0; a < 2; ++a)
#pragma unroll
            for (int b = 0; b < 2; ++b)
#pragma unroll
                for (int m = 0; m < 4; ++m)
#pragma unroll
                    for (int n = 0; n < 2; ++n) acc[a][b][m][n] = (f32x4){0.f, 0.f, 0.f, 0.f};
        cur = nxt; cA = nA; cB = nB; ++ui;
        if constexpr (ALIGN_EPI) { if (wr == 1) PG8_BAR; }
    }
    PG8_WAIT_V(0);
    if constexpr (!ALIGN_EPI) { if (wr == 0) PG8_BAR; }
    PG8_BAR;
    if constexpr (Epi::AFTER_DRAIN) { E.fused(acc, cur, wr, wc, fr, fq, lds, wid, lane); S.done(cur); }
#undef PG8_SA
#undef PG8_SB
#undef PG8_STAGE
#undef PG8_LDA
#undef PG8_LDB
#undef PG8_MMA
#undef PG8_WAIT_V
#undef PG8_WAIT_L
#undef PG8_BAR
#undef PG8_SCHED
}
}
#define LAS __attribute__((address_space(3)))
typedef unsigned short bf16_t;
typedef short bf16x8 __attribute__((ext_vector_type(8)));
typedef float f32x4 __attribute__((ext_vector_type(4)));
typedef float f32x2 __attribute__((ext_vector_type(2)));
typedef unsigned u32x4 __attribute__((ext_vector_type(4)));
typedef unsigned u32x2 __attribute__((ext_vector_type(2)));

constexpr int D = 1024, NB = 8, SEQ = 2048, CTXL = 256, DFF = 2816;
constexpr int MX = NB * SEQ;
constexpr int MC = NB * CTXL;
constexpr int MT = MX + MC;
constexpr int NMOD = 9;
constexpr int NEV = 3072;
constexpr int NQKV = 1536;
constexpr float EPS = 1e-6f;
constexpr int LDS_BYTES = 147456;
constexpr int NTHREADS = 512;

constexpr size_t MiB = 1u << 20;
constexpr size_t SZ_WIN = (size_t)5632 * 1024 * 2, SZ_WOUT = (size_t)1024 * 2816 * 2;
constexpr size_t WS_WIN = 0;
constexpr size_t WS_WOUT = WS_WIN + 4 * SZ_WIN;
constexpr size_t WS_WEIN = WS_WOUT + 4 * SZ_WOUT;
constexpr size_t WS_WEOUT = WS_WEIN + (size_t)3072 * 1024 * 2;
constexpr size_t WS_WQKV = WS_WEOUT + (size_t)1024 * 1024 * 2;
constexpr size_t WS_WOOUT = WS_WQKV + (size_t)1536 * 1024 * 2;
constexpr size_t WS_MOD = WS_WOOUT + (size_t)1024 * 1024 * 2;
constexpr size_t WS_WG = WS_MOD + (size_t)2 * 9 * 9216 * 4;
constexpr size_t WS_ROPE = WS_WG + (size_t)16 * 1024 * 4;
constexpr size_t WS_GATES = WS_ROPE + 8192;
constexpr size_t WS_HC = WS_GATES + (size_t)MT * 16 * 4;
constexpr size_t WS_A0 = ((WS_HC + (size_t)MC * D * 4 + 255) / 256) * 256;
constexpr size_t WS_QC = WS_A0 + (size_t)MT * D * 2;
constexpr size_t WS_KC = WS_QC + (size_t)MT * 512 * 2;
constexpr size_t WS_KCT = WS_KC + (size_t)MT * 512 * 2;
constexpr size_t WS_A1 = WS_KCT + (size_t)576 * 128 * 128 * 2;
constexpr size_t WS_BIG = WS_A1 + (size_t)MT * D * 2;
constexpr size_t WS_CTL = WS_BIG + (size_t)MT * 3072 * 2;
constexpr size_t CTL_BYTES = 16384;
constexpr size_t WS_PC = WS_CTL + CTL_BYTES;
constexpr size_t WS_END = WS_PC + (size_t)MC * D * 4;

struct Args {
    const float* x; const float* c; const float* ctx; const float* c_ctx; const float* ada_w; const float* ada_b;
    const float* ffn_w_in; const float* ffn_w_out; const float* even_w_in; const float* even_w_out;
    const float* mlstm_conv; const float* mlstm_gate_b; const float* mlstm_norm; const float* sgu_norm; const float* sgu_ws; const float* sgu_b;
    const float* odd_w_qkv; const float* odd_w_out; const float* attn_sink; const float* final_norm;
    float* out; unsigned char* ws; int ph_lo, ph_hi;
};

typedef const __attribute__((address_space(4))) Args* kargp;
__device__ __forceinline__ kargp kargs() { kargp p = (kargp)__builtin_amdgcn_kernarg_segment_ptr(); asm volatile("" : "+s"(p)); return p; }
#define KA(f) (kargs()->f)
typedef __bf16 bf16x2_t __attribute__((ext_vector_type(2)));
__device__ __forceinline__ unsigned pk2(float lo, float hi) { f32x2 v = {lo, hi}; bf16x2_t b = __builtin_convertvector(v, bf16x2_t); return __builtin_bit_cast(unsigned, b); }
__device__ __forceinline__ bf16_t f2bf(float f) { return (bf16_t)(pk2(f, 0.f) & 0xffffu); }
__device__ __forceinline__ float bf2f(bf16_t v) { return __uint_as_float(((unsigned)v) << 16); }
__device__ __forceinline__ float bflo(unsigned w) { return __uint_as_float(w << 16); }
__device__ __forceinline__ float bfhi(unsigned w) { return __uint_as_float(w & 0xffff0000u); }
__device__ __forceinline__ float silu_f(float v) { return v * __builtin_amdgcn_rcpf(1.f + __expf(-v)); }
__device__ __forceinline__ float sigmoid_f(float v) { return __builtin_amdgcn_rcpf(1.f + __expf(-v)); }
__device__ __forceinline__ float gelu_tanh(float v) {
    const float z = 0.7978845608028654f * (v + 0.044715f * v * v * v);
    const float t = 1.f - 2.f * __builtin_amdgcn_rcpf(1.f + __expf(2.f * z));
    return 0.5f * v * (1.f + t);
}
template <int CTRL> __device__ __forceinline__ float dppf(float v) { return __builtin_bit_cast(float, __builtin_amdgcn_update_dpp(0, __builtin_bit_cast(int, v), CTRL, 0xf, 0xf, false)); }
__device__ __forceinline__ float row16_sum(float v) { v += dppf<0xB1>(v); v += dppf<0x4E>(v); v += dppf<0x141>(v); v += dppf<0x140>(v); return v; }
__device__ __forceinline__ float row16_max(float v) { v = fmaxf(v, dppf<0xB1>(v)); v = fmaxf(v, dppf<0x4E>(v)); v = fmaxf(v, dppf<0x141>(v)); v = fmaxf(v, dppf<0x140>(v)); return v; }
__device__ __forceinline__ float wave_sum(float v) { v = row16_sum(v); v += __shfl_xor(v, 16); v += __shfl_xor(v, 32); return v; }
__device__ __forceinline__ float wave_max(float v) { v = row16_max(v); v = fmaxf(v, __shfl_xor(v, 16)); v = fmaxf(v, __shfl_xor(v, 32)); return v; }
__device__ __forceinline__ f32x4 mfma16(bf16x8 a, bf16x8 b, f32x4 c) { return __builtin_amdgcn_mfma_f32_16x16x32_bf16(a, b, c, 0, 0, 0); }
__device__ __forceinline__ bf16x8 ldsfrag(const LAS unsigned char* p) { return *(const LAS bf16x8*)p; }

namespace pg8 {
struct EpiSwiglu {
    static constexpr bool PERM = true, AFTER_DRAIN = false;
    bf16_t* O;
    __device__ __forceinline__ void operator()(const f32x4 (&acc)[2][2][4][2], const Unit& u, int wr, int wc, int fr, int fq) const {
        const int row0 = u.pm * BM + wr * 64 + fr, col0 = u.pn * 128 + wc * 32 + 8 * fq;
#pragma unroll
        for (int ai = 0; ai < 2; ++ai)
#pragma unroll
            for (int m = 0; m < 4; ++m) {
                bf16_t* rowp = O + (size_t)(row0 + ai * HALF + m * 16) * DFF + col0;
                const f32x4 g0 = acc[ai][0][m][0], g1 = acc[ai][0][m][1], u0 = acc[ai][1][m][0], u1 = acc[ai][1][m][1];
                u32x4 w;
                w.x = ::pk2(::silu_f(g0[0]) * u0[0], ::silu_f(g0[1]) * u0[1]); w.y = ::pk2(::silu_f(g0[2]) * u0[2], ::silu_f(g0[3]) * u0[3]);
                w.z = ::pk2(::silu_f(g1[0]) * u1[0], ::silu_f(g1[1]) * u1[1]); w.w = ::pk2(::silu_f(g1[2]) * u1[2], ::silu_f(g1[3]) * u1[3]);
                *(u32x4*)rowp = w;
            }
    }
};
struct EpiResid {
    static constexpr bool PERM = false, AFTER_DRAIN = false;
    const float* bx; const float* bc; float* ox; float* oc; float* pc; const float* gate;
    float coef;
    __device__ __forceinline__ void operator()(const f32x4 (&acc)[2][2][4][2], const Unit& u, int wr, int wc, int fr, int fq) const {
        const bool isx = u.pm < 64; const bool split = u.k0 != 0;
        const int bi = isx ? (u.pm >> 3) : 8;
        const float* base = isx ? bx : bc - (size_t)MX * D;
        float* outp = isx ? ox : oc - (size_t)MX * D;
        const int row0 = u.pm * BM + wr * 64 + fr, col0 = u.pn * BM + wc * 32 + 4 * fq;
        const float* gp = gate + (size_t)bi * 9216 + col0;
#pragma unroll
        for (int bj = 0; bj < 2; ++bj)
#pragma unroll
            for (int n = 0; n < 2; ++n) {
                const f32x4 gv = *(const f32x4*)(gp + bj * HALF + n * 16) * coef;
#pragma unroll
                for (int ai = 0; ai < 2; ++ai)
#pragma unroll
                    for (int m = 0; m < 4; ++m) {
                        const size_t off = (size_t)(row0 + ai * HALF + m * 16) * D + col0 + bj * HALF + n * 16;
                        const f32x4 pv = gv * acc[ai][bj][m][n];
                        if (split) {
                            *(f32x4*)(pc + off - (size_t)MX * D) = pv;
                        } else {
                            const f32x4 b = *(const f32x4*)(base + off);
                            *(f32x4*)(outp + off) = b + pv;
                        }
                        if (m & 1) asm volatile("" ::: "memory");
                    }
            }
    }
};
struct EpiPlain {
    static constexpr bool PERM = true, AFTER_DRAIN = false;
    bf16_t* O; int ldc;
    __device__ __forceinline__ void operator()(const f32x4 (&acc)[2][2][4][2], const Unit& u, int wr, int wc, int fr, int fq) const {
        const int row0 = u.pm * BM + wr * 64 + fr, col0 = u.pn * BM + wc * 32 + 8 * fq;
#pragma unroll
        for (int ai = 0; ai < 2; ++ai)
#pragma unroll
            for (int m = 0; m < 4; ++m) {
                bf16_t* rowp = O + (size_t)(row0 + ai * HALF + m * 16) * ldc + col0;
#pragma unroll
                for (int bj = 0; bj < 2; ++bj) {
                    const f32x4 v0 = acc[ai][bj][m][0], v1 = acc[ai][bj][m][1];
                    u32x4 w; w.x = ::pk2(v0[0], v0[1]); w.y = ::pk2(v0[2], v0[3]); w.z = ::pk2(v1[0], v1[1]); w.w = ::pk2(v1[2], v1[3]);
                    *(u32x4*)(rowp + bj * HALF) = w;
                }
            }
    }
};
struct EpiQKV {
    static constexpr bool PERM = true, AFTER_DRAIN = false;
    bf16_t* O; const float* rope;
    __device__ __forceinline__ void operator()(const f32x4 (&acc)[2][2][4][2], const Unit& u, int wr, int wc, int fr, int fq) const {
        const int row0 = u.pm * BM + wr * 64 + fr;
        const bool isx = u.pm < 64;
#pragma unroll
        for (int bj = 0; bj < 2; ++bj) {
            const int col0 = u.pn * BM + bj * HALF + wc * 32 + 8 * fq;
            const bool dorope = isx && (col0 < 1280);
            const float qs = (col0 < 1024) ? 0.125f : 1.f;
            const int p0 = (col0 & 63) >> 1;
            const int f0 = p0 & 15;
#pragma unroll
            for (int ai = 0; ai < 2; ++ai)
#pragma unroll
                for (int m = 0; m < 4; ++m) {
                    const int row = row0 + ai * HALF + m * 16;
                    f32x4 v0 = acc[ai][bj][m][0] * qs, v1 = acc[ai][bj][m][1] * qs;
                    if (dorope) {
                        const int t = row & 2047;
                        const int pos = (p0 < 16) ? (t >> 6) : (t & 63);
                        const f32x4 cs0 = *(const f32x4*)(rope + (pos * 16 + f0) * 2), cs1 = *(const f32x4*)(rope + (pos * 16 + f0) * 2 + 4);
                        f32x4 r0, r1;
                        r0[0] = v0[0] * cs0[0] - v0[1] * cs0[1]; r0[1] = v0[0] * cs0[1] + v0[1] * cs0[0];
                        r0[2] = v0[2] * cs0[2] - v0[3] * cs0[3]; r0[3] = v0[2] * cs0[3] + v0[3] * cs0[2];
                        r1[0] = v1[0] * cs1[0] - v1[1] * cs1[1]; r1[1] = v1[0] * cs1[1] + v1[1] * cs1[0];
                        r1[2] = v1[2] * cs1[2] - v1[3] * cs1[3]; r1[3] = v1[2] * cs1[3] + v1[3] * cs1[2];
                        v0 = r0; v1 = r1;
                    }
                    u32x4 w; w.x = ::pk2(v0[0], v0[1]); w.y = ::pk2(v0[2], v0[3]); w.z = ::pk2(v1[0], v1[1]); w.w = ::pk2(v1[2], v1[3]);
                    *(u32x4*)(O + (size_t)row * NQKV + col0) = w;
                }
        }
    }
};
}

__device__ __forceinline__ void tr_item(const float* W, int ldw, int k0, int srccol0, bf16_t* WT, int K, int destrow0, LAS float* scr, int lane) {
#pragma unroll 8
    for (int i = 0; i < 32; ++i) { const int kk = 2 * i + (lane >> 5); scr[kk * 33 + (lane & 31)] = W[(size_t)(k0 + kk) * ldw + srccol0 + (lane & 31)]; }
    asm volatile("s_waitcnt lgkmcnt(0)" ::: "memory");
    const int c = lane & 7;
#pragma unroll
    for (int j = 0; j < 4; ++j) { const int n = (lane >> 3) + 8 * j; const LAS float* s = scr + (8 * c) * 33 + n;
        u32x4 o; o.x = pk2(s[0 * 33], s[1 * 33]); o.y = pk2(s[2 * 33], s[3 * 33]); o.z = pk2(s[4 * 33], s[5 * 33]); o.w = pk2(s[6 * 33], s[7 * 33]);
        *(u32x4*)(WT + (size_t)(destrow0 + n) * K + k0 + 8 * c) = o; }
    asm volatile("s_waitcnt lgkmcnt(0)" ::: "memory");
}

__device__ __forceinline__ void p0_phase(LAS unsigned char* lds) {
    int tid_ = threadIdx.x; asm volatile("" : "+v"(tid_)); const int tid = tid_, lane = tid & 63, wid = __builtin_amdgcn_readfirstlane(tid >> 6), G = gridDim.x;
    unsigned char* ws = KA(ws);
    {
        LAS float* s = (LAS float*)lds;
        LAS float* red = (LAS float*)(lds + 36864);
        for (int i = tid; i < 9 * 1024; i += NTHREADS) { const float v = (i < 8192) ? KA(c)[i] : KA(c_ctx)[i - 8192]; s[i] = v / (1.f + expf(-v)); }
        __syncthreads();
        float* mod = (float*)(ws + WS_MOD);
        for (int tile = blockIdx.x; tile < 288; tile += G) {
            const int l = tile / 144, cg = tile % 144, n = cg * 64 + lane, kg = wid;
            float acc[9];
#pragma unroll
            for (int bi = 0; bi < 9; ++bi) acc[bi] = 0.f;
            const float* wp = KA(ada_w) + ((size_t)l * 1024 + kg * 128) * 9216 + n;
#pragma unroll 4
            for (int kk = 0; kk < 128; ++kk) {
                const float w = wp[(size_t)kk * 9216];
#pragma unroll
                for (int bi = 0; bi < 9; ++bi) acc[bi] += s[bi * 1024 + kg * 128 + kk] * w;
            }
#pragma unroll
            for (int bi = 0; bi < 9; ++bi) red[(kg * 9 + bi) * 64 + lane] = acc[bi];
            __syncthreads();
            for (int i = tid; i < 576; i += NTHREADS) {
                const int bi = i >> 6, cc = i & 63; float sum = 0.f;
#pragma unroll
                for (int k2 = 0; k2 < 8; ++k2) sum += red[(k2 * 9 + bi) * 64 + cc];
                mod[((size_t)l * 9 + bi) * 9216 + cg * 64 + cc] = sum + KA(ada_b)[l * 9216 + cg * 64 + cc];
            }
            __syncthreads();
        }
    }
    {
        const int gt = blockIdx.x * NTHREADS + tid, GT = G * NTHREADS;
        float* wg = (float*)(ws + WS_WG);
        for (int i = gt; i < 16 * 1024; i += GT) { const int g = i >> 10, k = i & 1023; wg[i] = KA(even_w_in)[(size_t)k * 3088 + 2048 + g]; }
        float* rope = (float*)(ws + WS_ROPE);
        for (int i = gt; i < 64 * 16; i += GT) { const int pos = i >> 4, f = i & 15; const float inv = powf(10000.f, -(float)f / 16.f); const float ang = (float)pos * inv; rope[2 * i] = cosf(ang); rope[2 * i + 1] = sinf(ang); }
    }
    {
        LAS float* scr = (LAS float*)(lds + wid * 16384);
        const int gw = blockIdx.x * 8 + wid, NGW = G * 8;
        constexpr int I_IN = 16 * 176, I_OUT = 44 * 32, I_EIN = 16 * 96, I_SQ = 16 * 32, I_QKV = 16 * 48;
        constexpr int NITEMS = 4 * I_IN + 4 * I_OUT + I_EIN + I_SQ + I_QKV + I_SQ;
        for (int it = gw; it < NITEMS; it += NGW) {
            int r = it;
            if (r < 4 * I_IN) { const int mi = r / I_IN; r -= mi * I_IN; const int kb = r / 176, nb = r % 176; const int n0 = nb * 32;
                const int dest = (n0 < 2816) ? ((n0 >> 7) * 256 + (n0 & 127)) : ((((n0 - 2816) >> 7) * 256) + 128 + ((n0 - 2816) & 127));
                tr_item(KA(ffn_w_in) + (size_t)mi * 1024 * 5632, 5632, kb * 64, n0, (bf16_t*)(ws + WS_WIN + mi * SZ_WIN), 1024, dest, scr, lane); continue; }
            r -= 4 * I_IN;
            if (r < 4 * I_OUT) { const int mi = r / I_OUT; r -= mi * I_OUT; const int kb = r / 32, nb = r % 32;
                tr_item(KA(ffn_w_out) + (size_t)mi * 2816 * 1024, 1024, kb * 64, nb * 32, (bf16_t*)(ws + WS_WOUT + mi * SZ_WOUT), 2816, nb * 32, scr, lane); continue; }
            r -= 4 * I_OUT;
            if (r < I_EIN) { const int kb = r / 96, nb = r % 96; const int src = nb < 64 ? nb * 32 : 2064 + (nb - 64) * 32;
                tr_item(KA(even_w_in), 3088, kb * 64, src, (bf16_t*)(ws + WS_WEIN), 1024, nb * 32, scr, lane); continue; }
            r -= I_EIN;
            if (r < I_SQ) { const int kb = r / 32, nb = r % 32; tr_item(KA(even_w_out), 1024, kb * 64, nb * 32, (bf16_t*)(ws + WS_WEOUT), 1024, nb * 32, scr, lane); continue; }
            r -= I_SQ;
            if (r < I_QKV) { const int kb = r / 48, nb = r % 48; tr_item(KA(odd_w_qkv), 1536, kb * 64, nb * 32, (bf16_t*)(ws + WS_WQKV), 1024, nb * 32, scr, lane); continue; }
            r -= I_QKV;
            { const int kb = r / 32, nb = r % 32; tr_item(KA(odd_w_out), 1024, kb * 64, nb * 32, (bf16_t*)(ws + WS_WOOUT), 1024, nb * 32, scr, lane); }
        }
    }
}

template <bool GATES>
__device__ __forceinline__ void norm_phase(LAS unsigned char* lds, const float* hx, const float* hc, bf16_t* A0, const float* modl, int shift_i, int scale_i, int nrows,
                                           const float* wg, const float* gate_b, float* gates, float* copy_c) {
    int tid_ = threadIdx.x; asm volatile("" : "+v"(tid_)); const int tid = tid_, lane = tid & 63, wid = __builtin_amdgcn_readfirstlane(tid >> 6), G = gridDim.x;
    LAS float* wgs = (LAS float*)lds;
    if (GATES) { for (int i = tid; i < 16 * 1024 / 4; i += NTHREADS) ((LAS f32x4*)wgs)[i] = ((const f32x4*)wg)[i]; __syncthreads(); }
    const int R0 = blockIdx.x * 8 + wid, RS = G * 8;
    f32x4 vn[4], pn[4];
#define NORM_LOAD(R_) do { const bool isx_ = (R_) < MX; const float* src_ = isx_ ? hx + (size_t)(R_) * D : hc + (size_t)((R_) - MX) * D; \
        _Pragma("unroll") for (int j = 0; j < 4; ++j) { vn[j] = *(const f32x4*)(src_ + 256 * j + 4 * lane); \
            pn[j] = (copy_c && !isx_) ? *(const f32x4*)(copy_c + (size_t)((R_) - MX) * D + 256 * j + 4 * lane) : (f32x4){0.f, 0.f, 0.f, 0.f}; } } while (0)
    if (R0 < nrows) NORM_LOAD(R0);
    for (int R = R0; R < nrows; R += RS) {
        const bool isx = R < MX;
        const int bi = isx ? (R >> 11) : 8;
        const float* mb = modl + (size_t)bi * 9216;
        f32x4 v[4]; float ss = 0.f;
#pragma unroll
        for (int j = 0; j < 4; ++j) { v[j] = vn[j] + pn[j];
            if (copy_c && !isx) *(f32x4*)((float*)hc + (size_t)(R - MX) * D + 256 * j + 4 * lane) = v[j];
            ss += (v[j][0] * v[j][0] + v[j][1] * v[j][1]) + (v[j][2] * v[j][2] + v[j][3] * v[j][3]); }
        if (R + RS < nrows) NORM_LOAD(R + RS);
        const float rstd = 1.0f / sqrtf(wave_sum(ss) * (1.f / D) + EPS);
#pragma unroll
        for (int j = 0; j < 4; ++j) {
            const f32x4 sc = *(const f32x4*)(mb + scale_i * 1024 + 256 * j + 4 * lane), sh = *(const f32x4*)(mb + shift_i * 1024 + 256 * j + 4 * lane);
            v[j] = v[j] * rstd * (sc + 1.f) + sh;
            u32x2 w; w.x = pk2(v[j][0], v[j][1]); w.y = pk2(v[j][2], v[j][3]);
            *(u32x2*)(A0 + (size_t)R * D + 256 * j + 4 * lane) = w;
        }
        if (GATES) {
            float mine = 0.f;
#pragma unroll 1
            for (int g = 0; g < 16; ++g) {
                float d = 0.f;
#pragma unroll
                for (int j = 0; j < 4; ++j) { const f32x4 w = *(const LAS f32x4*)(wgs + g * 1024 + 256 * j + 4 * lane); d += (v[j][0] * w[0] + v[j][1] * w[1]) + (v[j][2] * w[2] + v[j][3] * w[3]); }
                d = wave_sum(d);
                if (lane == g) mine = d;
            }
            if (lane < 16) gates[(size_t)R * 16 + lane] = mine + gate_b[lane];
        }
    }
    if (GATES) __syncthreads();
}

__device__ __forceinline__ void qkprep_phase(LAS unsigned char* lds, const bf16_t* P, const float* convw, bf16_t* Qc, bf16_t* Kc, bf16_t* KcT) {
    int tid_ = threadIdx.x; asm volatile("" : "+v"(tid_)); const int tid = tid_;
    constexpr int LD = 136;
    LAS bf16_t* Tt = (LAS bf16_t*)lds;
    LAS float* cw = (LAS float*)(lds + 34816);
    const int seg = tid & 15;
    for (int unit = blockIdx.x; unit < 576; unit += gridDim.x) {
        const int h = unit & 3, gc = unit >> 2, n = gc % 18, b = gc / 18;
        const int sbase = n < 2 ? MX + b * CTXL : b * SEQ, T = n < 2 ? CTXL : SEQ, t0 = n < 2 ? n * 128 : (n - 2) * 128;
        for (int i = tid; i < 768; i += NTHREADS) { const int qk = i / 384, j = (i % 384) >> 7, ch = i & 127; cw[i] = convw[j * 1024 + qk * 512 + h * 128 + ch]; }
        __syncthreads();
#pragma unroll 1
        for (int it = 0; it < 4; ++it) {
            const int l = (tid + NTHREADS * it) >> 4;
            const int tin = t0 + l;
            const size_t R = (size_t)(sbase + tin);
            const bf16_t* pr = P + R * NEV + h * 128 + seg * 8;
            const u32x4 z = (u32x4){0u, 0u, 0u, 0u};
#pragma unroll
            for (int qk = 0; qk < 2; ++qk) {
                const bf16_t* pp = pr + qk * 512;
                const u32x4 c0 = *(const u32x4*)pp; const u32x4 pv = tin > 0 ? *(const u32x4*)(pp - NEV) : z; const u32x4 nx = tin < T - 1 ? *(const u32x4*)(pp + NEV) : z;
                float y[8];
#pragma unroll
                for (int hf = 0; hf < 2; ++hf) {
                    const f32x4 w0 = *(const LAS f32x4*)(cw + (qk * 3 + 0) * 128 + seg * 8 + 4 * hf), w1 = *(const LAS f32x4*)(cw + (qk * 3 + 1) * 128 + seg * 8 + 4 * hf), w2v = *(const LAS f32x4*)(cw + (qk * 3 + 2) * 128 + seg * 8 + 4 * hf);
                    y[4 * hf + 0] = w0[0] * bflo(pv[2 * hf]) + w1[0] * bflo(c0[2 * hf]) + w2v[0] * bflo(nx[2 * hf]);
                    y[4 * hf + 1] = w0[1] * bfhi(pv[2 * hf]) + w1[1] * bfhi(c0[2 * hf]) + w2v[1] * bfhi(nx[2 * hf]);
                    y[4 * hf + 2] = w0[2] * bflo(pv[2 * hf + 1]) + w1[2] * bflo(c0[2 * hf + 1]) + w2v[2] * bflo(nx[2 * hf + 1]);
                    y[4 * hf + 3] = w0[3] * bfhi(pv[2 * hf + 1]) + w1[3] * bfhi(c0[2 * hf + 1]) + w2v[3] * bfhi(nx[2 * hf + 1]);
                }
                const float scl = qk ? 0.08838834764831845f : 1.f;
                u32x4 o;
#pragma unroll
                for (int w2 = 0; w2 < 4; ++w2) o[w2] = pk2(silu_f(y[2 * w2]) * scl, silu_f(y[2 * w2 + 1]) * scl);
                *(u32x4*)((qk ? Kc : Qc) + R * 512 + h * 128 + seg * 8) = o;
                if (qk) {
#pragma unroll
                    for (int w2 = 0; w2 < 4; ++w2) { Tt[(seg * 8 + 2 * w2) * LD + l] = (bf16_t)(o[w2] & 0xffffu); Tt[(seg * 8 + 2 * w2 + 1) * LD + l] = (bf16_t)(o[w2] >> 16); }
                }
            }
        }
        __syncthreads();
#pragma unroll
        for (int it = 0; it < 4; ++it) { const int i = tid + NTHREADS * it; const int d = i >> 4, sg = i & 15;
            *(u32x4*)(KcT + ((size_t)unit * 128 + d) * 128 + sg * 8) = *(const LAS u32x4*)(Tt + d * LD + sg * 8); }
        __syncthreads();
    }
}

__device__ __forceinline__ void mlstm_phase(LAS unsigned char* lds, const bf16_t* P, const float* gates, const bf16_t* Qc, const bf16_t* Kc, const bf16_t* KcT, bf16_t* Hdir) {
    int tid_ = threadIdx.x; asm volatile("" : "+v"(tid_)); const int tid = tid_, lane = tid & 63, wid = __builtin_amdgcn_readfirstlane(tid >> 6), r = lane & 15, q = lane >> 4;
    constexpr int LD = 136, LDB = LD * 2;
    constexpr int OFF_Q = 0, OFF_K = 34816, OFF_KT = 69632, OFF_VT = 104448, OFF_VW = 113152, OFF_CT = 121856, OFF_SC = 130560;
    LAS bf16_t* Qs = (LAS bf16_t*)(lds + OFF_Q); LAS bf16_t* Ks = (LAS bf16_t*)(lds + OFF_K); LAS bf16_t* Kt = (LAS bf16_t*)(lds + OFF_KT);
    LAS bf16_t* Vt = (LAS bf16_t*)(lds + OFF_VT); LAS bf16_t* Vw = (LAS bf16_t*)(lds + OFF_VW); LAS bf16_t* Ct = (LAS bf16_t*)(lds + OFF_CT);
    LAS float* sc = (LAS float*)(lds + OFF_SC);
    LAS float* rowf = sc; LAS float* dmb = sc + 128; LAS float* inter = sc + 256; LAS float* wl = sc + 384; LAS float* en = sc + 512; LAS float* qn = sc + 640; LAS float* nvec = sc + 768; LAS float* misc = sc + 896;
    for (int unit = blockIdx.x; unit < 256; unit += gridDim.x) {
        const int es = unit & 3, dir = (unit >> 2) & 1, h = (unit >> 3) & 3, b = unit >> 5;
        for (int i = tid; i < 32 * LD / 2; i += NTHREADS) ((LAS unsigned*)Ct)[i] = 0u;
        if (tid < 128) nvec[tid] = 0.f;
        f32x4 Cacc[2]; Cacc[0] = (f32x4){0.f, 0.f, 0.f, 0.f}; Cacc[1] = Cacc[0];
        float m_state = 0.f;
        u32x4 pq[4], pvv; float pgi[2], pgf[2];
        const unsigned voffq = (unsigned)(((tid >> 4) * 512 + (tid & 15) * 8) * 2), vofft = (unsigned)(((tid >> 4) * 128 + (tid & 15) * 8) * 2);
#define MLSTM_CHUNK_INFO(ci_, n_, gc_, rb_) do { if ((ci_) < 2) n_ = dir ? 1 - (ci_) : (ci_); else n_ = dir ? 19 - (ci_) : (ci_); gc_ = b * 18 + n_; rb_ = n_ < 2 ? MX + b * CTXL + n_ * 128 : b * SEQ + (n_ - 2) * 128; } while (0)
#define MLSTM_PREFETCH(ci_) do { int n2, gc2, rb2; MLSTM_CHUNK_INFO(ci_, n2, gc2, rb2); \
            const bf16_t* qg = Qc + (size_t)rb2 * 512 + h * 128; (void)gc2; \
            _Pragma("unroll") for (int it = 0; it < 4; ++it) { \
                pq[it] = *(const u32x4*)((const char*)(qg + it * 16384) + voffq); } \
            pvv = *(const u32x4*)(P + (size_t)(rb2 + (tid >> 2)) * NEV + 1024 + h * 128 + es * 32 + (tid & 3) * 8); \
            if (wid == 0) { _Pragma("unroll") for (int hf = 0; hf < 2; ++hf) { const int l = lane + 64 * hf; const int R = rb2 + (dir ? 127 - l : l); \
                pgi[hf] = gates[(size_t)R * 16 + dir * 8 + h]; pgf[hf] = gates[(size_t)R * 16 + dir * 8 + 4 + h]; } } } while (0)
        MLSTM_PREFETCH(0);
        __syncthreads();
        for (int ci = 0; ci < 18; ++ci) {
            int wc_ = wid, dc_ = dir; asm volatile("" : "+s"(wc_), "+s"(dc_)); const int widc = wc_, dirc = dc_;
            int n, gc, rbase;
            MLSTM_CHUNK_INFO(ci, n, gc, rbase);
            if (wid == 0) {
                float ig[2], bc[2];
#pragma unroll
                for (int hf = 0; hf < 2; ++hf) { ig[hf] = pgi[hf]; const float fg = pgf[hf];
                    bc[hf] = fminf(fg, 0.f) - log1pf(expf(-fabsf(fg))); }
#pragma unroll
                for (int off = 1; off < 64; off <<= 1) { const float t0 = __shfl_up(bc[0], off), t1 = __shfl_up(bc[1], off); if (lane >= off) { bc[0] += t0; bc[1] += t1; } }
                bc[1] += __shfl(bc[0], 63);
                const float g = __shfl(bc[1], 63);
                const float d0 = ig[0] - bc[0], d1 = ig[1] - bc[1];
                float p0 = d0, p1 = d1;
#pragma unroll
                for (int off = 1; off < 64; off <<= 1) { const float t0 = __shfl_up(p0, off), t1 = __shfl_up(p1, off); if (lane >= off) { p0 = fmaxf(p0, t0); p1 = fmaxf(p1, t1); } }
                p1 = fmaxf(p1, __shfl(p0, 63));
                const float a0 = g + d0, a1 = g + d1;
                const float mloc = wave_max(fmaxf(a0, a1));
                const float m_new = fmaxf(g + m_state, mloc);
                const float dec = expf(g + m_state - m_new);
                const float mt0 = bc[0] + fmaxf(m_state, p0), mt1 = bc[1] + fmaxf(m_state, p1);
                const int i0 = dir ? 127 - lane : lane, i1 = dir ? 63 - lane : lane + 64;
                rowf[i0] = bc[0] - mt0; rowf[i1] = bc[1] - mt1;
                dmb[i0] = d0; dmb[i1] = d1;
                inter[i0] = expf(bc[0] + m_state - mt0); inter[i1] = expf(bc[1] + m_state - mt1);
                wl[i0] = expf(a0 - m_new); wl[i1] = expf(a1 - m_new);
                en[i0] = expf(-mt0); en[i1] = expf(-mt1);
                if (lane == 0) misc[0] = dec;
                m_state = m_new;
            }
            u32x4 pk[4], pt[4];
            { const bf16_t* kg = Kc + (size_t)rbase * 512 + h * 128; const bf16_t* tg = KcT + (size_t)(gc * 4 + h) * 128 * 128;
#pragma unroll
              for (int it = 0; it < 4; ++it) pk[it] = *(const u32x4*)((const char*)(kg + it * 16384) + voffq);
#pragma unroll
              for (int it = 0; it < 4; ++it) pt[it] = *(const u32x4*)((const char*)(tg + it * 4096) + vofft); }
#pragma unroll
            for (int it = 0; it < 4; ++it) { const int i = tid + NTHREADS * it; const int row = i >> 4, sg = i & 15; *(LAS u32x4*)(Qs + row * LD + sg * 8) = pq[it]; }
#pragma unroll
            for (int it = 0; it < 4; ++it) { const int i = tid + NTHREADS * it; const int row = i >> 4, sg = i & 15; *(LAS u32x4*)(Ks + row * LD + sg * 8) = pk[it]; }
            __syncthreads();
            const float dec = misc[0];
            {
                const int t = tid >> 2, sg = tid & 3;
                const u32x4 vv = pvv;
                const float w = wl[t];
#pragma unroll
                for (int w2 = 0; w2 < 4; ++w2) {
                    Vt[(sg * 8 + 2 * w2) * LD + t] = (bf16_t)(vv[w2] & 0xffffu); Vt[(sg * 8 + 2 * w2 + 1) * LD + t] = (bf16_t)(vv[w2] >> 16);
                    Vw[(sg * 8 + 2 * w2) * LD + t] = f2bf(bflo(vv[w2]) * w); Vw[(sg * 8 + 2 * w2 + 1) * LD + t] = f2bf(bfhi(vv[w2]) * w);
                }
            }
            f32x4 sacc[8];
            {
                bf16x8 af[4];
#pragma unroll
                for (int ks = 0; ks < 4; ++ks) af[ks] = ldsfrag(lds + OFF_Q + (16 * wid + r) * LDB + (32 * ks + 8 * q) * 2);
#pragma unroll
                for (int jb = 0; jb < 8; ++jb) {
                    sacc[jb] = (f32x4){0.f, 0.f, 0.f, 0.f};
                    if (dirc ? (jb >= widc) : (jb <= widc)) {
#pragma unroll
                        for (int ks = 0; ks < 4; ++ks) sacc[jb] = mfma16(af[ks], ldsfrag(lds + OFF_K + (16 * jb + r) * LDB + (32 * ks + 8 * q) * 2), sacc[jb]);
                    }
                }
            }
            {
                const int t = tid >> 2, part = tid & 3; float s = 0.f;
#pragma unroll
                for (int i = 0; i < 4; ++i) {
                    const u32x4 qv = *(const LAS u32x4*)(Qs + t * LD + part * 32 + i * 8);
                    const f32x4 n0 = *(const LAS f32x4*)(nvec + part * 32 + i * 8), n1 = *(const LAS f32x4*)(nvec + part * 32 + i * 8 + 4);
                    s += bflo(qv[0]) * n0[0] + bfhi(qv[0]) * n0[1] + bflo(qv[1]) * n0[2] + bfhi(qv[1]) * n0[3] + bflo(qv[2]) * n1[0] + bfhi(qv[2]) * n1[1] + bflo(qv[3]) * n1[2] + bfhi(qv[3]) * n1[3];
                }
                s += dppf<0xB1>(s); s += dppf<0x4E>(s);
                if (part == 0) qn[t] = s;
            }
#pragma unroll
            for (int it = 0; it < 4; ++it) { const int i = tid + NTHREADS * it; *(LAS u32x4*)(Kt + (i >> 4) * LD + (i & 15) * 8) = pt[it]; }
            __syncthreads();
            LAS bf16_t* Ss = Ks;
            float rs[4] = {0.f, 0.f, 0.f, 0.f};
            {
                const f32x4 rf = *(const LAS f32x4*)(rowf + 16 * wid + 4 * q);
                const int zb = dirc ? ((widc & 1) ? widc - 1 : -1) : ((widc & 1) ? -1 : widc + 1);
#pragma unroll
                for (int jb = 0; jb < 8; ++jb) {
                    if (dirc ? (jb >= widc) : (jb <= widc)) {
                        const int s = 16 * jb + r; const float dm = dmb[s];
#pragma unroll
                        for (int reg = 0; reg < 4; ++reg) { const int t = 16 * wid + 4 * q + reg;
                            const bool ok = dirc ? (s >= t) : (s <= t);
                            const float v = ok ? sacc[jb][reg] * __expf(rf[reg] + dm) : 0.f;
                            rs[reg] += v; Ss[t * LD + s] = f2bf(v); }
                    } else if (jb == zb) {
#pragma unroll
                        for (int reg = 0; reg < 4; ++reg) Ss[(16 * wid + 4 * q + reg) * LD + 16 * jb + r] = 0;
                    }
                }
#pragma unroll
                for (int reg = 0; reg < 4; ++reg) rs[reg] = row16_sum(rs[reg]);
            }
            {
                const int kh = widc >> 1;
                const f32x4 it4 = *(const LAS f32x4*)(inter + 16 * wid + 4 * q), qn4 = *(const LAS f32x4*)(qn + 16 * wid + 4 * q), en4 = *(const LAS f32x4*)(en + 16 * wid + 4 * q);
                bf16x8 qf[4];
#pragma unroll
                for (int ks = 0; ks < 4; ++ks) qf[ks] = ldsfrag(lds + OFF_Q + (16 * wid + r) * LDB + (32 * ks + 8 * q) * 2);
#pragma unroll
                for (int nt = 0; nt < 2; ++nt) {
                    f32x4 a1 = (f32x4){0.f, 0.f, 0.f, 0.f}, a2 = a1;
#pragma unroll
                    for (int ks = 0; ks < 4; ++ks) {
                        if (dirc ? (ks >= kh) : (ks <= kh)) a1 = mfma16(ldsfrag(lds + OFF_K + (16 * wid + r) * LDB + (32 * ks + 8 * q) * 2), ldsfrag(lds + OFF_VT + (16 * nt + r) * LDB + (32 * ks + 8 * q) * 2), a1);
                        a2 = mfma16(qf[ks], ldsfrag(lds + OFF_CT + (16 * nt + r) * LDB + (32 * ks + 8 * q) * 2), a2);
                    }
#pragma unroll
                    for (int reg = 0; reg < 4; ++reg) {
                        const int t = 16 * wid + 4 * q + reg;
                        const float den = rs[reg] + it4[reg] * qn4[reg];
                        const float hv = (a1[reg] + it4[reg] * a2[reg]) / fmaxf(fabsf(den), en4[reg]);
                        Hdir[((size_t)dir * MT + rbase + t) * 512 + h * 128 + es * 32 + 16 * nt + r] = f2bf(hv);
                    }
                }
            }
            asm volatile("" ::: "memory");
            if (ci + 1 < 18) MLSTM_PREFETCH(ci + 1);
            asm volatile("" ::: "memory");
            {
                bf16x8 kf[4];
#pragma unroll
                for (int ks = 0; ks < 4; ++ks) kf[ks] = ldsfrag(lds + OFF_KT + (16 * wid + r) * LDB + (32 * ks + 8 * q) * 2);
#pragma unroll
                for (int nt = 0; nt < 2; ++nt) {
                    Cacc[nt] = Cacc[nt] * dec;
#pragma unroll
                    for (int ks = 0; ks < 4; ++ks) Cacc[nt] = mfma16(kf[ks], ldsfrag(lds + OFF_VW + (16 * nt + r) * LDB + (32 * ks + 8 * q) * 2), Cacc[nt]);
                }
            }
            float nnew;
            {
                const int d = tid >> 2, part = tid & 3; float s = 0.f;
#pragma unroll
                for (int i = 0; i < 4; ++i) {
                    const u32x4 kv = *(const LAS u32x4*)(Kt + d * LD + part * 32 + i * 8);
                    const f32x4 w0 = *(const LAS f32x4*)(wl + part * 32 + i * 8), w1 = *(const LAS f32x4*)(wl + part * 32 + i * 8 + 4);
                    s += bflo(kv[0]) * w0[0] + bfhi(kv[0]) * w0[1] + bflo(kv[1]) * w0[2] + bfhi(kv[1]) * w0[3] + bflo(kv[2]) * w1[0] + bfhi(kv[2]) * w1[1] + bflo(kv[3]) * w1[2] + bfhi(kv[3]) * w1[3];
                }
                s += dppf<0xB1>(s); s += dppf<0x4E>(s);
                nnew = dec * nvec[d] + s;
            }
            __syncthreads();
#pragma unroll
            for (int nt = 0; nt < 2; ++nt) { u32x2 w; w.x = pk2(Cacc[nt][0], Cacc[nt][1]); w.y = pk2(Cacc[nt][2], Cacc[nt][3]); *(LAS u32x2*)(Ct + (16 * nt + r) * LD + 16 * wid + 4 * q) = w; }
            if ((tid & 3) == 0) nvec[tid >> 2] = nnew;
        }
        __syncthreads();
    }
}

__device__ __forceinline__ void sgu_phase(LAS unsigned char* lds, const bf16_t* P, const float* sgu_norm, const float* sgu_ws, const float* sgu_b, bf16_t* A1) {
    int tid_ = threadIdx.x; asm volatile("" : "+v"(tid_)); const int tid = tid_, lane = tid & 63, wid = __builtin_amdgcn_readfirstlane(tid >> 6), r = lane & 15, q = lane >> 4;
    constexpr int LD = 136, LDB = LD * 2, OFF_W = 0, OFF_V = 34816, OFF_R = 69632;
    LAS bf16_t* Ws = (LAS bf16_t*)(lds + OFF_W); LAS bf16_t* Vt = (LAS bf16_t*)(lds + OFF_V); LAS float* rstd = (LAS float*)(lds + OFF_R);
    for (int unit = (int)gridDim.x - 1 - (int)blockIdx.x; unit < 144; unit += gridDim.x) {
        const int n = unit % 18, b = unit / 18;
        const int rbase = n < 2 ? MX + b * CTXL + n * 128 : b * SEQ + (n - 2) * 128;
        {
            const int tok = tid >> 2, part = tid & 3; float ss = 0.f;
            const bf16_t* pv = P + (size_t)(rbase + tok) * NEV + 2560 + part * 128;
#pragma unroll 4
            for (int i = 0; i < 16; ++i) { const u32x4 w = *(const u32x4*)(pv + i * 8);
#pragma unroll
                for (int k = 0; k < 4; ++k) { const float a0 = gelu_tanh(bflo(w[k])), a1 = gelu_tanh(bfhi(w[k])); ss += a0 * a0 + a1 * a1; } }
            ss += dppf<0xB1>(ss); ss += dppf<0x4E>(ss);
            if (part == 0) rstd[tok] = 1.0f / sqrtf(ss * (1.f / 512.f) + EPS);
        }
#pragma unroll 1
        for (int g = 0; g < 4; ++g) {
#pragma unroll
            for (int it = 0; it < 4; ++it) { const int i = tid + NTHREADS * it; const int p = i >> 4, sg = i & 15;
                const float* wp = sgu_ws + ((size_t)g * 128 + p) * 128 + sg * 8; const f32x4 w0 = *(const f32x4*)wp, w1 = *(const f32x4*)(wp + 4);
                u32x4 o; o.x = pk2(w0[0], w0[1]); o.y = pk2(w0[2], w0[3]); o.z = pk2(w1[0], w1[1]); o.w = pk2(w1[2], w1[3]);
                *(LAS u32x4*)(Ws + p * LD + sg * 8) = o; }
            if (g == 0) __syncthreads();
#pragma unroll
            for (int it = 0; it < 4; ++it) { const int i = tid + NTHREADS * it; const int tq = i >> 4, sg = i & 15;
                const u32x4 w = *(const u32x4*)(P + (size_t)(rbase + tq) * NEV + 2560 + g * 128 + sg * 8);
                const float rq = rstd[tq];
                const f32x4 g0 = *(const f32x4*)(sgu_norm + g * 128 + sg * 8), g1 = *(const f32x4*)(sgu_norm + g * 128 + sg * 8 + 4);
                Vt[(sg * 8 + 0) * LD + tq] = f2bf(gelu_tanh(bflo(w[0])) * rq * g0[0]); Vt[(sg * 8 + 1) * LD + tq] = f2bf(gelu_tanh(bfhi(w[0])) * rq * g0[1]);
                Vt[(sg * 8 + 2) * LD + tq] = f2bf(gelu_tanh(bflo(w[1])) * rq * g0[2]); Vt[(sg * 8 + 3) * LD + tq] = f2bf(gelu_tanh(bfhi(w[1])) * rq * g0[3]);
                Vt[(sg * 8 + 4) * LD + tq] = f2bf(gelu_tanh(bflo(w[2])) * rq * g1[0]); Vt[(sg * 8 + 5) * LD + tq] = f2bf(gelu_tanh(bfhi(w[2])) * rq * g1[1]);
                Vt[(sg * 8 + 6) * LD + tq] = f2bf(gelu_tanh(bflo(w[3])) * rq * g1[2]); Vt[(sg * 8 + 7) * LD + tq] = f2bf(gelu_tanh(bfhi(w[3])) * rq * g1[3]); }
            __syncthreads();
            {
                bf16x8 wf[4];
#pragma unroll
                for (int ks = 0; ks < 4; ++ks) wf[ks] = ldsfrag(lds + OFF_W + (16 * wid + r) * LDB + (32 * ks + 8 * q) * 2);
                const float sbp = sgu_b[g * 128 + 16 * wid + r];
                const size_t R = (size_t)(rbase + 16 * wid + r);
#pragma unroll
                for (int jb = 0; jb < 8; ++jb) {
                    f32x4 acc = (f32x4){0.f, 0.f, 0.f, 0.f};
#pragma unroll
                    for (int ks = 0; ks < 4; ++ks) acc = mfma16(ldsfrag(lds + OFF_V + (16 * jb + r) * LDB + (32 * ks + 8 * q) * 2), wf[ks], acc);
                    const u32x2 uu = *(const u32x2*)(P + R * NEV + 2048 + g * 128 + 16 * jb + 4 * q);
                    u32x2 w; w.x = pk2(gelu_tanh(bflo(uu.x)) * (acc[0] + sbp), gelu_tanh(bfhi(uu.x)) * (acc[1] + sbp)); w.y = pk2(gelu_tanh(bflo(uu.y)) * (acc[2] + sbp), gelu_tanh(bfhi(uu.y)) * (acc[3] + sbp));
                    *(u32x2*)(A1 + R * D + 512 + g * 128 + 16 * jb + 4 * q) = w;
                }
            }
            __syncthreads();
        }
    }
}

__device__ __forceinline__ void combine_phase(const bf16_t* Hdir, const bf16_t* P, const float* mnorm, bf16_t* A1) {
    int tid_ = threadIdx.x; asm volatile("" : "+v"(tid_)); const int tid = tid_, lane = tid & 63, wid = __builtin_amdgcn_readfirstlane(tid >> 6);
    for (int R = blockIdx.x * 8 + wid; R < MT; R += gridDim.x * 8) {
        const int col = lane * 8;
        const u32x4 h0 = *(const u32x4*)(Hdir + (size_t)R * 512 + col), h1 = *(const u32x4*)(Hdir + ((size_t)MT + R) * 512 + col);
        float a[8];
#pragma unroll
        for (int k = 0; k < 4; ++k) { a[2 * k] = bflo(h0[k]) + bflo(h1[k]); a[2 * k + 1] = bfhi(h0[k]) + bfhi(h1[k]); }
        float ss = 0.f;
#pragma unroll
        for (int k = 0; k < 8; ++k) ss += a[k] * a[k];
        ss = row16_sum(ss);
        const float rstd = 1.0f / sqrtf(ss * (1.f / 128.f) + EPS);
        const f32x4 m0 = *(const f32x4*)(mnorm + col), m1 = *(const f32x4*)(mnorm + col + 4);
        const u32x4 ov = *(const u32x4*)(P + (size_t)R * NEV + 1536 + col);
        u32x4 w;
        w.x = pk2(sigmoid_f(bflo(ov[0])) * a[0] * rstd * m0[0], sigmoid_f(bfhi(ov[0])) * a[1] * rstd * m0[1]);
        w.y = pk2(sigmoid_f(bflo(ov[1])) * a[2] * rstd * m0[2], sigmoid_f(bfhi(ov[1])) * a[3] * rstd * m0[3]);
        w.z = pk2(sigmoid_f(bflo(ov[2])) * a[4] * rstd * m1[0], sigmoid_f(bfhi(ov[2])) * a[5] * rstd * m1[1]);
        w.w = pk2(sigmoid_f(bflo(ov[3])) * a[6] * rstd * m1[2], sigmoid_f(bfhi(ov[3])) * a[7] * rstd * m1[3]);
        *(u32x4*)(A1 + (size_t)R * D + col) = w;
    }
}

__device__ __forceinline__ void attn_phase(LAS unsigned char* lds, const bf16_t* QKV, const float* sink, bf16_t* A1) {
    int tid_ = threadIdx.x; asm volatile("" : "+v"(tid_)); const int tid = tid_, lane = tid & 63, wid = __builtin_amdgcn_readfirstlane(tid >> 6), r = lane & 15, q = lane >> 4;
    constexpr int LK = 72, LKB = LK * 2, OFF_K = 0, OFF_V = 9216, OFF_P = 18432, PSZ = 64 * LKB;
    LAS bf16_t* Ks = (LAS bf16_t*)(lds + OFF_K); LAS bf16_t* Vt = (LAS bf16_t*)(lds + OFF_V);
    LAS bf16_t* Ps = (LAS bf16_t*)(lds + OFF_P + wid * PSZ);
    const LAS unsigned char* Pb = lds + OFF_P + wid * PSZ;
    for (int unit = blockIdx.x; unit < 512; unit += gridDim.x) {
        asm volatile("" : "+s"(QKV), "+s"(A1));
        const int hk = unit & 3, j = (unit >> 2) & 15, b = unit >> 6;
        const int g = wid >> 1, hq = hk * 4 + g, tok0 = (wid & 1) * 64;
        const int qrow0 = b * SEQ + j * 128 + tok0;
        bf16x8 qf[4][2];
#pragma unroll
        for (int mt = 0; mt < 4; ++mt)
#pragma unroll
            for (int ks = 0; ks < 2; ++ks) qf[mt][ks] = *(const bf16x8*)(QKV + (size_t)(qrow0 + 16 * mt + r) * NQKV + hq * 64 + 32 * ks + 8 * q);
        float mrun[4], lrun[4]; f32x4 oacc[4][4];
        const float sk = sink[hq];
#pragma unroll
        for (int mt = 0; mt < 4; ++mt) { mrun[mt] = sk; lrun[mt] = 1.f;
#pragma unroll
            for (int dt = 0; dt < 4; ++dt) oacc[dt][mt] = (f32x4){0.f, 0.f, 0.f, 0.f}; }
        const int tfirst = 0, tlast = (j == 15) ? 7 : 9;
        u32x4 kvn, vvn;
        const unsigned voffk = (unsigned)(((tid >> 3) * NQKV + (tid & 7) * 8) * 2);
#define ATTN_TILE_ROW(ti_) ((ti_) < 4 ? MX + b * CTXL + (ti_) * 64 : b * SEQ + (j - 1 + (((ti_) - 4) >> 1)) * 128 + (((ti_) - 4) & 1) * 64)
#define ATTN_LOAD(ti_) do { const char* kp_ = (const char*)(QKV + (size_t)ATTN_TILE_ROW(ti_) * NQKV + 1024 + hk * 64); kvn = *(const u32x4*)(kp_ + voffk); vvn = *(const u32x4*)(kp_ + 512 + voffk); } while (0)
        ATTN_LOAD(tfirst);
        for (int ti = tfirst; ti <= tlast; ++ti) {
            if (j == 0 && (ti == 4 || ti == 5)) continue;
            int kpos0; bool band;
            if (ti < 4) { kpos0 = 0; band = false; }
            else { const int kb = j - 1 + ((ti - 4) >> 1); kpos0 = kb * 128 + ((ti - 4) & 1) * 64; band = (kb != j); }
            __syncthreads();
            {
                const int key = tid >> 3, sg = tid & 7;
                *(LAS u32x4*)(Ks + key * LK + sg * 8) = kvn;
#pragma unroll
                for (int w2 = 0; w2 < 4; ++w2) { Vt[(sg * 8 + 2 * w2) * LK + key] = (bf16_t)(vvn[w2] & 0xffffu); Vt[(sg * 8 + 2 * w2 + 1) * LK + key] = (bf16_t)(vvn[w2] >> 16); }
            }
            { int tn = ti + 1; if (j == 0 && tn == 4) tn = 6; if (tn <= tlast) ATTN_LOAD(tn); }
            __syncthreads();
            {
                bf16x8 kf0[4];
#pragma unroll
                for (int nt = 0; nt < 4; ++nt) kf0[nt] = ldsfrag(lds + OFF_K + (16 * nt + r) * LKB + (8 * q) * 2);
#pragma unroll
                for (int mt = 0; mt < 4; ++mt) {
                    f32x4 s[4];
#pragma unroll
                    for (int nt = 0; nt < 4; ++nt) { f32x4 a = (f32x4){0.f, 0.f, 0.f, 0.f}; a = mfma16(kf0[nt], qf[mt][0], a); a = mfma16(ldsfrag(lds + OFF_K + (16 * nt + r) * LKB + (32 + 8 * q) * 2), qf[mt][1], a); s[nt] = a; }
                    if (band) {
                        const int qp = j * 128 + tok0 + 16 * mt + r;
#pragma unroll
                        for (int nt = 0; nt < 4; ++nt)
#pragma unroll
                            for (int i = 0; i < 4; ++i) { const int df = qp - (kpos0 + 16 * nt + 4 * q + i); if (df > 128 || df < -128) s[nt][i] = -1e30f; }
                    }
                    float mx = fmaxf(fmaxf(fmaxf(s[0][0], s[0][1]), fmaxf(s[0][2], s[0][3])), fmaxf(fmaxf(s[1][0], s[1][1]), fmaxf(s[1][2], s[1][3])));
                    mx = fmaxf(mx, fmaxf(fmaxf(fmaxf(s[2][0], s[2][1]), fmaxf(s[2][2], s[2][3])), fmaxf(fmaxf(s[3][0], s[3][1]), fmaxf(s[3][2], s[3][3]))));
                    mx = fmaxf(mx, __shfl_xor(mx, 16)); mx = fmaxf(mx, __shfl_xor(mx, 32));
                    const float mn = fmaxf(mrun[mt], mx), alpha = __expf(mrun[mt] - mn);
                    float rsum = 0.f;
#pragma unroll
                    for (int nt = 0; nt < 4; ++nt) {
                        const float p0 = __expf(s[nt][0] - mn), p1 = __expf(s[nt][1] - mn), p2 = __expf(s[nt][2] - mn), p3 = __expf(s[nt][3] - mn);
                        rsum += (p0 + p1) + (p2 + p3);
                        u32x2 w; w.x = pk2(p0, p1); w.y = pk2(p2, p3);
                        *(LAS u32x2*)(Ps + (16 * mt + r) * LK + 16 * nt + 4 * q) = w;
                    }
                    rsum += __shfl_xor(rsum, 16); rsum += __shfl_xor(rsum, 32);
                    lrun[mt] = lrun[mt] * alpha + rsum; mrun[mt] = mn;
#pragma unroll
                    for (int dt = 0; dt < 4; ++dt) oacc[dt][mt] *= alpha;
                    asm volatile("" ::: "memory");
                }
            }
#pragma unroll
            for (int mt = 0; mt < 4; ++mt) {
                const bf16x8 p0 = ldsfrag(Pb + (16 * mt + r) * LKB + (8 * q) * 2), p1 = ldsfrag(Pb + (16 * mt + r) * LKB + (32 + 8 * q) * 2);
#pragma unroll
                for (int dt = 0; dt < 4; ++dt) {
                    oacc[dt][mt] = mfma16(ldsfrag(lds + OFF_V + (16 * dt + r) * LKB + (8 * q) * 2), p0, oacc[dt][mt]);
                    oacc[dt][mt] = mfma16(ldsfrag(lds + OFF_V + (16 * dt + r) * LKB + (32 + 8 * q) * 2), p1, oacc[dt][mt]);
                }
                asm volatile("" ::: "memory");
            }
        }
#pragma unroll
        for (int mt = 0; mt < 4; ++mt) { const float inv = 1.f / lrun[mt]; const size_t R = (size_t)(qrow0 + 16 * mt + r);
#pragma unroll
            for (int dt = 0; dt < 4; ++dt) { const f32x4 o = oacc[dt][mt] * inv; u32x2 w; w.x = pk2(o[0], o[1]); w.y = pk2(o[2], o[3]);
                *(u32x2*)(A1 + R * D + hq * 64 + 16 * dt + 4 * q) = w; } }
    }
    __syncthreads();
}

__device__ __forceinline__ void final_phase(float* out, const float* fnorm) {
    int tid_ = threadIdx.x; asm volatile("" : "+v"(tid_)); const int tid = tid_, lane = tid & 63, wid = __builtin_amdgcn_readfirstlane(tid >> 6);
    for (int R = blockIdx.x * 8 + wid; R < MX; R += gridDim.x * 8) {
        float* src = out + (size_t)R * D;
        f32x4 v[4]; float ss = 0.f;
#pragma unroll
        for (int j = 0; j < 4; ++j) { v[j] = *(const f32x4*)(src + 256 * j + 4 * lane); ss += (v[j][0] * v[j][0] + v[j][1] * v[j][1]) + (v[j][2] * v[j][2] + v[j][3] * v[j][3]); }
        const float rstd = 1.0f / sqrtf(wave_sum(ss) * (1.f / D) + EPS);
#pragma unroll
        for (int j = 0; j < 4; ++j) { const f32x4 w = *(const f32x4*)(fnorm + 256 * j + 4 * lane); *(f32x4*)(src + 256 * j + 4 * lane) = v[j] * rstd * w; }
    }
}

#define GAS __attribute__((address_space(1)))
typedef GAS unsigned gu32;
#define RLX_AGENT __ATOMIC_RELAXED, __HIP_MEMORY_SCOPE_AGENT
#define XB_TMO      128
#define XB_XCNT(j)  (256  + 64 * (j))
#define XB_XSUB(j)  (1280 + 64 * (j))
#define XB_XGEN(j)  (2304 + 64 * (j))
#define XB_TOP      3328
#define XB_TOPGEN   3392
#define XCD_BAR_WORDS 3456
#define XB_SPIN_CAP (1u << 18)

__device__ __forceinline__ unsigned xb_ld(unsigned* p)              { return __hip_atomic_load(p, __ATOMIC_RELAXED, __HIP_MEMORY_SCOPE_AGENT); }
__device__ __forceinline__ unsigned xb_add(unsigned* p, unsigned v) { return __hip_atomic_fetch_add(p, v, __ATOMIC_RELAXED, __HIP_MEMORY_SCOPE_AGENT); }
__device__ __forceinline__ unsigned xb_xcc_id() { return (unsigned)__builtin_amdgcn_s_getreg((3 << 11) | 20) & 0xFu; }
#define XB_SPIN(cond, bar) do { unsigned _sp = 0; while (cond) { __builtin_amdgcn_s_sleep(1); \
    if ((++_sp & 255u) == 0u) { if (xb_ld(&(bar)[XB_TMO])) break; if (_sp > XB_SPIN_CAP) { atomicAdd(&(bar)[XB_TMO], 1u); break; } } } } while (0)

struct XcdBarrier {
    unsigned* bar; unsigned x;
    volatile LAS unsigned* st;
};

__device__ __forceinline__ XcdBarrier xcd_barrier_post(unsigned* bar, volatile LAS unsigned* st) {
    XcdBarrier b; b.bar = bar; b.x = xb_xcc_id(); b.st = st;
    if (threadIdx.x == 0) (void)xb_add(&bar[XB_XCNT(b.x)], 1u);
    return b;
}
__device__ __forceinline__ void xcd_barrier_complete(unsigned* bar, unsigned x, unsigned& nloc, unsigned& nx) {
    const unsigned G = gridDim.x * gridDim.y * gridDim.z;
    unsigned sum, cnt, mine, sp = 0u;
    for (;;) {
        sum = 0u; cnt = 0u;
#pragma unroll 1
        for (unsigned j = 0; j < 16; ++j) { const unsigned c = xb_ld(&bar[XB_XCNT(j)]); sum += c; cnt += (c > 0u) ? 1u : 0u; }
        mine = xb_ld(&bar[XB_XCNT(x)]);
        if (sum == G) break;
        __builtin_amdgcn_s_sleep(1);
        if ((++sp & 255u) == 0u) { if (xb_ld(&bar[XB_TMO])) break; if (sp > XB_SPIN_CAP) { atomicAdd(&bar[XB_TMO], 1u); break; } }
    }
    nloc = mine > 0u ? mine : 1u; nx = cnt > 0u ? cnt : 1u;
}

__device__ __forceinline__ void xcd_barrier(const XcdBarrier& b) {
    asm volatile("s_waitcnt vmcnt(0)" ::: "memory");
    __syncthreads();
    if (threadIdx.x == 0) {
        unsigned* bar = b.bar;
        __builtin_amdgcn_s_waitcnt(0);
        unsigned nloc = b.st[0], nx = b.st[1];
        if (nloc == 0u) { xcd_barrier_complete(bar, b.x, nloc, nx); b.st[0] = nloc; b.st[1] = nx; }
        const unsigned old = xb_add(&bar[XB_XSUB(b.x)], 1u);
        const unsigned gen = old / nloc;
        if (old + 1u == (gen + 1u) * nloc) {
            __builtin_amdgcn_fence(__ATOMIC_RELEASE, "agent");
            asm volatile("s_waitcnt vmcnt(0)" ::: "memory");
            const unsigned og = xb_add(&bar[XB_TOP], 1u);
            const unsigned tg = og / nx;
            if (og + 1u == (tg + 1u) * nx) xb_add(&bar[XB_TOPGEN], 1u);
            else XB_SPIN(xb_ld(&bar[XB_TOPGEN]) == tg, bar);
            __builtin_amdgcn_fence(__ATOMIC_ACQUIRE, "agent");
            xb_add(&bar[XB_XGEN(b.x)], 1u);
            asm volatile("s_waitcnt vmcnt(0)" ::: "memory");
        } else {
            XB_SPIN(xb_ld(&bar[XB_XGEN(b.x)]) == gen, bar);
            __builtin_amdgcn_fence(__ATOMIC_ACQUIRE, "agent");
            asm volatile("s_waitcnt vmcnt(0)" ::: "memory");
        }
    }
    __syncthreads();
}

#ifndef MK_SINGLE
#define MK_SINGLE 1
#endif
constexpr int NPHASES = 24;
#ifndef EN_PREP
#define EN_PREP 1
#endif
#ifndef REP_MASK
#define REP_MASK 0
#endif
#ifndef USE_CG_FIRST
#define USE_CG_FIRST 0
#endif
#ifndef NSYNC_REP
#define NSYNC_REP 1
#endif
#ifndef EN_ALL
#define EN_ALL 1
#endif
#ifndef EN_P0
#define EN_P0 EN_ALL
#endif
#ifndef EN_NORM
#define EN_NORM EN_ALL
#endif
#ifndef EN_GEMM
#define EN_GEMM (EN_ALL ? 15 : 0)
#endif
#ifndef EN_MLSTM
#define EN_MLSTM EN_ALL
#endif
#ifndef EN_SGU
#define EN_SGU EN_ALL
#endif
#ifndef EN_COMB
#define EN_COMB EN_ALL
#endif
#ifndef EN_ATTN
#define EN_ATTN EN_ALL
#endif
#ifndef EN_FINAL
#define EN_FINAL EN_ALL
#endif
__global__ void __launch_bounds__(NTHREADS, 2) fwd_kernel(Args a_unused) {
    extern __shared__ __attribute__((aligned(16))) unsigned char lds_raw[];
    LAS unsigned char* lds = (LAS unsigned char*)lds_raw;
    cg::grid_group grid = cg::this_grid();
    unsigned char* ws = KA(ws);
    const int G = gridDim.x, c = blockIdx.x;
    float* Hx = KA(out); float* Hc = (float*)(ws + WS_HC);
    bf16_t* A0 = (bf16_t*)(ws + WS_A0); bf16_t* A1 = (bf16_t*)(ws + WS_A1); bf16_t* BIG = (bf16_t*)(ws + WS_BIG);
    bf16_t* Hdir = (bf16_t*)(ws + WS_A0);
    const float* mod = (const float*)(ws + WS_MOD);
    float* gates = (float*)(ws + WS_GATES);
    const int lo = KA(ph_lo), hi = KA(ph_hi);
    volatile LAS unsigned* barst = (volatile LAS unsigned*)(lds + LDS_BYTES - 16);
    if (threadIdx.x < 2) barst[threadIdx.x] = 0u;
    __syncthreads();
    XcdBarrier bar = xcd_barrier_post((unsigned*)(ws + WS_CTL), barst);
    enum { K_P0, K_NORM, K_NORMG, K_SWIGLU, K_RESID, K_PLAIN, K_QKV, K_MIX0, K_COMB, K_ATTN, K_FINAL, K_PREP };
    for (int ph = lo; ph < hi; ++ph) {
        const int layer = ph >= 13 ? 1 : 0;
        const int lp = ph >= 13 ? ph - 13 : ph - 1;
        const float* modl = mod + (size_t)layer * 9 * 9216;
        int kind = K_P0, M = MT, gi = 0, ffn = 0, Kd = 1024; float coef = 1.f;
        const bf16_t* Aop = A0; const bf16_t* Wop = nullptr;
        const float* bxp = Hx; const float* bcp = Hc;
        if (ph == 0) kind = K_P0;
        else if (ph == 23) kind = K_FINAL;
        else if (lp == 0) { kind = K_NORM; gi = 0; if (layer == 0) { bxp = KA(x); bcp = KA(ctx); } }
        else if (lp == 1) { kind = K_SWIGLU; ffn = layer * 2; }
        else if (lp == 2) { kind = K_RESID; Aop = BIG; Wop = (const bf16_t*)(ws + WS_WOUT + (size_t)(layer * 2) * SZ_WOUT); Kd = 2816; gi = 2; coef = 0.5f; if (layer == 0) { bxp = KA(x); bcp = KA(ctx); } }
        else if (layer == 0) {
            if (lp == 3) { kind = K_NORMG; gi = 3; }
            else if (lp == 4) kind = K_PLAIN;
            else if (lp == 5) kind = K_PREP;
            else if (lp == 6) kind = K_MIX0;
            else if (lp == 7) kind = K_COMB;
            else if (lp == 8) { kind = K_RESID; Aop = A1; Wop = (const bf16_t*)(ws + WS_WEOUT); gi = 5; }
            else if (lp == 9) { kind = K_NORM; gi = 6; }
            else if (lp == 10) { kind = K_SWIGLU; ffn = 1; }
            else { kind = K_RESID; Aop = BIG; Wop = (const bf16_t*)(ws + WS_WOUT + SZ_WOUT); Kd = 2816; gi = 8; coef = 0.5f; }
        } else {
            if (lp == 3) { kind = K_NORM; gi = 3; }
            else if (lp == 4) kind = K_QKV;
            else if (lp == 5) kind = K_ATTN;
            else if (lp == 6) { kind = K_RESID; Aop = A1; Wop = (const bf16_t*)(ws + WS_WOOUT); gi = 5; M = MX; }
            else if (lp == 7) { kind = K_NORM; gi = 6; M = MX; }
            else if (lp == 8) { kind = K_SWIGLU; ffn = 3; M = MX; }
            else { kind = K_RESID; Aop = BIG; Wop = (const bf16_t*)(ws + WS_WOUT + 3 * SZ_WOUT); Kd = 2816; gi = 8; coef = 0.5f; M = MX; }
        }
        const int nrep = ((REP_MASK >> kind) & 1) ? 2 : 1;
        for (int rep = 0; rep < nrep; ++rep) {
        if (rep == 1) { if (kind == K_RESID) { bxp = Hx; bcp = Hc; coef = 0.f; } __syncthreads(); }
        if (kind == K_P0) { if (EN_P0) p0_phase(lds); }
        else if (kind == K_NORM) { if (EN_NORM) norm_phase<false>(lds, bxp, bcp, A0, modl, gi, gi + 1, M, nullptr, nullptr, nullptr, (ph > 1 && M == MT) ? (float*)(ws + WS_PC) : nullptr); }
        else if (kind == K_NORMG) { if (EN_NORM) norm_phase<true>(lds, Hx, Hc, A0, modl, gi, gi + 1, M, (const float*)(ws + WS_WG), KA(mlstm_gate_b), gates, (float*)(ws + WS_PC)); }
        else if (kind == K_SWIGLU) { if (EN_GEMM & 1) { pg8::Gemm g{A0, (const bf16_t*)(ws + WS_WIN + (size_t)ffn * SZ_WIN), M, 5632, 1024}; pg8::StaticOrder S; S.init(M, 5632, G, c, 1024); pg8::EpiSwiglu E{BIG};
            pg8::gemm_phase<pg8::EpiSwiglu, pg8::StaticOrder, true, true>(lds, g, S, E); } }
        else if (kind == K_RESID) { if (EN_GEMM & 2) { pg8::Gemm g{Aop, Wop, M, 1024, Kd}; pg8::SplitCtxOrder S; S.init(1024, G, c, Kd, M == MT ? 64 : 0); pg8::EpiResid E{bxp, bcp, Hx, Hc, (float*)(ws + WS_PC), modl + gi * 1024, coef};
            pg8::gemm_phase<pg8::EpiResid, pg8::SplitCtxOrder, true, true>(lds, g, S, E); } }
        else if (kind == K_PLAIN) { if (EN_GEMM & 4) { pg8::Gemm g{A0, (const bf16_t*)(ws + WS_WEIN), MT, NEV, 1024}; pg8::StaticOrder S; S.init(MT, NEV, G, c, 1024); pg8::EpiPlain E{BIG, NEV};
            pg8::gemm_phase<pg8::EpiPlain, pg8::StaticOrder, true, true>(lds, g, S, E); } }
        else if (kind == K_QKV) { if (EN_GEMM & 8) { pg8::Gemm g{A0, (const bf16_t*)(ws + WS_WQKV), MT, NQKV, 1024}; pg8::StaticOrder S; S.init(MT, NQKV, G, c, 1024); pg8::EpiQKV E{BIG, (const float*)(ws + WS_ROPE)};
            pg8::gemm_phase<pg8::EpiQKV, pg8::StaticOrder, true, true>(lds, g, S, E); } }
        else if (kind == K_PREP) { if (EN_MLSTM && EN_PREP) qkprep_phase(lds, BIG, KA(mlstm_conv), (bf16_t*)(ws + WS_QC), (bf16_t*)(ws + WS_KC), (bf16_t*)(ws + WS_KCT)); if (EN_SGU) sgu_phase(lds, BIG, KA(sgu_norm), KA(sgu_ws), KA(sgu_b), A1); }
        else if (kind == K_MIX0) { if (EN_MLSTM) mlstm_phase(lds, BIG, gates, (const bf16_t*)(ws + WS_QC), (const bf16_t*)(ws + WS_KC), (const bf16_t*)(ws + WS_KCT), Hdir); }
        else if (kind == K_COMB) { if (EN_COMB) combine_phase(Hdir, BIG, KA(mlstm_norm), A1); }
        else if (kind == K_ATTN) { if (EN_ATTN) attn_phase(lds, BIG, KA(attn_sink), A1); }
        else { if (EN_FINAL) final_phase(Hx, KA(final_norm)); }
        }
        if (ph + 1 < hi) {
            if (ph == 0 && USE_CG_FIRST) {
                __syncthreads();
                if (threadIdx.x < 64) { __builtin_amdgcn_fence(__ATOMIC_RELEASE, "agent"); asm volatile("s_waitcnt vmcnt(0)" ::: "memory"); }
                grid.sync();
                if (threadIdx.x < 64) { __builtin_amdgcn_fence(__ATOMIC_ACQUIRE, "agent"); asm volatile("s_waitcnt vmcnt(0)" ::: "memory"); }
                __syncthreads();
            } else {
                for (int srep = 0; srep < NSYNC_REP; ++srep) xcd_barrier(bar);
            }
        }
    }
}

extern "C" void kernel_launch(void* const* d_in, const int* in_sizes, int n_in, void* d_out, int out_size, void* d_ws, size_t ws_size, hipStream_t stream) {
    static int grid = 0;
    if (grid == 0) {
        if (n_in != 20 || out_size != MX * D || ws_size < WS_END) { fprintf(stderr, "kernel_launch: unexpected problem (n_in %d out %d ws %zu need %zu)\n", n_in, out_size, ws_size, (size_t)WS_END); grid = -1; return; }
        int dev = 0, cus = 0, per_cu = 0;
        hipGetDevice(&dev);
        hipDeviceGetAttribute(&cus, hipDeviceAttributeMultiprocessorCount, dev);
        hipFuncSetAttribute((const void*)fwd_kernel, hipFuncAttributeMaxDynamicSharedMemorySize, LDS_BYTES);
        hipOccupancyMaxActiveBlocksPerMultiprocessor(&per_cu, (const void*)fwd_kernel, NTHREADS, LDS_BYTES);
        if (per_cu < 1) { fprintf(stderr, "kernel_launch: occupancy query says %d blocks per CU\n", per_cu); grid = -1; return; }
        grid = cus;
    }
    if (grid < 0) return;
    if (hipMemsetAsync((char*)d_ws + WS_CTL, 0, CTL_BYTES, stream) != hipSuccess) { fprintf(stderr, "kernel_launch: memset failed\n"); return; }
    Args a{};
#ifdef DBG_MEMSET
    hipMemsetAsync(d_ws, 0, WS_END, stream); hipMemsetAsync(d_out, 0, (size_t)out_size * 4, stream);
#endif
    a.x = (const float*)d_in[0]; a.c = (const float*)d_in[1]; a.ctx = (const float*)d_in[2]; a.c_ctx = (const float*)d_in[3]; a.ada_w = (const float*)d_in[4]; a.ada_b = (const float*)d_in[5];
    a.ffn_w_in = (const float*)d_in[6]; a.ffn_w_out = (const float*)d_in[7]; a.even_w_in = (const float*)d_in[8]; a.even_w_out = (const float*)d_in[9];
    a.mlstm_conv = (const float*)d_in[10]; a.mlstm_gate_b = (const float*)d_in[11]; a.mlstm_norm = (const float*)d_in[12]; a.sgu_norm = (const float*)d_in[13]; a.sgu_ws = (const float*)d_in[14]; a.sgu_b = (const float*)d_in[15];
    a.odd_w_qkv = (const float*)d_in[16]; a.odd_w_out = (const float*)d_in[17]; a.attn_sink = (const float*)d_in[18]; a.final_norm = (const float*)d_in[19];
    a.out = (float*)d_out; a.ws = (unsigned char*)d_ws;
#if MK_SINGLE
    a.ph_lo = 0; a.ph_hi = NPHASES;
    { void* args[] = {&a}; hipError_t e = hipLaunchCooperativeKernel((const void*)fwd_kernel, dim3(grid), dim3(NTHREADS), args, LDS_BYTES, stream);
      if (e != hipSuccess) fprintf(stderr, "cooperative launch failed: %s\n", hipGetErrorString(e)); }
#else
    for (int p = 0; p < NPHASES; ++p) { a.ph_lo = p; a.ph_hi = p + 1; void* args[] = {&a};
        hipError_t e = hipLaunchCooperativeKernel((const void*)fwd_kernel, dim3(grid), dim3(NTHREADS), args, LDS_BYTES, stream);
        if (e != hipSuccess) { fprintf(stderr, "launch %d failed: %s\n", p, hipGetErrorString(e)); break; } }
#endif
}
```

```cpp
#include <hip/hip_runtime.h>
#include <hip/hip_cooperative_groups.h>
#include <cstdio>
#include <cstdint>
namespace cg = cooperative_groups;
namespace pg8 {
#define PG8_LAS __attribute__((address_space(3)))
typedef unsigned short bf16_t;
typedef short bf16x8 __attribute__((ext_vector_type(8)));
typedef float f32x4 __attribute__((ext_vector_type(4)));
typedef unsigned u32x4 __attribute__((ext_vector_type(4)));
constexpr int BM = 256, BK = 64, HALF = 128, HTB = HALF * BK * 2  , STAGE_BYTES = 8 * HTB, NXCD = 8, WGM = 8;

__host__ __device__ __forceinline__ int lds_byte(int r, int c) { const int st = (r >> 4) * 2 + (c >> 5), rr = r & 15, cc = c & 31, ob = rr * 64 + cc * 2; return st * 1024 + (ob ^ (((ob >> 9) & 1) << 5)); }
__host__ __device__ __forceinline__ void stage_rc(int b, int& R, int& C) { const int st = b / 1024, sb = b % 1024, swz = sb ^ (((sb >> 9) & 1) << 5); R = (st >> 1) * 16 + swz / 64; C = (st & 1) * 32 + (swz % 64) / 2; }
__host__ __device__ __forceinline__ int perm32(int rho) { const int n = rho >> 4, i = rho & 15; return 8 * (i >> 2) + 4 * n + (i & 3); }

struct Unit { int pm, pn, k0, nt; };
struct Gemm { const bf16_t* A; const bf16_t* Bt; int M, N, K; };

struct StaticOrder {
    int nM, nN, nwg, G, c, ntf;
    __host__ __device__ void init(int M, int N, int G_, int c_, int K_) { nM = M / BM; nN = N / BM; nwg = nM * nN; G = G_; c = c_; ntf = K_ / BK; }
    __host__ __device__ __forceinline__ bool next(int i, Unit& u) const {
        const long L = (long)i * G + c; if (L >= nwg) return false;
        int wgid = (int)L; { const int q = nwg / NXCD, r = nwg % NXCD, xcd = wgid % NXCD, off = wgid / NXCD; wgid = (xcd < r ? xcd * (q + 1) : r * (q + 1) + (xcd - r) * q) + off; }
        const int nig = WGM * nN, gid = wgid / nig, fm = gid * WGM, gsz = (nM - fm) < WGM ? (nM - fm) : WGM;
        u.pm = fm + ((wgid % nig) % gsz); u.pn = (wgid % nig) / gsz; u.k0 = 0; u.nt = ntf; return true;
    }
    __device__ __forceinline__ void a_ready(const Unit&) const {}
    __device__ __forceinline__ void done(const Unit&) const {}
};

struct SplitCtxOrder {
    int nN, G, c, ntf, nctx;
    __host__ __device__ void init(int N, int G_, int c_, int K_, int nctx_) { nN = N / BM; G = G_; c = c_; ntf = K_ / BK; nctx = nctx_; }
    __host__ __device__ __forceinline__ bool next(int i, Unit& u) const {
        const int L = i * G + c, nwg = 64 * nN;
        if (L >= nwg + nctx) return false;
        int wgid = L < nwg ? L : 0; { const int q = nwg / NXCD, xcd = wgid % NXCD, off = wgid / NXCD; wgid = xcd * q + off; }
        const int nig = WGM * nN, gid = wgid / nig, fm = gid * WGM;
        const int pm0 = fm + ((wgid % nig) % WGM), pn0 = (wgid % nig) / WGM;
        const int L2 = L - nwg, tt = L2 >> 1;
        const bool ctxu = L >= nwg;
        Unit r;
        r.pm = ctxu ? 64 + tt / nN : pm0; r.pn = ctxu ? tt % nN : pn0; r.nt = ctxu ? ntf / 2 : ntf; r.k0 = ctxu ? (L2 & 1) * (ntf / 2) * BK : 0;
        u = r; return true;
    }
    __device__ __forceinline__ void a_ready(const Unit&) const {}
    __device__ __forceinline__ void done(const Unit&) const {}
};

__device__ __forceinline__ unsigned cvt_pk_bf16(float lo, float hi) { unsigned r; asm volatile("v_cvt_pk_bf16_f32 %0, %1, %2" : "=v"(r) : "v"(lo), "v"(hi)); return r; }
typedef float f32x2 __attribute__((ext_vector_type(2)));
template <class Epi, class Sched, bool ALIGN_EPI = false, bool SP2 = false>
__device__ __forceinline__ void gemm_phase(PG8_LAS unsigned char* lds, const Gemm g, const Sched& S, const Epi& E) {
    int tid_ = threadIdx.x; asm volatile("" : "+v"(tid_)); const int tid = tid_, wid = __builtin_amdgcn_readfirstlane(tid >> 6), lane = tid & 63, wr = wid >> 2, wc = wid & 3, fr = lane & 15, fq = lane >> 4;
    const int K = g.K;
    unsigned voffA[2], voffB[2];
#pragma unroll
    for (int i = 0; i < 2; ++i) { int R, C; stage_rc(tid * 16 + i * 8192, R, C); const int Rb = Epi::PERM ? ((R & ~31) + perm32(R & 31)) : R;
        voffA[i] = (unsigned)(R * K + C) * 2u; voffB[i] = (unsigned)(Rb * K + C) * 2u; }
    const size_t kstep = (size_t)(BK * 2);
    const size_t hstep = (size_t)HALF * K * 2;
    const size_t tstep = 2 * hstep;
    const unsigned ldsw = (unsigned)wid * 1024u;
    const int aoff = lds_byte(wr * 64 + fr, fq * 8), boff = lds_byte(wc * 32 + fr, fq * 8);
#define PG8_SA(b, h) (((b) * 2 + (h)) * HTB)
#define PG8_SB(b, h) ((4 + (b) * 2 + (h)) * HTB)
#define PG8_STAGE(bufoff, gbase, voff) do { _Pragma("unroll") for (int _i = 0; _i < 2; ++_i) \
        __builtin_amdgcn_global_load_lds((const unsigned*)((const char*)(gbase) + (voff)[_i]), (PG8_LAS unsigned*)(lds + (bufoff) + ldsw + _i * 8192), 16, 0, 0); } while (0)
#define PG8_LDA(dst, b, h) do { _Pragma("unroll") for (int m = 0; m < 4; ++m) _Pragma("unroll") for (int k = 0; k < 2; ++k) dst[m][k] = *(const PG8_LAS bf16x8*)(lds + PG8_SA(b, h) + aoff + m * 2048 + k * 1024); } while (0)
#define PG8_LDB(dst, b, h) do { _Pragma("unroll") for (int n = 0; n < 2; ++n) _Pragma("unroll") for (int k = 0; k < 2; ++k) dst[n][k] = *(const PG8_LAS bf16x8*)(lds + PG8_SB(b, h) + boff + n * 2048 + k * 1024); } while (0)
#define PG8_MMA(ai, bj, At, Bt) do { __builtin_amdgcn_s_setprio(1); _Pragma("unroll") for (int m = 0; m < 4; ++m) _Pragma("unroll") for (int n = 0; n < 2; ++n) _Pragma("unroll") for (int k = 0; k < 2; ++k) \
        acc[ai][bj][m][n] = __builtin_amdgcn_mfma_f32_16x16x32_bf16(Bt[n][k], At[m][k], acc[ai][bj][m][n], 0, 0, 0); __builtin_amdgcn_s_setprio(0); } while (0)
#define PG8_WAIT_V(n) asm volatile("s_waitcnt vmcnt(" #n ")" ::: "memory")
#define PG8_WAIT_L(n) asm volatile("s_waitcnt lgkmcnt(" #n ")" ::: "memory")
#define PG8_BAR __builtin_amdgcn_s_barrier()
#define PG8_SCHED __builtin_amdgcn_sched_barrier(0)
    Unit cur, nxt; int ui = 0;
    if (!S.next(0, cur)) return;
    f32x4 acc[2][2][4][2];
#pragma unroll
    for (int a = 0; a < 2; ++a)
#pragma unroll
        for (int b = 0; b < 2; ++b)
#pragma unroll
            for (int m = 0; m < 4; ++m)
#pragma unroll
                for (int n = 0; n < 2; ++n) acc[a][b][m][n] = (f32x4){0.f, 0.f, 0.f, 0.f};
    bf16x8 At[4][2], B0[2][2], B1[2][2];
    const char* cA = (const char*)g.A + (size_t)cur.pm * tstep + (size_t)cur.k0 * 2; const char* cB = (const char*)g.Bt + (size_t)cur.pn * tstep + (size_t)cur.k0 * 2;
    S.a_ready(cur);
    if constexpr (SP2) {
        PG8_STAGE(PG8_SB(0, 0), cB, voffB); PG8_STAGE(PG8_SB(0, 1), cB + hstep, voffB); PG8_STAGE(PG8_SA(0, 0), cA, voffA); PG8_STAGE(PG8_SA(0, 1), cA + hstep, voffA);
        if (wr == 1) PG8_BAR;
        PG8_WAIT_V(2); PG8_BAR;
        PG8_STAGE(PG8_SB(1, 0), cB + kstep, voffB); PG8_STAGE(PG8_SA(1, 0), cA + kstep, voffA); PG8_STAGE(PG8_SB(1, 1), cB + hstep + kstep, voffB);
        PG8_WAIT_V(6); PG8_BAR;
    } else {
        PG8_STAGE(PG8_SB(0, 0), cB, voffB); PG8_STAGE(PG8_SA(0, 0), cA, voffA); PG8_STAGE(PG8_SB(0, 1), cB + hstep, voffB); PG8_STAGE(PG8_SA(0, 1), cA + hstep, voffA);
        if (wr == 1) PG8_BAR;
        PG8_WAIT_V(4); PG8_BAR;
        PG8_STAGE(PG8_SB(1, 0), cB + kstep, voffB); PG8_STAGE(PG8_SA(1, 0), cA + kstep, voffA); PG8_STAGE(PG8_SB(1, 1), cB + hstep + kstep, voffB);
        PG8_WAIT_V(6); PG8_BAR;
    }
    for (;;) {
        const bool has_next = S.next(ui + 1, nxt);
        const char* nA = has_next ? (const char*)g.A + (size_t)nxt.pm * tstep + (size_t)nxt.k0 * 2 : cA; const char* nB = has_next ? (const char*)g.Bt + (size_t)nxt.pn * tstep + (size_t)nxt.k0 * 2 : cB;
        const int nt = cur.nt;
        for (int t = 0; t < nt; t += 2) {
            const bool last = (t == nt - 2);
            const char* a1 = cA + (size_t)(t + 1) * kstep;
            const char* a2 = last ? nA : cA + (size_t)(t + 2) * kstep; const char* b2 = last ? nB : cB + (size_t)(t + 2) * kstep;
            const char* a3 = a2 + kstep; const char* b3 = b2 + kstep;
            if (last && has_next) S.a_ready(nxt);
            if constexpr (SP2) {
            PG8_LDB(B0, 0, 0); PG8_LDB(B1, 0, 1); PG8_SCHED; PG8_LDA(At, 0, 0); PG8_STAGE(PG8_SA(1, 1), a1 + hstep, voffA);
            PG8_WAIT_V(8); PG8_WAIT_L(0); PG8_BAR; PG8_MMA(0, 0, At, B0); PG8_MMA(0, 1, At, B1); PG8_BAR; PG8_SCHED;
            PG8_LDA(At, 0, 1); PG8_STAGE(PG8_SB(0, 0), b2, voffB); PG8_STAGE(PG8_SB(0, 1), b2 + hstep, voffB); PG8_STAGE(PG8_SA(0, 0), a2, voffA);
            PG8_WAIT_V(8); PG8_WAIT_L(0); PG8_BAR; PG8_MMA(1, 0, At, B0); PG8_MMA(1, 1, At, B1); PG8_BAR; PG8_SCHED;
            PG8_LDB(B0, 1, 0); PG8_LDB(B1, 1, 1); PG8_SCHED; PG8_LDA(At, 1, 0); PG8_STAGE(PG8_SA(0, 1), a2 + hstep, voffA);
            PG8_WAIT_V(8); PG8_WAIT_L(0); PG8_BAR; PG8_MMA(0, 0, At, B0); PG8_MMA(0, 1, At, B1); PG8_BAR; PG8_SCHED;
            PG8_LDA(At, 1, 1); PG8_STAGE(PG8_SB(1, 0), b3, voffB); PG8_STAGE(PG8_SB(1, 1), b3 + hstep, voffB); PG8_STAGE(PG8_SA(1, 0), a3, voffA);
            PG8_WAIT_V(8); PG8_WAIT_L(0); PG8_BAR; PG8_MMA(1, 0, At, B0); PG8_MMA(1, 1, At, B1); PG8_BAR; PG8_SCHED;
            } else {
            PG8_LDB(B0, 0, 0); PG8_SCHED; PG8_LDA(At, 0, 0); PG8_STAGE(PG8_SA(1, 1), a1 + hstep, voffA);
            PG8_WAIT_L(8); PG8_BAR; PG8_WAIT_L(0); PG8_MMA(0, 0, At, B0); PG8_BAR; PG8_SCHED;
            PG8_LDB(B1, 0, 1); PG8_STAGE(PG8_SB(0, 0), b2, voffB);
            PG8_BAR; PG8_WAIT_L(0); PG8_MMA(0, 1, At, B1); PG8_BAR;
            PG8_LDA(At, 0, 1); PG8_STAGE(PG8_SA(0, 0), a2, voffA);
            PG8_BAR; PG8_WAIT_L(0); PG8_MMA(1, 0, At, B0); PG8_BAR; PG8_SCHED;
            PG8_STAGE(PG8_SB(0, 1), b2 + hstep, voffB);
            PG8_WAIT_V(6); PG8_BAR; PG8_MMA(1, 1, At, B1); PG8_BAR;
            PG8_LDB(B0, 1, 0); PG8_SCHED; PG8_LDA(At, 1, 0); PG8_STAGE(PG8_SA(0, 1), a2 + hstep, voffA);
            PG8_WAIT_L(8); PG8_BAR; PG8_WAIT_L(0); PG8_MMA(0, 0, At, B0); PG8_BAR; PG8_SCHED;
            PG8_LDB(B1, 1, 1); PG8_STAGE(PG8_SB(1, 0), b3, voffB);
            PG8_BAR; PG8_WAIT_L(0); PG8_MMA(0, 1, At, B1); PG8_BAR;
            PG8_LDA(At, 1, 1); PG8_STAGE(PG8_SA(1, 0), a3, voffA);
            PG8_BAR; PG8_WAIT_L(0); PG8_MMA(1, 0, At, B0); PG8_BAR; PG8_SCHED;
            PG8_STAGE(PG8_SB(1, 1), b3 + hstep, voffB);
            PG8_WAIT_V(6); PG8_BAR; PG8_MMA(1, 1, At, B1); PG8_BAR;
            }
        }
        if constexpr (ALIGN_EPI) { if (wr == 0) PG8_BAR; }
        if constexpr (!Epi::AFTER_DRAIN) { E(acc, cur, wr, wc, fr, fq); S.done(cur); }
        if (!has_next) break;
#pragma unroll
        for (int a = 0; a < 2; ++a)
#pragma unroll
            for (int b = 0; b < 2; ++b)
#pragma unroll
                for (int m = 0; m < 4; ++m)
#pragma unroll
                    for (int n = 0; n < 2; ++n) acc[a][b][m][n] = (f32x4){0.f, 0.f, 0.f, 0.f};
        cur = nxt; cA = nA; cB = nB; ++ui;
        if constexpr (ALIGN_EPI) { if (wr == 1) PG8_BAR; }
    }
    PG8_WAIT_V(0);
    if constexpr (!ALIGN_EPI) { if (wr == 0) PG8_BAR; }
    PG8_BAR;
    if constexpr (Epi::AFTER_DRAIN) { E.fused(acc, cur, wr, wc, fr, fq, lds, wid, lane); S.done(cur); }
#undef PG8_SA
#undef PG8_SB
#undef PG8_STAGE
#undef PG8_LDA
#undef PG8_LDB
#undef PG8_MMA
#undef PG8_WAIT_V
#undef PG8_WAIT_L
#undef PG8_BAR
#undef PG8_SCHED
}
}
#define LAS __attribute__((address_space(3)))
typedef unsigned short bf16_t;
typedef short bf16x8 __attribute__((ext_vector_type(8)));
typedef float f32x4 __attribute__((ext_vector_type(4)));
typedef float f32x2 __attribute__((ext_vector_type(2)));
typedef unsigned u32x4 __attribute__((ext_vector_type(4)));
typedef unsigned u32x2 __attribute__((ext_vector_type(2)));

constexpr int D = 1024, NB = 8, SEQ = 2048, CTXL = 256, DFF = 2816;
constexpr int MX = NB * SEQ;
constexpr int MC = NB * CTXL;
constexpr int MT = MX + MC;
constexpr int NMOD = 9;
constexpr int NEV = 3072;
constexpr int NQKV = 1536;
constexpr float EPS = 1e-6f;
constexpr int LDS_BYTES = 147456;
constexpr int NTHREADS = 512;

constexpr size_t MiB = 1u << 20;
constexpr size_t SZ_WIN = (size_t)5632 * 1024 * 2, SZ_WOUT = (size_t)1024 * 2816 * 2;
constexpr size_t WS_WIN = 0;
constexpr size_t WS_WOUT = WS_WIN + 4 * SZ_WIN;
constexpr size_t WS_WEIN = WS_WOUT + 4 * SZ_WOUT;
constexpr size_t WS_WEOUT = WS_WEIN + (size_t)3072 * 1024 * 2;
constexpr size_t WS_WQKV = WS_WEOUT + (size_t)1024 * 1024 * 2;
constexpr size_t WS_WOOUT = WS_WQKV + (size_t)1536 * 1024 * 2;
constexpr size_t WS_MOD = WS_WOOUT + (size_t)1024 * 1024 * 2;
constexpr size_t WS_WG = WS_MOD + (size_t)2 * 9 * 9216 * 4;
constexpr size_t WS_ROPE = WS_WG + (size_t)16 * 1024 * 4;
constexpr size_t WS_GATES = WS_ROPE + 8192;
constexpr size_t WS_HC = WS_GATES + (size_t)MT * 16 * 4;
constexpr size_t WS_A0 = ((WS_HC + (size_t)MC * D * 4 + 255) / 256) * 256;
constexpr size_t WS_QC = WS_A0 + (size_t)MT * D * 2;
constexpr size_t WS_KC = WS_QC + (size_t)MT * 512 * 2;
constexpr size_t WS_KCT = WS_KC + (size_t)MT * 512 * 2;
constexpr size_t WS_A1 = WS_KCT + (size_t)576 * 128 * 128 * 2;
constexpr size_t WS_BIG = WS_A1 + (size_t)MT * D * 2;
constexpr size_t WS_CTL = WS_BIG + (size_t)MT * 3072 * 2;
constexpr size_t CTL_BYTES = 16384;
constexpr size_t WS_PC = WS_CTL + CTL_BYTES;
constexpr size_t WS_END = WS_PC + (size_t)MC * D * 4;

struct Args {
    const float* x; const float* c; const float* ctx; const float* c_ctx; const float* ada_w; const float* ada_b;
    const float* ffn_w_in; const float* ffn_w_out; const float* even_w_in; const float* even_w_out;
    const float* mlstm_conv; const float* mlstm_gate_b; const float* mlstm_norm; const float* sgu_norm; const float* sgu_ws; const float* sgu_b;
    const float* odd_w_qkv; const float* odd_w_out; const float* attn_sink; const float* final_norm;
    float* out; unsigned char* ws; int ph_lo, ph_hi;
};

typedef const __attribute__((address_space(4))) Args* kargp;
__device__ __forceinline__ kargp kargs() { kargp p = (kargp)__builtin_amdgcn_kernarg_segment_ptr(); asm volatile("" : "+s"(p)); return p; }
#define KA(f) (kargs()->f)
typedef __bf16 bf16x2_t __attribute__((ext_vector_type(2)));
__device__ __forceinline__ unsigned pk2(float lo, float hi) { f32x2 v = {lo, hi}; bf16x2_t b = __builtin_convertvector(v, bf16x2_t); return __builtin_bit_cast(unsigned, b); }
__device__ __forceinline__ bf16_t f2bf(float f) { return (bf16_t)(pk2(f, 0.f) & 0xffffu); }
__device__ __forceinline__ float bf2f(bf16_t v) { return __uint_as_float(((unsigned)v) << 16); }
__device__ __forceinline__ float bflo(unsigned w) { return __uint_as_float(w << 16); }
__device__ __forceinline__ float bfhi(unsigned w) { return __uint_as_float(w & 0xffff0000u); }
__device__ __forceinline__ float silu_f(float v) { return v * __builtin_amdgcn_rcpf(1.f + __expf(-v)); }
__device__ __forceinline__ float sigmoid_f(float v) { return __builtin_amdgcn_rcpf(1.f + __expf(-v)); }
__device__ __forceinline__ float gelu_tanh(float v) {
    const float z = 0.7978845608028654f * (v + 0.044715f * v * v * v);
    const float t = 1.f - 2.f * __builtin_amdgcn_rcpf(1.f + __expf(2.f * z));
    return 0.5f * v * (1.f + t);
}
template <int CTRL> __device__ __forceinline__ float dppf(float v) { return __builtin_bit_cast(float, __builtin_amdgcn_update_dpp(0, __builtin_bit_cast(int, v), CTRL, 0xf, 0xf, false)); }
__device__ __forceinline__ float row16_sum(float v) { v += dppf<0xB1>(v); v += dppf<0x4E>(v); v += dppf<0x141>(v); v += dppf<0x140>(v); return v; }
__device__ __forceinline__ float row16_max(float v) { v = fmaxf(v, dppf<0xB1>(v)); v = fmaxf(v, dppf<0x4E>(v)); v = fmaxf(v, dppf<0x141>(v)); v = fmaxf(v, dppf<0x140>(v)); return v; }
__device__ __forceinline__ float wave_sum(float v) { v = row16_sum(v); v += __shfl_xor(v, 16); v += __shfl_xor(v, 32); return v; }
__device__ __forceinline__ float wave_max(float v) { v = row16_max(v); v = fmaxf(v, __shfl_xor(v, 16)); v = fmaxf(v, __shfl_xor(v, 32)); return v; }
__device__ __forceinline__ f32x4 mfma16(bf16x8 a, bf16x8 b, f32x4 c) { return __builtin_amdgcn_mfma_f32_16x16x32_bf16(a, b, c, 0, 0, 0); }
__device__ __forceinline__ bf16x8 ldsfrag(const LAS unsigned char* p) { return *(const LAS bf16x8*)p; }

namespace pg8 {
struct EpiSwiglu {
    static constexpr bool PERM = true, AFTER_DRAIN = false;
    bf16_t* O;
    __device__ __forceinline__ void operator()(const f32x4 (&acc)[2][2][4][2], const Unit& u, int wr, int wc, int fr, int fq) const {
        const int row0 = u.pm * BM + wr * 64 + fr, col0 = u.pn * 128 + wc * 32 + 8 * fq;
#pragma unroll
        for (int ai = 0; ai < 2; ++ai)
#pragma unroll
            for (int m = 0; m < 4; ++m) {
                bf16_t* rowp = O + (size_t)(row0 + ai * HALF + m * 16) * DFF + col0;
                const f32x4 g0 = acc[ai][0][m][0], g1 = acc[ai][0][m][1], u0 = acc[ai][1][m][0], u1 = acc[ai][1][m][1];
                u32x4 w;
                w.x = ::pk2(::silu_f(g0[0]) * u0[0], ::silu_f(g0[1]) * u0[1]); w.y = ::pk2(::silu_f(g0[2]) * u0[2], ::silu_f(g0[3]) * u0[3]);
                w.z = ::pk2(::silu_f(g1[0]) * u1[0], ::silu_f(g1[1]) * u1[1]); w.w = ::pk2(::silu_f(g1[2]) * u1[2], ::silu_f(g1[3]) * u1[3]);
                *(u32x4*)rowp = w;
            }
    }
};
struct EpiResid {
    static constexpr bool PERM = false, AFTER_DRAIN = false;
    const float* bx; const float* bc; float* ox; float* oc; float* pc; const float* gate;
    float coef;
    __device__ __forceinline__ void operator()(const f32x4 (&acc)[2][2][4][2], const Unit& u, int wr, int wc, int fr, int fq) const {
        const bool isx = u.pm < 64; const bool split = u.k0 != 0;
        const int bi = isx ? (u.pm >> 3) : 8;
        const float* base = isx ? bx : bc - (size_t)MX * D;
        float* outp = isx ? ox : oc - (size_t)MX * D;
        const int row0 = u.pm * BM + wr * 64 + fr, col0 = u.pn * BM + wc * 32 + 4 * fq;
        const float* gp = gate + (size_t)bi * 9216 + col0;
#pragma unroll
        for (int bj = 0; bj < 2; ++bj)
#pragma unroll
            for (int n = 0; n < 2; ++n) {
                const f32x4 gv = *(const f32x4*)(gp + bj * HALF + n * 16) * coef;
#pragma unroll
                for (int ai = 0; ai < 2; ++ai)
#pragma unroll
                    for (int m = 0; m < 4; ++m) {
                        const size_t off = (size_t)(row0 + ai * HALF + m * 16) * D + col0 + bj * HALF + n * 16;
                        const f32x4 pv = gv * acc[ai][bj][m][n];
                        if (split) {
                            *(f32x4*)(pc + off - (size_t)MX * D) = pv;
                        } else {
                            const f32x4 b = *(const f32x4*)(base + off);
                            *(f32x4*)(outp + off) = b + pv;
                        }
                        if (m & 1) asm volatile("" ::: "memory");
                    }
            }
    }
};
struct EpiPlain {
    static constexpr bool PERM = true, AFTER_DRAIN = false;
    bf16_t* O; int ldc;
    __device__ __forceinline__ void operator()(const f32x4 (&acc)[2][2][4][2], const Unit& u, int wr, int wc, int fr, int fq) const {
        const int row0 = u.pm * BM + wr * 64 + fr, col0 = u.pn * BM + wc * 32 + 8 * fq;
#pragma unroll
        for (int ai = 0; ai < 2; ++ai)
#pragma unroll
            for (int m = 0; m < 4; ++m) {
                bf16_t* rowp = O + (size_t)(row0 + ai * HALF + m * 16) * ldc + col0;
#pragma unroll
                for (int bj = 0; bj < 2; ++bj) {
                    const f32x4 v0 = acc[ai][bj][m][0], v1 = acc[ai][bj][m][1];
                    u32x4 w; w.x = ::pk2(v0[0], v0[1]); w.y = ::pk2(v0[2], v0[3]); w.z = ::pk2(v1[0], v1[1]); w.w = ::pk2(v1[2], v1[3]);
                    *(u32x4*)(rowp + bj * HALF) = w;
                }
            }
    }
};
struct EpiQKV {
    static constexpr bool PERM = true, AFTER_DRAIN = false;
    bf16_t* O; const float* rope;
    __device__ __forceinline__ void operator()(const f32x4 (&acc)[2][2][4][2], const Unit& u, int wr, int wc, int fr, int fq) const {
        const int row0 = u.pm * BM + wr * 64 + fr;
        const bool isx = u.pm < 64;
#pragma unroll
        for (int bj = 0; bj < 2; ++bj) {
            const int col0 = u.pn * BM + bj * HALF + wc * 32 + 8 * fq;
            const bool dorope = isx && (col0 < 1280);
            const float qs = (col0 < 1024) ? 0.125f : 1.f;
            const int p0 = (col0 & 63) >> 1;
            const int f0 = p0 & 15;
#pragma unroll
            for (int ai = 0; ai < 2; ++ai)
#pragma unroll
                for (int m = 0; m < 4; ++m) {
                    const int row = row0 + ai * HALF + m * 16;
                    f32x4 v0 = acc[ai][bj][m][0] * qs, v1 = acc[ai][bj][m][1] * qs;
                    if (dorope) {
                        const int t = row & 2047;
                        const int pos = (p0 < 16) ? (t >> 6) : (t & 63);
                        const f32x4 cs0 = *(const f32x4*)(rope + (pos * 16 + f0) * 2), cs1 = *(const f32x4*)(rope + (pos * 16 + f0) * 2 + 4);
                        f32x4 r0, r1;
                        r0[0] = v0[0] * cs0[0] - v0[1] * cs0[1]; r0[1] = v0[0] * cs0[1] + v0[1] * cs0[0];
                        r0[2] = v0[2] * cs0[2] - v0[3] * cs0[3]; r0[3] = v0[2] * cs0[3] + v0[3] * cs0[2];
                        r1[0] = v1[0] * cs1[0] - v1[1] * cs1[1]; r1[1] = v1[0] * cs1[1] + v1[1] * cs1[0];
                        r1[2] = v1[2] * cs1[2] - v1[3] * cs1[3]; r1[3] = v1[2] * cs1[3] + v1[3] * cs1[2];
                        v0 = r0; v1 = r1;
                    }
                    u32x4 w; w.x = ::pk2(v0[0], v0[1]); w.y = ::pk2(v0[2], v0[3]); w.z = ::pk2(v1[0], v1[1]); w.w = ::pk2(v1[2], v1[3]);
                    *(u32x4*)(O + (size_t)row * NQKV + col0) = w;
                }
        }
    }
};
}

__device__ __forceinline__ void tr_item(const float* W, int ldw, int k0, int srccol0, bf16_t* WT, int K, int destrow0, LAS float* scr, int lane) {
#pragma unroll 8
    for (int i = 0; i < 32; ++i) { const int kk = 2 * i + (lane >> 5); scr[kk * 33 + (lane & 31)] = W[(size_t)(k0 + kk) * ldw + srccol0 + (lane & 31)]; }
    asm volatile("s_waitcnt lgkmcnt(0)" ::: "memory");
    const int c = lane & 7;
#pragma unroll
    for (int j = 0; j < 4; ++j) { const int n = (lane >> 3) + 8 * j; const LAS float* s = scr + (8 * c) * 33 + n;
        u32x4 o; o.x = pk2(s[0 * 33], s[1 * 33]); o.y = pk2(s[2 * 33], s[3 * 33]); o.z = pk2(s[4 * 33], s[5 * 33]); o.w = pk2(s[6 * 33], s[7 * 33]);
        *(u32x4*)(WT + (size_t)(destrow0 + n) * K + k0 + 8 * c) = o; }
    asm volatile("s_waitcnt lgkmcnt(0)" ::: "memory");
}

__device__ __forceinline__ void convert_group(LAS unsigned char* lds, int grp, int worker, int nworkers) {
    int tid_ = threadIdx.x; asm volatile("" : "+v"(tid_)); const int tid = tid_, lane = tid & 63, wid = __builtin_amdgcn_readfirstlane(tid >> 6);
    unsigned char* ws = KA(ws);
    LAS float* scr = (LAS float*)(lds + wid * 16384);
    constexpr int I_IN = 16 * 176, I_OUT = 44 * 32, I_EIN = 16 * 96, I_SQ = 16 * 32, I_QKV = 16 * 48;
    const int n2 = grp == 1 ? I_EIN : (grp == 2 ? I_QKV : 0), n3 = (grp == 1 || grp == 2) ? I_SQ : 0;
    const int total = I_IN + I_OUT + n2 + n3;
    for (int it = worker + wid; it < total; it += nworkers) {
        int r = it;
        if (r < I_IN) { const int kb = r / 176, nb = r % 176; const int n0 = nb * 32;
            const int dest = (n0 < 2816) ? ((n0 >> 7) * 256 + (n0 & 127)) : ((((n0 - 2816) >> 7) * 256) + 128 + ((n0 - 2816) & 127));
            tr_item(KA(ffn_w_in) + (size_t)grp * 1024 * 5632, 5632, kb * 64, n0, (bf16_t*)(ws + WS_WIN + grp * SZ_WIN), 1024, dest, scr, lane); continue; }
        r -= I_IN;
        if (r < I_OUT) { const int kb = r / 32, nb = r % 32;
            tr_item(KA(ffn_w_out) + (size_t)grp * 2816 * 1024, 1024, kb * 64, nb * 32, (bf16_t*)(ws + WS_WOUT + grp * SZ_WOUT), 2816, nb * 32, scr, lane); continue; }
        r -= I_OUT;
        if (r < n2) {
            if (grp == 1) { const int kb = r / 96, nb = r % 96; const int src = nb < 64 ? nb * 32 : 2064 + (nb - 64) * 32;
                tr_item(KA(even_w_in), 3088, kb * 64, src, (bf16_t*)(ws + WS_WEIN), 1024, nb * 32, scr, lane); }
            else { const int kb = r / 48, nb = r % 48; tr_item(KA(odd_w_qkv), 1536, kb * 64, nb * 32, (bf16_t*)(ws + WS_WQKV), 1024, nb * 32, scr, lane); }
            continue; }
        r -= n2;
        { const int kb = r / 32, nb = r % 32;
          if (grp == 1) tr_item(KA(even_w_out), 1024, kb * 64, nb * 32, (bf16_t*)(ws + WS_WEOUT), 1024, nb * 32, scr, lane);
          else tr_item(KA(odd_w_out), 1024, kb * 64, nb * 32, (bf16_t*)(ws + WS_WOOUT), 1024, nb * 32, scr, lane); }
    }
}

__device__ __forceinline__ void p0_phase(LAS unsigned char* lds) {
    int tid_ = threadIdx.x; asm volatile("" : "+v"(tid_)); const int tid = tid_, lane = tid & 63, wid = __builtin_amdgcn_readfirstlane(tid >> 6), G = gridDim.x;
    unsigned char* ws = KA(ws);
    {
        LAS float* s = (LAS float*)lds;
        LAS float* red = (LAS float*)(lds + 36864);
        for (int i = tid; i < 9 * 1024; i += NTHREADS) { const float v = (i < 8192) ? KA(c)[i] : KA(c_ctx)[i - 8192]; s[i] = v / (1.f + expf(-v)); }
        __syncthreads();
        float* mod = (float*)(ws + WS_MOD);
        for (int tile = blockIdx.x; tile < 288; tile += G) {
            const int l = tile / 144, cg = tile % 144, n = cg * 64 + lane, kg = wid;
            float acc[9];
#pragma unroll
            for (int bi = 0; bi < 9; ++bi) acc[bi] = 0.f;
            const float* wp = KA(ada_w) + ((size_t)l * 1024 + kg * 128) * 9216 + n;
#pragma unroll 4
            for (int kk = 0; kk < 128; ++kk) {
                const float w = wp[(size_t)kk * 9216];
#pragma unroll
                for (int bi = 0; bi < 9; ++bi) acc[bi] += s[bi * 1024 + kg * 128 + kk] * w;
            }
#pragma unroll
            for (int bi = 0; bi < 9; ++bi) red[(kg * 9 + bi) * 64 + lane] = acc[bi];
            __syncthreads();
            for (int i = tid; i < 576; i += NTHREADS) {
                const int bi = i >> 6, cc = i & 63; float sum = 0.f;
#pragma unroll
                for (int k2 = 0; k2 < 8; ++k2) sum += red[(k2 * 9 + bi) * 64 + cc];
                mod[((size_t)l * 9 + bi) * 9216 + cg * 64 + cc] = sum + KA(ada_b)[l * 9216 + cg * 64 + cc];
            }
            __syncthreads();
        }
    }
    {
        const int gt = blockIdx.x * NTHREADS + tid, GT = G * NTHREADS;
        float* wg = (float*)(ws + WS_WG);
        for (int i = gt; i < 16 * 1024; i += GT) { const int g = i >> 10, k = i & 1023; wg[i] = KA(even_w_in)[(size_t)k * 3088 + 2048 + g]; }
        float* rope = (float*)(ws + WS_ROPE);
        for (int i = gt; i < 64 * 16; i += GT) { const int pos = i >> 4, f = i & 15; const float inv = powf(10000.f, -(float)f / 16.f); const float ang = (float)pos * inv; rope[2 * i] = cosf(ang); rope[2 * i + 1] = sinf(ang); }
    }
    convert_group(lds, 0, blockIdx.x * 8, G * 8);
}

template <bool GATES>
__device__ __forceinline__ void norm_phase(LAS unsigned char* lds, const float* hx, const float* hc, bf16_t* A0, const float* modl, int shift_i, int scale_i, int nrows,
                                           const float* wg, const float* gate_b, float* gates, float* copy_c) {
    int tid_ = threadIdx.x; asm volatile("" : "+v"(tid_)); const int tid = tid_, lane = tid & 63, wid = __builtin_amdgcn_readfirstlane(tid >> 6), G = gridDim.x;
    LAS float* wgs = (LAS float*)lds;
    if (GATES) { for (int i = tid; i < 16 * 1024 / 4; i += NTHREADS) ((LAS f32x4*)wgs)[i] = ((const f32x4*)wg)[i]; __syncthreads(); }
    const int R0 = blockIdx.x * 8 + wid, RS = G * 8;
    f32x4 vn[4], pn[4];
#define NORM_LOAD(R_) do { const bool isx_ = (R_) < MX; const float* src_ = isx_ ? hx + (size_t)(R_) * D : hc + (size_t)((R_) - MX) * D; \
        _Pragma("unroll") for (int j = 0; j < 4; ++j) { vn[j] = *(const f32x4*)(src_ + 256 * j + 4 * lane); \
            pn[j] = (copy_c && !isx_) ? *(const f32x4*)(copy_c + (size_t)((R_) - MX) * D + 256 * j + 4 * lane) : (f32x4){0.f, 0.f, 0.f, 0.f}; } } while (0)
    if (R0 < nrows) NORM_LOAD(R0);
    for (int R = R0; R < nrows; R += RS) {
        const bool isx = R < MX;
        const int bi = isx ? (R >> 11) : 8;
        const float* mb = modl + (size_t)bi * 9216;
        f32x4 v[4]; float ss = 0.f;
#pragma unroll
        for (int j = 0; j < 4; ++j) { v[j] = vn[j] + pn[j];
            if (copy_c && !isx) *(f32x4*)((float*)hc + (size_t)(R - MX) * D + 256 * j + 4 * lane) = v[j];
            ss += (v[j][0] * v[j][0] + v[j][1] * v[j][1]) + (v[j][2] * v[j][2] + v[j][3] * v[j][3]); }
        if (R + RS < nrows) NORM_LOAD(R + RS);
        const float rstd = 1.0f / sqrtf(wave_sum(ss) * (1.f / D) + EPS);
#pragma unroll
        for (int j = 0; j < 4; ++j) {
            const f32x4 sc = *(const f32x4*)(mb + scale_i * 1024 + 256 * j + 4 * lane), sh = *(const f32x4*)(mb + shift_i * 1024 + 256 * j + 4 * lane);
            v[j] = v[j] * rstd * (sc + 1.f) + sh;
            u32x2 w; w.x = pk2(v[j][0], v[j][1]); w.y = pk2(v[j][2], v[j][3]);
            *(u32x2*)(A0 + (size_t)R * D + 256 * j + 4 * lane) = w;
        }
        if (GATES) {
            float mine = 0.f;
#pragma unroll 1
            for (int g = 0; g < 16; ++g) {
                float d = 0.f;
#pragma unroll
                for (int j = 0; j < 4; ++j) { const f32x4 w = *(const LAS f32x4*)(wgs + g * 1024 + 256 * j + 4 * lane); d += (v[j][0] * w[0] + v[j][1] * w[1]) + (v[j][2] * w[2] + v[j][3] * w[3]); }
                d = wave_sum(d);
                if (lane == g) mine = d;
            }
            if (lane < 16) gates[(size_t)R * 16 + lane] = mine + gate_b[lane];
        }
    }
    if (GATES) __syncthreads();
}

__device__ __forceinline__ void qkprep_phase(LAS unsigned char* lds, const bf16_t* P, const float* convw, bf16_t* Qc, bf16_t* Kc, bf16_t* KcT) {
    int tid_ = threadIdx.x; asm volatile("" : "+v"(tid_)); const int tid = tid_;
    constexpr int LD = 136;
    LAS bf16_t* Tt = (LAS bf16_t*)lds;
    LAS float* cw = (LAS float*)(lds + 34816);
    const int seg = tid & 15;
    for (int unit = blockIdx.x; unit < 576; unit += gridDim.x) {
        const int h = unit & 3, gc = unit >> 2, n = gc % 18, b = gc / 18;
        const int sbase = n < 2 ? MX + b * CTXL : b * SEQ, T = n < 2 ? CTXL : SEQ, t0 = n < 2 ? n * 128 : (n - 2) * 128;
        for (int i = tid; i < 768; i += NTHREADS) { const int qk = i / 384, j = (i % 384) >> 7, ch = i & 127; cw[i] = convw[j * 1024 + qk * 512 + h * 128 + ch]; }
        __syncthreads();
#pragma unroll 1
        for (int it = 0; it < 4; ++it) {
            const int l = (tid + NTHREADS * it) >> 4;
            const int tin = t0 + l;
            const size_t R = (size_t)(sbase + tin);
            const bf16_t* pr = P + R * NEV + h * 128 + seg * 8;
            const u32x4 z = (u32x4){0u, 0u, 0u, 0u};
#pragma unroll
            for (int qk = 0; qk < 2; ++qk) {
                const bf16_t* pp = pr + qk * 512;
                const u32x4 c0 = *(const u32x4*)pp; const u32x4 pv = tin > 0 ? *(const u32x4*)(pp - NEV) : z; const u32x4 nx = tin < T - 1 ? *(const u32x4*)(pp + NEV) : z;
                float y[8];
#pragma unroll
                for (int hf = 0; hf < 2; ++hf) {
                    const f32x4 w0 = *(const LAS f32x4*)(cw + (qk * 3 + 0) * 128 + seg * 8 + 4 * hf), w1 = *(const LAS f32x4*)(cw + (qk * 3 + 1) * 128 + seg * 8 + 4 * hf), w2v = *(const LAS f32x4*)(cw + (qk * 3 + 2) * 128 + seg * 8 + 4 * hf);
                    y[4 * hf + 0] = w0[0] * bflo(pv[2 * hf]) + w1[0] * bflo(c0[2 * hf]) + w2v[0] * bflo(nx[2 * hf]);
                    y[4 * hf + 1] = w0[1] * bfhi(pv[2 * hf]) + w1[1] * bfhi(c0[2 * hf]) + w2v[1] * bfhi(nx[2 * hf]);
                    y[4 * hf + 2] = w0[2] * bflo(pv[2 * hf + 1]) + w1[2] * bflo(c0[2 * hf + 1]) + w2v[2] * bflo(nx[2 * hf + 1]);
                    y[4 * hf + 3] = w0[3] * bfhi(pv[2 * hf + 1]) + w1[3] * bfhi(c0[2 * hf + 1]) + w2v[3] * bfhi(nx[2 * hf + 1]);
                }
                const float scl = qk ? 0.08838834764831845f : 1.f;
                u32x4 o;
#pragma unroll
                for (int w2 = 0; w2 < 4; ++w2) o[w2] = pk2(silu_f(y[2 * w2]) * scl, silu_f(y[2 * w2 + 1]) * scl);
                *(u32x4*)((qk ? Kc : Qc) + R * 512 + h * 128 + seg * 8) = o;
                if (qk) {
#pragma unroll
                    for (int w2 = 0; w2 < 4; ++w2) { Tt[(seg * 8 + 2 * w2) * LD + l] = (bf16_t)(o[w2] & 0xffffu); Tt[(seg * 8 + 2 * w2 + 1) * LD + l] = (bf16_t)(o[w2] >> 16); }
                }
            }
        }
        __syncthreads();
#pragma unroll
        for (int it = 0; it < 4; ++it) { const int i = tid + NTHREADS * it; const int d = i >> 4, sg = i & 15;
            *(u32x4*)(KcT + ((size_t)unit * 128 + d) * 128 + sg * 8) = *(const LAS u32x4*)(Tt + d * LD + sg * 8); }
        __syncthreads();
    }
}

__device__ __forceinline__ void mlstm_phase(LAS unsigned char* lds, const bf16_t* P, const float* gates, const bf16_t* Qc, const bf16_t* Kc, const bf16_t* KcT, bf16_t* Hdir) {
    int tid_ = threadIdx.x; asm volatile("" : "+v"(tid_)); const int tid = tid_, lane = tid & 63, wid = __builtin_amdgcn_readfirstlane(tid >> 6), r = lane & 15, q = lane >> 4;
    constexpr int LD = 136, LDB = LD * 2;
    constexpr int OFF_Q = 0, OFF_K = 34816, OFF_KT = 69632, OFF_VT = 104448, OFF_VW = 113152, OFF_CT = 121856, OFF_SC = 130560;
    LAS bf16_t* Qs = (LAS bf16_t*)(lds + OFF_Q); LAS bf16_t* Ks = (LAS bf16_t*)(lds + OFF_K); LAS bf16_t* Kt = (LAS bf16_t*)(lds + OFF_KT);
    LAS bf16_t* Vt = (LAS bf16_t*)(lds + OFF_VT); LAS bf16_t* Vw = (LAS bf16_t*)(lds + OFF_VW); LAS bf16_t* Ct = (LAS bf16_t*)(lds + OFF_CT);
    LAS float* sc = (LAS float*)(lds + OFF_SC);
    LAS float* rowf = sc; LAS float* dmb = sc + 128; LAS float* inter = sc + 256; LAS float* wl = sc + 384; LAS float* en = sc + 512; LAS float* qn = sc + 640; LAS float* nvec = sc + 768; LAS float* misc = sc + 896;
    for (int unit = blockIdx.x; unit < 256; unit += gridDim.x) {
        const int es = unit & 3, dir = (unit >> 2) & 1, h = (unit >> 3) & 3, b = unit >> 5;
        for (int i = tid; i < 32 * LD / 2; i += NTHREADS) ((LAS unsigned*)Ct)[i] = 0u;
        if (tid < 128) nvec[tid] = 0.f;
        f32x4 Cacc[2]; Cacc[0] = (f32x4){0.f, 0.f, 0.f, 0.f}; Cacc[1] = Cacc[0];
        float m_state = 0.f;
        u32x4 pq[4], pvv; float pgi[2], pgf[2];
        const unsigned voffq = (unsigned)(((tid >> 4) * 512 + (tid & 15) * 8) * 2), vofft = (unsigned)(((tid >> 4) * 128 + (tid & 15) * 8) * 2);
#define MLSTM_CHUNK_INFO(ci_, n_, gc_, rb_) do { if ((ci_) < 2) n_ = dir ? 1 - (ci_) : (ci_); else n_ = dir ? 19 - (ci_) : (ci_); gc_ = b * 18 + n_; rb_ = n_ < 2 ? MX + b * CTXL + n_ * 128 : b * SEQ + (n_ - 2) * 128; } while (0)
#define MLSTM_PREFETCH(ci_) do { int n2, gc2, rb2; MLSTM_CHUNK_INFO(ci_, n2, gc2, rb2); \
            const bf16_t* qg = Qc + (size_t)rb2 * 512 + h * 128; (void)gc2; \
            _Pragma("unroll") for (int it = 0; it < 4; ++it) { \
                pq[it] = *(const u32x4*)((const char*)(qg + it * 16384) + voffq); } \
            pvv = *(const u32x4*)(P + (size_t)(rb2 + (tid >> 2)) * NEV + 1024 + h * 128 + es * 32 + (tid & 3) * 8); \
            if (wid == 0) { _Pragma("unroll") for (int hf = 0; hf < 2; ++hf) { const int l = lane + 64 * hf; const int R = rb2 + (dir ? 127 - l : l); \
                pgi[hf] = gates[(size_t)R * 16 + dir * 8 + h]; pgf[hf] = gates[(size_t)R * 16 + dir * 8 + 4 + h]; } } } while (0)
        MLSTM_PREFETCH(0);
        __syncthreads();
        for (int ci = 0; ci < 18; ++ci) {
            int wc_ = wid, dc_ = dir; asm volatile("" : "+s"(wc_), "+s"(dc_)); const int widc = wc_, dirc = dc_;
            int n, gc, rbase;
            MLSTM_CHUNK_INFO(ci, n, gc, rbase);
            if (wid == 0) {
                float ig[2], bc[2];
#pragma unroll
                for (int hf = 0; hf < 2; ++hf) { ig[hf] = pgi[hf]; const float fg = pgf[hf];
                    bc[hf] = fminf(fg, 0.f) - log1pf(expf(-fabsf(fg))); }
#pragma unroll
                for (int off = 1; off < 64; off <<= 1) { const float t0 = __shfl_up(bc[0], off), t1 = __shfl_up(bc[1], off); if (lane >= off) { bc[0] += t0; bc[1] += t1; } }
                bc[1] += __shfl(bc[0], 63);
                const float g = __shfl(bc[1], 63);
                const float d0 = ig[0] - bc[0], d1 = ig[1] - bc[1];
                float p0 = d0, p1 = d1;
#pragma unroll
                for (int off = 1; off < 64; off <<= 1) { const float t0 = __shfl_up(p0, off), t1 = __shfl_up(p1, off); if (lane >= off) { p0 = fmaxf(p0, t0); p1 = fmaxf(p1, t1); } }
                p1 = fmaxf(p1, __shfl(p0, 63));
                const float a0 = g + d0, a1 = g + d1;
                const float mloc = wave_max(fmaxf(a0, a1));
                const float m_new = fmaxf(g + m_state, mloc);
                const float dec = expf(g + m_state - m_new);
                const float mt0 = bc[0] + fmaxf(m_state, p0), mt1 = bc[1] + fmaxf(m_state, p1);
                const int i0 = dir ? 127 - lane : lane, i1 = dir ? 63 - lane : lane + 64;
                rowf[i0] = bc[0] - mt0; rowf[i1] = bc[1] - mt1;
                dmb[i0] = d0; dmb[i1] = d1;
                inter[i0] = expf(bc[0] + m_state - mt0); inter[i1] = expf(bc[1] + m_state - mt1);
                wl[i0] = expf(a0 - m_new); wl[i1] = expf(a1 - m_new);
                en[i0] = expf(-mt0); en[i1] = expf(-mt1);
                if (lane == 0) misc[0] = dec;
                m_state = m_new;
            }
            u32x4 pk[4], pt[4];
            { const bf16_t* kg = Kc + (size_t)rbase * 512 + h * 128; const bf16_t* tg = KcT + (size_t)(gc * 4 + h) * 128 * 128;
#pragma unroll
              for (int it = 0; it < 4; ++it) pk[it] = *(const u32x4*)((const char*)(kg + it * 16384) + voffq);
#pragma unroll
              for (int it = 0; it < 4; ++it) pt[it] = *(const u32x4*)((const char*)(tg + it * 4096) + vofft); }
#pragma unroll
            for (int it = 0; it < 4; ++it) { const int i = tid + NTHREADS * it; const int row = i >> 4, sg = i & 15; *(LAS u32x4*)(Qs + row * LD + sg * 8) = pq[it]; }
#pragma unroll
            for (int it = 0; it < 4; ++it) { const int i = tid + NTHREADS * it; const int row = i >> 4, sg = i & 15; *(LAS u32x4*)(Ks + row * LD + sg * 8) = pk[it]; }
            __syncthreads();
            const float dec = misc[0];
            {
                const int t = tid >> 2, sg = tid & 3;
                const u32x4 vv = pvv;
                const float w = wl[t];
#pragma unroll
                for (int w2 = 0; w2 < 4; ++w2) {
                    Vt[(sg * 8 + 2 * w2) * LD + t] = (bf16_t)(vv[w2] & 0xffffu); Vt[(sg * 8 + 2 * w2 + 1) * LD + t] = (bf16_t)(vv[w2] >> 16);
                    Vw[(sg * 8 + 2 * w2) * LD + t] = f2bf(bflo(vv[w2]) * w); Vw[(sg * 8 + 2 * w2 + 1) * LD + t] = f2bf(bfhi(vv[w2]) * w);
                }
            }
            f32x4 sacc[8];
            {
                bf16x8 af[4];
#pragma unroll
                for (int ks = 0; ks < 4; ++ks) af[ks] = ldsfrag(lds + OFF_Q + (16 * wid + r) * LDB + (32 * ks + 8 * q) * 2);
#pragma unroll
                for (int jb = 0; jb < 8; ++jb) {
                    sacc[jb] = (f32x4){0.f, 0.f, 0.f, 0.f};
                    if (dirc ? (jb >= widc) : (jb <= widc)) {
#pragma unroll
                        for (int ks = 0; ks < 4; ++ks) sacc[jb] = mfma16(af[ks], ldsfrag(lds + OFF_K + (16 * jb + r) * LDB + (32 * ks + 8 * q) * 2), sacc[jb]);
                    }
                }
            }
            {
                const int t = tid >> 2, part = tid & 3; float s = 0.f;
#pragma unroll
                for (int i = 0; i < 4; ++i) {
                    const u32x4 qv = *(const LAS u32x4*)(Qs + t * LD + part * 32 + i * 8);
                    const f32x4 n0 = *(const LAS f32x4*)(nvec + part * 32 + i * 8), n1 = *(const LAS f32x4*)(nvec + part * 32 + i * 8 + 4);
                    s += bflo(qv[0]) * n0[0] + bfhi(qv[0]) * n0[1] + bflo(qv[1]) * n0[2] + bfhi(qv[1]) * n0[3] + bflo(qv[2]) * n1[0] + bfhi(qv[2]) * n1[1] + bflo(qv[3]) * n1[2] + bfhi(qv[3]) * n1[3];
                }
                s += dppf<0xB1>(s); s += dppf<0x4E>(s);
                if (part == 0) qn[t] = s;
            }
#pragma unroll
            for (int it = 0; it < 4; ++it) { const int i = tid + NTHREADS * it; *(LAS u32x4*)(Kt + (i >> 4) * LD + (i & 15) * 8) = pt[it]; }
            __syncthreads();
            LAS bf16_t* Ss = Ks;
            float rs[4] = {0.f, 0.f, 0.f, 0.f};
            {
                const f32x4 rf = *(const LAS f32x4*)(rowf + 16 * wid + 4 * q);
                const int zb = dirc ? ((widc & 1) ? widc - 1 : -1) : ((widc & 1) ? -1 : widc + 1);
#pragma unroll
                for (int jb = 0; jb < 8; ++jb) {
                    if (dirc ? (jb >= widc) : (jb <= widc)) {
                        const int s = 16 * jb + r; const float dm = dmb[s];
#pragma unroll
                        for (int reg = 0; reg < 4; ++reg) { const int t = 16 * wid + 4 * q + reg;
                            const bool ok = dirc ? (s >= t) : (s <= t);
                            const float v = ok ? sacc[jb][reg] * __expf(rf[reg] + dm) : 0.f;
                            rs[reg] += v; Ss[t * LD + s] = f2bf(v); }
                    } else if (jb == zb) {
#pragma unroll
                        for (int reg = 0; reg < 4; ++reg) Ss[(16 * wid + 4 * q + reg) * LD + 16 * jb + r] = 0;
                    }
                }
#pragma unroll
                for (int reg = 0; reg < 4; ++reg) rs[reg] = row16_sum(rs[reg]);
            }
            {
                const int kh = widc >> 1;
                const f32x4 it4 = *(const LAS f32x4*)(inter + 16 * wid + 4 * q), qn4 = *(const LAS f32x4*)(qn + 16 * wid + 4 * q), en4 = *(const LAS f32x4*)(en + 16 * wid + 4 * q);
                bf16x8 qf[4];
#pragma unroll
                for (int ks = 0; ks < 4; ++ks) qf[ks] = ldsfrag(lds + OFF_Q + (16 * wid + r) * LDB + (32 * ks + 8 * q) * 2);
#pragma unroll
                for (int nt = 0; nt < 2; ++nt) {
                    f32x4 a1 = (f32x4){0.f, 0.f, 0.f, 0.f}, a2 = a1;
#pragma unroll
                    for (int ks = 0; ks < 4; ++ks) {
                        if (dirc ? (ks >= kh) : (ks <= kh)) a1 = mfma16(ldsfrag(lds + OFF_K + (16 * wid + r) * LDB + (32 * ks + 8 * q) * 2), ldsfrag(lds + OFF_VT + (16 * nt + r) * LDB + (32 * ks + 8 * q) * 2), a1);
                        a2 = mfma16(qf[ks], ldsfrag(lds + OFF_CT + (16 * nt + r) * LDB + (32 * ks + 8 * q) * 2), a2);
                    }
#pragma unroll
                    for (int reg = 0; reg < 4; ++reg) {
                        const int t = 16 * wid + 4 * q + reg;
                        const float den = rs[reg] + it4[reg] * qn4[reg];
                        const float hv = (a1[reg] + it4[reg] * a2[reg]) / fmaxf(fabsf(den), en4[reg]);
                        Hdir[((size_t)dir * MT + rbase + t) * 512 + h * 128 + es * 32 + 16 * nt + r] = f2bf(hv);
                    }
                }
            }
            asm volatile("" ::: "memory");
            if (ci + 1 < 18) MLSTM_PREFETCH(ci + 1);
            asm volatile("" ::: "memory");
            {
                bf16x8 kf[4];
#pragma unroll
                for (int ks = 0; ks < 4; ++ks) kf[ks] = ldsfrag(lds + OFF_KT + (16 * wid + r) * LDB + (32 * ks + 8 * q) * 2);
#pragma unroll
                for (int nt = 0; nt < 2; ++nt) {
                    Cacc[nt] = Cacc[nt] * dec;
#pragma unroll
                    for (int ks = 0; ks < 4; ++ks) Cacc[nt] = mfma16(kf[ks], ldsfrag(lds + OFF_VW + (16 * nt + r) * LDB + (32 * ks + 8 * q) * 2), Cacc[nt]);
                }
            }
            float nnew;
            {
                const int d = tid >> 2, part = tid & 3; float s = 0.f;
#pragma unroll
                for (int i = 0; i < 4; ++i) {
                    const u32x4 kv = *(const LAS u32x4*)(Kt + d * LD + part * 32 + i * 8);
                    const f32x4 w0 = *(const LAS f32x4*)(wl + part * 32 + i * 8), w1 = *(const LAS f32x4*)(wl + part * 32 + i * 8 + 4);
                    s += bflo(kv[0]) * w0[0] + bfhi(kv[0]) * w0[1] + bflo(kv[1]) * w0[2] + bfhi(kv[1]) * w0[3] + bflo(kv[2]) * w1[0] + bfhi(kv[2]) * w1[1] + bflo(kv[3]) * w1[2] + bfhi(kv[3]) * w1[3];
                }
                s += dppf<0xB1>(s); s += dppf<0x4E>(s);
                nnew = dec * nvec[d] + s;
            }
            __syncthreads();
#pragma unroll
            for (int nt = 0; nt < 2; ++nt) { u32x2 w; w.x = pk2(Cacc[nt][0], Cacc[nt][1]); w.y = pk2(Cacc[nt][2], Cacc[nt][3]); *(LAS u32x2*)(Ct + (16 * nt + r) * LD + 16 * wid + 4 * q) = w; }
            if ((tid & 3) == 0) nvec[tid >> 2] = nnew;
        }
        __syncthreads();
    }
}

__device__ __forceinline__ void sgu_phase(LAS unsigned char* lds, const bf16_t* P, const float* sgu_norm, const float* sgu_ws, const float* sgu_b, bf16_t* A1) {
    int tid_ = threadIdx.x; asm volatile("" : "+v"(tid_)); const int tid = tid_, lane = tid & 63, wid = __builtin_amdgcn_readfirstlane(tid >> 6), r = lane & 15, q = lane >> 4;
    constexpr int LD = 136, LDB = LD * 2, OFF_W = 0, OFF_V = 34816, OFF_R = 69632;
    LAS bf16_t* Ws = (LAS bf16_t*)(lds + OFF_W); LAS bf16_t* Vt = (LAS bf16_t*)(lds + OFF_V); LAS float* rstd = (LAS float*)(lds + OFF_R);
    for (int unit = (int)gridDim.x - 1 - (int)blockIdx.x; unit < 144; unit += gridDim.x) {
        const int n = unit % 18, b = unit / 18;
        const int rbase = n < 2 ? MX + b * CTXL + n * 128 : b * SEQ + (n - 2) * 128;
        {
            const int tok = tid >> 2, part = tid & 3; float ss = 0.f;
            const bf16_t* pv = P + (size_t)(rbase + tok) * NEV + 2560 + part * 128;
#pragma unroll 4
            for (int i = 0; i < 16; ++i) { const u32x4 w = *(const u32x4*)(pv + i * 8);
#pragma unroll
                for (int k = 0; k < 4; ++k) { const float a0 = gelu_tanh(bflo(w[k])), a1 = gelu_tanh(bfhi(w[k])); ss += a0 * a0 + a1 * a1; } }
            ss += dppf<0xB1>(ss); ss += dppf<0x4E>(ss);
            if (part == 0) rstd[tok] = 1.0f / sqrtf(ss * (1.f / 512.f) + EPS);
        }
#pragma unroll 1
        for (int g = 0; g < 4; ++g) {
#pragma unroll
            for (int it = 0; it < 4; ++it) { const int i = tid + NTHREADS * it; const int p = i >> 4, sg = i & 15;
                const float* wp = sgu_ws + ((size_t)g * 128 + p) * 128 + sg * 8; const f32x4 w0 = *(const f32x4*)wp, w1 = *(const f32x4*)(wp + 4);
                u32x4 o; o.x = pk2(w0[0], w0[1]); o.y = pk2(w0[2], w0[3]); o.z = pk2(w1[0], w1[1]); o.w = pk2(w1[2], w1[3]);
                *(LAS u32x4*)(Ws + p * LD + sg * 8) = o; }
            if (g == 0) __syncthreads();
#pragma unroll
            for (int it = 0; it < 4; ++it) { const int i = tid + NTHREADS * it; const int tq = i >> 4, sg = i & 15;
                const u32x4 w = *(const u32x4*)(P + (size_t)(rbase + tq) * NEV + 2560 + g * 128 + sg * 8);
                const float rq = rstd[tq];
                const f32x4 g0 = *(const f32x4*)(sgu_norm + g * 128 + sg * 8), g1 = *(const f32x4*)(sgu_norm + g * 128 + sg * 8 + 4);
                Vt[(sg * 8 + 0) * LD + tq] = f2bf(gelu_tanh(bflo(w[0])) * rq * g0[0]); Vt[(sg * 8 + 1) * LD + tq] = f2bf(gelu_tanh(bfhi(w[0])) * rq * g0[1]);
                Vt[(sg * 8 + 2) * LD + tq] = f2bf(gelu_tanh(bflo(w[1])) * rq * g0[2]); Vt[(sg * 8 + 3) * LD + tq] = f2bf(gelu_tanh(bfhi(w[1])) * rq * g0[3]);
                Vt[(sg * 8 + 4) * LD + tq] = f2bf(gelu_tanh(bflo(w[2])) * rq * g1[0]); Vt[(sg * 8 + 5) * LD + tq] = f2bf(gelu_tanh(bfhi(w[2])) * rq * g1[1]);
                Vt[(sg * 8 + 6) * LD + tq] = f2bf(gelu_tanh(bflo(w[3])) * rq * g1[2]); Vt[(sg * 8 + 7) * LD + tq] = f2bf(gelu_tanh(bfhi(w[3])) * rq * g1[3]); }
            __syncthreads();
            {
                bf16x8 wf[4];
#pragma unroll
                for (int ks = 0; ks < 4; ++ks) wf[ks] = ldsfrag(lds + OFF_W + (16 * wid + r) * LDB + (32 * ks + 8 * q) * 2);
                const float sbp = sgu_b[g * 128 + 16 * wid + r];
                const size_t R = (size_t)(rbase + 16 * wid + r);
#pragma unroll
                for (int jb = 0; jb < 8; ++jb) {
                    f32x4 acc = (f32x4){0.f, 0.f, 0.f, 0.f};
#pragma unroll
                    for (int ks = 0; ks < 4; ++ks) acc = mfma16(ldsfrag(lds + OFF_V + (16 * jb + r) * LDB + (32 * ks + 8 * q) * 2), wf[ks], acc);
                    const u32x2 uu = *(const u32x2*)(P + R * NEV + 2048 + g * 128 + 16 * jb + 4 * q);
                    u32x2 w; w.x = pk2(gelu_tanh(bflo(uu.x)) * (acc[0] + sbp), gelu_tanh(bfhi(uu.x)) * (acc[1] + sbp)); w.y = pk2(gelu_tanh(bflo(uu.y)) * (acc[2] + sbp), gelu_tanh(bfhi(uu.y)) * (acc[3] + sbp));
                    *(u32x2*)(A1 + R * D + 512 + g * 128 + 16 * jb + 4 * q) = w;
                }
            }
            __syncthreads();
        }
    }
}

__device__ __forceinline__ void combine_phase(const bf16_t* Hdir, const bf16_t* P, const float* mnorm, bf16_t* A1) {
    int tid_ = threadIdx.x; asm volatile("" : "+v"(tid_)); const int tid = tid_, lane = tid & 63, wid = __builtin_amdgcn_readfirstlane(tid >> 6);
    for (int R = blockIdx.x * 8 + wid; R < MT; R += gridDim.x * 8) {
        const int col = lane * 8;
        const u32x4 h0 = *(const u32x4*)(Hdir + (size_t)R * 512 + col), h1 = *(const u32x4*)(Hdir + ((size_t)MT + R) * 512 + col);
        float a[8];
#pragma unroll
        for (int k = 0; k < 4; ++k) { a[2 * k] = bflo(h0[k]) + bflo(h1[k]); a[2 * k + 1] = bfhi(h0[k]) + bfhi(h1[k]); }
        float ss = 0.f;
#pragma unroll
        for (int k = 0; k < 8; ++k) ss += a[k] * a[k];
        ss = row16_sum(ss);
        const float rstd = 1.0f / sqrtf(ss * (1.f / 128.f) + EPS);
        const f32x4 m0 = *(const f32x4*)(mnorm + col), m1 = *(const f32x4*)(mnorm + col + 4);
        const u32x4 ov = *(const u32x4*)(P + (size_t)R * NEV + 1536 + col);
        u32x4 w;
        w.x = pk2(sigmoid_f(bflo(ov[0])) * a[0] * rstd * m0[0], sigmoid_f(bfhi(ov[0])) * a[1] * rstd * m0[1]);
        w.y = pk2(sigmoid_f(bflo(ov[1])) * a[2] * rstd * m0[2], sigmoid_f(bfhi(ov[1])) * a[3] * rstd * m0[3]);
        w.z = pk2(sigmoid_f(bflo(ov[2])) * a[4] * rstd * m1[0], sigmoid_f(bfhi(ov[2])) * a[5] * rstd * m1[1]);
        w.w = pk2(sigmoid_f(bflo(ov[3])) * a[6] * rstd * m1[2], sigmoid_f(bfhi(ov[3])) * a[7] * rstd * m1[3]);
        *(u32x4*)(A1 + (size_t)R * D + col) = w;
    }
}

__device__ __forceinline__ void attn_phase(LAS unsigned char* lds, const bf16_t* QKV, const float* sink, bf16_t* A1) {
    int tid_ = threadIdx.x; asm volatile("" : "+v"(tid_)); const int tid = tid_, lane = tid & 63, wid = __builtin_amdgcn_readfirstlane(tid >> 6), r = lane & 15, q = lane >> 4;
    constexpr int LK = 72, LKB = LK * 2, OFF_K = 0, OFF_V = 9216, OFF_P = 18432, PSZ = 64 * LKB;
    LAS bf16_t* Ks = (LAS bf16_t*)(lds + OFF_K); LAS bf16_t* Vt = (LAS bf16_t*)(lds + OFF_V);
    LAS bf16_t* Ps = (LAS bf16_t*)(lds + OFF_P + wid * PSZ);
    const LAS unsigned char* Pb = lds + OFF_P + wid * PSZ;
    for (int unit = blockIdx.x; unit < 512; unit += gridDim.x) {
        asm volatile("" : "+s"(QKV), "+s"(A1));
        const int hk = unit & 3, j = (unit >> 2) & 15, b = unit >> 6;
        const int g = wid >> 1, hq = hk * 4 + g, tok0 = (wid & 1) * 64;
        const int qrow0 = b * SEQ + j * 128 + tok0;
        bf16x8 qf[4][2];
#pragma unroll
        for (int mt = 0; mt < 4; ++mt)
#pragma unroll
            for (int ks = 0; ks < 2; ++ks) qf[mt][ks] = *(const bf16x8*)(QKV + (size_t)(qrow0 + 16 * mt + r) * NQKV + hq * 64 + 32 * ks + 8 * q);
        float mrun[4], lrun[4]; f32x4 oacc[4][4];
        const float sk = sink[hq];
#pragma unroll
        for (int mt = 0; mt < 4; ++mt) { mrun[mt] = sk; lrun[mt] = 1.f;
#pragma unroll
            for (int dt = 0; dt < 4; ++dt) oacc[dt][mt] = (f32x4){0.f, 0.f, 0.f, 0.f}; }
        const int tfirst = 0, tlast = (j == 15) ? 7 : 9;
        u32x4 kvn, vvn;
        const unsigned voffk = (unsigned)(((tid >> 3) * NQKV + (tid & 7) * 8) * 2);
#define ATTN_TILE_ROW(ti_) ((ti_) < 4 ? MX + b * CTXL + (ti_) * 64 : b * SEQ + (j - 1 + (((ti_) - 4) >> 1)) * 128 + (((ti_) - 4) & 1) * 64)
#define ATTN_LOAD(ti_) do { const char* kp_ = (const char*)(QKV + (size_t)ATTN_TILE_ROW(ti_) * NQKV + 1024 + hk * 64); kvn = *(const u32x4*)(kp_ + voffk); vvn = *(const u32x4*)(kp_ + 512 + voffk); } while (0)
        ATTN_LOAD(tfirst);
        for (int ti = tfirst; ti <= tlast; ++ti) {
            if (j == 0 && (ti == 4 || ti == 5)) continue;
            int kpos0; bool band;
            if (ti < 4) { kpos0 = 0; band = false; }
            else { const int kb = j - 1 + ((ti - 4) >> 1); kpos0 = kb * 128 + ((ti - 4) & 1) * 64; band = (kb != j); }
            __syncthreads();
            {
                const int key = tid >> 3, sg = tid & 7;
                *(LAS u32x4*)(Ks + key * LK + sg * 8) = kvn;
#pragma unroll
                for (int w2 = 0; w2 < 4; ++w2) { Vt[(sg * 8 + 2 * w2) * LK + key] = (bf16_t)(vvn[w2] & 0xffffu); Vt[(sg * 8 + 2 * w2 + 1) * LK + key] = (bf16_t)(vvn[w2] >> 16); }
            }
            { int tn = ti + 1; if (j == 0 && tn == 4) tn = 6; if (tn <= tlast) ATTN_LOAD(tn); }
            __syncthreads();
            {
#pragma unroll
                for (int mt = 0; mt < 4; ++mt) {
                    f32x4 s[4];
#pragma unroll
                    for (int nt = 0; nt < 4; ++nt) { f32x4 a = (f32x4){0.f, 0.f, 0.f, 0.f}; a = mfma16(ldsfrag(lds + OFF_K + (16 * nt + r) * LKB + (8 * q) * 2), qf[mt][0], a); a = mfma16(ldsfrag(lds + OFF_K + (16 * nt + r) * LKB + (32 + 8 * q) * 2), qf[mt][1], a); s[nt] = a; }
                    if (band) {
                        const int qp = j * 128 + tok0 + 16 * mt + r;
#pragma unroll
                        for (int nt = 0; nt < 4; ++nt)
#pragma unroll
                            for (int i = 0; i < 4; ++i) { const int df = qp - (kpos0 + 16 * nt + 4 * q + i); if (df > 128 || df < -128) s[nt][i] = -1e30f; }
                    }
                    float mx = fmaxf(fmaxf(fmaxf(s[0][0], s[0][1]), fmaxf(s[0][2], s[0][3])), fmaxf(fmaxf(s[1][0], s[1][1]), fmaxf(s[1][2], s[1][3])));
                    mx = fmaxf(mx, fmaxf(fmaxf(fmaxf(s[2][0], s[2][1]), fmaxf(s[2][2], s[2][3])), fmaxf(fmaxf(s[3][0], s[3][1]), fmaxf(s[3][2], s[3][3]))));
                    mx = fmaxf(mx, __shfl_xor(mx, 16)); mx = fmaxf(mx, __shfl_xor(mx, 32));
                    const float mn = fmaxf(mrun[mt], mx), alpha = __expf(mrun[mt] - mn);
                    float rsum = 0.f;
#pragma unroll
                    for (int nt = 0; nt < 4; ++nt) {
                        const float p0 = __expf(s[nt][0] - mn), p1 = __expf(s[nt][1] - mn), p2 = __expf(s[nt][2] - mn), p3 = __expf(s[nt][3] - mn);
                        rsum += (p0 + p1) + (p2 + p3);
                        u32x2 w; w.x = pk2(p0, p1); w.y = pk2(p2, p3);
                        *(LAS u32x2*)(Ps + (16 * mt + r) * LK + 16 * nt + 4 * q) = w;
                    }
                    rsum += __shfl_xor(rsum, 16); rsum += __shfl_xor(rsum, 32);
                    lrun[mt] = lrun[mt] * alpha + rsum; mrun[mt] = mn;
#pragma unroll
                    for (int dt = 0; dt < 4; ++dt) oacc[dt][mt] *= alpha;
                    asm volatile("" ::: "memory");
                }
            }
#pragma unroll
            for (int mt = 0; mt < 4; ++mt) {
                const bf16x8 p0 = ldsfrag(Pb + (16 * mt + r) * LKB + (8 * q) * 2), p1 = ldsfrag(Pb + (16 * mt + r) * LKB + (32 + 8 * q) * 2);
#pragma unroll
                for (int dt = 0; dt < 4; ++dt) {
                    oacc[dt][mt] = mfma16(ldsfrag(lds + OFF_V + (16 * dt + r) * LKB + (8 * q) * 2), p0, oacc[dt][mt]);
                    oacc[dt][mt] = mfma16(ldsfrag(lds + OFF_V + (16 * dt + r) * LKB + (32 + 8 * q) * 2), p1, oacc[dt][mt]);
                }
                asm volatile("" ::: "memory");
            }
        }
#pragma unroll
        for (int mt = 0; mt < 4; ++mt) { const float inv = 1.f / lrun[mt]; const size_t R = (size_t)(qrow0 + 16 * mt + r);
#pragma unroll
            for (int dt = 0; dt < 4; ++dt) { const f32x4 o = oacc[dt][mt] * inv; u32x2 w; w.x = pk2(o[0], o[1]); w.y = pk2(o[2], o[3]);
                *(u32x2*)(A1 + R * D + hq * 64 + 16 * dt + 4 * q) = w; } }
    }
    __syncthreads();
}

__device__ __forceinline__ void final_phase(float* out, const float* fnorm) {
    int tid_ = threadIdx.x; asm volatile("" : "+v"(tid_)); const int tid = tid_, lane = tid & 63, wid = __builtin_amdgcn_readfirstlane(tid >> 6);
    for (int R = blockIdx.x * 8 + wid; R < MX; R += gridDim.x * 8) {
        float* src = out + (size_t)R * D;
        f32x4 v[4]; float ss = 0.f;
#pragma unroll
        for (int j = 0; j < 4; ++j) { v[j] = *(const f32x4*)(src + 256 * j + 4 * lane); ss += (v[j][0] * v[j][0] + v[j][1] * v[j][1]) + (v[j][2] * v[j][2] + v[j][3] * v[j][3]); }
        const float rstd = 1.0f / sqrtf(wave_sum(ss) * (1.f / D) + EPS);
#pragma unroll
        for (int j = 0; j < 4; ++j) { const f32x4 w = *(const f32x4*)(fnorm + 256 * j + 4 * lane); *(f32x4*)(src + 256 * j + 4 * lane) = v[j] * rstd * w; }
    }
}

#define GAS __attribute__((address_space(1)))
typedef GAS unsigned gu32;
#define RLX_AGENT __ATOMIC_RELAXED, __HIP_MEMORY_SCOPE_AGENT
#define XB_TMO      128
#define XB_XCNT(j)  (256  + 64 * (j))
#define XB_XSUB(j)  (1280 + 64 * (j))
#define XB_XGEN(j)  (2304 + 64 * (j))
#define XB_TOP      3328
#define XB_TOPGEN   3392
#define XCD_BAR_WORDS 3456
#define XB_SPIN_CAP (1u << 18)

__device__ __forceinline__ unsigned xb_ld(unsigned* p)              { return __hip_atomic_load(p, __ATOMIC_RELAXED, __HIP_MEMORY_SCOPE_AGENT); }
__device__ __forceinline__ unsigned xb_add(unsigned* p, unsigned v) { return __hip_atomic_fetch_add(p, v, __ATOMIC_RELAXED, __HIP_MEMORY_SCOPE_AGENT); }
__device__ __forceinline__ unsigned xb_xcc_id() { return (unsigned)__builtin_amdgcn_s_getreg((3 << 11) | 20) & 0xFu; }
#define XB_SPIN(cond, bar) do { unsigned _sp = 0; while (cond) { __builtin_amdgcn_s_sleep(1); \
    if ((++_sp & 255u) == 0u) { if (xb_ld(&(bar)[XB_TMO])) break; if (_sp > XB_SPIN_CAP) { atomicAdd(&(bar)[XB_TMO], 1u); break; } } } } while (0)

struct XcdBarrier {
    unsigned* bar; unsigned x;
    volatile LAS unsigned* st;
};

__device__ __forceinline__ XcdBarrier xcd_barrier_post(unsigned* bar, volatile LAS unsigned* st) {
    XcdBarrier b; b.bar = bar; b.x = xb_xcc_id(); b.st = st;
    if (threadIdx.x == 0) (void)xb_add(&bar[XB_XCNT(b.x)], 1u);
    return b;
}
__device__ __forceinline__ void xcd_barrier_complete(unsigned* bar, unsigned x, unsigned& nloc, unsigned& nx) {
    const unsigned G = gridDim.x * gridDim.y * gridDim.z;
    unsigned sum, cnt, mine, sp = 0u;
    for (;;) {
        sum = 0u; cnt = 0u;
#pragma unroll 1
        for (unsigned j = 0; j < 16; ++j) { const unsigned c = xb_ld(&bar[XB_XCNT(j)]); sum += c; cnt += (c > 0u) ? 1u : 0u; }
        mine = xb_ld(&bar[XB_XCNT(x)]);
        if (sum == G) break;
        __builtin_amdgcn_s_sleep(1);
        if ((++sp & 255u) == 0u) { if (xb_ld(&bar[XB_TMO])) break; if (sp > XB_SPIN_CAP) { atomicAdd(&bar[XB_TMO], 1u); break; } }
    }
    nloc = mine > 0u ? mine : 1u; nx = cnt > 0u ? cnt : 1u;
}

__device__ __forceinline__ void xcd_barrier(const XcdBarrier& b) {
    asm volatile("s_waitcnt vmcnt(0)" ::: "memory");
    __syncthreads();
    if (threadIdx.x == 0) {
        unsigned* bar = b.bar;
        __builtin_amdgcn_s_waitcnt(0);
        unsigned nloc = b.st[0], nx = b.st[1];
        if (nloc == 0u) { xcd_barrier_complete(bar, b.x, nloc, nx); b.st[0] = nloc; b.st[1] = nx; }
        const unsigned old = xb_add(&bar[XB_XSUB(b.x)], 1u);
        const unsigned gen = old / nloc;
        if (old + 1u == (gen + 1u) * nloc) {
            __builtin_amdgcn_fence(__ATOMIC_RELEASE, "agent");
            asm volatile("s_waitcnt vmcnt(0)" ::: "memory");
            const unsigned og = xb_add(&bar[XB_TOP], 1u);
            const unsigned tg = og / nx;
            if (og + 1u == (tg + 1u) * nx) xb_add(&bar[XB_TOPGEN], 1u);
            else XB_SPIN(xb_ld(&bar[XB_TOPGEN]) == tg, bar);
            __builtin_amdgcn_fence(__ATOMIC_ACQUIRE, "agent");
            xb_add(&bar[XB_XGEN(b.x)], 1u);
            asm volatile("s_waitcnt vmcnt(0)" ::: "memory");
        } else {
            XB_SPIN(xb_ld(&bar[XB_XGEN(b.x)]) == gen, bar);
            __builtin_amdgcn_fence(__ATOMIC_ACQUIRE, "agent");
            asm volatile("s_waitcnt vmcnt(0)" ::: "memory");
        }
    }
    __syncthreads();
}

#ifndef MK_SINGLE
#define MK_SINGLE 1
#endif
constexpr int NPHASES = 24;
#ifndef EN_PREP
#define EN_PREP 1
#endif
#ifndef REP_MASK
#define REP_MASK 0
#endif
#ifndef USE_CG_FIRST
#define USE_CG_FIRST 0
#endif
#ifndef NSYNC_REP
#define NSYNC_REP 1
#endif
#ifndef EN_ALL
#define EN_ALL 1
#endif
#ifndef EN_P0
#define EN_P0 EN_ALL
#endif
#ifndef EN_NORM
#define EN_NORM EN_ALL
#endif
#ifndef EN_GEMM
#define EN_GEMM (EN_ALL ? 15 : 0)
#endif
#ifndef EN_MLSTM
#define EN_MLSTM EN_ALL
#endif
#ifndef EN_SGU
#define EN_SGU EN_ALL
#endif
#ifndef EN_COMB
#define EN_COMB EN_ALL
#endif
#ifndef EN_ATTN
#define EN_ATTN EN_ALL
#endif
#ifndef EN_FINAL
#define EN_FINAL EN_ALL
#endif
__global__ void __launch_bounds__(NTHREADS, 2) fwd_kernel(Args a_unused) {
    extern __shared__ __attribute__((aligned(16))) unsigned char lds_raw[];
    LAS unsigned char* lds = (LAS unsigned char*)lds_raw;
    cg::grid_group grid = cg::this_grid();
    unsigned char* ws = KA(ws);
    const int G = gridDim.x, c = blockIdx.x;
    float* Hx = KA(out); float* Hc = (float*)(ws + WS_HC);
    bf16_t* A0 = (bf16_t*)(ws + WS_A0); bf16_t* A1 = (bf16_t*)(ws + WS_A1); bf16_t* BIG = (bf16_t*)(ws + WS_BIG);
    bf16_t* Hdir = (bf16_t*)(ws + WS_A0);
    const float* mod = (const float*)(ws + WS_MOD);
    float* gates = (float*)(ws + WS_GATES);
    const int lo = KA(ph_lo), hi = KA(ph_hi);
    volatile LAS unsigned* barst = (volatile LAS unsigned*)(lds + LDS_BYTES - 16);
    if (threadIdx.x < 2) barst[threadIdx.x] = 0u;
    __syncthreads();
    XcdBarrier bar = xcd_barrier_post((unsigned*)(ws + WS_CTL), barst);
    enum { K_P0, K_NORM, K_NORMG, K_SWIGLU, K_RESID, K_PLAIN, K_QKV, K_MIX0, K_COMB, K_ATTN, K_FINAL, K_PREP };
    for (int ph = lo; ph < hi; ++ph) {
        const int layer = ph >= 13 ? 1 : 0;
        const int lp = ph >= 13 ? ph - 13 : ph - 1;
        const float* modl = mod + (size_t)layer * 9 * 9216;
        int kind = K_P0, M = MT, gi = 0, ffn = 0, Kd = 1024; float coef = 1.f;
        const bf16_t* Aop = A0; const bf16_t* Wop = nullptr;
        const float* bxp = Hx; const float* bcp = Hc;
        if (ph == 0) kind = K_P0;
        else if (ph == 23) kind = K_FINAL;
        else if (lp == 0) { kind = K_NORM; gi = 0; if (layer == 0) { bxp = KA(x); bcp = KA(ctx); } }
        else if (lp == 1) { kind = K_SWIGLU; ffn = layer * 2; }
        else if (lp == 2) { kind = K_RESID; Aop = BIG; Wop = (const bf16_t*)(ws + WS_WOUT + (size_t)(layer * 2) * SZ_WOUT); Kd = 2816; gi = 2; coef = 0.5f; if (layer == 0) { bxp = KA(x); bcp = KA(ctx); } }
        else if (layer == 0) {
            if (lp == 3) { kind = K_NORMG; gi = 3; }
            else if (lp == 4) kind = K_PLAIN;
            else if (lp == 5) kind = K_PREP;
            else if (lp == 6) kind = K_MIX0;
            else if (lp == 7) kind = K_COMB;
            else if (lp == 8) { kind = K_RESID; Aop = A1; Wop = (const bf16_t*)(ws + WS_WEOUT); gi = 5; }
            else if (lp == 9) { kind = K_NORM; gi = 6; }
            else if (lp == 10) { kind = K_SWIGLU; ffn = 1; }
            else { kind = K_RESID; Aop = BIG; Wop = (const bf16_t*)(ws + WS_WOUT + SZ_WOUT); Kd = 2816; gi = 8; coef = 0.5f; }
        } else {
            if (lp == 3) { kind = K_NORM; gi = 3; }
            else if (lp == 4) kind = K_QKV;
            else if (lp == 5) kind = K_ATTN;
            else if (lp == 6) { kind = K_RESID; Aop = A1; Wop = (const bf16_t*)(ws + WS_WOOUT); gi = 5; M = MX; }
            else if (lp == 7) { kind = K_NORM; gi = 6; M = MX; }
            else if (lp == 8) { kind = K_SWIGLU; ffn = 3; M = MX; }
            else { kind = K_RESID; Aop = BIG; Wop = (const bf16_t*)(ws + WS_WOUT + 3 * SZ_WOUT); Kd = 2816; gi = 8; coef = 0.5f; M = MX; }
        }
        const int nrep = ((REP_MASK >> kind) & 1) ? 2 : 1;
        for (int rep = 0; rep < nrep; ++rep) {
        if (rep == 1) { if (kind == K_RESID) { bxp = Hx; bcp = Hc; coef = 0.f; } __syncthreads(); }
        if (kind == K_P0) { if (EN_P0) p0_phase(lds); }
        else if (kind == K_NORM) { if (EN_NORM) norm_phase<false>(lds, bxp, bcp, A0, modl, gi, gi + 1, M, nullptr, nullptr, nullptr, (ph > 1 && M == MT) ? (float*)(ws + WS_PC) : nullptr); }
        else if (kind == K_NORMG) { if (EN_NORM) norm_phase<true>(lds, Hx, Hc, A0, modl, gi, gi + 1, M, (const float*)(ws + WS_WG), KA(mlstm_gate_b), gates, (float*)(ws + WS_PC)); }
        else if (kind == K_SWIGLU) { if (EN_GEMM & 1) { pg8::Gemm g{A0, (const bf16_t*)(ws + WS_WIN + (size_t)ffn * SZ_WIN), M, 5632, 1024}; pg8::StaticOrder S; S.init(M, 5632, G, c, 1024); pg8::EpiSwiglu E{BIG};
            pg8::gemm_phase<pg8::EpiSwiglu, pg8::StaticOrder, true, true>(lds, g, S, E); } }
        else if (kind == K_RESID) { if (EN_GEMM & 2) { pg8::Gemm g{Aop, Wop, M, 1024, Kd}; pg8::SplitCtxOrder S; S.init(1024, G, c, Kd, M == MT ? 64 : 0); pg8::EpiResid E{bxp, bcp, Hx, Hc, (float*)(ws + WS_PC), modl + gi * 1024, coef};
            pg8::gemm_phase<pg8::EpiResid, pg8::SplitCtxOrder, true, true>(lds, g, S, E);
            const int cgrp = (rep == 0 && M == MT && Kd == 2816) ? (layer == 0 ? (lp == 2 ? 1 : 2) : 3) : 0;
            if (cgrp != 0 && c >= 64 && G > 64) convert_group(lds, cgrp, (c - 64) * 8, (G - 64) * 8); } }
        else if (kind == K_PLAIN) { if (EN_GEMM & 4) { pg8::Gemm g{A0, (const bf16_t*)(ws + WS_WEIN), MT, NEV, 1024}; pg8::StaticOrder S; S.init(MT, NEV, G, c, 1024); pg8::EpiPlain E{BIG, NEV};
            pg8::gemm_phase<pg8::EpiPlain, pg8::StaticOrder, true, true>(lds, g, S, E); } }
        else if (kind == K_QKV) { if (EN_GEMM & 8) { pg8::Gemm g{A0, (const bf16_t*)(ws + WS_WQKV), MT, NQKV, 1024}; pg8::StaticOrder S; S.init(MT, NQKV, G, c, 1024); pg8::EpiQKV E{BIG, (const float*)(ws + WS_ROPE)};
            pg8::gemm_phase<pg8::EpiQKV, pg8::StaticOrder, true, true>(lds, g, S, E); } }
        else if (kind == K_PREP) { if (EN_MLSTM && EN_PREP) qkprep_phase(lds, BIG, KA(mlstm_conv), (bf16_t*)(ws + WS_QC), (bf16_t*)(ws + WS_KC), (bf16_t*)(ws + WS_KCT)); if (EN_SGU) sgu_phase(lds, BIG, KA(sgu_norm), KA(sgu_ws), KA(sgu_b), A1); }
        else if (kind == K_MIX0) { if (EN_MLSTM) mlstm_phase(lds, BIG, gates, (const bf16_t*)(ws + WS_QC), (const bf16_t*)(ws + WS_KC), (const bf16_t*)(ws + WS_KCT), Hdir); }
        else if (kind == K_COMB) { if (EN_COMB) combine_phase(Hdir, BIG, KA(mlstm_norm), A1); }
        else if (kind == K_ATTN) { if (EN_ATTN) attn_phase(lds, BIG, KA(attn_sink), A1); }
        else { if (EN_FINAL) final_phase(Hx, KA(final_norm)); }
        }
        if (ph + 1 < hi) {
            if (ph == 0 && USE_CG_FIRST) {
                __syncthreads();
                if (threadIdx.x < 64) { __builtin_amdgcn_fence(__ATOMIC_RELEASE, "agent"); asm volatile("s_waitcnt vmcnt(0)" ::: "memory"); }
                grid.sync();
                if (threadIdx.x < 64) { __builtin_amdgcn_fence(__ATOMIC_ACQUIRE, "agent"); asm volatile("s_waitcnt vmcnt(0)" ::: "memory"); }
                __syncthreads();
            } else {
                for (int srep = 0; srep < NSYNC_REP; ++srep) xcd_barrier(bar);
            }
        }
    }
}

extern "C" void kernel_launch(void* const* d_in, const int* in_sizes, int n_in, void* d_out, int out_size, void* d_ws, size_t ws_size, hipStream_t stream) {
    static int grid = 0;
    if (grid == 0) {
        if (n_in != 20 || out_size != MX * D || ws_size < WS_END) { fprintf(stderr, "kernel_launch: unexpected problem (n_in %d out %d ws %zu need %zu)\n", n_in, out_size, ws_size, (size_t)WS_END); grid = -1; return; }
        int dev = 0, cus = 0, per_cu = 0;
        hipGetDevice(&dev);
        hipDeviceGetAttribute(&cus, hipDeviceAttributeMultiprocessorCount, dev);
        hipFuncSetAttribute((const void*)fwd_kernel, hipFuncAttributeMaxDynamicSharedMemorySize, LDS_BYTES);
        hipOccupancyMaxActiveBlocksPerMultiprocessor(&per_cu, (const void*)fwd_kernel, NTHREADS, LDS_BYTES);
        if (per_cu < 1) { fprintf(stderr, "kernel_launch: occupancy query says %d blocks per CU\n", per_cu); grid = -1; return; }
        grid = cus;
    }
    if (grid < 0) return;
    if (hipMemsetAsync((char*)d_ws + WS_CTL, 0, CTL_BYTES, stream) != hipSuccess) { fprintf(stderr, "kernel_launch: memset failed\n"); return; }
    Args a{};
#ifdef DBG_MEMSET
    hipMemsetAsync(d_ws, 0, WS_END, stream); hipMemsetAsync(d_out, 0, (size_t)out_size * 4, stream);
#endif
    a.x = (const float*)d_in[0]; a.c = (const float*)d_in[1]; a.ctx = (const float*)d_in[2]; a.c_ctx = (const float*)d_in[3]; a.ada_w = (const float*)d_in[4]; a.ada_b = (const float*)d_in[5];
    a.ffn_w_in = (const float*)d_in[6]; a.ffn_w_out = (const float*)d_in[7]; a.even_w_in = (const float*)d_in[8]; a.even_w_out = (const float*)d_in[9];
    a.mlstm_conv = (const float*)d_in[10]; a.mlstm_gate_b = (const float*)d_in[11]; a.mlstm_norm = (const float*)d_in[12]; a.sgu_norm = (const float*)d_in[13]; a.sgu_ws = (const float*)d_in[14]; a.sgu_b = (const float*)d_in[15];
    a.odd_w_qkv = (const float*)d_in[16]; a.odd_w_out = (const float*)d_in[17]; a.attn_sink = (const float*)d_in[18]; a.final_norm = (const float*)d_in[19];
    a.out = (float*)d_out; a.ws = (unsigned char*)d_ws;
#if MK_SINGLE
    a.ph_lo = 0; a.ph_hi = NPHASES;
    { void* args[] = {&a}; hipError_t e = hipLaunchCooperativeKernel((const void*)fwd_kernel, dim3(grid), dim3(NTHREADS), args, LDS_BYTES, stream);
      if (e != hipSuccess) fprintf(stderr, "cooperative launch failed: %s\n", hipGetErrorString(e)); }
#else
    for (int p = 0; p < NPHASES; ++p) { a.ph_lo = p; a.ph_hi = p + 1; void* args[] = {&a};
        hipError_t e = hipLaunchCooperativeKernel((const void*)fwd_kernel, dim3(grid), dim3(NTHREADS), args, LDS_BYTES, stream);
        if (e != hipSuccess) { fprintf(stderr, "launch %d failed: %s\n", p, hipGetErrorString(e)); break; } }
#endif
}
```

```cpp
#include <hip/hip_runtime.h>
#include <hip/hip_cooperative_groups.h>
#include <cstdio>
#include <cstdint>
namespace cg = cooperative_groups;
namespace pg8 {
#define PG8_LAS __attribute__((address_space(3)))
typedef unsigned short bf16_t;
typedef short bf16x8 __attribute__((ext_vector_type(8)));
typedef float f32x4 __attribute__((ext_vector_type(4)));
typedef unsigned u32x4 __attribute__((ext_vector_type(4)));
constexpr int BM = 256, BK = 64, HALF = 128, HTB = HALF * BK * 2  , STAGE_BYTES = 8 * HTB, NXCD = 8, WGM = 8;

__host__ __device__ __forceinline__ int lds_byte(int r, int c) { const int st = (r >> 4) * 2 + (c >> 5), rr = r & 15, cc = c & 31, ob = rr * 64 + cc * 2; return st * 1024 + (ob ^ (((ob >> 9) & 1) << 5)); }
__host__ __device__ __forceinline__ void stage_rc(int b, int& R, int& C) { const int st = b / 1024, sb = b % 1024, swz = sb ^ (((sb >> 9) & 1) << 5); R = (st >> 1) * 16 + swz / 64; C = (st & 1) * 32 + (swz % 64) / 2; }
__host__ __device__ __forceinline__ int perm32(int rho) { const int n = rho >> 4, i = rho & 15; return 8 * (i >> 2) + 4 * n + (i & 3); }

struct Unit { int pm, pn, k0, nt; };
struct Gemm { const bf16_t* A; const bf16_t* Bt; int M, N, K; };

struct StaticOrder {
    int nM, nN, nwg, G, c, ntf;
    __host__ __device__ void init(int M, int N, int G_, int c_, int K_) { nM = M / BM; nN = N / BM; nwg = nM * nN; G = G_; c = c_; ntf = K_ / BK; }
    __host__ __device__ __forceinline__ bool next(int i, Unit& u) const {
        const long L = (long)i * G + c; if (L >= nwg) return false;
        int wgid = (int)L; { const int q = nwg / NXCD, r = nwg % NXCD, xcd = wgid % NXCD, off = wgid / NXCD; wgid = (xcd < r ? xcd * (q + 1) : r * (q + 1) + (xcd - r) * q) + off; }
        const int nig = WGM * nN, gid = wgid / nig, fm = gid * WGM, gsz = (nM - fm) < WGM ? (nM - fm) : WGM;
        u.pm = fm + ((wgid % nig) % gsz); u.pn = (wgid % nig) / gsz; u.k0 = 0; u.nt = ntf; return true;
    }
    __device__ __forceinline__ void a_ready(const Unit&) const {}
    __device__ __forceinline__ void done(const Unit&) const {}
};

struct SplitCtxOrder {
    int nN, G, c, ntf, nctx;
    __host__ __device__ void init(int N, int G_, int c_, int K_, int nctx_) { nN = N / BM; G = G_; c = c_; ntf = K_ / BK; nctx = nctx_; }
    __host__ __device__ __forceinline__ bool next(int i, Unit& u) const {
        const int L = i * G + c, nwg = 64 * nN;
        if (L >= nwg + nctx) return false;
        int wgid = L < nwg ? L : 0; { const int q = nwg / NXCD, xcd = wgid % NXCD, off = wgid / NXCD; wgid = xcd * q + off; }
        const int nig = WGM * nN, gid = wgid / nig, fm = gid * WGM;
        const int pm0 = fm + ((wgid % nig) % WGM), pn0 = (wgid % nig) / WGM;
        const int L2 = L - nwg, tt = L2 >> 1;
        const bool ctxu = L >= nwg;
        Unit r;
        r.pm = ctxu ? 64 + tt / nN : pm0; r.pn = ctxu ? tt % nN : pn0; r.nt = ctxu ? ntf / 2 : ntf; r.k0 = ctxu ? (L2 & 1) * (ntf / 2) * BK : 0;
        u = r; return true;
    }
    __device__ __forceinline__ void a_ready(const Unit&) const {}
    __device__ __forceinline__ void done(const Unit&) const {}
};

__device__ __forceinline__ unsigned cvt_pk_bf16(float lo, float hi) { unsigned r; asm volatile("v_cvt_pk_bf16_f32 %0, %1, %2" : "=v"(r) : "v"(lo), "v"(hi)); return r; }
typedef float f32x2 __attribute__((ext_vector_type(2)));
template <class Epi, class Sched, bool ALIGN_EPI = false, bool SP2 = false>
__device__ __forceinline__ void gemm_phase(PG8_LAS unsigned char* lds, const Gemm g, const Sched& S, const Epi& E) {
    int tid_ = threadIdx.x; asm volatile("" : "+v"(tid_)); const int tid = tid_, wid = __builtin_amdgcn_readfirstlane(tid >> 6), lane = tid & 63, wr = wid >> 2, wc = wid & 3, fr = lane & 15, fq = lane >> 4;
    const int K = g.K;
    unsigned voffA[2], voffB[2];
#pragma unroll
    for (int i = 0; i < 2; ++i) { int R, C; stage_rc(tid * 16 + i * 8192, R, C); const int Rb = Epi::PERM ? ((R & ~31) + perm32(R & 31)) : R;
        voffA[i] = (unsigned)(R * K + C) * 2u; voffB[i] = (unsigned)(Rb * K + C) * 2u; }
    const size_t kstep = (size_t)(BK * 2);
    const size_t hstep = (size_t)HALF * K * 2;
    const size_t tstep = 2 * hstep;
    const unsigned ldsw = (unsigned)wid * 1024u;
    const int aoff = lds_byte(wr * 64 + fr, fq * 8), boff = lds_byte(wc * 32 + fr, fq * 8);
#define PG8_SA(b, h) (((b) * 2 + (h)) * HTB)
#define PG8_SB(b, h) ((4 + (b) * 2 + (h)) * HTB)
#define PG8_STAGE(bufoff, gbase, voff) do { _Pragma("unroll") for (int _i = 0; _i < 2; ++_i) \
        __builtin_amdgcn_global_load_lds((const unsigned*)((const char*)(gbase) + (voff)[_i]), (PG8_LAS unsigned*)(lds + (bufoff) + ldsw + _i * 8192), 16, 0, 0); } while (0)
#define PG8_LDA(dst, b, h) do { _Pragma("unroll") for (int m = 0; m < 4; ++m) _Pragma("unroll") for (int k = 0; k < 2; ++k) dst[m][k] = *(const PG8_LAS bf16x8*)(lds + PG8_SA(b, h) + aoff + m * 2048 + k * 1024); } while (0)
#define PG8_LDB(dst, b, h) do { _Pragma("unroll") for (int n = 0; n < 2; ++n) _Pragma("unroll") for (int k = 0; k < 2; ++k) dst[n][k] = *(const PG8_LAS bf16x8*)(lds + PG8_SB(b, h) + boff + n * 2048 + k * 1024); } while (0)
#define PG8_MMA(ai, bj, At, Bt) do { __builtin_amdgcn_s_setprio(1); _Pragma("unroll") for (int m = 0; m < 4; ++m) _Pragma("unroll") for (int n = 0; n < 2; ++n) _Pragma("unroll") for (int k = 0; k < 2; ++k) \
        acc[ai][bj][m][n] = __builtin_amdgcn_mfma_f32_16x16x32_bf16(Bt[n][k], At[m][k], acc[ai][bj][m][n], 0, 0, 0); __builtin_amdgcn_s_setprio(0); } while (0)
#define PG8_WAIT_V(n) asm volatile("s_waitcnt vmcnt(" #n ")" ::: "memory")
#define PG8_WAIT_L(n) asm volatile("s_waitcnt lgkmcnt(" #n ")" ::: "memory")
#define PG8_BAR __builtin_amdgcn_s_barrier()
#define PG8_SCHED __builtin_amdgcn_sched_barrier(0)
    Unit cur, nxt; int ui = 0;
    if (!S.next(0, cur)) return;
    f32x4 acc[2][2][4][2];
#pragma unroll
    for (int a = 0; a < 2; ++a)
#pragma unroll
        for (int b = 0; b < 2; ++b)
#pragma unroll
            for (int m = 0; m < 4; ++m)
#pragma unroll
                for (int n = 0; n < 2; ++n) acc[a][b][m][n] = (f32x4){0.f, 0.f, 0.f, 0.f};
    bf16x8 At[4][2], B0[2][2], B1[2][2];
    const char* cA = (const char*)g.A + (size_t)cur.pm * tstep + (size_t)cur.k0 * 2; const char* cB = (const char*)g.Bt + (size_t)cur.pn * tstep + (size_t)cur.k0 * 2;
    S.a_ready(cur);
    if constexpr (SP2) {
        PG8_STAGE(PG8_SB(0, 0), cB, voffB); PG8_STAGE(PG8_SB(0, 1), cB + hstep, voffB); PG8_STAGE(PG8_SA(0, 0), cA, voffA); PG8_STAGE(PG8_SA(0, 1), cA + hstep, voffA);
        if (wr == 1) PG8_BAR;
        PG8_WAIT_V(2); PG8_BAR;
        PG8_STAGE(PG8_SB(1, 0), cB + kstep, voffB); PG8_STAGE(PG8_SA(1, 0), cA + kstep, voffA); PG8_STAGE(PG8_SB(1, 1), cB + hstep + kstep, voffB);
        PG8_WAIT_V(6); PG8_BAR;
    } else {
        PG8_STAGE(PG8_SB(0, 0), cB, voffB); PG8_STAGE(PG8_SA(0, 0), cA, voffA); PG8_STAGE(PG8_SB(0, 1), cB + hstep, voffB); PG8_STAGE(PG8_SA(0, 1), cA + hstep, voffA);
        if (wr == 1) PG8_BAR;
        PG8_WAIT_V(4); PG8_BAR;
        PG8_STAGE(PG8_SB(1, 0), cB + kstep, voffB); PG8_STAGE(PG8_SA(1, 0), cA + kstep, voffA); PG8_STAGE(PG8_SB(1, 1), cB + hstep + kstep, voffB);
        PG8_WAIT_V(6); PG8_BAR;
    }
    for (;;) {
        const bool has_next = S.next(ui + 1, nxt);
        const char* nA = has_next ? (const char*)g.A + (size_t)nxt.pm * tstep + (size_t)nxt.k0 * 2 : cA; const char* nB = has_next ? (const char*)g.Bt + (size_t)nxt.pn * tstep + (size_t)nxt.k0 * 2 : cB;
        const int nt = cur.nt;
        for (int t = 0; t < nt; t += 2) {
            const bool last = (t == nt - 2);
            const char* a1 = cA + (size_t)(t + 1) * kstep;
            const char* a2 = last ? nA : cA + (size_t)(t + 2) * kstep; const char* b2 = last ? nB : cB + (size_t)(t + 2) * kstep;
            const char* a3 = a2 + kstep; const char* b3 = b2 + kstep;
            if (last && has_next) S.a_ready(nxt);
            if constexpr (SP2) {
            PG8_LDB(B0, 0, 0); PG8_LDB(B1, 0, 1); PG8_SCHED; PG8_LDA(At, 0, 0); PG8_STAGE(PG8_SA(1, 1), a1 + hstep, voffA);
            PG8_WAIT_V(8); PG8_WAIT_L(0); PG8_BAR; PG8_MMA(0, 0, At, B0); PG8_MMA(0, 1, At, B1); PG8_BAR; PG8_SCHED;
            PG8_LDA(At, 0, 1); PG8_STAGE(PG8_SB(0, 0), b2, voffB); PG8_STAGE(PG8_SB(0, 1), b2 + hstep, voffB); PG8_STAGE(PG8_SA(0, 0), a2, voffA);
            PG8_WAIT_V(8); PG8_WAIT_L(0); PG8_BAR; PG8_MMA(1, 0, At, B0); PG8_MMA(1, 1, At, B1); PG8_BAR; PG8_SCHED;
            PG8_LDB(B0, 1, 0); PG8_LDB(B1, 1, 1); PG8_SCHED; PG8_LDA(At, 1, 0); PG8_STAGE(PG8_SA(0, 1), a2 + hstep, voffA);
            PG8_WAIT_V(8); PG8_WAIT_L(0); PG8_BAR; PG8_MMA(0, 0, At, B0); PG8_MMA(0, 1, At, B1); PG8_BAR; PG8_SCHED;
            PG8_LDA(At, 1, 1); PG8_STAGE(PG8_SB(1, 0), b3, voffB); PG8_STAGE(PG8_SB(1, 1), b3 + hstep, voffB); PG8_STAGE(PG8_SA(1, 0), a3, voffA);
            PG8_WAIT_V(8); PG8_WAIT_L(0); PG8_BAR; PG8_MMA(1, 0, At, B0); PG8_MMA(1, 1, At, B1); PG8_BAR; PG8_SCHED;
            } else {
            PG8_LDB(B0, 0, 0); PG8_SCHED; PG8_LDA(At, 0, 0); PG8_STAGE(PG8_SA(1, 1), a1 + hstep, voffA);
            PG8_WAIT_L(8); PG8_BAR; PG8_WAIT_L(0); PG8_MMA(0, 0, At, B0); PG8_BAR; PG8_SCHED;
            PG8_LDB(B1, 0, 1); PG8_STAGE(PG8_SB(0, 0), b2, voffB);
            PG8_BAR; PG8_WAIT_L(0); PG8_MMA(0, 1, At, B1); PG8_BAR;
            PG8_LDA(At, 0, 1); PG8_STAGE(PG8_SA(0, 0), a2, voffA);
            PG8_BAR; PG8_WAIT_L(0); PG8_MMA(1, 0, At, B0); PG8_BAR; PG8_SCHED;
            PG8_STAGE(PG8_SB(0, 1), b2 + hstep, voffB);
            PG8_WAIT_V(6); PG8_BAR; PG8_MMA(1, 1, At, B1); PG8_BAR;
            PG8_LDB(B0, 1, 0); PG8_SCHED; PG8_LDA(At, 1, 0); PG8_STAGE(PG8_SA(0, 1), a2 + hstep, voffA);
            PG8_WAIT_L(8); PG8_BAR; PG8_WAIT_L(0); PG8_MMA(0, 0, At, B0); PG8_BAR; PG8_SCHED;
            PG8_LDB(B1, 1, 1); PG8_STAGE(PG8_SB(1, 0), b3, voffB);
            PG8_BAR; PG8_WAIT_L(0); PG8_MMA(0, 1, At, B1); PG8_BAR;
            PG8_LDA(At, 1, 1); PG8_STAGE(PG8_SA(1, 0), a3, voffA);
            PG8_BAR; PG8_WAIT_L(0); PG8_MMA(1, 0, At, B0); PG8_BAR; PG8_SCHED;
            PG8_STAGE(PG8_SB(1, 1), b3 + hstep, voffB);
            PG8_WAIT_V(6); PG8_BAR; PG8_MMA(1, 1, At, B1); PG8_BAR;
            }
        }
        if constexpr (ALIGN_EPI) { if (wr == 0) PG8_BAR; }
        if constexpr (!Epi::AFTER_DRAIN) { E(acc, cur, wr, wc, fr, fq); S.done(cur); }
        if (!has_next) break;
#pragma unroll
        for (int a = 0; a < 2; ++a)
#pragma unroll
            for (int b = 0; b < 2; ++b)
#pragma unroll
                for (int m = 0; m < 4; ++m)
#pragma unroll
                    for (int n = 0; n < 2; ++n) acc[a][b][m][n] = (f32x4){0.f, 0.f, 0.f, 0.f};
        cur = nxt; cA = nA; cB = nB; ++ui;
        if constexpr (ALIGN_EPI) { if (wr == 1) PG8_BAR; }
    }
    PG8_WAIT_V(0);
    if constexpr (!ALIGN_EPI) { if (wr == 0) PG8_BAR; }
    PG8_BAR;
    if constexpr (Epi::AFTER_DRAIN) { E.fused(acc, cur, wr, wc, fr, fq, lds, wid, lane); S.done(cur); }
#undef PG8_SA
#undef PG8_SB
#undef PG8_STAGE
#undef PG8_LDA
#undef PG8_LDB
#undef PG8_MMA
#undef PG8_WAIT_V
#undef PG8_WAIT_L
#undef PG8_BAR
#undef PG8_SCHED
}
}
#define LAS __attribute__((address_space(3)))
typedef unsigned short bf16_t;
typedef short bf16x8 __attribute__((ext_vector_type(8)));
typedef float f32x4 __attribute__((ext_vector_type(4)));
typedef float f32x2 __attribute__((ext_vector_type(2)));
typedef unsigned u32x4 __attribute__((ext_vector_type(4)));
typedef unsigned u32x2 __attribute__((ext_vector_type(2)));

constexpr int D = 1024, NB = 8, SEQ = 2048, CTXL = 256, DFF = 2816;
constexpr int MX = NB * SEQ;
constexpr int MC = NB * CTXL;
constexpr int MT = MX + MC;
constexpr int NMOD = 9;
constexpr int NEV = 3072;
constexpr int NQKV = 1536;
constexpr float EPS = 1e-6f;
constexpr int LDS_BYTES = 147456;
constexpr int NTHREADS = 512;

constexpr size_t MiB = 1u << 20;
constexpr size_t SZ_WIN = (size_t)5632 * 1024 * 2, SZ_WOUT = (size_t)1024 * 2816 * 2;
constexpr size_t WS_WIN = 0;
constexpr size_t WS_WOUT = WS_WIN + 4 * SZ_WIN;
constexpr size_t WS_WEIN = WS_WOUT + 4 * SZ_WOUT;
constexpr size_t WS_WEOUT = WS_WEIN + (size_t)3072 * 1024 * 2;
constexpr size_t WS_WQKV = WS_WEOUT + (size_t)1024 * 1024 * 2;
constexpr size_t WS_WOOUT = WS_WQKV + (size_t)1536 * 1024 * 2;
constexpr size_t WS_MOD = WS_WOOUT + (size_t)1024 * 1024 * 2;
constexpr size_t WS_WG = WS_MOD + (size_t)2 * 9 * 9216 * 4;
constexpr size_t WS_ROPE = WS_WG + (size_t)16 * 1024 * 4;
constexpr size_t WS_GATES = WS_ROPE + 8192;
constexpr size_t WS_HC = WS_GATES + (size_t)MT * 16 * 4;
constexpr size_t WS_A0 = ((WS_HC + (size_t)MC * D * 4 + 255) / 256) * 256;
constexpr size_t WS_QC = WS_A0 + (size_t)MT * D * 2;
constexpr size_t WS_KC = WS_QC + (size_t)MT * 512 * 2;
constexpr size_t WS_KCT = WS_KC + (size_t)MT * 512 * 2;
constexpr size_t WS_A1 = WS_KCT + (size_t)576 * 128 * 128 * 2;
constexpr size_t WS_BIG = WS_A1 + (size_t)MT * D * 2;
constexpr size_t WS_CTL = WS_BIG + (size_t)MT * 3072 * 2;
constexpr size_t CTL_BYTES = 16384;
constexpr size_t WS_PC = WS_CTL + CTL_BYTES;
constexpr size_t WS_END = WS_PC + (size_t)MC * D * 4;

struct Args {
    const float* x; const float* c; const float* ctx; const float* c_ctx; const float* ada_w; const float* ada_b;
    const float* ffn_w_in; const float* ffn_w_out; const float* even_w_in; const float* even_w_out;
    const float* mlstm_conv; const float* mlstm_gate_b; const float* mlstm_norm; const float* sgu_norm; const float* sgu_ws; const float* sgu_b;
    const float* odd_w_qkv; const float* odd_w_out; const float* attn_sink; const float* final_norm;
    float* out; unsigned char* ws; int ph_lo, ph_hi;
};

typedef const __attribute__((address_space(4))) Args* kargp;
__device__ __forceinline__ kargp kargs() { kargp p = (kargp)__builtin_amdgcn_kernarg_segment_ptr(); asm volatile("" : "+s"(p)); return p; }
#define KA(f) (kargs()->f)
typedef __bf16 bf16x2_t __attribute__((ext_vector_type(2)));
__device__ __forceinline__ unsigned pk2(float lo, float hi) { f32x2 v = {lo, hi}; bf16x2_t b = __builtin_convertvector(v, bf16x2_t); return __builtin_bit_cast(unsigned, b); }
__device__ __forceinline__ bf16_t f2bf(float f) { return (bf16_t)(pk2(f, 0.f) & 0xffffu); }
__device__ __forceinline__ float bf2f(bf16_t v) { return __uint_as_float(((unsigned)v) << 16); }
__device__ __forceinline__ float bflo(unsigned w) { return __uint_as_float(w << 16); }
__device__ __forceinline__ float bfhi(unsigned w) { return __uint_as_float(w & 0xffff0000u); }
__device__ __forceinline__ float silu_f(float v) { return v * __builtin_amdgcn_rcpf(1.f + __expf(-v)); }
__device__ __forceinline__ float sigmoid_f(float v) { return __builtin_amdgcn_rcpf(1.f + __expf(-v)); }
__device__ __forceinline__ float gelu_tanh(float v) {
    const float z = 0.7978845608028654f * (v + 0.044715f * v * v * v);
    const float t = 1.f - 2.f * __builtin_amdgcn_rcpf(1.f + __expf(2.f * z));
    return 0.5f * v * (1.f + t);
}
template <int CTRL> __device__ __forceinline__ float dppf(float v) { return __builtin_bit_cast(float, __builtin_amdgcn_update_dpp(0, __builtin_bit_cast(int, v), CTRL, 0xf, 0xf, false)); }
__device__ __forceinline__ float row16_sum(float v) { v += dppf<0xB1>(v); v += dppf<0x4E>(v); v += dppf<0x141>(v); v += dppf<0x140>(v); return v; }
__device__ __forceinline__ float row16_max(float v) { v = fmaxf(v, dppf<0xB1>(v)); v = fmaxf(v, dppf<0x4E>(v)); v = fmaxf(v, dppf<0x141>(v)); v = fmaxf(v, dppf<0x140>(v)); return v; }
__device__ __forceinline__ float wave_sum(float v) { v = row16_sum(v); v += __shfl_xor(v, 16); v += __shfl_xor(v, 32); return v; }
__device__ __forceinline__ float wave_max(float v) { v = row16_max(v); v = fmaxf(v, __shfl_xor(v, 16)); v = fmaxf(v, __shfl_xor(v, 32)); return v; }
__device__ __forceinline__ f32x4 mfma16(bf16x8 a, bf16x8 b, f32x4 c) { return __builtin_amdgcn_mfma_f32_16x16x32_bf16(a, b, c, 0, 0, 0); }
__device__ __forceinline__ bf16x8 ldsfrag(const LAS unsigned char* p) { return *(const LAS bf16x8*)p; }

namespace pg8 {
struct EpiSwiglu {
    static constexpr bool PERM = true, AFTER_DRAIN = false;
    bf16_t* O;
    __device__ __forceinline__ void operator()(const f32x4 (&acc)[2][2][4][2], const Unit& u, int wr, int wc, int fr, int fq) const {
        const int row0 = u.pm * BM + wr * 64 + fr, col0 = u.pn * 128 + wc * 32 + 8 * fq;
#pragma unroll
        for (int ai = 0; ai < 2; ++ai)
#pragma unroll
            for (int m = 0; m < 4; ++m) {
                bf16_t* rowp = O + (size_t)(row0 + ai * HALF + m * 16) * DFF + col0;
                const f32x4 g0 = acc[ai][0][m][0], g1 = acc[ai][0][m][1], u0 = acc[ai][1][m][0], u1 = acc[ai][1][m][1];
                u32x4 w;
                w.x = ::pk2(::silu_f(g0[0]) * u0[0], ::silu_f(g0[1]) * u0[1]); w.y = ::pk2(::silu_f(g0[2]) * u0[2], ::silu_f(g0[3]) * u0[3]);
                w.z = ::pk2(::silu_f(g1[0]) * u1[0], ::silu_f(g1[1]) * u1[1]); w.w = ::pk2(::silu_f(g1[2]) * u1[2], ::silu_f(g1[3]) * u1[3]);
                *(u32x4*)rowp = w;
            }
    }
};
struct EpiResid {
    static constexpr bool PERM = false, AFTER_DRAIN = false;
    const float* bx; const float* bc; float* ox; float* oc; float* pc; const float* gate;
    float coef;
    __device__ __forceinline__ void operator()(const f32x4 (&acc)[2][2][4][2], const Unit& u, int wr, int wc, int fr, int fq) const {
        const bool isx = u.pm < 64; const bool split = u.k0 != 0;
        const int bi = isx ? (u.pm >> 3) : 8;
        const float* base = isx ? bx : bc - (size_t)MX * D;
        float* outp = isx ? ox : oc - (size_t)MX * D;
        const int row0 = u.pm * BM + wr * 64 + fr, col0 = u.pn * BM + wc * 32 + 4 * fq;
        const float* gp = gate + (size_t)bi * 9216 + col0;
#pragma unroll
        for (int bj = 0; bj < 2; ++bj)
#pragma unroll
            for (int n = 0; n < 2; ++n) {
                const f32x4 gv = *(const f32x4*)(gp + bj * HALF + n * 16) * coef;
#pragma unroll
                for (int ai = 0; ai < 2; ++ai)
#pragma unroll
                    for (int m = 0; m < 4; ++m) {
                        const size_t off = (size_t)(row0 + ai * HALF + m * 16) * D + col0 + bj * HALF + n * 16;
                        const f32x4 pv = gv * acc[ai][bj][m][n];
                        if (split) {
                            *(f32x4*)(pc + off - (size_t)MX * D) = pv;
                        } else {
                            const f32x4 b = *(const f32x4*)(base + off);
                            *(f32x4*)(outp + off) = b + pv;
                        }
                        if (m & 1) asm volatile("" ::: "memory");
                    }
            }
    }
};
struct EpiPlain {
    static constexpr bool PERM = true, AFTER_DRAIN = false;
    bf16_t* O; int ldc;
    __device__ __forceinline__ void operator()(const f32x4 (&acc)[2][2][4][2], const Unit& u, int wr, int wc, int fr, int fq) const {
        const int row0 = u.pm * BM + wr * 64 + fr, col0 = u.pn * BM + wc * 32 + 8 * fq;
#pragma unroll
        for (int ai = 0; ai < 2; ++ai)
#pragma unroll
            for (int m = 0; m < 4; ++m) {
                bf16_t* rowp = O + (size_t)(row0 + ai * HALF + m * 16) * ldc + col0;
#pragma unroll
                for (int bj = 0; bj < 2; ++bj) {
                    const f32x4 v0 = acc[ai][bj][m][0], v1 = acc[ai][bj][m][1];
                    u32x4 w; w.x = ::pk2(v0[0], v0[1]); w.y = ::pk2(v0[2], v0[3]); w.z = ::pk2(v1[0], v1[1]); w.w = ::pk2(v1[2], v1[3]);
                    *(u32x4*)(rowp + bj * HALF) = w;
                }
            }
    }
};
struct EpiQKV {
    static constexpr bool PERM = true, AFTER_DRAIN = false;
    bf16_t* O; const float* rope;
    __device__ __forceinline__ void operator()(const f32x4 (&acc)[2][2][4][2], const Unit& u, int wr, int wc, int fr, int fq) const {
        const int row0 = u.pm * BM + wr * 64 + fr;
        const bool isx = u.pm < 64;
#pragma unroll
        for (int bj = 0; bj < 2; ++bj) {
            const int col0 = u.pn * BM + bj * HALF + wc * 32 + 8 * fq;
            const bool dorope = isx && (col0 < 1280);
            const float qs = (col0 < 1024) ? 0.125f : 1.f;
            const int p0 = (col0 & 63) >> 1;
            const int f0 = p0 & 15;
#pragma unroll
            for (int ai = 0; ai < 2; ++ai)
#pragma unroll
                for (int m = 0; m < 4; ++m) {
                    const int row = row0 + ai * HALF + m * 16;
                    f32x4 v0 = acc[ai][bj][m][0] * qs, v1 = acc[ai][bj][m][1] * qs;
                    if (dorope) {
                        const int t = row & 2047;
                        const int pos = (p0 < 16) ? (t >> 6) : (t & 63);
                        const f32x4 cs0 = *(const f32x4*)(rope + (pos * 16 + f0) * 2), cs1 = *(const f32x4*)(rope + (pos * 16 + f0) * 2 + 4);
                        f32x4 r0, r1;
                        r0[0] = v0[0] * cs0[0] - v0[1] * cs0[1]; r0[1] = v0[0] * cs0[1] + v0[1] * cs0[0];
                        r0[2] = v0[2] * cs0[2] - v0[3] * cs0[3]; r0[3] = v0[2] * cs0[3] + v0[3] * cs0[2];
                        r1[0] = v1[0] * cs1[0] - v1[1] * cs1[1]; r1[1] = v1[0] * cs1[1] + v1[1] * cs1[0];
                        r1[2] = v1[2] * cs1[2] - v1[3] * cs1[3]; r1[3] = v1[2] * cs1[3] + v1[3] * cs1[2];
                        v0 = r0; v1 = r1;
                    }
                    u32x4 w; w.x = ::pk2(v0[0], v0[1]); w.y = ::pk2(v0[2], v0[3]); w.z = ::pk2(v1[0], v1[1]); w.w = ::pk2(v1[2], v1[3]);
                    *(u32x4*)(O + (size_t)row * NQKV + col0) = w;
                }
        }
    }
};
}

__device__ __forceinline__ void tr_item(const float* W, int ldw, int k0, int srccol0, bf16_t* WT, int K, int destrow0, LAS float* scr, int lane) {
#pragma unroll 8
    for (int i = 0; i < 32; ++i) { const int kk = 2 * i + (lane >> 5); scr[kk * 33 + (lane & 31)] = W[(size_t)(k0 + kk) * ldw + srccol0 + (lane & 31)]; }
    asm volatile("s_waitcnt lgkmcnt(0)" ::: "memory");
    const int c = lane & 7;
#pragma unroll
    for (int j = 0; j < 4; ++j) { const int n = (lane >> 3) + 8 * j; const LAS float* s = scr + (8 * c) * 33 + n;
        u32x4 o; o.x = pk2(s[0 * 33], s[1 * 33]); o.y = pk2(s[2 * 33], s[3 * 33]); o.z = pk2(s[4 * 33], s[5 * 33]); o.w = pk2(s[6 * 33], s[7 * 33]);
        *(u32x4*)(WT + (size_t)(destrow0 + n) * K + k0 + 8 * c) = o; }
    asm volatile("s_waitcnt lgkmcnt(0)" ::: "memory");
}

__device__ __forceinline__ void convert_group(LAS unsigned char* lds, int grp, int worker, int nworkers) {
    int tid_ = threadIdx.x; asm volatile("" : "+v"(tid_)); const int tid = tid_, lane = tid & 63, wid = __builtin_amdgcn_readfirstlane(tid >> 6);
    unsigned char* ws = KA(ws);
    LAS float* scr = (LAS float*)(lds + wid * 16384);
    constexpr int I_IN = 16 * 176, I_OUT = 44 * 32, I_EIN = 16 * 96, I_SQ = 16 * 32, I_QKV = 16 * 48;
    const int n2 = grp == 1 ? I_EIN : (grp == 2 ? I_QKV : 0), n3 = (grp == 1 || grp == 2) ? I_SQ : 0;
    const int total = I_IN + I_OUT + n2 + n3;
    for (int it = worker + wid; it < total; it += nworkers) {
        int r = it;
        if (r < I_IN) { const int kb = r / 176, nb = r % 176; const int n0 = nb * 32;
            const int dest = (n0 < 2816) ? ((n0 >> 7) * 256 + (n0 & 127)) : ((((n0 - 2816) >> 7) * 256) + 128 + ((n0 - 2816) & 127));
            tr_item(KA(ffn_w_in) + (size_t)grp * 1024 * 5632, 5632, kb * 64, n0, (bf16_t*)(ws + WS_WIN + grp * SZ_WIN), 1024, dest, scr, lane); continue; }
        r -= I_IN;
        if (r < I_OUT) { const int kb = r / 32, nb = r % 32;
            tr_item(KA(ffn_w_out) + (size_t)grp * 2816 * 1024, 1024, kb * 64, nb * 32, (bf16_t*)(ws + WS_WOUT + grp * SZ_WOUT), 2816, nb * 32, scr, lane); continue; }
        r -= I_OUT;
        if (r < n2) {
            if (grp == 1) { const int kb = r / 96, nb = r % 96; const int src = nb < 64 ? nb * 32 : 2064 + (nb - 64) * 32;
                tr_item(KA(even_w_in), 3088, kb * 64, src, (bf16_t*)(ws + WS_WEIN), 1024, nb * 32, scr, lane); }
            else { const int kb = r / 48, nb = r % 48; tr_item(KA(odd_w_qkv), 1536, kb * 64, nb * 32, (bf16_t*)(ws + WS_WQKV), 1024, nb * 32, scr, lane); }
            continue; }
        r -= n2;
        { const int kb = r / 32, nb = r % 32;
          if (grp == 1) tr_item(KA(even_w_out), 1024, kb * 64, nb * 32, (bf16_t*)(ws + WS_WEOUT), 1024, nb * 32, scr, lane);
          else tr_item(KA(odd_w_out), 1024, kb * 64, nb * 32, (bf16_t*)(ws + WS_WOOUT), 1024, nb * 32, scr, lane); }
    }
}

__device__ __forceinline__ void p0_phase(LAS unsigned char* lds) {
    int tid_ = threadIdx.x; asm volatile("" : "+v"(tid_)); const int tid = tid_, lane = tid & 63, wid = __builtin_amdgcn_readfirstlane(tid >> 6), G = gridDim.x;
    unsigned char* ws = KA(ws);
    {
        LAS float* s = (LAS float*)lds;
        LAS float* red = (LAS float*)(lds + 36864);
        for (int i = tid; i < 9 * 1024; i += NTHREADS) { const float v = (i < 8192) ? KA(c)[i] : KA(c_ctx)[i - 8192]; s[i] = v / (1.f + expf(-v)); }
        __syncthreads();
        float* mod = (float*)(ws + WS_MOD);
        for (int tile = blockIdx.x; tile < 288; tile += G) {
            const int l = tile / 144, cg = tile % 144, n = cg * 64 + lane, kg = wid;
            float acc[9];
#pragma unroll
            for (int bi = 0; bi < 9; ++bi) acc[bi] = 0.f;
            const float* wp = KA(ada_w) + ((size_t)l * 1024 + kg * 128) * 9216 + n;
#pragma unroll 4
            for (int kk = 0; kk < 128; ++kk) {
                const float w = wp[(size_t)kk * 9216];
#pragma unroll
                for (int bi = 0; bi < 9; ++bi) acc[bi] += s[bi * 1024 + kg * 128 + kk] * w;
            }
#pragma unroll
            for (int bi = 0; bi < 9; ++bi) red[(kg * 9 + bi) * 64 + lane] = acc[bi];
            __syncthreads();
            for (int i = tid; i < 576; i += NTHREADS) {
                const int bi = i >> 6, cc = i & 63; float sum = 0.f;
#pragma unroll
                for (int k2 = 0; k2 < 8; ++k2) sum += red[(k2 * 9 + bi) * 64 + cc];
                mod[((size_t)l * 9 + bi) * 9216 + cg * 64 + cc] = sum + KA(ada_b)[l * 9216 + cg * 64 + cc];
            }
            __syncthreads();
        }
    }
    {
        const int gt = blockIdx.x * NTHREADS + tid, GT = G * NTHREADS;
        float* wg = (float*)(ws + WS_WG);
        for (int i = gt; i < 16 * 1024; i += GT) { const int g = i >> 10, k = i & 1023; wg[i] = KA(even_w_in)[(size_t)k * 3088 + 2048 + g]; }
        float* rope = (float*)(ws + WS_ROPE);
        for (int i = gt; i < 64 * 16; i += GT) { const int pos = i >> 4, f = i & 15; const float inv = powf(10000.f, -(float)f / 16.f); const float ang = (float)pos * inv; rope[2 * i] = cosf(ang); rope[2 * i + 1] = sinf(ang); }
    }
    convert_group(lds, 0, blockIdx.x * 8, G * 8);
}

template <bool GATES>
__device__ __forceinline__ void norm_phase(LAS unsigned char* lds, const float* hx, const float* hc, bf16_t* A0, const float* modl, int shift_i, int scale_i, int nrows,
                                           const float* wg, const float* gate_b, float* gates, float* copy_c) {
    int tid_ = threadIdx.x; asm volatile("" : "+v"(tid_)); const int tid = tid_, lane = tid & 63, wid = __builtin_amdgcn_readfirstlane(tid >> 6), G = gridDim.x;
    LAS float* wgs = (LAS float*)lds;
    if (GATES) { for (int i = tid; i < 16 * 1024 / 4; i += NTHREADS) ((LAS f32x4*)wgs)[i] = ((const f32x4*)wg)[i]; __syncthreads(); }
    const int R0 = blockIdx.x * 8 + wid, RS = G * 8;
    f32x4 vn[4], pn[4];
#define NORM_LOAD(R_) do { const bool isx_ = (R_) < MX; const float* src_ = isx_ ? hx + (size_t)(R_) * D : hc + (size_t)((R_) - MX) * D; \
        _Pragma("unroll") for (int j = 0; j < 4; ++j) { vn[j] = *(const f32x4*)(src_ + 256 * j + 4 * lane); \
            pn[j] = (copy_c && !isx_) ? *(const f32x4*)(copy_c + (size_t)((R_) - MX) * D + 256 * j + 4 * lane) : (f32x4){0.f, 0.f, 0.f, 0.f}; } } while (0)
    if (R0 < nrows) NORM_LOAD(R0);
    for (int R = R0; R < nrows; R += RS) {
        const bool isx = R < MX;
        const int bi = isx ? (R >> 11) : 8;
        const float* mb = modl + (size_t)bi * 9216;
        f32x4 v[4]; float ss = 0.f;
#pragma unroll
        for (int j = 0; j < 4; ++j) { v[j] = vn[j] + pn[j];
            if (copy_c && !isx) *(f32x4*)((float*)hc + (size_t)(R - MX) * D + 256 * j + 4 * lane) = v[j];
            ss += (v[j][0] * v[j][0] + v[j][1] * v[j][1]) + (v[j][2] * v[j][2] + v[j][3] * v[j][3]); }
        if (R + RS < nrows) NORM_LOAD(R + RS);
        const float rstd = 1.0f / sqrtf(wave_sum(ss) * (1.f / D) + EPS);
#pragma unroll
        for (int j = 0; j < 4; ++j) {
            const f32x4 sc = *(const f32x4*)(mb + scale_i * 1024 + 256 * j + 4 * lane), sh = *(const f32x4*)(mb + shift_i * 1024 + 256 * j + 4 * lane);
            v[j] = v[j] * rstd * (sc + 1.f) + sh;
            u32x2 w; w.x = pk2(v[j][0], v[j][1]); w.y = pk2(v[j][2], v[j][3]);
            *(u32x2*)(A0 + (size_t)R * D + 256 * j + 4 * lane) = w;
        }
        if (GATES) {
            float mine = 0.f;
#pragma unroll 1
            for (int g = 0; g < 16; ++g) {
                float d = 0.f;
#pragma unroll
                for (int j = 0; j < 4; ++j) { const f32x4 w = *(const LAS f32x4*)(wgs + g * 1024 + 256 * j + 4 * lane); d += (v[j][0] * w[0] + v[j][1] * w[1]) + (v[j][2] * w[2] + v[j][3] * w[3]); }
                d = wave_sum(d);
                if (lane == g) mine = d;
            }
            if (lane < 16) gates[(size_t)R * 16 + lane] = mine + gate_b[lane];
        }
    }
    if (GATES) __syncthreads();
}

__device__ __forceinline__ void qkprep_phase(LAS unsigned char* lds, const bf16_t* P, const float* convw, bf16_t* Qc, bf16_t* Kc, bf16_t* KcT) {
    int tid_ = threadIdx.x; asm volatile("" : "+v"(tid_)); const int tid = tid_;
    constexpr int LD = 136;
    LAS bf16_t* Tt = (LAS bf16_t*)lds;
    LAS float* cw = (LAS float*)(lds + 34816);
    const int seg = tid & 15;
    for (int unit = blockIdx.x; unit < 576; unit += gridDim.x) {
        const int h = unit & 3, gc = unit >> 2, n = gc % 18, b = gc / 18;
        const int sbase = n < 2 ? MX + b * CTXL : b * SEQ, T = n < 2 ? CTXL : SEQ, t0 = n < 2 ? n * 128 : (n - 2) * 128;
        for (int i = tid; i < 768; i += NTHREADS) { const int qk = i / 384, j = (i % 384) >> 7, ch = i & 127; cw[i] = convw[j * 1024 + qk * 512 + h * 128 + ch]; }
        __syncthreads();
#pragma unroll 1
        for (int it = 0; it < 4; ++it) {
            const int l = (tid + NTHREADS * it) >> 4;
            const int tin = t0 + l;
            const size_t R = (size_t)(sbase + tin);
            const bf16_t* pr = P + R * NEV + h * 128 + seg * 8;
            const u32x4 z = (u32x4){0u, 0u, 0u, 0u};
#pragma unroll
            for (int qk = 0; qk < 2; ++qk) {
                const bf16_t* pp = pr + qk * 512;
                const u32x4 c0 = *(const u32x4*)pp; const u32x4 pv = tin > 0 ? *(const u32x4*)(pp - NEV) : z; const u32x4 nx = tin < T - 1 ? *(const u32x4*)(pp + NEV) : z;
                float y[8];
#pragma unroll
                for (int hf = 0; hf < 2; ++hf) {
                    const f32x4 w0 = *(const LAS f32x4*)(cw + (qk * 3 + 0) * 128 + seg * 8 + 4 * hf), w1 = *(const LAS f32x4*)(cw + (qk * 3 + 1) * 128 + seg * 8 + 4 * hf), w2v = *(const LAS f32x4*)(cw + (qk * 3 + 2) * 128 + seg * 8 + 4 * hf);
                    y[4 * hf + 0] = w0[0] * bflo(pv[2 * hf]) + w1[0] * bflo(c0[2 * hf]) + w2v[0] * bflo(nx[2 * hf]);
                    y[4 * hf + 1] = w0[1] * bfhi(pv[2 * hf]) + w1[1] * bfhi(c0[2 * hf]) + w2v[1] * bfhi(nx[2 * hf]);
                    y[4 * hf + 2] = w0[2] * bflo(pv[2 * hf + 1]) + w1[2] * bflo(c0[2 * hf + 1]) + w2v[2] * bflo(nx[2 * hf + 1]);
                    y[4 * hf + 3] = w0[3] * bfhi(pv[2 * hf + 1]) + w1[3] * bfhi(c0[2 * hf + 1]) + w2v[3] * bfhi(nx[2 * hf + 1]);
                }
                const float scl = qk ? 0.08838834764831845f : 1.f;
                u32x4 o;
#pragma unroll
                for (int w2 = 0; w2 < 4; ++w2) o[w2] = pk2(silu_f(y[2 * w2]) * scl, silu_f(y[2 * w2 + 1]) * scl);
                *(u32x4*)((qk ? Kc : Qc) + R * 512 + h * 128 + seg * 8) = o;
                if (qk) {
#pragma unroll
                    for (int w2 = 0; w2 < 4; ++w2) { Tt[(seg * 8 + 2 * w2) * LD + l] = (bf16_t)(o[w2] & 0xffffu); Tt[(seg * 8 + 2 * w2 + 1) * LD + l] = (bf16_t)(o[w2] >> 16); }
                }
            }
        }
        __syncthreads();
#pragma unroll
        for (int it = 0; it < 4; ++it) { const int i = tid + NTHREADS * it; const int d = i >> 4, sg = i & 15;
            *(u32x4*)(KcT + ((size_t)unit * 128 + d) * 128 + sg * 8) = *(const LAS u32x4*)(Tt + d * LD + sg * 8); }
        __syncthreads();
    }
}

__device__ __forceinline__ void mlstm_phase(LAS unsigned char* lds, const bf16_t* P, const float* gates, const bf16_t* Qc, const bf16_t* Kc, const bf16_t* KcT, bf16_t* Hdir) {
    int tid_ = threadIdx.x; asm volatile("" : "+v"(tid_)); const int tid = tid_, lane = tid & 63, wid = __builtin_amdgcn_readfirstlane(tid >> 6), r = lane & 15, q = lane >> 4;
    constexpr int LD = 136, LDB = LD * 2;
    constexpr int OFF_Q = 0, OFF_K = 34816, OFF_KT = 69632, OFF_VT = 104448, OFF_VW = 113152, OFF_CT = 121856, OFF_SC = 130560;
    LAS bf16_t* Qs = (LAS bf16_t*)(lds + OFF_Q); LAS bf16_t* Ks = (LAS bf16_t*)(lds + OFF_K); LAS bf16_t* Kt = (LAS bf16_t*)(lds + OFF_KT);
    LAS bf16_t* Vt = (LAS bf16_t*)(lds + OFF_VT); LAS bf16_t* Vw = (LAS bf16_t*)(lds + OFF_VW); LAS bf16_t* Ct = (LAS bf16_t*)(lds + OFF_CT);
    LAS float* sc = (LAS float*)(lds + OFF_SC);
    LAS float* qn = sc + 1536; LAS float* nvec = sc + 1664;
    for (int unit = blockIdx.x; unit < 256; unit += gridDim.x) {
        const int es = unit & 3, dir = (unit >> 2) & 1, h = (unit >> 3) & 3, b = unit >> 5;
        for (int i = tid; i < 32 * LD / 2; i += NTHREADS) ((LAS unsigned*)Ct)[i] = 0u;
        if (tid < 128) nvec[tid] = 0.f;
        f32x4 Cacc[2]; Cacc[0] = (f32x4){0.f, 0.f, 0.f, 0.f}; Cacc[1] = Cacc[0];
        float m_state = 0.f;
        u32x4 pq[4], pvv; float pgi[2], pgf[2];
        const unsigned voffq = (unsigned)(((tid >> 4) * 512 + (tid & 15) * 8) * 2), vofft = (unsigned)(((tid >> 4) * 128 + (tid & 15) * 8) * 2);
#define MLSTM_CHUNK_INFO(ci_, n_, gc_, rb_) do { if ((ci_) < 2) n_ = dir ? 1 - (ci_) : (ci_); else n_ = dir ? 19 - (ci_) : (ci_); gc_ = b * 18 + n_; rb_ = n_ < 2 ? MX + b * CTXL + n_ * 128 : b * SEQ + (n_ - 2) * 128; } while (0)
#define MLSTM_PREFETCH(ci_) do { int n2, gc2, rb2; MLSTM_CHUNK_INFO(ci_, n2, gc2, rb2); \
            const bf16_t* qg = Qc + (size_t)rb2 * 512 + h * 128; (void)gc2; \
            _Pragma("unroll") for (int it = 0; it < 4; ++it) { \
                pq[it] = *(const u32x4*)((const char*)(qg + it * 16384) + voffq); } \
            pvv = *(const u32x4*)(P + (size_t)(rb2 + (tid >> 2)) * NEV + 1024 + h * 128 + es * 32 + (tid & 3) * 8); } while (0)
#define MLSTM_LOAD_GATES(ci_) do { int n3, gc3, rb3; MLSTM_CHUNK_INFO(ci_, n3, gc3, rb3); (void)gc3; \
            _Pragma("unroll") for (int hf = 0; hf < 2; ++hf) { const int l = lane + 64 * hf; const int R = rb3 + (dir ? 127 - l : l); \
                pgi[hf] = gates[(size_t)R * 16 + dir * 8 + h]; pgf[hf] = gates[(size_t)R * 16 + dir * 8 + 4 + h]; } } while (0)
#define MLSTM_SCALARS(D_) do { LAS float* rowf_ = (D_); LAS float* dmb_ = (D_) + 128; LAS float* inter_ = (D_) + 256; LAS float* wl_ = (D_) + 384; LAS float* en_ = (D_) + 512; LAS float* misc_ = (D_) + 640; \
            float ig[2], bc[2]; \
            _Pragma("unroll") for (int hf = 0; hf < 2; ++hf) { ig[hf] = pgi[hf]; const float fg = pgf[hf]; bc[hf] = fminf(fg, 0.f) - log1pf(expf(-fabsf(fg))); } \
            _Pragma("unroll") for (int off = 1; off < 64; off <<= 1) { const float t0 = __shfl_up(bc[0], off), t1 = __shfl_up(bc[1], off); if (lane >= off) { bc[0] += t0; bc[1] += t1; } } \
            bc[1] += __shfl(bc[0], 63); \
            const float g_ = __shfl(bc[1], 63); \
            const float d0 = ig[0] - bc[0], d1 = ig[1] - bc[1]; \
            float p0 = d0, p1 = d1; \
            _Pragma("unroll") for (int off = 1; off < 64; off <<= 1) { const float t0 = __shfl_up(p0, off), t1 = __shfl_up(p1, off); if (lane >= off) { p0 = fmaxf(p0, t0); p1 = fmaxf(p1, t1); } } \
            p1 = fmaxf(p1, __shfl(p0, 63)); \
            const float a0 = g_ + d0, a1 = g_ + d1; \
            const float mloc = wave_max(fmaxf(a0, a1)); \
            const float m_new = fmaxf(g_ + m_state, mloc); \
            const float dec_ = expf(g_ + m_state - m_new); \
            const float mt0 = bc[0] + fmaxf(m_state, p0), mt1 = bc[1] + fmaxf(m_state, p1); \
            const int i0 = dir ? 127 - lane : lane, i1 = dir ? 63 - lane : lane + 64; \
            rowf_[i0] = bc[0] - mt0; rowf_[i1] = bc[1] - mt1; \
            dmb_[i0] = d0; dmb_[i1] = d1; \
            inter_[i0] = expf(bc[0] + m_state - mt0); inter_[i1] = expf(bc[1] + m_state - mt1); \
            wl_[i0] = expf(a0 - m_new); wl_[i1] = expf(a1 - m_new); \
            en_[i0] = expf(-mt0); en_[i1] = expf(-mt1); \
            if (lane == 0) misc_[0] = dec_; \
            m_state = m_new; } while (0)
        const bool swave = wid == (dir ? 7 : 0);
        if (swave) { MLSTM_LOAD_GATES(0); MLSTM_SCALARS(sc); MLSTM_LOAD_GATES(1); }
        MLSTM_PREFETCH(0);
        __syncthreads();
        for (int ci = 0; ci < 18; ++ci) {
            int wc_ = wid, dc_ = dir; asm volatile("" : "+s"(wc_), "+s"(dc_)); const int widc = wc_, dirc = dc_;
            int n, gc, rbase;
            MLSTM_CHUNK_INFO(ci, n, gc, rbase);
            LAS float* scb = sc + (ci & 1) * 768;
            LAS float* rowf = scb; LAS float* dmb = scb + 128; LAS float* inter = scb + 256; LAS float* wl = scb + 384; LAS float* en = scb + 512; LAS float* misc = scb + 640;
            u32x4 pk[4], pt[4];
            { const bf16_t* kg = Kc + (size_t)rbase * 512 + h * 128; const bf16_t* tg = KcT + (size_t)(gc * 4 + h) * 128 * 128;
#pragma unroll
              for (int it = 0; it < 4; ++it) pk[it] = *(const u32x4*)((const char*)(kg + it * 16384) + voffq);
#pragma unroll
              for (int it = 0; it < 4; ++it) pt[it] = *(const u32x4*)((const char*)(tg + it * 4096) + vofft); }
#pragma unroll
            for (int it = 0; it < 4; ++it) { const int i = tid + NTHREADS * it; const int row = i >> 4, sg = i & 15; *(LAS u32x4*)(Qs + row * LD + sg * 8) = pq[it]; }
#pragma unroll
            for (int it = 0; it < 4; ++it) { const int i = tid + NTHREADS * it; const int row = i >> 4, sg = i & 15; *(LAS u32x4*)(Ks + row * LD + sg * 8) = pk[it]; }
            __syncthreads();
            const float dec = misc[0];
            {
                const int t = tid >> 2, sg = tid & 3;
                const u32x4 vv = pvv;
                const float w = wl[t];
#pragma unroll
                for (int w2 = 0; w2 < 4; ++w2) {
                    Vt[(sg * 8 + 2 * w2) * LD + t] = (bf16_t)(vv[w2] & 0xffffu); Vt[(sg * 8 + 2 * w2 + 1) * LD + t] = (bf16_t)(vv[w2] >> 16);
                    Vw[(sg * 8 + 2 * w2) * LD + t] = f2bf(bflo(vv[w2]) * w); Vw[(sg * 8 + 2 * w2 + 1) * LD + t] = f2bf(bfhi(vv[w2]) * w);
                }
            }
            f32x4 sacc[8];
            {
                bf16x8 af[4];
#pragma unroll
                for (int ks = 0; ks < 4; ++ks) af[ks] = ldsfrag(lds + OFF_Q + (16 * wid + r) * LDB + (32 * ks + 8 * q) * 2);
#pragma unroll
                for (int jb = 0; jb < 8; ++jb) {
                    sacc[jb] = (f32x4){0.f, 0.f, 0.f, 0.f};
                    if (dirc ? (jb >= widc) : (jb <= widc)) {
#pragma unroll
                        for (int ks = 0; ks < 4; ++ks) sacc[jb] = mfma16(af[ks], ldsfrag(lds + OFF_K + (16 * jb + r) * LDB + (32 * ks + 8 * q) * 2), sacc[jb]);
                    }
                }
            }
            {
                const int t = tid >> 2, part = tid & 3; float s = 0.f;
#pragma unroll
                for (int i = 0; i < 4; ++i) {
                    const u32x4 qv = *(const LAS u32x4*)(Qs + t * LD + part * 32 + i * 8);
                    const f32x4 n0 = *(const LAS f32x4*)(nvec + part * 32 + i * 8), n1 = *(const LAS f32x4*)(nvec + part * 32 + i * 8 + 4);
                    s += bflo(qv[0]) * n0[0] + bfhi(qv[0]) * n0[1] + bflo(qv[1]) * n0[2] + bfhi(qv[1]) * n0[3] + bflo(qv[2]) * n1[0] + bfhi(qv[2]) * n1[1] + bflo(qv[3]) * n1[2] + bfhi(qv[3]) * n1[3];
                }
                s += dppf<0xB1>(s); s += dppf<0x4E>(s);
                if (part == 0) qn[t] = s;
            }
#pragma unroll
            for (int it = 0; it < 4; ++it) { const int i = tid + NTHREADS * it; *(LAS u32x4*)(Kt + (i >> 4) * LD + (i & 15) * 8) = pt[it]; }
            __syncthreads();
            if (swave && ci + 1 < 18) { MLSTM_SCALARS(sc + ((ci + 1) & 1) * 768); if (ci + 2 < 18) MLSTM_LOAD_GATES(ci + 2); }
            LAS bf16_t* Ss = Ks;
            float rs[4] = {0.f, 0.f, 0.f, 0.f};
            {
                const f32x4 rf = *(const LAS f32x4*)(rowf + 16 * wid + 4 * q);
                const int zb = dirc ? ((widc & 1) ? widc - 1 : -1) : ((widc & 1) ? -1 : widc + 1);
#pragma unroll
                for (int jb = 0; jb < 8; ++jb) {
                    if (dirc ? (jb >= widc) : (jb <= widc)) {
                        const int s = 16 * jb + r; const float dm = dmb[s];
#pragma unroll
                        for (int reg = 0; reg < 4; ++reg) { const int t = 16 * wid + 4 * q + reg;
                            const bool ok = dirc ? (s >= t) : (s <= t);
                            const float v = ok ? sacc[jb][reg] * __expf(rf[reg] + dm) : 0.f;
                            rs[reg] += v; Ss[t * LD + s] = f2bf(v); }
                    } else if (jb == zb) {
#pragma unroll
                        for (int reg = 0; reg < 4; ++reg) Ss[(16 * wid + 4 * q + reg) * LD + 16 * jb + r] = 0;
                    }
                }
#pragma unroll
                for (int reg = 0; reg < 4; ++reg) rs[reg] = row16_sum(rs[reg]);
            }
            {
                const int kh = widc >> 1;
                const f32x4 it4 = *(const LAS f32x4*)(inter + 16 * wid + 4 * q), qn4 = *(const LAS f32x4*)(qn + 16 * wid + 4 * q), en4 = *(const LAS f32x4*)(en + 16 * wid + 4 * q);
                bf16x8 qf[4];
#pragma unroll
                for (int ks = 0; ks < 4; ++ks) qf[ks] = ldsfrag(lds + OFF_Q + (16 * wid + r) * LDB + (32 * ks + 8 * q) * 2);
#pragma unroll
                for (int nt = 0; nt < 2; ++nt) {
                    f32x4 a1 = (f32x4){0.f, 0.f, 0.f, 0.f}, a2 = a1;
#pragma unroll
                    for (int ks = 0; ks < 4; ++ks) {
                        if (dirc ? (ks >= kh) : (ks <= kh)) a1 = mfma16(ldsfrag(lds + OFF_K + (16 * wid + r) * LDB + (32 * ks + 8 * q) * 2), ldsfrag(lds + OFF_VT + (16 * nt + r) * LDB + (32 * ks + 8 * q) * 2), a1);
                        a2 = mfma16(qf[ks], ldsfrag(lds + OFF_CT + (16 * nt + r) * LDB + (32 * ks + 8 * q) * 2), a2);
                    }
#pragma unroll
                    for (int reg = 0; reg < 4; ++reg) {
                        const int t = 16 * wid + 4 * q + reg;
                        const float den = rs[reg] + it4[reg] * qn4[reg];
                        const float hv = (a1[reg] + it4[reg] * a2[reg]) / fmaxf(fabsf(den), en4[reg]);
                        Hdir[((size_t)dir * MT + rbase + t) * 512 + h * 128 + es * 32 + 16 * nt + r] = f2bf(hv);
                    }
                }
            }
            asm volatile("" ::: "memory");
            if (ci + 1 < 18) MLSTM_PREFETCH(ci + 1);
            asm volatile("" ::: "memory");
            {
                bf16x8 kf[4];
#pragma unroll
                for (int ks = 0; ks < 4; ++ks) kf[ks] = ldsfrag(lds + OFF_KT + (16 * wid + r) * LDB + (32 * ks + 8 * q) * 2);
#pragma unroll
                for (int nt = 0; nt < 2; ++nt) {
                    Cacc[nt] = Cacc[nt] * dec;
#pragma unroll
                    for (int ks = 0; ks < 4; ++ks) Cacc[nt] = mfma16(kf[ks], ldsfrag(lds + OFF_VW + (16 * nt + r) * LDB + (32 * ks + 8 * q) * 2), Cacc[nt]);
                }
            }
            float nnew;
            {
                const int d = tid >> 2, part = tid & 3; float s = 0.f;
#pragma unroll
                for (int i = 0; i < 4; ++i) {
                    const u32x4 kv = *(const LAS u32x4*)(Kt + d * LD + part * 32 + i * 8);
                    const f32x4 w0 = *(const LAS f32x4*)(wl + part * 32 + i * 8), w1 = *(const LAS f32x4*)(wl + part * 32 + i * 8 + 4);
                    s += bflo(kv[0]) * w0[0] + bfhi(kv[0]) * w0[1] + bflo(kv[1]) * w0[2] + bfhi(kv[1]) * w0[3] + bflo(kv[2]) * w1[0] + bfhi(kv[2]) * w1[1] + bflo(kv[3]) * w1[2] + bfhi(kv[3]) * w1[3];
                }
                s += dppf<0xB1>(s); s += dppf<0x4E>(s);
                nnew = dec * nvec[d] + s;
            }
            __syncthreads();
#pragma unroll
            for (int nt = 0; nt < 2; ++nt) { u32x2 w; w.x = pk2(Cacc[nt][0], Cacc[nt][1]); w.y = pk2(Cacc[nt][2], Cacc[nt][3]); *(LAS u32x2*)(Ct + (16 * nt + r) * LD + 16 * wid + 4 * q) = w; }
            if ((tid & 3) == 0) nvec[tid >> 2] = nnew;
        }
        __syncthreads();
    }
}

__device__ __forceinline__ void sgu_phase(LAS unsigned char* lds, const bf16_t* P, const float* sgu_norm, const float* sgu_ws, const float* sgu_b, bf16_t* A1) {
    int tid_ = threadIdx.x; asm volatile("" : "+v"(tid_)); const int tid = tid_, lane = tid & 63, wid = __builtin_amdgcn_readfirstlane(tid >> 6), r = lane & 15, q = lane >> 4;
    constexpr int LD = 136, LDB = LD * 2, OFF_W = 0, OFF_V = 34816, OFF_R = 69632;
    LAS bf16_t* Ws = (LAS bf16_t*)(lds + OFF_W); LAS bf16_t* Vt = (LAS bf16_t*)(lds + OFF_V); LAS float* rstd = (LAS float*)(lds + OFF_R);
    for (int unit = (int)gridDim.x - 1 - (int)blockIdx.x; unit < 144; unit += gridDim.x) {
        const int n = unit % 18, b = unit / 18;
        const int rbase = n < 2 ? MX + b * CTXL + n * 128 : b * SEQ + (n - 2) * 128;
        {
            const int tok = tid >> 2, part = tid & 3; float ss = 0.f;
            const bf16_t* pv = P + (size_t)(rbase + tok) * NEV + 2560 + part * 128;
#pragma unroll 4
            for (int i = 0; i < 16; ++i) { const u32x4 w = *(const u32x4*)(pv + i * 8);
#pragma unroll
                for (int k = 0; k < 4; ++k) { const float a0 = gelu_tanh(bflo(w[k])), a1 = gelu_tanh(bfhi(w[k])); ss += a0 * a0 + a1 * a1; } }
            ss += dppf<0xB1>(ss); ss += dppf<0x4E>(ss);
            if (part == 0) rstd[tok] = 1.0f / sqrtf(ss * (1.f / 512.f) + EPS);
        }
#pragma unroll 1
        for (int g = 0; g < 4; ++g) {
#pragma unroll
            for (int it = 0; it < 4; ++it) { const int i = tid + NTHREADS * it; const int p = i >> 4, sg = i & 15;
                const float* wp = sgu_ws + ((size_t)g * 128 + p) * 128 + sg * 8; const f32x4 w0 = *(const f32x4*)wp, w1 = *(const f32x4*)(wp + 4);
                u32x4 o; o.x = pk2(w0[0], w0[1]); o.y = pk2(w0[2], w0[3]); o.z = pk2(w1[0], w1[1]); o.w = pk2(w1[2], w1[3]);
                *(LAS u32x4*)(Ws + p * LD + sg * 8) = o; }
            if (g == 0) __syncthreads();
#pragma unroll
            for (int it = 0; it < 4; ++it) { const int i = tid + NTHREADS * it; const int tq = i >> 4, sg = i & 15;
                const u32x4 w = *(const u32x4*)(P + (size_t)(rbase + tq) * NEV + 2560 + g * 128 + sg * 8);
                const float rq = rstd[tq];
                const f32x4 g0 = *(const f32x4*)(sgu_norm + g * 128 + sg * 8), g1 = *(const f32x4*)(sgu_norm + g * 128 + sg * 8 + 4);
                Vt[(sg * 8 + 0) * LD + tq] = f2bf(gelu_tanh(bflo(w[0])) * rq * g0[0]); Vt[(sg * 8 + 1) * LD + tq] = f2bf(gelu_tanh(bfhi(w[0])) * rq * g0[1]);
                Vt[(sg * 8 + 2) * LD + tq] = f2bf(gelu_tanh(bflo(w[1])) * rq * g0[2]); Vt[(sg * 8 + 3) * LD + tq] = f2bf(gelu_tanh(bfhi(w[1])) * rq * g0[3]);
                Vt[(sg * 8 + 4) * LD + tq] = f2bf(gelu_tanh(bflo(w[2])) * rq * g1[0]); Vt[(sg * 8 + 5) * LD + tq] = f2bf(gelu_tanh(bfhi(w[2])) * rq * g1[1]);
                Vt[(sg * 8 + 6) * LD + tq] = f2bf(gelu_tanh(bflo(w[3])) * rq * g1[2]); Vt[(sg * 8 + 7) * LD + tq] = f2bf(gelu_tanh(bfhi(w[3])) * rq * g1[3]); }
            __syncthreads();
            {
                bf16x8 wf[4];
#pragma unroll
                for (int ks = 0; ks < 4; ++ks) wf[ks] = ldsfrag(lds + OFF_W + (16 * wid + r) * LDB + (32 * ks + 8 * q) * 2);
                const float sbp = sgu_b[g * 128 + 16 * wid + r];
                const size_t R = (size_t)(rbase + 16 * wid + r);
#pragma unroll
                for (int jb = 0; jb < 8; ++jb) {
                    f32x4 acc = (f32x4){0.f, 0.f, 0.f, 0.f};
#pragma unroll
                    for (int ks = 0; ks < 4; ++ks) acc = mfma16(ldsfrag(lds + OFF_V + (16 * jb + r) * LDB + (32 * ks + 8 * q) * 2), wf[ks], acc);
                    const u32x2 uu = *(const u32x2*)(P + R * NEV + 2048 + g * 128 + 16 * jb + 4 * q);
                    u32x2 w; w.x = pk2(gelu_tanh(bflo(uu.x)) * (acc[0] + sbp), gelu_tanh(bfhi(uu.x)) * (acc[1] + sbp)); w.y = pk2(gelu_tanh(bflo(uu.y)) * (acc[2] + sbp), gelu_tanh(bfhi(uu.y)) * (acc[3] + sbp));
                    *(u32x2*)(A1 + R * D + 512 + g * 128 + 16 * jb + 4 * q) = w;
                }
            }
            __syncthreads();
        }
    }
}

__device__ __forceinline__ void combine_phase(const bf16_t* Hdir, const bf16_t* P, const float* mnorm, bf16_t* A1) {
    int tid_ = threadIdx.x; asm volatile("" : "+v"(tid_)); const int tid = tid_, lane = tid & 63, wid = __builtin_amdgcn_readfirstlane(tid >> 6);
    for (int R = blockIdx.x * 8 + wid; R < MT; R += gridDim.x * 8) {
        const int col = lane * 8;
        const u32x4 h0 = *(const u32x4*)(Hdir + (size_t)R * 512 + col), h1 = *(const u32x4*)(Hdir + ((size_t)MT + R) * 512 + col);
        float a[8];
#pragma unroll
        for (int k = 0; k < 4; ++k) { a[2 * k] = bflo(h0[k]) + bflo(h1[k]); a[2 * k + 1] = bfhi(h0[k]) + bfhi(h1[k]); }
        float ss = 0.f;
#pragma unroll
        for (int k = 0; k < 8; ++k) ss += a[k] * a[k];
        ss = row16_sum(ss);
        const float rstd = 1.0f / sqrtf(ss * (1.f / 128.f) + EPS);
        const f32x4 m0 = *(const f32x4*)(mnorm + col), m1 = *(const f32x4*)(mnorm + col + 4);
        const u32x4 ov = *(const u32x4*)(P + (size_t)R * NEV + 1536 + col);
        u32x4 w;
        w.x = pk2(sigmoid_f(bflo(ov[0])) * a[0] * rstd * m0[0], sigmoid_f(bfhi(ov[0])) * a[1] * rstd * m0[1]);
        w.y = pk2(sigmoid_f(bflo(ov[1])) * a[2] * rstd * m0[2], sigmoid_f(bfhi(ov[1])) * a[3] * rstd * m0[3]);
        w.z = pk2(sigmoid_f(bflo(ov[2])) * a[4] * rstd * m1[0], sigmoid_f(bfhi(ov[2])) * a[5] * rstd * m1[1]);
        w.w = pk2(sigmoid_f(bflo(ov[3])) * a[6] * rstd * m1[2], sigmoid_f(bfhi(ov[3])) * a[7] * rstd * m1[3]);
        *(u32x4*)(A1 + (size_t)R * D + col) = w;
    }
}

__device__ __forceinline__ void attn_phase(LAS unsigned char* lds, const bf16_t* QKV, const float* sink, bf16_t* A1) {
    int tid_ = threadIdx.x; asm volatile("" : "+v"(tid_)); const int tid = tid_, lane = tid & 63, wid = __builtin_amdgcn_readfirstlane(tid >> 6), r = lane & 15, q = lane >> 4;
    constexpr int LK = 72, LKB = LK * 2, OFF_K = 0, OFF_V = 9216, OFF_P = 18432, PSZ = 64 * LKB;
    LAS bf16_t* Ks = (LAS bf16_t*)(lds + OFF_K); LAS bf16_t* Vt = (LAS bf16_t*)(lds + OFF_V);
    LAS bf16_t* Ps = (LAS bf16_t*)(lds + OFF_P + wid * PSZ);
    const LAS unsigned char* Pb = lds + OFF_P + wid * PSZ;
    for (int unit = blockIdx.x; unit < 512; unit += gridDim.x) {
        asm volatile("" : "+s"(QKV), "+s"(A1));
        const int hk = unit & 3, j = (unit >> 2) & 15, b = unit >> 6;
        const int g = wid >> 1, hq = hk * 4 + g, tok0 = (wid & 1) * 64;
        const int qrow0 = b * SEQ + j * 128 + tok0;
        bf16x8 qf[4][2];
#pragma unroll
        for (int mt = 0; mt < 4; ++mt)
#pragma unroll
            for (int ks = 0; ks < 2; ++ks) qf[mt][ks] = *(const bf16x8*)(QKV + (size_t)(qrow0 + 16 * mt + r) * NQKV + hq * 64 + 32 * ks + 8 * q);
        float mrun[4], lrun[4]; f32x4 oacc[4][4];
        const float sk = sink[hq];
#pragma unroll
        for (int mt = 0; mt < 4; ++mt) { mrun[mt] = sk; lrun[mt] = 1.f;
#pragma unroll
            for (int dt = 0; dt < 4; ++dt) oacc[dt][mt] = (f32x4){0.f, 0.f, 0.f, 0.f}; }
        const int tfirst = 0, tlast = (j == 15) ? 7 : 9;
        u32x4 kvn, vvn;
        const unsigned voffk = (unsigned)(((tid >> 3) * NQKV + (tid & 7) * 8) * 2);
#define ATTN_TILE_ROW(ti_) ((ti_) < 4 ? MX + b * CTXL + (ti_) * 64 : b * SEQ + (j - 1 + (((ti_) - 4) >> 1)) * 128 + (((ti_) - 4) & 1) * 64)
#define ATTN_LOAD(ti_) do { const char* kp_ = (const char*)(QKV + (size_t)ATTN_TILE_ROW(ti_) * NQKV + 1024 + hk * 64); kvn = *(const u32x4*)(kp_ + voffk); vvn = *(const u32x4*)(kp_ + 512 + voffk); } while (0)
        ATTN_LOAD(tfirst);
        for (int ti = tfirst; ti <= tlast; ++ti) {
            if (j == 0 && (ti == 4 || ti == 5)) continue;
            int kpos0; bool band;
            if (ti < 4) { kpos0 = 0; band = false; }
            else { const int kb = j - 1 + ((ti - 4) >> 1); kpos0 = kb * 128 + ((ti - 4) & 1) * 64; band = (kb != j); }
            __syncthreads();
            {
                const int key = tid >> 3, sg = tid & 7;
                *(LAS u32x4*)(Ks + key * LK + sg * 8) = kvn;
#pragma unroll
                for (int w2 = 0; w2 < 4; ++w2) { Vt[(sg * 8 + 2 * w2) * LK + key] = (bf16_t)(vvn[w2] & 0xffffu); Vt[(sg * 8 + 2 * w2 + 1) * LK + key] = (bf16_t)(vvn[w2] >> 16); }
            }
            { int tn = ti + 1; if (j == 0 && tn == 4) tn = 6; if (tn <= tlast) ATTN_LOAD(tn); }
            __syncthreads();
            {
#pragma unroll
                for (int mt = 0; mt < 4; ++mt) {
                    f32x4 s[4];
#pragma unroll
                    for (int nt = 0; nt < 4; ++nt) { f32x4 a = (f32x4){0.f, 0.f, 0.f, 0.f}; a = mfma16(ldsfrag(lds + OFF_K + (16 * nt + r) * LKB + (8 * q) * 2), qf[mt][0], a); a = mfma16(ldsfrag(lds + OFF_K + (16 * nt + r) * LKB + (32 + 8 * q) * 2), qf[mt][1], a); s[nt] = a; }
                    if (band) {
                        const int qp = j * 128 + tok0 + 16 * mt + r;
#pragma unroll
                        for (int nt = 0; nt < 4; ++nt)
#pragma unroll
                            for (int i = 0; i < 4; ++i) { const int df = qp - (kpos0 + 16 * nt + 4 * q + i); if (df > 128 || df < -128) s[nt][i] = -1e30f; }
                    }
                    float mx = fmaxf(fmaxf(fmaxf(s[0][0], s[0][1]), fmaxf(s[0][2], s[0][3])), fmaxf(fmaxf(s[1][0], s[1][1]), fmaxf(s[1][2], s[1][3])));
                    mx = fmaxf(mx, fmaxf(fmaxf(fmaxf(s[2][0], s[2][1]), fmaxf(s[2][2], s[2][3])), fmaxf(fmaxf(s[3][0], s[3][1]), fmaxf(s[3][2], s[3][3]))));
                    mx = fmaxf(mx, __shfl_xor(mx, 16)); mx = fmaxf(mx, __shfl_xor(mx, 32));
                    const float mn = fmaxf(mrun[mt], mx), alpha = __expf(mrun[mt] - mn);
                    float rsum = 0.f;
#pragma unroll
                    for (int nt = 0; nt < 4; ++nt) {
                        const float p0 = __expf(s[nt][0] - mn), p1 = __expf(s[nt][1] - mn), p2 = __expf(s[nt][2] - mn), p3 = __expf(s[nt][3] - mn);
                        rsum += (p0 + p1) + (p2 + p3);
                        u32x2 w; w.x = pk2(p0, p1); w.y = pk2(p2, p3);
                        *(LAS u32x2*)(Ps + (16 * mt + r) * LK + 16 * nt + 4 * q) = w;
                    }
                    rsum += __shfl_xor(rsum, 16); rsum += __shfl_xor(rsum, 32);
                    lrun[mt] = lrun[mt] * alpha + rsum; mrun[mt] = mn;
#pragma unroll
                    for (int dt = 0; dt < 4; ++dt) oacc[dt][mt] *= alpha;
                    asm volatile("" ::: "memory");
                }
            }
#pragma unroll
            for (int mt = 0; mt < 4; ++mt) {
                const bf16x8 p0 = ldsfrag(Pb + (16 * mt + r) * LKB + (8 * q) * 2), p1 = ldsfrag(Pb + (16 * mt + r) * LKB + (32 + 8 * q) * 2);
#pragma unroll
                for (int dt = 0; dt < 4; ++dt) {
                    oacc[dt][mt] = mfma16(ldsfrag(lds + OFF_V + (16 * dt + r) * LKB + (8 * q) * 2), p0, oacc[dt][mt]);
                    oacc[dt][mt] = mfma16(ldsfrag(lds + OFF_V + (16 * dt + r) * LKB + (32 + 8 * q) * 2), p1, oacc[dt][mt]);
                }
                asm volatile("" ::: "memory");
            }
        }
#pragma unroll
        for (int mt = 0; mt < 4; ++mt) { const float inv = 1.f / lrun[mt]; const size_t R = (size_t)(qrow0 + 16 * mt + r);
#pragma unroll
            for (int dt = 0; dt < 4; ++dt) { const f32x4 o = oacc[dt][mt] * inv; u32x2 w; w.x = pk2(o[0], o[1]); w.y = pk2(o[2], o[3]);
                *(u32x2*)(A1 + R * D + hq * 64 + 16 * dt + 4 * q) = w; } }
    }
    __syncthreads();
}

__device__ __forceinline__ void final_phase(float* out, const float* fnorm) {
    int tid_ = threadIdx.x; asm volatile("" : "+v"(tid_)); const int tid = tid_, lane = tid & 63, wid = __builtin_amdgcn_readfirstlane(tid >> 6);
    for (int R = blockIdx.x * 8 + wid; R < MX; R += gridDim.x * 8) {
        float* src = out + (size_t)R * D;
        f32x4 v[4]; float ss = 0.f;
#pragma unroll
        for (int j = 0; j < 4; ++j) { v[j] = *(const f32x4*)(src + 256 * j + 4 * lane); ss += (v[j][0] * v[j][0] + v[j][1] * v[j][1]) + (v[j][2] * v[j][2] + v[j][3] * v[j][3]); }
        const float rstd = 1.0f / sqrtf(wave_sum(ss) * (1.f / D) + EPS);
#pragma unroll
        for (int j = 0; j < 4; ++j) { const f32x4 w = *(const f32x4*)(fnorm + 256 * j + 4 * lane); *(f32x4*)(src + 256 * j + 4 * lane) = v[j] * rstd * w; }
    }
}

#define GAS __attribute__((address_space(1)))
typedef GAS unsigned gu32;
#define RLX_AGENT __ATOMIC_RELAXED, __HIP_MEMORY_SCOPE_AGENT
#define XB_TMO      128
#define XB_XCNT(j)  (256  + 64 * (j))
#define XB_XSUB(j)  (1280 + 64 * (j))
#define XB_XGEN(j)  (2304 + 64 * (j))
#define XB_TOP      3328
#define XB_TOPGEN   3392
#define XCD_BAR_WORDS 3456
#define XB_SPIN_CAP (1u << 18)

__device__ __forceinline__ unsigned xb_ld(unsigned* p)              { return __hip_atomic_load(p, __ATOMIC_RELAXED, __HIP_MEMORY_SCOPE_AGENT); }
__device__ __forceinline__ unsigned xb_add(unsigned* p, unsigned v) { return __hip_atomic_fetch_add(p, v, __ATOMIC_RELAXED, __HIP_MEMORY_SCOPE_AGENT); }
__device__ __forceinline__ unsigned xb_xcc_id() { return (unsigned)__builtin_amdgcn_s_getreg((3 << 11) | 20) & 0xFu; }
#define XB_SPIN(cond, bar) do { unsigned _sp = 0; while (cond) { __builtin_amdgcn_s_sleep(1); \
    if ((++_sp & 255u) == 0u) { if (xb_ld(&(bar)[XB_TMO])) break; if (_sp > XB_SPIN_CAP) { atomicAdd(&(bar)[XB_TMO], 1u); break; } } } } while (0)

struct XcdBarrier {
    unsigned* bar; unsigned x;
    volatile LAS unsigned* st;
};

__device__ __forceinline__ XcdBarrier xcd_barrier_post(unsigned* bar, volatile LAS unsigned* st) {
    XcdBarrier b; b.bar = bar; b.x = xb_xcc_id(); b.st = st;
    if (threadIdx.x == 0) (void)xb_add(&bar[XB_XCNT(b.x)], 1u);
    return b;
}
__device__ __forceinline__ void xcd_barrier_complete(unsigned* bar, unsigned x, unsigned& nloc, unsigned& nx) {
    const unsigned G = gridDim.x * gridDim.y * gridDim.z;
    unsigned sum, cnt, mine, sp = 0u;
    for (;;) {
        sum = 0u; cnt = 0u;
#pragma unroll 1
        for (unsigned j = 0; j < 16; ++j) { const unsigned c = xb_ld(&bar[XB_XCNT(j)]); sum += c; cnt += (c > 0u) ? 1u : 0u; }
        mine = xb_ld(&bar[XB_XCNT(x)]);
        if (sum == G) break;
        __builtin_amdgcn_s_sleep(1);
        if ((++sp & 255u) == 0u) { if (xb_ld(&bar[XB_TMO])) break; if (sp > XB_SPIN_CAP) { atomicAdd(&bar[XB_TMO], 1u); break; } }
    }
    nloc = mine > 0u ? mine : 1u; nx = cnt > 0u ? cnt : 1u;
}

__device__ __forceinline__ void xcd_barrier(const XcdBarrier& b) {
    asm volatile("s_waitcnt vmcnt(0)" ::: "memory");
    __syncthreads();
    if (threadIdx.x == 0) {
        unsigned* bar = b.bar;
        __builtin_amdgcn_s_waitcnt(0);
        unsigned nloc = b.st[0], nx = b.st[1];
        if (nloc == 0u) { xcd_barrier_complete(bar, b.x, nloc, nx); b.st[0] = nloc; b.st[1] = nx; }
        const unsigned old = xb_add(&bar[XB_XSUB(b.x)], 1u);
        const unsigned gen = old / nloc;
        if (old + 1u == (gen + 1u) * nloc) {
            __builtin_amdgcn_fence(__ATOMIC_RELEASE, "agent");
            asm volatile("s_waitcnt vmcnt(0)" ::: "memory");
            const unsigned og = xb_add(&bar[XB_TOP], 1u);
            const unsigned tg = og / nx;
            if (og + 1u == (tg + 1u) * nx) xb_add(&bar[XB_TOPGEN], 1u);
            else XB_SPIN(xb_ld(&bar[XB_TOPGEN]) == tg, bar);
            __builtin_amdgcn_fence(__ATOMIC_ACQUIRE, "agent");
            xb_add(&bar[XB_XGEN(b.x)], 1u);
            asm volatile("s_waitcnt vmcnt(0)" ::: "memory");
        } else {
            XB_SPIN(xb_ld(&bar[XB_XGEN(b.x)]) == gen, bar);
            __builtin_amdgcn_fence(__ATOMIC_ACQUIRE, "agent");
            asm volatile("s_waitcnt vmcnt(0)" ::: "memory");
        }
    }
    __syncthreads();
}

#ifndef MK_SINGLE
#define MK_SINGLE 1
#endif
constexpr int NPHASES = 24;
#ifndef EN_PREP
#define EN_PREP 1
#endif
#ifndef REP_MASK
#define REP_MASK 0
#endif
#ifndef USE_CG_FIRST
#define USE_CG_FIRST 0
#endif
#ifndef NSYNC_REP
#define NSYNC_REP 1
#endif
#ifndef EN_ALL
#define EN_ALL 1
#endif
#ifndef EN_P0
#define EN_P0 EN_ALL
#endif
#ifndef EN_NORM
#define EN_NORM EN_ALL
#endif
#ifndef EN_GEMM
#define EN_GEMM (EN_ALL ? 15 : 0)
#endif
#ifndef EN_MLSTM
#define EN_MLSTM EN_ALL
#endif
#ifndef EN_SGU
#define EN_SGU EN_ALL
#endif
#ifndef EN_COMB
#define EN_COMB EN_ALL
#endif
#ifndef EN_ATTN
#define EN_ATTN EN_ALL
#endif
#ifndef EN_FINAL
#define EN_FINAL EN_ALL
#endif
__global__ void __launch_bounds__(NTHREADS, 2) fwd_kernel(Args a_unused) {
    extern __shared__ __attribute__((aligned(16))) unsigned char lds_raw[];
    LAS unsigned char* lds = (LAS unsigned char*)lds_raw;
    cg::grid_group grid = cg::this_grid();
    unsigned char* ws = KA(ws);
    const int G = gridDim.x, c = blockIdx.x;
    float* Hx = KA(out); float* Hc = (float*)(ws + WS_HC);
    bf16_t* A0 = (bf16_t*)(ws + WS_A0); bf16_t* A1 = (bf16_t*)(ws + WS_A1); bf16_t* BIG = (bf16_t*)(ws + WS_BIG);
    bf16_t* Hdir = (bf16_t*)(ws + WS_A0);
    const float* mod = (const float*)(ws + WS_MOD);
    float* gates = (float*)(ws + WS_GATES);
    const int lo = KA(ph_lo), hi = KA(ph_hi);
    volatile LAS unsigned* barst = (volatile LAS unsigned*)(lds + LDS_BYTES - 16);
    if (threadIdx.x < 2) barst[threadIdx.x] = 0u;
    __syncthreads();
    XcdBarrier bar = xcd_barrier_post((unsigned*)(ws + WS_CTL), barst);
    enum { K_P0, K_NORM, K_NORMG, K_SWIGLU, K_RESID, K_PLAIN, K_QKV, K_MIX0, K_COMB, K_ATTN, K_FINAL, K_PREP };
    for (int ph = lo; ph < hi; ++ph) {
        const int layer = ph >= 13 ? 1 : 0;
        const int lp = ph >= 13 ? ph - 13 : ph - 1;
        const float* modl = mod + (size_t)layer * 9 * 9216;
        int kind = K_P0, M = MT, gi = 0, ffn = 0, Kd = 1024; float coef = 1.f;
        const bf16_t* Aop = A0; const bf16_t* Wop = nullptr;
        const float* bxp = Hx; const float* bcp = Hc;
        if (ph == 0) kind = K_P0;
        else if (ph == 23) kind = K_FINAL;
        else if (lp == 0) { kind = K_NORM; gi = 0; if (layer == 0) { bxp = KA(x); bcp = KA(ctx); } }
        else if (lp == 1) { kind = K_SWIGLU; ffn = layer * 2; }
        else if (lp == 2) { kind = K_RESID; Aop = BIG; Wop = (const bf16_t*)(ws + WS_WOUT + (size_t)(layer * 2) * SZ_WOUT); Kd = 2816; gi = 2; coef = 0.5f; if (layer == 0) { bxp = KA(x); bcp = KA(ctx); } }
        else if (layer == 0) {
            if (lp == 3) { kind = K_NORMG; gi = 3; }
            else if (lp == 4) kind = K_PLAIN;
            else if (lp == 5) kind = K_PREP;
            else if (lp == 6) kind = K_MIX0;
            else if (lp == 7) kind = K_COMB;
            else if (lp == 8) { kind = K_RESID; Aop = A1; Wop = (const bf16_t*)(ws + WS_WEOUT); gi = 5; }
            else if (lp == 9) { kind = K_NORM; gi = 6; }
            else if (lp == 10) { kind = K_SWIGLU; ffn = 1; }
            else { kind = K_RESID; Aop = BIG; Wop = (const bf16_t*)(ws + WS_WOUT + SZ_WOUT); Kd = 2816; gi = 8; coef = 0.5f; }
        } else {
            if (lp == 3) { kind = K_NORM; gi = 3; }
            else if (lp == 4) kind = K_QKV;
            else if (lp == 5) kind = K_ATTN;
            else if (lp == 6) { kind = K_RESID; Aop = A1; Wop = (const bf16_t*)(ws + WS_WOOUT); gi = 5; M = MX; }
            else if (lp == 7) { kind = K_NORM; gi = 6; M = MX; }
            else if (lp == 8) { kind = K_SWIGLU; ffn = 3; M = MX; }
            else { kind = K_RESID; Aop = BIG; Wop = (const bf16_t*)(ws + WS_WOUT + 3 * SZ_WOUT); Kd = 2816; gi = 8; coef = 0.5f; M = MX; }
        }
        const int nrep = ((REP_MASK >> kind) & 1) ? 2 : 1;
        for (int rep = 0; rep < nrep; ++rep) {
        if (rep == 1) { if (kind == K_RESID) { bxp = Hx; bcp = Hc; coef = 0.f; } __syncthreads(); }
        if (kind == K_P0) { if (EN_P0) p0_phase(lds); }
        else if (kind == K_NORM) { if (EN_NORM) norm_phase<false>(lds, bxp, bcp, A0, modl, gi, gi + 1, M, nullptr, nullptr, nullptr, (ph > 1 && M == MT) ? (float*)(ws + WS_PC) : nullptr); }
        else if (kind == K_NORMG) { if (EN_NORM) norm_phase<true>(lds, Hx, Hc, A0, modl, gi, gi + 1, M, (const float*)(ws + WS_WG), KA(mlstm_gate_b), gates, (float*)(ws + WS_PC)); }
        else if (kind == K_SWIGLU) { if (EN_GEMM & 1) { pg8::Gemm g{A0, (const bf16_t*)(ws + WS_WIN + (size_t)ffn * SZ_WIN), M, 5632, 1024}; pg8::StaticOrder S; S.init(M, 5632, G, c, 1024); pg8::EpiSwiglu E{BIG};
            pg8::gemm_phase<pg8::EpiSwiglu, pg8::StaticOrder, true, true>(lds, g, S, E); } }
        else if (kind == K_RESID) { if (EN_GEMM & 2) { pg8::Gemm g{Aop, Wop, M, 1024, Kd}; pg8::SplitCtxOrder S; S.init(1024, G, c, Kd, M == MT ? 64 : 0); pg8::EpiResid E{bxp, bcp, Hx, Hc, (float*)(ws + WS_PC), modl + gi * 1024, coef};
            pg8::gemm_phase<pg8::EpiResid, pg8::SplitCtxOrder, true, true>(lds, g, S, E);
            const int cgrp = (rep == 0 && M == MT && Kd == 2816) ? (layer == 0 ? (lp == 2 ? 1 : 2) : 3) : 0;
            if (cgrp != 0 && c >= 64 && G > 64) convert_group(lds, cgrp, (c - 64) * 8, (G - 64) * 8); } }
        else if (kind == K_PLAIN) { if (EN_GEMM & 4) { pg8::Gemm g{A0, (const bf16_t*)(ws + WS_WEIN), MT, NEV, 1024}; pg8::StaticOrder S; S.init(MT, NEV, G, c, 1024); pg8::EpiPlain E{BIG, NEV};
            pg8::gemm_phase<pg8::EpiPlain, pg8::StaticOrder, true, true>(lds, g, S, E); } }
        else if (kind == K_QKV) { if (EN_GEMM & 8) { pg8::Gemm g{A0, (const bf16_t*)(ws + WS_WQKV), MT, NQKV, 1024}; pg8::StaticOrder S; S.init(MT, NQKV, G, c, 1024); pg8::EpiQKV E{BIG, (const float*)(ws + WS_ROPE)};
            pg8::gemm_phase<pg8::EpiQKV, pg8::StaticOrder, true, true>(lds, g, S, E); } }
        else if (kind == K_PREP) { if (EN_MLSTM && EN_PREP) qkprep_phase(lds, BIG, KA(mlstm_conv), (bf16_t*)(ws + WS_QC), (bf16_t*)(ws + WS_KC), (bf16_t*)(ws + WS_KCT)); if (EN_SGU) sgu_phase(lds, BIG, KA(sgu_norm), KA(sgu_ws), KA(sgu_b), A1); }
        else if (kind == K_MIX0) { if (EN_MLSTM) mlstm_phase(lds, BIG, gates, (const bf16_t*)(ws + WS_QC), (const bf16_t*)(ws + WS_KC), (const bf16_t*)(ws + WS_KCT), Hdir); }
        else if (kind == K_COMB) { if (EN_COMB) combine_phase(Hdir, BIG, KA(mlstm_norm), A1); }
        else if (kind == K_ATTN) { if (EN_ATTN) attn_phase(lds, BIG, KA(attn_sink), A1); }
        else { if (EN_FINAL) final_phase(Hx, KA(final_norm)); }
        }
        if (ph + 1 < hi) {
            if (ph == 0 && USE_CG_FIRST) {
                __syncthreads();
                if (threadIdx.x < 64) { __builtin_amdgcn_fence(__ATOMIC_RELEASE, "agent"); asm volatile("s_waitcnt vmcnt(0)" ::: "memory"); }
                grid.sync();
                if (threadIdx.x < 64) { __builtin_amdgcn_fence(__ATOMIC_ACQUIRE, "agent"); asm volatile("s_waitcnt vmcnt(0)" ::: "memory"); }
                __syncthreads();
            } else {
                for (int srep = 0; srep < NSYNC_REP; ++srep) xcd_barrier(bar);
            }
        }
    }
}

extern "C" void kernel_launch(void* const* d_in, const int* in_sizes, int n_in, void* d_out, int out_size, void* d_ws, size_t ws_size, hipStream_t stream) {
    static int grid = 0;
    if (grid == 0) {
        if (n_in != 20 || out_size != MX * D || ws_size < WS_END) { fprintf(stderr, "kernel_launch: unexpected problem (n_in %d out %d ws %zu need %zu)\n", n_in, out_size, ws_size, (size_t)WS_END); grid = -1; return; }
        int dev = 0, cus = 0, per_cu = 0;
        hipGetDevice(&dev);
        hipDeviceGetAttribute(&cus, hipDeviceAttributeMultiprocessorCount, dev);
        hipFuncSetAttribute((const void*)fwd_kernel, hipFuncAttributeMaxDynamicSharedMemorySize, LDS_BYTES);
        hipOccupancyMaxActiveBlocksPerMultiprocessor(&per_cu, (const void*)fwd_kernel, NTHREADS, LDS_BYTES);
        if (per_cu < 1) { fprintf(stderr, "kernel_launch: occupancy query says %d blocks per CU\n", per_cu); grid = -1; return; }
        grid = cus;
    }
    if (grid < 0) return;
    if (hipMemsetAsync((char*)d_ws + WS_CTL, 0, CTL_BYTES, stream) != hipSuccess) { fprintf(stderr, "kernel_launch: memset failed\n"); return; }
    Args a{};
#ifdef DBG_MEMSET
    hipMemsetAsync(d_ws, 0, WS_END, stream); hipMemsetAsync(d_out, 0, (size_t)out_size * 4, stream);
#endif
    a.x = (const float*)d_in[0]; a.c = (const float*)d_in[1]; a.ctx = (const float*)d_in[2]; a.c_ctx = (const float*)d_in[3]; a.ada_w = (const float*)d_in[4]; a.ada_b = (const float*)d_in[5];
    a.ffn_w_in = (const float*)d_in[6]; a.ffn_w_out = (const float*)d_in[7]; a.even_w_in = (const float*)d_in[8]; a.even_w_out = (const float*)d_in[9];
    a.mlstm_conv = (const float*)d_in[10]; a.mlstm_gate_b = (const float*)d_in[11]; a.mlstm_norm = (const float*)d_in[12]; a.sgu_norm = (const float*)d_in[13]; a.sgu_ws = (const float*)d_in[14]; a.sgu_b = (const float*)d_in[15];
    a.odd_w_qkv = (const float*)d_in[16]; a.odd_w_out = (const float*)d_in[17]; a.attn_sink = (const float*)d_in[18]; a.final_norm = (const float*)d_in[19];
    a.out = (float*)d_out; a.ws = (unsigned char*)d_ws;
#if MK_SINGLE
    a.ph_lo = 0; a.ph_hi = NPHASES;
    { void* args[] = {&a}; hipError_t e = hipLaunchCooperativeKernel((const void*)fwd_kernel, dim3(grid), dim3(NTHREADS), args, LDS_BYTES, stream);
      if (e != hipSuccess) fprintf(stderr, "cooperative launch failed: %s\n", hipGetErrorString(e)); }
#else
    for (int p = 0; p < NPHASES; ++p) { a.ph_lo = p; a.ph_hi = p + 1; void* args[] = {&a};
        hipError_t e = hipLaunchCooperativeKernel((const void*)fwd_kernel, dim3(grid), dim3(NTHREADS), args, LDS_BYTES, stream);
        if (e != hipSuccess) { fprintf(stderr, "launch %d failed: %s\n", p, hipGetErrorString(e)); break; } }
#endif
}
```

```cpp
#include <hip/hip_runtime.h>
#include <hip/hip_cooperative_groups.h>
#include <cstdio>
#include <cstdint>
namespace cg = cooperative_groups;
namespace pg8 {
#define PG8_LAS __attribute__((address_space(3)))
typedef unsigned short bf16_t;
typedef short bf16x8 __attribute__((ext_vector_type(8)));
typedef float f32x4 __attribute__((ext_vector_type(4)));
typedef unsigned u32x4 __attribute__((ext_vector_type(4)));
constexpr int BM = 256, BK = 64, HALF = 128, HTB = HALF * BK * 2  , STAGE_BYTES = 8 * HTB, NXCD = 8, WGM = 8;

__host__ __device__ __forceinline__ int lds_byte(int r, int c) { const int st = (r >> 4) * 2 + (c >> 5), rr = r & 15, cc = c & 31, ob = rr * 64 + cc * 2; return st * 1024 + (ob ^ (((ob >> 9) & 1) << 5)); }
__host__ __device__ __forceinline__ void stage_rc(int b, int& R, int& C) { const int st = b / 1024, sb = b % 1024, swz = sb ^ (((sb >> 9) & 1) << 5); R = (st >> 1) * 16 + swz / 64; C = (st & 1) * 32 + (swz % 64) / 2; }
__host__ __device__ __forceinline__ int perm32(int rho) { const int n = rho >> 4, i = rho & 15; return 8 * (i >> 2) + 4 * n + (i & 3); }

struct Unit { int pm, pn, k0, nt; };
struct Gemm { const bf16_t* A; const bf16_t* Bt; int M, N, K; };

struct StaticOrder {
    int nM, nN, nwg, G, c, ntf;
    __host__ __device__ void init(int M, int N, int G_, int c_, int K_) { nM = M / BM; nN = N / BM; nwg = nM * nN; G = G_; c = c_; ntf = K_ / BK; }
    __host__ __device__ __forceinline__ bool next(int i, Unit& u) const {
        const long L = (long)i * G + c; if (L >= nwg) return false;
        int wgid = (int)L; { const int q = nwg / NXCD, r = nwg % NXCD, xcd = wgid % NXCD, off = wgid / NXCD; wgid = (xcd < r ? xcd * (q + 1) : r * (q + 1) + (xcd - r) * q) + off; }
        const int nig = WGM * nN, gid = wgid / nig, fm = gid * WGM, gsz = (nM - fm) < WGM ? (nM - fm) : WGM;
        u.pm = fm + ((wgid % nig) % gsz); u.pn = (wgid % nig) / gsz; u.k0 = 0; u.nt = ntf; return true;
    }
    __device__ __forceinline__ void a_ready(const Unit&) const {}
    __device__ __forceinline__ void done(const Unit&) const {}
};

struct SplitCtxOrder {
    int nN, G, c, ntf, nctx;
    __host__ __device__ void init(int N, int G_, int c_, int K_, int nctx_) { nN = N / BM; G = G_; c = c_; ntf = K_ / BK; nctx = nctx_; }
    __host__ __device__ __forceinline__ bool next(int i, Unit& u) const {
        const int L = i * G + c, nwg = 64 * nN;
        if (L >= nwg + nctx) return false;
        int wgid = L < nwg ? L : 0; { const int q = nwg / NXCD, xcd = wgid % NXCD, off = wgid / NXCD; wgid = xcd * q + off; }
        const int nig = WGM * nN, gid = wgid / nig, fm = gid * WGM;
        const int pm0 = fm + ((wgid % nig) % WGM), pn0 = (wgid % nig) / WGM;
        const int L2 = L - nwg, tt = L2 >> 1;
        const bool ctxu = L >= nwg;
        Unit r;
        r.pm = ctxu ? 64 + tt / nN : pm0; r.pn = ctxu ? tt % nN : pn0; r.nt = ctxu ? ntf / 2 : ntf; r.k0 = ctxu ? (L2 & 1) * (ntf / 2) * BK : 0;
        u = r; return true;
    }
    __device__ __forceinline__ void a_ready(const Unit&) const {}
    __device__ __forceinline__ void done(const Unit&) const {}
};

__device__ __forceinline__ unsigned cvt_pk_bf16(float lo, float hi) { unsigned r; asm volatile("v_cvt_pk_bf16_f32 %0, %1, %2" : "=v"(r) : "v"(lo), "v"(hi)); return r; }
typedef float f32x2 __attribute__((ext_vector_type(2)));
template <class Epi, class Sched, bool ALIGN_EPI = false, bool SP2 = false>
__device__ __forceinline__ void gemm_phase(PG8_LAS unsigned char* lds, const Gemm g, const Sched& S, const Epi& E) {
    int tid_ = threadIdx.x; asm volatile("" : "+v"(tid_)); const int tid = tid_, wid = __builtin_amdgcn_readfirstlane(tid >> 6), lane = tid & 63, wr = wid >> 2, wc = wid & 3, fr = lane & 15, fq = lane >> 4;
    const int K = g.K;
    unsigned voffA[2], voffB[2];
#pragma unroll
    for (int i = 0; i < 2; ++i) { int R, C; stage_rc(tid * 16 + i * 8192, R, C); const int Rb = Epi::PERM ? ((R & ~31) + perm32(R & 31)) : R;
        voffA[i] = (unsigned)(R * K + C) * 2u; voffB[i] = (unsigned)(Rb * K + C) * 2u; }
    const size_t kstep = (size_t)(BK * 2);
    const size_t hstep = (size_t)HALF * K * 2;
    const size_t tstep = 2 * hstep;
    const unsigned ldsw = (unsigned)wid * 1024u;
    const int aoff = lds_byte(wr * 64 + fr, fq * 8), boff = lds_byte(wc * 32 + fr, fq * 8);
#define PG8_SA(b, h) (((b) * 2 + (h)) * HTB)
#define PG8_SB(b, h) ((4 + (b) * 2 + (h)) * HTB)
#define PG8_STAGE(bufoff, gbase, voff) do { _Pragma("unroll") for (int _i = 0; _i < 2; ++_i) \
        __builtin_amdgcn_global_load_lds((const unsigned*)((const char*)(gbase) + (voff)[_i]), (PG8_LAS unsigned*)(lds + (bufoff) + ldsw + _i * 8192), 16, 0, 0); } while (0)
#define PG8_LDA(dst, b, h) do { _Pragma("unroll") for (int m = 0; m < 4; ++m) _Pragma("unroll") for (int k = 0; k < 2; ++k) dst[m][k] = *(const PG8_LAS bf16x8*)(lds + PG8_SA(b, h) + aoff + m * 2048 + k * 1024); } while (0)
#define PG8_LDB(dst, b, h) do { _Pragma("unroll") for (int n = 0; n < 2; ++n) _Pragma("unroll") for (int k = 0; k < 2; ++k) dst[n][k] = *(const PG8_LAS bf16x8*)(lds + PG8_SB(b, h) + boff + n * 2048 + k * 1024); } while (0)
#define PG8_MMA(ai, bj, At, Bt) do { __builtin_amdgcn_s_setprio(1); _Pragma("unroll") for (int m = 0; m < 4; ++m) _Pragma("unroll") for (int n = 0; n < 2; ++n) _Pragma("unroll") for (int k = 0; k < 2; ++k) \
        acc[ai][bj][m][n] = __builtin_amdgcn_mfma_f32_16x16x32_bf16(Bt[n][k], At[m][k], acc[ai][bj][m][n], 0, 0, 0); __builtin_amdgcn_s_setprio(0); } while (0)
#define PG8_WAIT_V(n) asm volatile("s_waitcnt vmcnt(" #n ")" ::: "memory")
#define PG8_WAIT_L(n) asm volatile("s_waitcnt lgkmcnt(" #n ")" ::: "memory")
#define PG8_BAR __builtin_amdgcn_s_barrier()
#define PG8_SCHED __builtin_amdgcn_sched_barrier(0)
    Unit cur, nxt; int ui = 0;
    if (!S.next(0, cur)) return;
    f32x4 acc[2][2][4][2];
#pragma unroll
    for (int a = 0; a < 2; ++a)
#pragma unroll
        for (int b = 0; b < 2; ++b)
#pragma unroll
            for (int m = 0; m < 4; ++m)
#pragma unroll
                for (int n = 0; n < 2; ++n) acc[a][b][m][n] = (f32x4){0.f, 0.f, 0.f, 0.f};
    bf16x8 At[4][2], B0[2][2], B1[2][2];
    const char* cA = (const char*)g.A + (size_t)cur.pm * tstep + (size_t)cur.k0 * 2; const char* cB = (const char*)g.Bt + (size_t)cur.pn * tstep + (size_t)cur.k0 * 2;
    S.a_ready(cur);
    if constexpr (SP2) {
        PG8_STAGE(PG8_SB(0, 0), cB, voffB); PG8_STAGE(PG8_SB(0, 1), cB + hstep, voffB); PG8_STAGE(PG8_SA(0, 0), cA, voffA); PG8_STAGE(PG8_SA(0, 1), cA + hstep, voffA);
        if (wr == 1) PG8_BAR;
        PG8_WAIT_V(2); PG8_BAR;
        PG8_STAGE(PG8_SB(1, 0), cB + kstep, voffB); PG8_STAGE(PG8_SA(1, 0), cA + kstep, voffA); PG8_STAGE(PG8_SB(1, 1), cB + hstep + kstep, voffB);
        PG8_WAIT_V(6); PG8_BAR;
    } else {
        PG8_STAGE(PG8_SB(0, 0), cB, voffB); PG8_STAGE(PG8_SA(0, 0), cA, voffA); PG8_STAGE(PG8_SB(0, 1), cB + hstep, voffB); PG8_STAGE(PG8_SA(0, 1), cA + hstep, voffA);
        if (wr == 1) PG8_BAR;
        PG8_WAIT_V(4); PG8_BAR;
        PG8_STAGE(PG8_SB(1, 0), cB + kstep, voffB); PG8_STAGE(PG8_SA(1, 0), cA + kstep, voffA); PG8_STAGE(PG8_SB(1, 1), cB + hstep + kstep, voffB);
        PG8_WAIT_V(6); PG8_BAR;
    }
    for (;;) {
        const bool has_next = S.next(ui + 1, nxt);
        const char* nA = has_next ? (const char*)g.A + (size_t)nxt.pm * tstep + (size_t)nxt.k0 * 2 : cA; const char* nB = has_next ? (const char*)g.Bt + (size_t)nxt.pn * tstep + (size_t)nxt.k0 * 2 : cB;
        const int nt = cur.nt;
        for (int t = 0; t < nt; t += 2) {
            const bool last = (t == nt - 2);
            const char* a1 = cA + (size_t)(t + 1) * kstep;
            const char* a2 = last ? nA : cA + (size_t)(t + 2) * kstep; const char* b2 = last ? nB : cB + (size_t)(t + 2) * kstep;
            const char* a3 = a2 + kstep; const char* b3 = b2 + kstep;
            if (last && has_next) S.a_ready(nxt);
            if constexpr (SP2) {
            PG8_LDB(B0, 0, 0); PG8_LDB(B1, 0, 1); PG8_SCHED; PG8_LDA(At, 0, 0); PG8_STAGE(PG8_SA(1, 1), a1 + hstep, voffA);
            PG8_WAIT_V(8); PG8_WAIT_L(0); PG8_BAR; PG8_MMA(0, 0, At, B0); PG8_MMA(0, 1, At, B1); PG8_BAR; PG8_SCHED;
            PG8_LDA(At, 0, 1); PG8_STAGE(PG8_SB(0, 0), b2, voffB); PG8_STAGE(PG8_SB(0, 1), b2 + hstep, voffB); PG8_STAGE(PG8_SA(0, 0), a2, voffA);
            PG8_WAIT_V(8); PG8_WAIT_L(0); PG8_BAR; PG8_MMA(1, 0, At, B0); PG8_MMA(1, 1, At, B1); PG8_BAR; PG8_SCHED;
            PG8_LDB(B0, 1, 0); PG8_LDB(B1, 1, 1); PG8_SCHED; PG8_LDA(At, 1, 0); PG8_STAGE(PG8_SA(0, 1), a2 + hstep, voffA);
            PG8_WAIT_V(8); PG8_WAIT_L(0); PG8_BAR; PG8_MMA(0, 0, At, B0); PG8_MMA(0, 1, At, B1); PG8_BAR; PG8_SCHED;
            PG8_LDA(At, 1, 1); PG8_STAGE(PG8_SB(1, 0), b3, voffB); PG8_STAGE(PG8_SB(1, 1), b3 + hstep, voffB); PG8_STAGE(PG8_SA(1, 0), a3, voffA);
            PG8_WAIT_V(8); PG8_WAIT_L(0); PG8_BAR; PG8_MMA(1, 0, At, B0); PG8_MMA(1, 1, At, B1); PG8_BAR; PG8_SCHED;
            } else {
            PG8_LDB(B0, 0, 0); PG8_SCHED; PG8_LDA(At, 0, 0); PG8_STAGE(PG8_SA(1, 1), a1 + hstep, voffA);
            PG8_WAIT_L(8); PG8_BAR; PG8_WAIT_L(0); PG8_MMA(0, 0, At, B0); PG8_BAR; PG8_SCHED;
            PG8_LDB(B1, 0, 1); PG8_STAGE(PG8_SB(0, 0), b2, voffB);
            PG8_BAR; PG8_WAIT_L(0); PG8_MMA(0, 1, At, B1); PG8_BAR;
            PG8_LDA(At, 0, 1); PG8_STAGE(PG8_SA(0, 0), a2, voffA);
            PG8_BAR; PG8_WAIT_L(0); PG8_MMA(1, 0, At, B0); PG8_BAR; PG8_SCHED;
            PG8_STAGE(PG8_SB(0, 1), b2 + hstep, voffB);
            PG8_WAIT_V(6); PG8_BAR; PG8_MMA(1, 1, At, B1); PG8_BAR;
            PG8_LDB(B0, 1, 0); PG8_SCHED; PG8_LDA(At, 1, 0); PG8_STAGE(PG8_SA(0, 1), a2 + hstep, voffA);
            PG8_WAIT_L(8); PG8_BAR; PG8_WAIT_L(0); PG8_MMA(0, 0, At, B0); PG8_BAR; PG8_SCHED;
            PG8_LDB(B1, 1, 1); PG8_STAGE(PG8_SB(1, 0), b3, voffB);
            PG8_BAR; PG8_WAIT_L(0); PG8_MMA(0, 1, At, B1); PG8_BAR;
            PG8_LDA(At, 1, 1); PG8_STAGE(PG8_SA(1, 0), a3, voffA);
            PG8_BAR; PG8_WAIT_L(0); PG8_MMA(1, 0, At, B0); PG8_BAR; PG8_SCHED;
            PG8_STAGE(PG8_SB(1, 1), b3 + hstep, voffB);
            PG8_WAIT_V(6); PG8_BAR; PG8_MMA(1, 1, At, B1); PG8_BAR;
            }
        }
        if constexpr (ALIGN_EPI) { if (wr == 0) PG8_BAR; }
        if constexpr (!Epi::AFTER_DRAIN) { E(acc, cur, wr, wc, fr, fq); S.done(cur); }
        if (!has_next) break;
#pragma unroll
        for (int a = 0; a < 2; ++a)
#pragma unroll
            for (int b = 0; b < 2; ++b)
#pragma unroll
                for (int m = 0; m < 4; ++m)
#pragma unroll
                    for (int n = 0; n < 2; ++n) acc[a][b][m][n] = (f32x4){0.f, 0.f, 0.f, 0.f};
        cur = nxt; cA = nA; cB = nB; ++ui;
        if constexpr (ALIGN_EPI) { if (wr == 1) PG8_BAR; }
    }
    PG8_WAIT_V(0);
    if constexpr (!ALIGN_EPI) { if (wr == 0) PG8_BAR; }
    PG8_BAR;
    if constexpr (Epi::AFTER_DRAIN) { E.fused(acc, cur, wr, wc, fr, fq, lds, wid, lane); S.done(cur); }
#undef PG8_SA
#undef PG8_SB
#undef PG8_STAGE
#undef PG8_LDA
#undef PG8_LDB
#undef PG8_MMA
#undef PG8_WAIT_V
#undef PG8_WAIT_L
#undef PG8_BAR
#undef PG8_SCHED
}
}
#define LAS __attribute__((address_space(3)))
typedef unsigned short bf16_t;
typedef short bf16x8 __attribute__((ext_vector_type(8)));
typedef float f32x4 __attribute__((ext_vector_type(4)));
typedef float f32x2 __attribute__((ext_vector_type(2)));
typedef unsigned u32x4 __attribute__((ext_vector_type(4)));
typedef unsigned u32x2 __attribute__((ext_vector_type(2)));

constexpr int D = 1024, NB = 8, SEQ = 2048, CTXL = 256, DFF = 2816;
constexpr int MX = NB * SEQ;
constexpr int MC = NB * CTXL;
constexpr int MT = MX + MC;
constexpr int NMOD = 9;
constexpr int NEV = 3072;
constexpr int NQKV = 1536;
constexpr float EPS = 1e-6f;
constexpr int LDS_BYTES = 147456;
constexpr int NTHREADS = 512;

constexpr size_t MiB = 1u << 20;
constexpr size_t SZ_WIN = (size_t)5632 * 1024 * 2, SZ_WOUT = (size_t)1024 * 2816 * 2;
constexpr size_t WS_WIN = 0;
constexpr size_t WS_WOUT = WS_WIN + 4 * SZ_WIN;
constexpr size_t WS_WEIN = WS_WOUT + 4 * SZ_WOUT;
constexpr size_t WS_WEOUT = WS_WEIN + (size_t)3072 * 1024 * 2;
constexpr size_t WS_WQKV = WS_WEOUT + (size_t)1024 * 1024 * 2;
constexpr size_t WS_WOOUT = WS_WQKV + (size_t)1536 * 1024 * 2;
constexpr size_t WS_MOD = WS_WOOUT + (size_t)1024 * 1024 * 2;
constexpr size_t WS_WG = WS_MOD + (size_t)2 * 9 * 9216 * 4;
constexpr size_t WS_ROPE = WS_WG + (size_t)16 * 1024 * 4;
constexpr size_t WS_GATES = WS_ROPE + 8192;
constexpr size_t WS_HC = WS_GATES + (size_t)MT * 16 * 4;
constexpr size_t WS_A0 = ((WS_HC + (size_t)MC * D * 4 + 255) / 256) * 256;
constexpr size_t WS_QC = WS_A0 + (size_t)MT * D * 2;
constexpr size_t WS_KC = WS_QC + (size_t)MT * 512 * 2;
constexpr size_t WS_KCT = WS_KC + (size_t)MT * 512 * 2;
constexpr size_t WS_A1 = WS_KCT + (size_t)576 * 128 * 128 * 2;
constexpr size_t WS_BIG = WS_A1 + (size_t)MT * D * 2;
constexpr size_t WS_CTL = WS_BIG + (size_t)MT * 3072 * 2;
constexpr size_t CTL_BYTES = 16384;
constexpr size_t WS_PC = WS_CTL + CTL_BYTES;
constexpr size_t WS_END = WS_PC + (size_t)MC * D * 4;

struct Args {
    const float* x; const float* c; const float* ctx; const float* c_ctx; const float* ada_w; const float* ada_b;
    const float* ffn_w_in; const float* ffn_w_out; const float* even_w_in; const float* even_w_out;
    const float* mlstm_conv; const float* mlstm_gate_b; const float* mlstm_norm; const float* sgu_norm; const float* sgu_ws; const float* sgu_b;
    const float* odd_w_qkv; const float* odd_w_out; const float* attn_sink; const float* final_norm;
    float* out; unsigned char* ws; int ph_lo, ph_hi;
};

typedef const __attribute__((address_space(4))) Args* kargp;
__device__ __forceinline__ kargp kargs() { kargp p = (kargp)__builtin_amdgcn_kernarg_segment_ptr(); asm volatile("" : "+s"(p)); return p; }
#define KA(f) (kargs()->f)
typedef __bf16 bf16x2_t __attribute__((ext_vector_type(2)));
__device__ __forceinline__ unsigned pk2(float lo, float hi) { f32x2 v = {lo, hi}; bf16x2_t b = __builtin_convertvector(v, bf16x2_t); return __builtin_bit_cast(unsigned, b); }
__device__ __forceinline__ bf16_t f2bf(float f) { return (bf16_t)(pk2(f, 0.f) & 0xffffu); }
__device__ __forceinline__ float bf2f(bf16_t v) { return __uint_as_float(((unsigned)v) << 16); }
__device__ __forceinline__ float bflo(unsigned w) { return __uint_as_float(w << 16); }
__device__ __forceinline__ float bfhi(unsigned w) { return __uint_as_float(w & 0xffff0000u); }
__device__ __forceinline__ float silu_f(float v) { return v * __builtin_amdgcn_rcpf(1.f + __expf(-v)); }
__device__ __forceinline__ float sigmoid_f(float v) { return __builtin_amdgcn_rcpf(1.f + __expf(-v)); }
__device__ __forceinline__ float gelu_tanh(float v) {
    const float z = 0.7978845608028654f * (v + 0.044715f * v * v * v);
    const float t = 1.f - 2.f * __builtin_amdgcn_rcpf(1.f + __expf(2.f * z));
    return 0.5f * v * (1.f + t);
}
template <int CTRL> __device__ __forceinline__ float dppf(float v) { return __builtin_bit_cast(float, __builtin_amdgcn_update_dpp(0, __builtin_bit_cast(int, v), CTRL, 0xf, 0xf, false)); }
__device__ __forceinline__ float row16_sum(float v) { v += dppf<0xB1>(v); v += dppf<0x4E>(v); v += dppf<0x141>(v); v += dppf<0x140>(v); return v; }
__device__ __forceinline__ float row16_max(float v) { v = fmaxf(v, dppf<0xB1>(v)); v = fmaxf(v, dppf<0x4E>(v)); v = fmaxf(v, dppf<0x141>(v)); v = fmaxf(v, dppf<0x140>(v)); return v; }
__device__ __forceinline__ float wave_sum(float v) { v = row16_sum(v); v += __shfl_xor(v, 16); v += __shfl_xor(v, 32); return v; }
__device__ __forceinline__ float wave_max(float v) { v = row16_max(v); v = fmaxf(v, __shfl_xor(v, 16)); v = fmaxf(v, __shfl_xor(v, 32)); return v; }
__device__ __forceinline__ f32x4 mfma16(bf16x8 a, bf16x8 b, f32x4 c) { return __builtin_amdgcn_mfma_f32_16x16x32_bf16(a, b, c, 0, 0, 0); }
__device__ __forceinline__ bf16x8 ldsfrag(const LAS unsigned char* p) { return *(const LAS bf16x8*)p; }

namespace pg8 {
struct EpiSwiglu {
    static constexpr bool PERM = true, AFTER_DRAIN = false;
    bf16_t* O;
    __device__ __forceinline__ void operator()(const f32x4 (&acc)[2][2][4][2], const Unit& u, int wr, int wc, int fr, int fq) const {
        const int row0 = u.pm * BM + wr * 64 + fr, col0 = u.pn * 128 + wc * 32 + 8 * fq;
#pragma unroll
        for (int ai = 0; ai < 2; ++ai)
#pragma unroll
            for (int m = 0; m < 4; ++m) {
                bf16_t* rowp = O + (size_t)(row0 + ai * HALF + m * 16) * DFF + col0;
                const f32x4 g0 = acc[ai][0][m][0], g1 = acc[ai][0][m][1], u0 = acc[ai][1][m][0], u1 = acc[ai][1][m][1];
                u32x4 w;
                w.x = ::pk2(::silu_f(g0[0]) * u0[0], ::silu_f(g0[1]) * u0[1]); w.y = ::pk2(::silu_f(g0[2]) * u0[2], ::silu_f(g0[3]) * u0[3]);
                w.z = ::pk2(::silu_f(g1[0]) * u1[0], ::silu_f(g1[1]) * u1[1]); w.w = ::pk2(::silu_f(g1[2]) * u1[2], ::silu_f(g1[3]) * u1[3]);
                *(u32x4*)rowp = w;
            }
    }
};
struct EpiResid {
    static constexpr bool PERM = false, AFTER_DRAIN = false;
    const float* bx; const float* bc; float* ox; float* oc; float* pc; const float* gate;
    float coef;
    __device__ __forceinline__ void operator()(const f32x4 (&acc)[2][2][4][2], const Unit& u, int wr, int wc, int fr, int fq) const {
        const bool isx = u.pm < 64; const bool split = u.k0 != 0;
        const int bi = isx ? (u.pm >> 3) : 8;
        const float* base = isx ? bx : bc - (size_t)MX * D;
        float* outp = isx ? ox : oc - (size_t)MX * D;
        const int row0 = u.pm * BM + wr * 64 + fr, col0 = u.pn * BM + wc * 32 + 4 * fq;
        const float* gp = gate + (size_t)bi * 9216 + col0;
#pragma unroll
        for (int bj = 0; bj < 2; ++bj)
#pragma unroll
            for (int n = 0; n < 2; ++n) {
                const f32x4 gv = *(const f32x4*)(gp + bj * HALF + n * 16) * coef;
#pragma unroll
                for (int ai = 0; ai < 2; ++ai)
#pragma unroll
                    for (int m = 0; m < 4; ++m) {
                        const size_t off = (size_t)(row0 + ai * HALF + m * 16) * D + col0 + bj * HALF + n * 16;
                        const f32x4 pv = gv * acc[ai][bj][m][n];
                        if (split) {
                            *(f32x4*)(pc + off - (size_t)MX * D) = pv;
                        } else {
                            const f32x4 b = *(const f32x4*)(base + off);
                            *(f32x4*)(outp + off) = b + pv;
                        }
                        if (m & 1) asm volatile("" ::: "memory");
                    }
            }
    }
};
struct EpiPlain {
    static constexpr bool PERM = true, AFTER_DRAIN = false;
    bf16_t* O; int ldc;
    __device__ __forceinline__ void operator()(const f32x4 (&acc)[2][2][4][2], const Unit& u, int wr, int wc, int fr, int fq) const {
        const int row0 = u.pm * BM + wr * 64 + fr, col0 = u.pn * BM + wc * 32 + 8 * fq;
#pragma unroll
        for (int ai = 0; ai < 2; ++ai)
#pragma unroll
            for (int m = 0; m < 4; ++m) {
                bf16_t* rowp = O + (size_t)(row0 + ai * HALF + m * 16) * ldc + col0;
#pragma unroll
                for (int bj = 0; bj < 2; ++bj) {
                    const f32x4 v0 = acc[ai][bj][m][0], v1 = acc[ai][bj][m][1];
                    u32x4 w; w.x = ::pk2(v0[0], v0[1]); w.y = ::pk2(v0[2], v0[3]); w.z = ::pk2(v1[0], v1[1]); w.w = ::pk2(v1[2], v1[3]);
                    *(u32x4*)(rowp + bj * HALF) = w;
                }
            }
    }
};
struct EpiQKV {
    static constexpr bool PERM = true, AFTER_DRAIN = false;
    bf16_t* O; const float* rope;
    __device__ __forceinline__ void operator()(const f32x4 (&acc)[2][2][4][2], const Unit& u, int wr, int wc, int fr, int fq) const {
        const int row0 = u.pm * BM + wr * 64 + fr;
        const bool isx = u.pm < 64;
#pragma unroll
        for (int bj = 0; bj < 2; ++bj) {
            const int col0 = u.pn * BM + bj * HALF + wc * 32 + 8 * fq;
            const bool dorope = isx && (col0 < 1280);
            const float qs = (col0 < 1024) ? 0.125f : 1.f;
            const int p0 = (col0 & 63) >> 1;
            const int f0 = p0 & 15;
#pragma unroll
            for (int ai = 0; ai < 2; ++ai)
#pragma unroll
                for (int m = 0; m < 4; ++m) {
                    const int row = row0 + ai * HALF + m * 16;
                    f32x4 v0 = acc[ai][bj][m][0] * qs, v1 = acc[ai][bj][m][1] * qs;
                    if (dorope) {
                        const int t = row & 2047;
                        const int pos = (p0 < 16) ? (t >> 6) : (t & 63);
                        const f32x4 cs0 = *(const f32x4*)(rope + (pos * 16 + f0) * 2), cs1 = *(const f32x4*)(rope + (pos * 16 + f0) * 2 + 4);
                        f32x4 r0, r1;
                        r0[0] = v0[0] * cs0[0] - v0[1] * cs0[1]; r0[1] = v0[0] * cs0[1] + v0[1] * cs0[0];
                        r0[2] = v0[2] * cs0[2] - v0[3] * cs0[3]; r0[3] = v0[2] * cs0[3] + v0[3] * cs0[2];
                        r1[0] = v1[0] * cs1[0] - v1[1] * cs1[1]; r1[1] = v1[0] * cs1[1] + v1[1] * cs1[0];
                        r1[2] = v1[2] * cs1[2] - v1[3] * cs1[3]; r1[3] = v1[2] * cs1[3] + v1[3] * cs1[2];
                        v0 = r0; v1 = r1;
                    }
                    u32x4 w; w.x = ::pk2(v0[0], v0[1]); w.y = ::pk2(v0[2], v0[3]); w.z = ::pk2(v1[0], v1[1]); w.w = ::pk2(v1[2], v1[3]);
                    *(u32x4*)(O + (size_t)row * NQKV + col0) = w;
                }
        }
    }
};
}

__device__ __forceinline__ void tr_item(const float* W, int ldw, int k0, int srccol0, bf16_t* WT, int K, int destrow0, LAS float* scr, int lane) {
#pragma unroll 8
    for (int i = 0; i < 32; ++i) { const int kk = 2 * i + (lane >> 5); scr[kk * 33 + (lane & 31)] = W[(size_t)(k0 + kk) * ldw + srccol0 + (lane & 31)]; }
    asm volatile("s_waitcnt lgkmcnt(0)" ::: "memory");
    const int c = lane & 7;
#pragma unroll
    for (int j = 0; j < 4; ++j) { const int n = (lane >> 3) + 8 * j; const LAS float* s = scr + (8 * c) * 33 + n;
        u32x4 o; o.x = pk2(s[0 * 33], s[1 * 33]); o.y = pk2(s[2 * 33], s[3 * 33]); o.z = pk2(s[4 * 33], s[5 * 33]); o.w = pk2(s[6 * 33], s[7 * 33]);
        *(u32x4*)(WT + (size_t)(destrow0 + n) * K + k0 + 8 * c) = o; }
    asm volatile("s_waitcnt lgkmcnt(0)" ::: "memory");
}

__device__ __forceinline__ void convert_group(LAS unsigned char* lds, int grp, int worker, int nworkers) {
    int tid_ = threadIdx.x; asm volatile("" : "+v"(tid_)); const int tid = tid_, lane = tid & 63, wid = __builtin_amdgcn_readfirstlane(tid >> 6);
    unsigned char* ws = KA(ws);
    LAS float* scr = (LAS float*)(lds + wid * 16384);
    constexpr int I_IN = 16 * 176, I_OUT = 44 * 32, I_EIN = 16 * 96, I_SQ = 16 * 32, I_QKV = 16 * 48;
    const int n2 = grp == 1 ? I_EIN : (grp == 2 ? I_QKV : 0), n3 = (grp == 1 || grp == 2) ? I_SQ : 0;
    const int total = I_IN + I_OUT + n2 + n3;
    for (int it = worker + wid; it < total; it += nworkers) {
        int r = it;
        if (r < I_IN) { const int kb = r / 176, nb = r % 176; const int n0 = nb * 32;
            const int dest = (n0 < 2816) ? ((n0 >> 7) * 256 + (n0 & 127)) : ((((n0 - 2816) >> 7) * 256) + 128 + ((n0 - 2816) & 127));
            tr_item(KA(ffn_w_in) + (size_t)grp * 1024 * 5632, 5632, kb * 64, n0, (bf16_t*)(ws + WS_WIN + grp * SZ_WIN), 1024, dest, scr, lane); continue; }
        r -= I_IN;
        if (r < I_OUT) { const int kb = r / 32, nb = r % 32;
            tr_item(KA(ffn_w_out) + (size_t)grp * 2816 * 1024, 1024, kb * 64, nb * 32, (bf16_t*)(ws + WS_WOUT + grp * SZ_WOUT), 2816, nb * 32, scr, lane); continue; }
        r -= I_OUT;
        if (r < n2) {
            if (grp == 1) { const int kb = r / 96, nb = r % 96; const int src = nb < 64 ? nb * 32 : 2064 + (nb - 64) * 32;
                tr_item(KA(even_w_in), 3088, kb * 64, src, (bf16_t*)(ws + WS_WEIN), 1024, nb * 32, scr, lane); }
            else { const int kb = r / 48, nb = r % 48; tr_item(KA(odd_w_qkv), 1536, kb * 64, nb * 32, (bf16_t*)(ws + WS_WQKV), 1024, nb * 32, scr, lane); }
            continue; }
        r -= n2;
        { const int kb = r / 32, nb = r % 32;
          if (grp == 1) tr_item(KA(even_w_out), 1024, kb * 64, nb * 32, (bf16_t*)(ws + WS_WEOUT), 1024, nb * 32, scr, lane);
          else tr_item(KA(odd_w_out), 1024, kb * 64, nb * 32, (bf16_t*)(ws + WS_WOOUT), 1024, nb * 32, scr, lane); }
    }
}

__device__ __forceinline__ void p0_phase(LAS unsigned char* lds) {
    int tid_ = threadIdx.x; asm volatile("" : "+v"(tid_)); const int tid = tid_, lane = tid & 63, wid = __builtin_amdgcn_readfirstlane(tid >> 6), G = gridDim.x;
    unsigned char* ws = KA(ws);
    {
        LAS float* s = (LAS float*)lds;
        LAS float* red = (LAS float*)(lds + 36864);
        for (int i = tid; i < 9 * 1024; i += NTHREADS) { const float v = (i < 8192) ? KA(c)[i] : KA(c_ctx)[i - 8192]; s[i] = v / (1.f + expf(-v)); }
        __syncthreads();
        float* mod = (float*)(ws + WS_MOD);
        for (int tile = blockIdx.x; tile < 288; tile += G) {
            const int l = tile / 144, cg = tile % 144, n = cg * 64 + lane, kg = wid;
            float acc[9];
#pragma unroll
            for (int bi = 0; bi < 9; ++bi) acc[bi] = 0.f;
            const float* wp = KA(ada_w) + ((size_t)l * 1024 + kg * 128) * 9216 + n;
#pragma unroll 4
            for (int kk = 0; kk < 128; ++kk) {
                const float w = wp[(size_t)kk * 9216];
#pragma unroll
                for (int bi = 0; bi < 9; ++bi) acc[bi] += s[bi * 1024 + kg * 128 + kk] * w;
            }
#pragma unroll
            for (int bi = 0; bi < 9; ++bi) red[(kg * 9 + bi) * 64 + lane] = acc[bi];
            __syncthreads();
            for (int i = tid; i < 576; i += NTHREADS) {
                const int bi = i >> 6, cc = i & 63; float sum = 0.f;
#pragma unroll
                for (int k2 = 0; k2 < 8; ++k2) sum += red[(k2 * 9 + bi) * 64 + cc];
                mod[((size_t)l * 9 + bi) * 9216 + cg * 64 + cc] = sum + KA(ada_b)[l * 9216 + cg * 64 + cc];
            }
            __syncthreads();
        }
    }
    {
        const int gt = blockIdx.x * NTHREADS + tid, GT = G * NTHREADS;
        float* wg = (float*)(ws + WS_WG);
        for (int i = gt; i < 16 * 1024; i += GT) { const int g = i >> 10, k = i & 1023; wg[i] = KA(even_w_in)[(size_t)k * 3088 + 2048 + g]; }
        float* rope = (float*)(ws + WS_ROPE);
        for (int i = gt; i < 64 * 16; i += GT) { const int pos = i >> 4, f = i & 15; const float inv = powf(10000.f, -(float)f / 16.f); const float ang = (float)pos * inv; rope[2 * i] = cosf(ang); rope[2 * i + 1] = sinf(ang); }
    }
    convert_group(lds, 0, blockIdx.x * 8, G * 8);
    if (G <= 64) { convert_group(lds, 1, blockIdx.x * 8, G * 8); convert_group(lds, 2, blockIdx.x * 8, G * 8); convert_group(lds, 3, blockIdx.x * 8, G * 8); }
}

template <bool GATES>
__device__ __forceinline__ void norm_phase(LAS unsigned char* lds, const float* hx, const float* hc, bf16_t* A0, const float* modl, int shift_i, int scale_i, int nrows,
                                           const float* wg, const float* gate_b, float* gates, float* copy_c) {
    int tid_ = threadIdx.x; asm volatile("" : "+v"(tid_)); const int tid = tid_, lane = tid & 63, wid = __builtin_amdgcn_readfirstlane(tid >> 6), G = gridDim.x;
    LAS float* wgs = (LAS float*)lds;
    if (GATES) { for (int i = tid; i < 16 * 1024 / 4; i += NTHREADS) ((LAS f32x4*)wgs)[i] = ((const f32x4*)wg)[i]; __syncthreads(); }
    const int R0 = blockIdx.x * 8 + wid, RS = G * 8;
    f32x4 vn[4], pn[4];
#define NORM_LOAD(R_) do { const bool isx_ = (R_) < MX; const float* src_ = isx_ ? hx + (size_t)(R_) * D : hc + (size_t)((R_) - MX) * D; \
        _Pragma("unroll") for (int j = 0; j < 4; ++j) { vn[j] = *(const f32x4*)(src_ + 256 * j + 4 * lane); \
            pn[j] = (copy_c && !isx_) ? *(const f32x4*)(copy_c + (size_t)((R_) - MX) * D + 256 * j + 4 * lane) : (f32x4){0.f, 0.f, 0.f, 0.f}; } } while (0)
    if (R0 < nrows) NORM_LOAD(R0);
    for (int R = R0; R < nrows; R += RS) {
        const bool isx = R < MX;
        const int bi = isx ? (R >> 11) : 8;
        const float* mb = modl + (size_t)bi * 9216;
        f32x4 v[4]; float ss = 0.f;
#pragma unroll
        for (int j = 0; j < 4; ++j) { v[j] = vn[j] + pn[j];
            if (copy_c && !isx) *(f32x4*)((float*)hc + (size_t)(R - MX) * D + 256 * j + 4 * lane) = v[j];
            ss += (v[j][0] * v[j][0] + v[j][1] * v[j][1]) + (v[j][2] * v[j][2] + v[j][3] * v[j][3]); }
        if (R + RS < nrows) NORM_LOAD(R + RS);
        const float rstd = 1.0f / sqrtf(wave_sum(ss) * (1.f / D) + EPS);
#pragma unroll
        for (int j = 0; j < 4; ++j) {
            const f32x4 sc = *(const f32x4*)(mb + scale_i * 1024 + 256 * j + 4 * lane), sh = *(const f32x4*)(mb + shift_i * 1024 + 256 * j + 4 * lane);
            v[j] = v[j] * rstd * (sc + 1.f) + sh;
            u32x2 w; w.x = pk2(v[j][0], v[j][1]); w.y = pk2(v[j][2], v[j][3]);
            *(u32x2*)(A0 + (size_t)R * D + 256 * j + 4 * lane) = w;
        }
        if (GATES) {
            float mine = 0.f;
#pragma unroll 1
            for (int g = 0; g < 16; ++g) {
                float d = 0.f;
#pragma unroll
                for (int j = 0; j < 4; ++j) { const f32x4 w = *(const LAS f32x4*)(wgs + g * 1024 + 256 * j + 4 * lane); d += (v[j][0] * w[0] + v[j][1] * w[1]) + (v[j][2] * w[2] + v[j][3] * w[3]); }
                d = wave_sum(d);
                if (lane == g) mine = d;
            }
            if (lane < 16) gates[(size_t)R * 16 + lane] = mine + gate_b[lane];
        }
    }
    if (GATES) __syncthreads();
}

__device__ __forceinline__ void qkprep_phase(LAS unsigned char* lds, const bf16_t* P, const float* convw, bf16_t* Qc, bf16_t* Kc, bf16_t* KcT) {
    int tid_ = threadIdx.x; asm volatile("" : "+v"(tid_)); const int tid = tid_;
    constexpr int LD = 136;
    LAS bf16_t* Tt = (LAS bf16_t*)lds;
    LAS float* cw = (LAS float*)(lds + 34816);
    const int seg = tid & 15;
    for (int unit = blockIdx.x; unit < 576; unit += gridDim.x) {
        const int h = unit & 3, gc = unit >> 2, n = gc % 18, b = gc / 18;
        const int sbase = n < 2 ? MX + b * CTXL : b * SEQ, T = n < 2 ? CTXL : SEQ, t0 = n < 2 ? n * 128 : (n - 2) * 128;
        for (int i = tid; i < 768; i += NTHREADS) { const int qk = i / 384, j = (i % 384) >> 7, ch = i & 127; cw[i] = convw[j * 1024 + qk * 512 + h * 128 + ch]; }
        __syncthreads();
#pragma unroll 1
        for (int it = 0; it < 4; ++it) {
            const int l = (tid + NTHREADS * it) >> 4;
            const int tin = t0 + l;
            const size_t R = (size_t)(sbase + tin);
            const bf16_t* pr = P + R * NEV + h * 128 + seg * 8;
            const u32x4 z = (u32x4){0u, 0u, 0u, 0u};
#pragma unroll
            for (int qk = 0; qk < 2; ++qk) {
                const bf16_t* pp = pr + qk * 512;
                const u32x4 c0 = *(const u32x4*)pp; const u32x4 pv = tin > 0 ? *(const u32x4*)(pp - NEV) : z; const u32x4 nx = tin < T - 1 ? *(const u32x4*)(pp + NEV) : z;
                float y[8];
#pragma unroll
                for (int hf = 0; hf < 2; ++hf) {
                    const f32x4 w0 = *(const LAS f32x4*)(cw + (qk * 3 + 0) * 128 + seg * 8 + 4 * hf), w1 = *(const LAS f32x4*)(cw + (qk * 3 + 1) * 128 + seg * 8 + 4 * hf), w2v = *(const LAS f32x4*)(cw + (qk * 3 + 2) * 128 + seg * 8 + 4 * hf);
                    y[4 * hf + 0] = w0[0] * bflo(pv[2 * hf]) + w1[0] * bflo(c0[2 * hf]) + w2v[0] * bflo(nx[2 * hf]);
                    y[4 * hf + 1] = w0[1] * bfhi(pv[2 * hf]) + w1[1] * bfhi(c0[2 * hf]) + w2v[1] * bfhi(nx[2 * hf]);
                    y[4 * hf + 2] = w0[2] * bflo(pv[2 * hf + 1]) + w1[2] * bflo(c0[2 * hf + 1]) + w2v[2] * bflo(nx[2 * hf + 1]);
                    y[4 * hf + 3] = w0[3] * bfhi(pv[2 * hf + 1]) + w1[3] * bfhi(c0[2 * hf + 1]) + w2v[3] * bfhi(nx[2 * hf + 1]);
                }
                const float scl = qk ? 0.08838834764831845f : 1.f;
                u32x4 o;
#pragma unroll
                for (int w2 = 0; w2 < 4; ++w2) o[w2] = pk2(silu_f(y[2 * w2]) * scl, silu_f(y[2 * w2 + 1]) * scl);
                *(u32x4*)((qk ? Kc : Qc) + R * 512 + h * 128 + seg * 8) = o;
                if (qk) {
#pragma unroll
                    for (int w2 = 0; w2 < 4; ++w2) { Tt[(seg * 8 + 2 * w2) * LD + l] = (bf16_t)(o[w2] & 0xffffu); Tt[(seg * 8 + 2 * w2 + 1) * LD + l] = (bf16_t)(o[w2] >> 16); }
                }
            }
        }
        __syncthreads();
#pragma unroll
        for (int it = 0; it < 4; ++it) { const int i = tid + NTHREADS * it; const int d = i >> 4, sg = i & 15;
            *(u32x4*)(KcT + ((size_t)unit * 128 + d) * 128 + sg * 8) = *(const LAS u32x4*)(Tt + d * LD + sg * 8); }
        __syncthreads();
    }
}

__device__ __forceinline__ void mlstm_phase(LAS unsigned char* lds, const bf16_t* P, const float* gates, const bf16_t* Qc, const bf16_t* Kc, const bf16_t* KcT, bf16_t* Hdir) {
    int tid_ = threadIdx.x; asm volatile("" : "+v"(tid_)); const int tid = tid_, lane = tid & 63, wid = __builtin_amdgcn_readfirstlane(tid >> 6), r = lane & 15, q = lane >> 4;
    constexpr int LD = 136, LDB = LD * 2;
    constexpr int OFF_Q = 0, OFF_K = 34816, OFF_KT = 69632, OFF_VT = 104448, OFF_VW = 113152, OFF_CT = 121856, OFF_SC = 130560;
    LAS bf16_t* Qs = (LAS bf16_t*)(lds + OFF_Q); LAS bf16_t* Ks = (LAS bf16_t*)(lds + OFF_K); LAS bf16_t* Kt = (LAS bf16_t*)(lds + OFF_KT);
    LAS bf16_t* Vt = (LAS bf16_t*)(lds + OFF_VT); LAS bf16_t* Vw = (LAS bf16_t*)(lds + OFF_VW); LAS bf16_t* Ct = (LAS bf16_t*)(lds + OFF_CT);
    LAS float* sc = (LAS float*)(lds + OFF_SC);
    LAS float* qn = sc + 1536; LAS float* nvec = sc + 1664;
    for (int unit = blockIdx.x; unit < 256; unit += gridDim.x) {
        const int es = unit & 3, dir = (unit >> 2) & 1, h = (unit >> 3) & 3, b = unit >> 5;
        for (int i = tid; i < 32 * LD / 2; i += NTHREADS) ((LAS unsigned*)Ct)[i] = 0u;
        if (tid < 128) nvec[tid] = 0.f;
        f32x4 Cacc[2]; Cacc[0] = (f32x4){0.f, 0.f, 0.f, 0.f}; Cacc[1] = Cacc[0];
        float m_state = 0.f;
        u32x4 pq[4], pvv; float pgi[2], pgf[2];
        const unsigned voffq = (unsigned)(((tid >> 4) * 512 + (tid & 15) * 8) * 2), vofft = (unsigned)(((tid >> 4) * 128 + (tid & 15) * 8) * 2);
#define MLSTM_CHUNK_INFO(ci_, n_, gc_, rb_) do { if ((ci_) < 2) n_ = dir ? 1 - (ci_) : (ci_); else n_ = dir ? 19 - (ci_) : (ci_); gc_ = b * 18 + n_; rb_ = n_ < 2 ? MX + b * CTXL + n_ * 128 : b * SEQ + (n_ - 2) * 128; } while (0)
#define MLSTM_PREFETCH(ci_) do { int n2, gc2, rb2; MLSTM_CHUNK_INFO(ci_, n2, gc2, rb2); \
            const bf16_t* qg = Qc + (size_t)rb2 * 512 + h * 128; (void)gc2; \
            _Pragma("unroll") for (int it = 0; it < 4; ++it) { \
                pq[it] = *(const u32x4*)((const char*)(qg + it * 16384) + voffq); } \
            pvv = *(const u32x4*)(P + (size_t)(rb2 + (tid >> 2)) * NEV + 1024 + h * 128 + es * 32 + (tid & 3) * 8); } while (0)
#define MLSTM_LOAD_GATES(ci_) do { int n3, gc3, rb3; MLSTM_CHUNK_INFO(ci_, n3, gc3, rb3); (void)gc3; \
            _Pragma("unroll") for (int hf = 0; hf < 2; ++hf) { const int l = lane + 64 * hf; const int R = rb3 + (dir ? 127 - l : l); \
                pgi[hf] = gates[(size_t)R * 16 + dir * 8 + h]; pgf[hf] = gates[(size_t)R * 16 + dir * 8 + 4 + h]; } } while (0)
#define MLSTM_SCALARS(D_) do { LAS float* rowf_ = (D_); LAS float* dmb_ = (D_) + 128; LAS float* inter_ = (D_) + 256; LAS float* wl_ = (D_) + 384; LAS float* en_ = (D_) + 512; LAS float* misc_ = (D_) + 640; \
            float ig[2], bc[2]; \
            _Pragma("unroll") for (int hf = 0; hf < 2; ++hf) { ig[hf] = pgi[hf]; const float fg = pgf[hf]; bc[hf] = fminf(fg, 0.f) - log1pf(expf(-fabsf(fg))); } \
            _Pragma("unroll") for (int off = 1; off < 64; off <<= 1) { const float t0 = __shfl_up(bc[0], off), t1 = __shfl_up(bc[1], off); if (lane >= off) { bc[0] += t0; bc[1] += t1; } } \
            bc[1] += __shfl(bc[0], 63); \
            const float g_ = __shfl(bc[1], 63); \
            const float d0 = ig[0] - bc[0], d1 = ig[1] - bc[1]; \
            float p0 = d0, p1 = d1; \
            _Pragma("unroll") for (int off = 1; off < 64; off <<= 1) { const float t0 = __shfl_up(p0, off), t1 = __shfl_up(p1, off); if (lane >= off) { p0 = fmaxf(p0, t0); p1 = fmaxf(p1, t1); } } \
            p1 = fmaxf(p1, __shfl(p0, 63)); \
            const float a0 = g_ + d0, a1 = g_ + d1; \
            const float mloc = wave_max(fmaxf(a0, a1)); \
            const float m_new = fmaxf(g_ + m_state, mloc); \
            const float dec_ = expf(g_ + m_state - m_new); \
            const float mt0 = bc[0] + fmaxf(m_state, p0), mt1 = bc[1] + fmaxf(m_state, p1); \
            const int i0 = dir ? 127 - lane : lane, i1 = dir ? 63 - lane : lane + 64; \
            rowf_[i0] = bc[0] - mt0; rowf_[i1] = bc[1] - mt1; \
            dmb_[i0] = d0; dmb_[i1] = d1; \
            inter_[i0] = expf(bc[0] + m_state - mt0); inter_[i1] = expf(bc[1] + m_state - mt1); \
            wl_[i0] = expf(a0 - m_new); wl_[i1] = expf(a1 - m_new); \
            en_[i0] = expf(-mt0); en_[i1] = expf(-mt1); \
            if (lane == 0) misc_[0] = dec_; \
            m_state = m_new; } while (0)
        const bool swave = wid == (dir ? 7 : 0);
        if (swave) { MLSTM_LOAD_GATES(0); MLSTM_SCALARS(sc); MLSTM_LOAD_GATES(1); }
        MLSTM_PREFETCH(0);
        __syncthreads();
        for (int ci = 0; ci < 18; ++ci) {
            int wc_ = wid, dc_ = dir; asm volatile("" : "+s"(wc_), "+s"(dc_)); const int widc = wc_, dirc = dc_;
            int n, gc, rbase;
            MLSTM_CHUNK_INFO(ci, n, gc, rbase);
            LAS float* scb = sc + (ci & 1) * 768;
            LAS float* rowf = scb; LAS float* dmb = scb + 128; LAS float* inter = scb + 256; LAS float* wl = scb + 384; LAS float* en = scb + 512; LAS float* misc = scb + 640;
            u32x4 pk[4], pt[4];
            { const bf16_t* kg = Kc + (size_t)rbase * 512 + h * 128; const bf16_t* tg = KcT + (size_t)(gc * 4 + h) * 128 * 128;
#pragma unroll
              for (int it = 0; it < 4; ++it) pk[it] = *(const u32x4*)((const char*)(kg + it * 16384) + voffq);
#pragma unroll
              for (int it = 0; it < 4; ++it) pt[it] = *(const u32x4*)((const char*)(tg + it * 4096) + vofft); }
#pragma unroll
            for (int it = 0; it < 4; ++it) { const int i = tid + NTHREADS * it; const int row = i >> 4, sg = i & 15; *(LAS u32x4*)(Qs + row * LD + sg * 8) = pq[it]; }
#pragma unroll
            for (int it = 0; it < 4; ++it) { const int i = tid + NTHREADS * it; const int row = i >> 4, sg = i & 15; *(LAS u32x4*)(Ks + row * LD + sg * 8) = pk[it]; }
            __syncthreads();
            const float dec = misc[0];
            {
                const int t = tid >> 2, sg = tid & 3;
                const u32x4 vv = pvv;
                const float w = wl[t];
#pragma unroll
                for (int w2 = 0; w2 < 4; ++w2) {
                    Vt[(sg * 8 + 2 * w2) * LD + t] = (bf16_t)(vv[w2] & 0xffffu); Vt[(sg * 8 + 2 * w2 + 1) * LD + t] = (bf16_t)(vv[w2] >> 16);
                    Vw[(sg * 8 + 2 * w2) * LD + t] = f2bf(bflo(vv[w2]) * w); Vw[(sg * 8 + 2 * w2 + 1) * LD + t] = f2bf(bfhi(vv[w2]) * w);
                }
            }
            f32x4 sacc[8];
            {
                bf16x8 af[4];
#pragma unroll
                for (int ks = 0; ks < 4; ++ks) af[ks] = ldsfrag(lds + OFF_Q + (16 * wid + r) * LDB + (32 * ks + 8 * q) * 2);
#pragma unroll
                for (int jb = 0; jb < 8; ++jb) {
                    sacc[jb] = (f32x4){0.f, 0.f, 0.f, 0.f};
                    if (dirc ? (jb >= widc) : (jb <= widc)) {
#pragma unroll
                        for (int ks = 0; ks < 4; ++ks) sacc[jb] = mfma16(af[ks], ldsfrag(lds + OFF_K + (16 * jb + r) * LDB + (32 * ks + 8 * q) * 2), sacc[jb]);
                    }
                }
            }
            {
                const int t = tid >> 2, part = tid & 3; float s = 0.f;
#pragma unroll
                for (int i = 0; i < 4; ++i) {
                    const u32x4 qv = *(const LAS u32x4*)(Qs + t * LD + part * 32 + i * 8);
                    const f32x4 n0 = *(const LAS f32x4*)(nvec + part * 32 + i * 8), n1 = *(const LAS f32x4*)(nvec + part * 32 + i * 8 + 4);
                    s += bflo(qv[0]) * n0[0] + bfhi(qv[0]) * n0[1] + bflo(qv[1]) * n0[2] + bfhi(qv[1]) * n0[3] + bflo(qv[2]) * n1[0] + bfhi(qv[2]) * n1[1] + bflo(qv[3]) * n1[2] + bfhi(qv[3]) * n1[3];
                }
                s += dppf<0xB1>(s); s += dppf<0x4E>(s);
                if (part == 0) qn[t] = s;
            }
#pragma unroll
            for (int it = 0; it < 4; ++it) { const int i = tid + NTHREADS * it; *(LAS u32x4*)(Kt + (i >> 4) * LD + (i & 15) * 8) = pt[it]; }
            __syncthreads();
            if (swave && ci + 1 < 18) { MLSTM_SCALARS(sc + ((ci + 1) & 1) * 768); if (ci + 2 < 18) MLSTM_LOAD_GATES(ci + 2); }
            LAS bf16_t* Ss = Ks;
            float rs[4] = {0.f, 0.f, 0.f, 0.f};
            {
                const f32x4 rf = *(const LAS f32x4*)(rowf + 16 * wid + 4 * q);
                const int zb = dirc ? ((widc & 1) ? widc - 1 : -1) : ((widc & 1) ? -1 : widc + 1);
#pragma unroll
                for (int jb = 0; jb < 8; ++jb) {
                    if (dirc ? (jb >= widc) : (jb <= widc)) {
                        const int s = 16 * jb + r; const float dm = dmb[s];
#pragma unroll
                        for (int reg = 0; reg < 4; ++reg) { const int t = 16 * wid + 4 * q + reg;
                            const bool ok = dirc ? (s >= t) : (s <= t);
                            const float v = ok ? sacc[jb][reg] * __expf(rf[reg] + dm) : 0.f;
                            rs[reg] += v; Ss[t * LD + s] = f2bf(v); }
                    } else if (jb == zb) {
#pragma unroll
                        for (int reg = 0; reg < 4; ++reg) Ss[(16 * wid + 4 * q + reg) * LD + 16 * jb + r] = 0;
                    }
                }
#pragma unroll
                for (int reg = 0; reg < 4; ++reg) rs[reg] = row16_sum(rs[reg]);
            }
            {
                const int kh = widc >> 1;
                const f32x4 it4 = *(const LAS f32x4*)(inter + 16 * wid + 4 * q), qn4 = *(const LAS f32x4*)(qn + 16 * wid + 4 * q), en4 = *(const LAS f32x4*)(en + 16 * wid + 4 * q);
                bf16x8 qf[4];
#pragma unroll
                for (int ks = 0; ks < 4; ++ks) qf[ks] = ldsfrag(lds + OFF_Q + (16 * wid + r) * LDB + (32 * ks + 8 * q) * 2);
#pragma unroll
                for (int nt = 0; nt < 2; ++nt) {
                    f32x4 a1 = (f32x4){0.f, 0.f, 0.f, 0.f}, a2 = a1;
#pragma unroll
                    for (int ks = 0; ks < 4; ++ks) {
                        if (dirc ? (ks >= kh) : (ks <= kh)) a1 = mfma16(ldsfrag(lds + OFF_K + (16 * wid + r) * LDB + (32 * ks + 8 * q) * 2), ldsfrag(lds + OFF_VT + (16 * nt + r) * LDB + (32 * ks + 8 * q) * 2), a1);
                        a2 = mfma16(qf[ks], ldsfrag(lds + OFF_CT + (16 * nt + r) * LDB + (32 * ks + 8 * q) * 2), a2);
                    }
#pragma unroll
                    for (int reg = 0; reg < 4; ++reg) {
                        const int t = 16 * wid + 4 * q + reg;
                        const float den = rs[reg] + it4[reg] * qn4[reg];
                        const float hv = (a1[reg] + it4[reg] * a2[reg]) / fmaxf(fabsf(den), en4[reg]);
                        Hdir[((size_t)dir * MT + rbase + t) * 512 + h * 128 + es * 32 + 16 * nt + r] = f2bf(hv);
                    }
                }
            }
            asm volatile("" ::: "memory");
            if (ci + 1 < 18) MLSTM_PREFETCH(ci + 1);
            asm volatile("" ::: "memory");
            {
                bf16x8 kf[4];
#pragma unroll
                for (int ks = 0; ks < 4; ++ks) kf[ks] = ldsfrag(lds + OFF_KT + (16 * wid + r) * LDB + (32 * ks + 8 * q) * 2);
#pragma unroll
                for (int nt = 0; nt < 2; ++nt) {
                    Cacc[nt] = Cacc[nt] * dec;
#pragma unroll
                    for (int ks = 0; ks < 4; ++ks) Cacc[nt] = mfma16(kf[ks], ldsfrag(lds + OFF_VW + (16 * nt + r) * LDB + (32 * ks + 8 * q) * 2), Cacc[nt]);
                }
            }
            float nnew;
            {
                const int d = tid >> 2, part = tid & 3; float s = 0.f;
#pragma unroll
                for (int i = 0; i < 4; ++i) {
                    const u32x4 kv = *(const LAS u32x4*)(Kt + d * LD + part * 32 + i * 8);
                    const f32x4 w0 = *(const LAS f32x4*)(wl + part * 32 + i * 8), w1 = *(const LAS f32x4*)(wl + part * 32 + i * 8 + 4);
                    s += bflo(kv[0]) * w0[0] + bfhi(kv[0]) * w0[1] + bflo(kv[1]) * w0[2] + bfhi(kv[1]) * w0[3] + bflo(kv[2]) * w1[0] + bfhi(kv[2]) * w1[1] + bflo(kv[3]) * w1[2] + bfhi(kv[3]) * w1[3];
                }
                s += dppf<0xB1>(s); s += dppf<0x4E>(s);
                nnew = dec * nvec[d] + s;
            }
            __syncthreads();
#pragma unroll
            for (int nt = 0; nt < 2; ++nt) { u32x2 w; w.x = pk2(Cacc[nt][0], Cacc[nt][1]); w.y = pk2(Cacc[nt][2], Cacc[nt][3]); *(LAS u32x2*)(Ct + (16 * nt + r) * LD + 16 * wid + 4 * q) = w; }
            if ((tid & 3) == 0) nvec[tid >> 2] = nnew;
        }
        __syncthreads();
    }
}

__device__ __forceinline__ void sgu_phase(LAS unsigned char* lds, const bf16_t* P, const float* sgu_norm, const float* sgu_ws, const float* sgu_b, bf16_t* A1) {
    int tid_ = threadIdx.x; asm volatile("" : "+v"(tid_)); const int tid = tid_, lane = tid & 63, wid = __builtin_amdgcn_readfirstlane(tid >> 6), r = lane & 15, q = lane >> 4;
    constexpr int LD = 136, LDB = LD * 2, OFF_W = 0, OFF_V = 34816, OFF_R = 69632;
    LAS bf16_t* Ws = (LAS bf16_t*)(lds + OFF_W); LAS bf16_t* Vt = (LAS bf16_t*)(lds + OFF_V); LAS float* rstd = (LAS float*)(lds + OFF_R);
    for (int unit = (int)gridDim.x - 1 - (int)blockIdx.x; unit < 144; unit += gridDim.x) {
        const int n = unit % 18, b = unit / 18;
        const int rbase = n < 2 ? MX + b * CTXL + n * 128 : b * SEQ + (n - 2) * 128;
        {
            const int tok = tid >> 2, part = tid & 3; float ss = 0.f;
            const bf16_t* pv = P + (size_t)(rbase + tok) * NEV + 2560 + part * 128;
#pragma unroll 4
            for (int i = 0; i < 16; ++i) { const u32x4 w = *(const u32x4*)(pv + i * 8);
#pragma unroll
                for (int k = 0; k < 4; ++k) { const float a0 = gelu_tanh(bflo(w[k])), a1 = gelu_tanh(bfhi(w[k])); ss += a0 * a0 + a1 * a1; } }
            ss += dppf<0xB1>(ss); ss += dppf<0x4E>(ss);
            if (part == 0) rstd[tok] = 1.0f / sqrtf(ss * (1.f / 512.f) + EPS);
        }
#pragma unroll 1
        for (int g = 0; g < 4; ++g) {
#pragma unroll
            for (int it = 0; it < 4; ++it) { const int i = tid + NTHREADS * it; const int p = i >> 4, sg = i & 15;
                const float* wp = sgu_ws + ((size_t)g * 128 + p) * 128 + sg * 8; const f32x4 w0 = *(const f32x4*)wp, w1 = *(const f32x4*)(wp + 4);
                u32x4 o; o.x = pk2(w0[0], w0[1]); o.y = pk2(w0[2], w0[3]); o.z = pk2(w1[0], w1[1]); o.w = pk2(w1[2], w1[3]);
                *(LAS u32x4*)(Ws + p * LD + sg * 8) = o; }
            if (g == 0) __syncthreads();
#pragma unroll
            for (int it = 0; it < 4; ++it) { const int i = tid + NTHREADS * it; const int tq = i >> 4, sg = i & 15;
                const u32x4 w = *(const u32x4*)(P + (size_t)(rbase + tq) * NEV + 2560 + g * 128 + sg * 8);
                const float rq = rstd[tq];
                const f32x4 g0 = *(const f32x4*)(sgu_norm + g * 128 + sg * 8), g1 = *(const f32x4*)(sgu_norm + g * 128 + sg * 8 + 4);
                Vt[(sg * 8 + 0) * LD + tq] = f2bf(gelu_tanh(bflo(w[0])) * rq * g0[0]); Vt[(sg * 8 + 1) * LD + tq] = f2bf(gelu_tanh(bfhi(w[0])) * rq * g0[1]);
                Vt[(sg * 8 + 2) * LD + tq] = f2bf(gelu_tanh(bflo(w[1])) * rq * g0[2]); Vt[(sg * 8 + 3) * LD + tq] = f2bf(gelu_tanh(bfhi(w[1])) * rq * g0[3]);
                Vt[(sg * 8 + 4) * LD + tq] = f2bf(gelu_tanh(bflo(w[2])) * rq * g1[0]); Vt[(sg * 8 + 5) * LD + tq] = f2bf(gelu_tanh(bfhi(w[2])) * rq * g1[1]);
                Vt[(sg * 8 + 6) * LD + tq] = f2bf(gelu_tanh(bflo(w[3])) * rq * g1[2]); Vt[(sg * 8 + 7) * LD + tq] = f2bf(gelu_tanh(bfhi(w[3])) * rq * g1[3]); }
            __syncthreads();
            {
                bf16x8 wf[4];
#pragma unroll
                for (int ks = 0; ks < 4; ++ks) wf[ks] = ldsfrag(lds + OFF_W + (16 * wid + r) * LDB + (32 * ks + 8 * q) * 2);
                const float sbp = sgu_b[g * 128 + 16 * wid + r];
                const size_t R = (size_t)(rbase + 16 * wid + r);
#pragma unroll
                for (int jb = 0; jb < 8; ++jb) {
                    f32x4 acc = (f32x4){0.f, 0.f, 0.f, 0.f};
#pragma unroll
                    for (int ks = 0; ks < 4; ++ks) acc = mfma16(ldsfrag(lds + OFF_V + (16 * jb + r) * LDB + (32 * ks + 8 * q) * 2), wf[ks], acc);
                    const u32x2 uu = *(const u32x2*)(P + R * NEV + 2048 + g * 128 + 16 * jb + 4 * q);
                    u32x2 w; w.x = pk2(gelu_tanh(bflo(uu.x)) * (acc[0] + sbp), gelu_tanh(bfhi(uu.x)) * (acc[1] + sbp)); w.y = pk2(gelu_tanh(bflo(uu.y)) * (acc[2] + sbp), gelu_tanh(bfhi(uu.y)) * (acc[3] + sbp));
                    *(u32x2*)(A1 + R * D + 512 + g * 128 + 16 * jb + 4 * q) = w;
                }
            }
            __syncthreads();
        }
    }
}

__device__ __forceinline__ void combine_phase(const bf16_t* Hdir, const bf16_t* P, const float* mnorm, bf16_t* A1) {
    int tid_ = threadIdx.x; asm volatile("" : "+v"(tid_)); const int tid = tid_, lane = tid & 63, wid = __builtin_amdgcn_readfirstlane(tid >> 6);
    for (int R = blockIdx.x * 8 + wid; R < MT; R += gridDim.x * 8) {
        const int col = lane * 8;
        const u32x4 h0 = *(const u32x4*)(Hdir + (size_t)R * 512 + col), h1 = *(const u32x4*)(Hdir + ((size_t)MT + R) * 512 + col);
        float a[8];
#pragma unroll
        for (int k = 0; k < 4; ++k) { a[2 * k] = bflo(h0[k]) + bflo(h1[k]); a[2 * k + 1] = bfhi(h0[k]) + bfhi(h1[k]); }
        float ss = 0.f;
#pragma unroll
        for (int k = 0; k < 8; ++k) ss += a[k] * a[k];
        ss = row16_sum(ss);
        const float rstd = 1.0f / sqrtf(ss * (1.f / 128.f) + EPS);
        const f32x4 m0 = *(const f32x4*)(mnorm + col), m1 = *(const f32x4*)(mnorm + col + 4);
        const u32x4 ov = *(const u32x4*)(P + (size_t)R * NEV + 1536 + col);
        u32x4 w;
        w.x = pk2(sigmoid_f(bflo(ov[0])) * a[0] * rstd * m0[0], sigmoid_f(bfhi(ov[0])) * a[1] * rstd * m0[1]);
        w.y = pk2(sigmoid_f(bflo(ov[1])) * a[2] * rstd * m0[2], sigmoid_f(bfhi(ov[1])) * a[3] * rstd * m0[3]);
        w.z = pk2(sigmoid_f(bflo(ov[2])) * a[4] * rstd * m1[0], sigmoid_f(bfhi(ov[2])) * a[5] * rstd * m1[1]);
        w.w = pk2(sigmoid_f(bflo(ov[3])) * a[6] * rstd * m1[2], sigmoid_f(bfhi(ov[3])) * a[7] * rstd * m1[3]);
        *(u32x4*)(A1 + (size_t)R * D + col) = w;
    }
}

__device__ __forceinline__ void attn_phase(LAS unsigned char* lds, const bf16_t* QKV, const float* sink, bf16_t* A1) {
    int tid_ = threadIdx.x; asm volatile("" : "+v"(tid_)); const int tid = tid_, lane = tid & 63, wid = __builtin_amdgcn_readfirstlane(tid >> 6), r = lane & 15, q = lane >> 4;
    constexpr int LK = 72, LKB = LK * 2, OFF_K = 0, OFF_V = 9216, OFF_P = 18432, PSZ = 64 * LKB;
    LAS bf16_t* Ks = (LAS bf16_t*)(lds + OFF_K); LAS bf16_t* Vt = (LAS bf16_t*)(lds + OFF_V);
    LAS bf16_t* Ps = (LAS bf16_t*)(lds + OFF_P + wid * PSZ);
    const LAS unsigned char* Pb = lds + OFF_P + wid * PSZ;
    for (int unit = blockIdx.x; unit < 512; unit += gridDim.x) {
        asm volatile("" : "+s"(QKV), "+s"(A1));
        const int hk = unit & 3, j = (unit >> 2) & 15, b = unit >> 6;
        const int g = wid >> 1, hq = hk * 4 + g, tok0 = (wid & 1) * 64;
        const int qrow0 = b * SEQ + j * 128 + tok0;
        bf16x8 qf[4][2];
#pragma unroll
        for (int mt = 0; mt < 4; ++mt)
#pragma unroll
            for (int ks = 0; ks < 2; ++ks) qf[mt][ks] = *(const bf16x8*)(QKV + (size_t)(qrow0 + 16 * mt + r) * NQKV + hq * 64 + 32 * ks + 8 * q);
        float mrun[4], lrun[4]; f32x4 oacc[4][4];
        const float sk = sink[hq];
#pragma unroll
        for (int mt = 0; mt < 4; ++mt) { mrun[mt] = sk; lrun[mt] = 1.f;
#pragma unroll
            for (int dt = 0; dt < 4; ++dt) oacc[dt][mt] = (f32x4){0.f, 0.f, 0.f, 0.f}; }
        const int tfirst = 0, tlast = (j == 15) ? 7 : 9;
        u32x4 kvn, vvn;
        const unsigned voffk = (unsigned)(((tid >> 3) * NQKV + (tid & 7) * 8) * 2);
#define ATTN_TILE_ROW(ti_) ((ti_) < 4 ? MX + b * CTXL + (ti_) * 64 : b * SEQ + (j - 1 + (((ti_) - 4) >> 1)) * 128 + (((ti_) - 4) & 1) * 64)
#define ATTN_LOAD(ti_) do { const char* kp_ = (const char*)(QKV + (size_t)ATTN_TILE_ROW(ti_) * NQKV + 1024 + hk * 64); kvn = *(const u32x4*)(kp_ + voffk); vvn = *(const u32x4*)(kp_ + 512 + voffk); } while (0)
        ATTN_LOAD(tfirst);
        for (int ti = tfirst; ti <= tlast; ++ti) {
            if (j == 0 && (ti == 4 || ti == 5)) continue;
            int kpos0; bool band;
            if (ti < 4) { kpos0 = 0; band = false; }
            else { const int kb = j - 1 + ((ti - 4) >> 1); kpos0 = kb * 128 + ((ti - 4) & 1) * 64; band = (kb != j); }
            __syncthreads();
            {
                const int key = tid >> 3, sg = tid & 7;
                *(LAS u32x4*)(Ks + key * LK + sg * 8) = kvn;
#pragma unroll
                for (int w2 = 0; w2 < 4; ++w2) { Vt[(sg * 8 + 2 * w2) * LK + key] = (bf16_t)(vvn[w2] & 0xffffu); Vt[(sg * 8 + 2 * w2 + 1) * LK + key] = (bf16_t)(vvn[w2] >> 16); }
            }
            { int tn = ti + 1; if (j == 0 && tn == 4) tn = 6; if (tn <= tlast) ATTN_LOAD(tn); }
            __syncthreads();
            {
#pragma unroll
                for (int mt = 0; mt < 4; ++mt) {
                    f32x4 s[4];
#pragma unroll
                    for (int nt = 0; nt < 4; ++nt) { f32x4 a = (f32x4){0.f, 0.f, 0.f, 0.f}; a = mfma16(ldsfrag(lds + OFF_K + (16 * nt + r) * LKB + (8 * q) * 2), qf[mt][0], a); a = mfma16(ldsfrag(lds + OFF_K + (16 * nt + r) * LKB + (32 + 8 * q) * 2), qf[mt][1], a); s[nt] = a; }
                    if (band) {
                        const int qp = j * 128 + tok0 + 16 * mt + r;
#pragma unroll
                        for (int nt = 0; nt < 4; ++nt)
#pragma unroll
                            for (int i = 0; i < 4; ++i) { const int df = qp - (kpos0 + 16 * nt + 4 * q + i); if (df > 128 || df < -128) s[nt][i] = -1e30f; }
                    }
                    float mx = fmaxf(fmaxf(fmaxf(s[0][0], s[0][1]), fmaxf(s[0][2], s[0][3])), fmaxf(fmaxf(s[1][0], s[1][1]), fmaxf(s[1][2], s[1][3])));
                    mx = fmaxf(mx, fmaxf(fmaxf(fmaxf(s[2][0], s[2][1]), fmaxf(s[2][2], s[2][3])), fmaxf(fmaxf(s[3][0], s[3][1]), fmaxf(s[3][2], s[3][3]))));
                    mx = fmaxf(mx, __shfl_xor(mx, 16)); mx = fmaxf(mx, __shfl_xor(mx, 32));
                    const float mn = fmaxf(mrun[mt], mx), alpha = __expf(mrun[mt] - mn);
                    float rsum = 0.f;
#pragma unroll
                    for (int nt = 0; nt < 4; ++nt) {
                        const float p0 = __expf(s[nt][0] - mn), p1 = __expf(s[nt][1] - mn), p2 = __expf(s[nt][2] - mn), p3 = __expf(s[nt][3] - mn);
                        rsum += (p0 + p1) + (p2 + p3);
                        u32x2 w; w.x = pk2(p0, p1); w.y = pk2(p2, p3);
                        *(LAS u32x2*)(Ps + (16 * mt + r) * LK + 16 * nt + 4 * q) = w;
                    }
                    rsum += __shfl_xor(rsum, 16); rsum += __shfl_xor(rsum, 32);
                    lrun[mt] = lrun[mt] * alpha + rsum; mrun[mt] = mn;
#pragma unroll
                    for (int dt = 0; dt < 4; ++dt) oacc[dt][mt] *= alpha;
                    asm volatile("" ::: "memory");
                }
            }
#pragma unroll
            for (int mt = 0; mt < 4; ++mt) {
                const bf16x8 p0 = ldsfrag(Pb + (16 * mt + r) * LKB + (8 * q) * 2), p1 = ldsfrag(Pb + (16 * mt + r) * LKB + (32 + 8 * q) * 2);
#pragma unroll
                for (int dt = 0; dt < 4; ++dt) {
                    oacc[dt][mt] = mfma16(ldsfrag(lds + OFF_V + (16 * dt + r) * LKB + (8 * q) * 2), p0, oacc[dt][mt]);
                    oacc[dt][mt] = mfma16(ldsfrag(lds + OFF_V + (16 * dt + r) * LKB + (32 + 8 * q) * 2), p1, oacc[dt][mt]);
                }
                asm volatile("" ::: "memory");
            }
        }
#pragma unroll
        for (int mt = 0; mt < 4; ++mt) { const float inv = 1.f / lrun[mt]; const size_t R = (size_t)(qrow0 + 16 * mt + r);
#pragma unroll
            for (int dt = 0; dt < 4; ++dt) { const f32x4 o = oacc[dt][mt] * inv; u32x2 w; w.x = pk2(o[0], o[1]); w.y = pk2(o[2], o[3]);
                *(u32x2*)(A1 + R * D + hq * 64 + 16 * dt + 4 * q) = w; } }
    }
    __syncthreads();
}

__device__ __forceinline__ void final_phase(float* out, const float* fnorm) {
    int tid_ = threadIdx.x; asm volatile("" : "+v"(tid_)); const int tid = tid_, lane = tid & 63, wid = __builtin_amdgcn_readfirstlane(tid >> 6);
    for (int R = blockIdx.x * 8 + wid; R < MX; R += gridDim.x * 8) {
        float* src = out + (size_t)R * D;
        f32x4 v[4]; float ss = 0.f;
#pragma unroll
        for (int j = 0; j < 4; ++j) { v[j] = *(const f32x4*)(src + 256 * j + 4 * lane); ss += (v[j][0] * v[j][0] + v[j][1] * v[j][1]) + (v[j][2] * v[j][2] + v[j][3] * v[j][3]); }
        const float rstd = 1.0f / sqrtf(wave_sum(ss) * (1.f / D) + EPS);
#pragma unroll
        for (int j = 0; j < 4; ++j) { const f32x4 w = *(const f32x4*)(fnorm + 256 * j + 4 * lane); *(f32x4*)(src + 256 * j + 4 * lane) = v[j] * rstd * w; }
    }
}

#define GAS __attribute__((address_space(1)))
typedef GAS unsigned gu32;
#define RLX_AGENT __ATOMIC_RELAXED, __HIP_MEMORY_SCOPE_AGENT
#define XB_TMO      128
#define XB_XCNT(j)  (256  + 64 * (j))
#define XB_XSUB(j)  (1280 + 64 * (j))
#define XB_XGEN(j)  (2304 + 64 * (j))
#define XB_TOP      3328
#define XB_TOPGEN   3392
#define XCD_BAR_WORDS 3456
#define XB_SPIN_CAP (1u << 18)

__device__ __forceinline__ unsigned xb_ld(unsigned* p)              { return __hip_atomic_load(p, __ATOMIC_RELAXED, __HIP_MEMORY_SCOPE_AGENT); }
__device__ __forceinline__ unsigned xb_add(unsigned* p, unsigned v) { return __hip_atomic_fetch_add(p, v, __ATOMIC_RELAXED, __HIP_MEMORY_SCOPE_AGENT); }
__device__ __forceinline__ unsigned xb_xcc_id() { return (unsigned)__builtin_amdgcn_s_getreg((3 << 11) | 20) & 0xFu; }
#define XB_SPIN(cond, bar) do { unsigned _sp = 0; while (cond) { __builtin_amdgcn_s_sleep(1); \
    if ((++_sp & 255u) == 0u) { if (xb_ld(&(bar)[XB_TMO])) break; if (_sp > XB_SPIN_CAP) { atomicAdd(&(bar)[XB_TMO], 1u); break; } } } } while (0)

struct XcdBarrier {
    unsigned* bar; unsigned x;
    volatile LAS unsigned* st;
};

__device__ __forceinline__ XcdBarrier xcd_barrier_post(unsigned* bar, volatile LAS unsigned* st) {
    XcdBarrier b; b.bar = bar; b.x = xb_xcc_id(); b.st = st;
    if (threadIdx.x == 0) (void)xb_add(&bar[XB_XCNT(b.x)], 1u);
    return b;
}
__device__ __forceinline__ void xcd_barrier_complete(unsigned* bar, unsigned x, unsigned& nloc, unsigned& nx) {
    const unsigned G = gridDim.x * gridDim.y * gridDim.z;
    unsigned sum, cnt, mine, sp = 0u;
    for (;;) {
        sum = 0u; cnt = 0u;
#pragma unroll 1
        for (unsigned j = 0; j < 16; ++j) { const unsigned c = xb_ld(&bar[XB_XCNT(j)]); sum += c; cnt += (c > 0u) ? 1u : 0u; }
        mine = xb_ld(&bar[XB_XCNT(x)]);
        if (sum == G) break;
        __builtin_amdgcn_s_sleep(1);
        if ((++sp & 255u) == 0u) { if (xb_ld(&bar[XB_TMO])) break; if (sp > XB_SPIN_CAP) { atomicAdd(&bar[XB_TMO], 1u); break; } }
    }
    nloc = mine > 0u ? mine : 1u; nx = cnt > 0u ? cnt : 1u;
}

__device__ __forceinline__ void xcd_barrier(const XcdBarrier& b) {
    asm volatile("s_waitcnt vmcnt(0)" ::: "memory");
    __syncthreads();
    if (threadIdx.x == 0) {
        unsigned* bar = b.bar;
        __builtin_amdgcn_s_waitcnt(0);
        unsigned nloc = b.st[0], nx = b.st[1];
        if (nloc == 0u) { xcd_barrier_complete(bar, b.x, nloc, nx); b.st[0] = nloc; b.st[1] = nx; }
        const unsigned old = xb_add(&bar[XB_XSUB(b.x)], 1u);
        const unsigned gen = old / nloc;
        if (old + 1u == (gen + 1u) * nloc) {
            __builtin_amdgcn_fence(__ATOMIC_RELEASE, "agent");
            asm volatile("s_waitcnt vmcnt(0)" ::: "memory");
            const unsigned og = xb_add(&bar[XB_TOP], 1u);
            const unsigned tg = og / nx;
            if (og + 1u == (tg + 1u) * nx) xb_add(&bar[XB_TOPGEN], 1u);
            else XB_SPIN(xb_ld(&bar[XB_TOPGEN]) == tg, bar);
            __builtin_amdgcn_fence(__ATOMIC_ACQUIRE, "agent");
            xb_add(&bar[XB_XGEN(b.x)], 1u);
            asm volatile("s_waitcnt vmcnt(0)" ::: "memory");
        } else {
            XB_SPIN(xb_ld(&bar[XB_XGEN(b.x)]) == gen, bar);
            __builtin_amdgcn_fence(__ATOMIC_ACQUIRE, "agent");
            asm volatile("s_waitcnt vmcnt(0)" ::: "memory");
        }
    }
    __syncthreads();
}

#ifndef MK_SINGLE
#define MK_SINGLE 1
#endif
constexpr int NPHASES = 24;
#ifndef EN_PREP
#define EN_PREP 1
#endif
#ifndef REP_MASK
#define REP_MASK 0
#endif
#ifndef USE_CG_FIRST
#define USE_CG_FIRST 0
#endif
#ifndef NSYNC_REP
#define NSYNC_REP 1
#endif
#ifndef EN_ALL
#define EN_ALL 1
#endif
#ifndef EN_P0
#define EN_P0 EN_ALL
#endif
#ifndef EN_NORM
#define EN_NORM EN_ALL
#endif
#ifndef EN_GEMM
#define EN_GEMM (EN_ALL ? 15 : 0)
#endif
#ifndef EN_MLSTM
#define EN_MLSTM EN_ALL
#endif
#ifndef EN_SGU
#define EN_SGU EN_ALL
#endif
#ifndef EN_COMB
#define EN_COMB EN_ALL
#endif
#ifndef EN_ATTN
#define EN_ATTN EN_ALL
#endif
#ifndef EN_FINAL
#define EN_FINAL EN_ALL
#endif
__global__ void __launch_bounds__(NTHREADS, 2) fwd_kernel(Args a_unused) {
    extern __shared__ __attribute__((aligned(16))) unsigned char lds_raw[];
    LAS unsigned char* lds = (LAS unsigned char*)lds_raw;
    cg::grid_group grid = cg::this_grid();
    unsigned char* ws = KA(ws);
    const int G = gridDim.x, c = blockIdx.x;
    float* Hx = KA(out); float* Hc = (float*)(ws + WS_HC);
    bf16_t* A0 = (bf16_t*)(ws + WS_A0); bf16_t* A1 = (bf16_t*)(ws + WS_A1); bf16_t* BIG = (bf16_t*)(ws + WS_BIG);
    bf16_t* Hdir = (bf16_t*)(ws + WS_A0);
    const float* mod = (const float*)(ws + WS_MOD);
    float* gates = (float*)(ws + WS_GATES);
    const int lo = KA(ph_lo), hi = KA(ph_hi);
    volatile LAS unsigned* barst = (volatile LAS unsigned*)(lds + LDS_BYTES - 16);
    if (threadIdx.x < 2) barst[threadIdx.x] = 0u;
    __syncthreads();
    XcdBarrier bar = xcd_barrier_post((unsigned*)(ws + WS_CTL), barst);
    enum { K_P0, K_NORM, K_NORMG, K_SWIGLU, K_RESID, K_PLAIN, K_QKV, K_MIX0, K_COMB, K_ATTN, K_FINAL, K_PREP };
    for (int ph = lo; ph < hi; ++ph) {
        const int layer = ph >= 13 ? 1 : 0;
        const int lp = ph >= 13 ? ph - 13 : ph - 1;
        const float* modl = mod + (size_t)layer * 9 * 9216;
        int kind = K_P0, M = MT, gi = 0, ffn = 0, Kd = 1024; float coef = 1.f;
        const bf16_t* Aop = A0; const bf16_t* Wop = nullptr;
        const float* bxp = Hx; const float* bcp = Hc;
        if (ph == 0) kind = K_P0;
        else if (ph == 23) kind = K_FINAL;
        else if (lp == 0) { kind = K_NORM; gi = 0; if (layer == 0) { bxp = KA(x); bcp = KA(ctx); } }
        else if (lp == 1) { kind = K_SWIGLU; ffn = layer * 2; }
        else if (lp == 2) { kind = K_RESID; Aop = BIG; Wop = (const bf16_t*)(ws + WS_WOUT + (size_t)(layer * 2) * SZ_WOUT); Kd = 2816; gi = 2; coef = 0.5f; if (layer == 0) { bxp = KA(x); bcp = KA(ctx); } }
        else if (layer == 0) {
            if (lp == 3) { kind = K_NORMG; gi = 3; }
            else if (lp == 4) kind = K_PLAIN;
            else if (lp == 5) kind = K_PREP;
            else if (lp == 6) kind = K_MIX0;
            else if (lp == 7) kind = K_COMB;
            else if (lp == 8) { kind = K_RESID; Aop = A1; Wop = (const bf16_t*)(ws + WS_WEOUT); gi = 5; }
            else if (lp == 9) { kind = K_NORM; gi = 6; }
            else if (lp == 10) { kind = K_SWIGLU; ffn = 1; }
            else { kind = K_RESID; Aop = BIG; Wop = (const bf16_t*)(ws + WS_WOUT + SZ_WOUT); Kd = 2816; gi = 8; coef = 0.5f; }
        } else {
            if (lp == 3) { kind = K_NORM; gi = 3; }
            else if (lp == 4) kind = K_QKV;
            else if (lp == 5) kind = K_ATTN;
            else if (lp == 6) { kind = K_RESID; Aop = A1; Wop = (const bf16_t*)(ws + WS_WOOUT); gi = 5; M = MX; }
            else if (lp == 7) { kind = K_NORM; gi = 6; M = MX; }
            else if (lp == 8) { kind = K_SWIGLU; ffn = 3; M = MX; }
            else { kind = K_RESID; Aop = BIG; Wop = (const bf16_t*)(ws + WS_WOUT + 3 * SZ_WOUT); Kd = 2816; gi = 8; coef = 0.5f; M = MX; }
        }
        const int nrep = ((REP_MASK >> kind) & 1) ? 2 : 1;
        for (int rep = 0; rep < nrep; ++rep) {
        if (rep == 1) { if (kind == K_RESID) { bxp = Hx; bcp = Hc; coef = 0.f; } __syncthreads(); }
        if (kind == K_P0) { if (EN_P0) p0_phase(lds); }
        else if (kind == K_NORM) { if (EN_NORM) norm_phase<false>(lds, bxp, bcp, A0, modl, gi, gi + 1, M, nullptr, nullptr, nullptr, (ph > 1 && M == MT) ? (float*)(ws + WS_PC) : nullptr); }
        else if (kind == K_NORMG) { if (EN_NORM) norm_phase<true>(lds, Hx, Hc, A0, modl, gi, gi + 1, M, (const float*)(ws + WS_WG), KA(mlstm_gate_b), gates, (float*)(ws + WS_PC)); }
        else if (kind == K_SWIGLU) { if (EN_GEMM & 1) { pg8::Gemm g{A0, (const bf16_t*)(ws + WS_WIN + (size_t)ffn * SZ_WIN), M, 5632, 1024}; pg8::StaticOrder S; S.init(M, 5632, G, c, 1024); pg8::EpiSwiglu E{BIG};
            pg8::gemm_phase<pg8::EpiSwiglu, pg8::StaticOrder, true, true>(lds, g, S, E); } }
        else if (kind == K_RESID) { if (EN_GEMM & 2) { pg8::Gemm g{Aop, Wop, M, 1024, Kd}; pg8::SplitCtxOrder S; S.init(1024, G, c, Kd, M == MT ? 64 : 0); pg8::EpiResid E{bxp, bcp, Hx, Hc, (float*)(ws + WS_PC), modl + gi * 1024, coef};
            pg8::gemm_phase<pg8::EpiResid, pg8::SplitCtxOrder, true, true>(lds, g, S, E);
            const int cgrp = (rep == 0 && M == MT && Kd == 2816) ? (layer == 0 ? (lp == 2 ? 1 : 2) : 3) : 0;
            if (cgrp != 0 && c >= 64 && G > 64) convert_group(lds, cgrp, (c - 64) * 8, (G - 64) * 8); } }
        else if (kind == K_PLAIN) { if (EN_GEMM & 4) { pg8::Gemm g{A0, (const bf16_t*)(ws + WS_WEIN), MT, NEV, 1024}; pg8::StaticOrder S; S.init(MT, NEV, G, c, 1024); pg8::EpiPlain E{BIG, NEV};
            pg8::gemm_phase<pg8::EpiPlain, pg8::StaticOrder, true, true>(lds, g, S, E); } }
        else if (kind == K_QKV) { if (EN_GEMM & 8) { pg8::Gemm g{A0, (const bf16_t*)(ws + WS_WQKV), MT, NQKV, 1024}; pg8::StaticOrder S; S.init(MT, NQKV, G, c, 1024); pg8::EpiQKV E{BIG, (const float*)(ws + WS_ROPE)};
            pg8::gemm_phase<pg8::EpiQKV, pg8::StaticOrder, true, true>(lds, g, S, E); } }
        else if (kind == K_PREP) { if (EN_MLSTM && EN_PREP) qkprep_phase(lds, BIG, KA(mlstm_conv), (bf16_t*)(ws + WS_QC), (bf16_t*)(ws + WS_KC), (bf16_t*)(ws + WS_KCT)); if (EN_SGU) sgu_phase(lds, BIG, KA(sgu_norm), KA(sgu_ws), KA(sgu_b), A1); }
        else if (kind == K_MIX0) { if (EN_MLSTM) mlstm_phase(lds, BIG, gates, (const bf16_t*)(ws + WS_QC), (const bf16_t*)(ws + WS_KC), (const bf16_t*)(ws + WS_KCT), Hdir); }
        else if (kind == K_COMB) { if (EN_COMB) combine_phase(Hdir, BIG, KA(mlstm_norm), A1); }
        else if (kind == K_ATTN) { if (EN_ATTN) attn_phase(lds, BIG, KA(attn_sink), A1); }
        else { if (EN_FINAL) final_phase(Hx, KA(final_norm)); }
        }
        if (ph + 1 < hi) {
            if (ph == 0 && USE_CG_FIRST) {
                __syncthreads();
                if (threadIdx.x < 64) { __builtin_amdgcn_fence(__ATOMIC_RELEASE, "agent"); asm volatile("s_waitcnt vmcnt(0)" ::: "memory"); }
                grid.sync();
                if (threadIdx.x < 64) { __builtin_amdgcn_fence(__ATOMIC_ACQUIRE, "agent"); asm volatile("s_waitcnt vmcnt(0)" ::: "memory"); }
                __syncthreads();
            } else {
                for (int srep = 0; srep < NSYNC_REP; ++srep) xcd_barrier(bar);
            }
        }
    }
}

extern "C" void kernel_launch(void* const* d_in, const int* in_sizes, int n_in, void* d_out, int out_size, void* d_ws, size_t ws_size, hipStream_t stream) {
    static int grid = 0;
    if (grid == 0) {
        if (n_in != 20 || out_size != MX * D || ws_size < WS_END) { fprintf(stderr, "kernel_launch: unexpected problem (n_in %d out %d ws %zu need %zu)\n", n_in, out_size, ws_size, (size_t)WS_END); grid = -1; return; }
        int dev = 0, cus = 0, per_cu = 0;
        hipGetDevice(&dev);
        hipDeviceGetAttribute(&cus, hipDeviceAttributeMultiprocessorCount, dev);
        hipFuncSetAttribute((const void*)fwd_kernel, hipFuncAttributeMaxDynamicSharedMemorySize, LDS_BYTES);
        hipOccupancyMaxActiveBlocksPerMultiprocessor(&per_cu, (const void*)fwd_kernel, NTHREADS, LDS_BYTES);
        if (per_cu < 1) { fprintf(stderr, "kernel_launch: occupancy query says %d blocks per CU\n", per_cu); grid = -1; return; }
        grid = cus;
    }
    if (grid < 0) return;
    if (hipMemsetAsync((char*)d_ws + WS_CTL, 0, CTL_BYTES, stream) != hipSuccess) { fprintf(stderr, "kernel_launch: memset failed\n"); return; }
    Args a{};
#ifdef DBG_MEMSET
    hipMemsetAsync(d_ws, 0, WS_END, stream); hipMemsetAsync(d_out, 0, (size_t)out_size * 4, stream);
#endif
    a.x = (const float*)d_in[0]; a.c = (const float*)d_in[1]; a.ctx = (const float*)d_in[2]; a.c_ctx = (const float*)d_in[3]; a.ada_w = (const float*)d_in[4]; a.ada_b = (const float*)d_in[5];
    a.ffn_w_in = (const float*)d_in[6]; a.ffn_w_out = (const float*)d_in[7]; a.even_w_in = (const float*)d_in[8]; a.even_w_out = (const float*)d_in[9];
    a.mlstm_conv = (const float*)d_in[10]; a.mlstm_gate_b = (const float*)d_in[11]; a.mlstm_norm = (const float*)d_in[12]; a.sgu_norm = (const float*)d_in[13]; a.sgu_ws = (const float*)d_in[14]; a.sgu_b = (const float*)d_in[15];
    a.odd_w_qkv = (const float*)d_in[16]; a.odd_w_out = (const float*)d_in[17]; a.attn_sink = (const float*)d_in[18]; a.final_norm = (const float*)d_in[19];
    a.out = (float*)d_out; a.ws = (unsigned char*)d_ws;
#if MK_SINGLE
    a.ph_lo = 0; a.ph_hi = NPHASES;
    { void* args[] = {&a}; hipError_t e = hipLaunchCooperativeKernel((const void*)fwd_kernel, dim3(grid), dim3(NTHREADS), args, LDS_BYTES, stream);
      if (e != hipSuccess) fprintf(stderr, "cooperative launch failed: %s\n", hipGetErrorString(e)); }
#else
    for (int p = 0; p < NPHASES; ++p) { a.ph_lo = p; a.ph_hi = p + 1; void* args[] = {&a};
        hipError_t e = hipLaunchCooperativeKernel((const void*)fwd_kernel, dim3(grid), dim3(NTHREADS), args, LDS_BYTES, stream);
        if (e != hipSuccess) { fprintf(stderr, "launch %d failed: %s\n", p, hipGetErrorString(e)); break; } }
#endif
}
```

```cpp
#include <hip/hip_runtime.h>
#include <hip/hip_cooperative_groups.h>
#include <cstdio>
#include <cstdint>
namespace cg = cooperative_groups;
namespace pg8 {
#define PG8_LAS __attribute__((address_space(3)))
typedef unsigned short bf16_t;
typedef short bf16x8 __attribute__((ext_vector_type(8)));
typedef float f32x4 __attribute__((ext_vector_type(4)));
typedef unsigned u32x4 __attribute__((ext_vector_type(4)));
constexpr int BM = 256, BK = 64, HALF = 128, HTB = HALF * BK * 2  , STAGE_BYTES = 8 * HTB, NXCD = 8, WGM = 8;

__host__ __device__ __forceinline__ int lds_byte(int r, int c) { const int st = (r >> 4) * 2 + (c >> 5), rr = r & 15, cc = c & 31, ob = rr * 64 + cc * 2; return st * 1024 + (ob ^ (((ob >> 9) & 1) << 5)); }
__host__ __device__ __forceinline__ void stage_rc(int b, int& R, int& C) { const int st = b / 1024, sb = b % 1024, swz = sb ^ (((sb >> 9) & 1) << 5); R = (st >> 1) * 16 + swz / 64; C = (st & 1) * 32 + (swz % 64) / 2; }
__host__ __device__ __forceinline__ int perm32(int rho) { const int n = rho >> 4, i = rho & 15; return 8 * (i >> 2) + 4 * n + (i & 3); }

struct Unit { int pm, pn, k0, nt; };
struct Gemm { const bf16_t* A; const bf16_t* Bt; int M, N, K; };

struct StaticOrder {
    int nM, nN, nwg, G, c, ntf;
    __host__ __device__ void init(int M, int N, int G_, int c_, int K_) { nM = M / BM; nN = N / BM; nwg = nM * nN; G = G_; c = c_; ntf = K_ / BK; }
    __host__ __device__ __forceinline__ bool next(int i, Unit& u) const {
        const long L = (long)i * G + c; if (L >= nwg) return false;
        int wgid = (int)L; { const int q = nwg / NXCD, r = nwg % NXCD, xcd = wgid % NXCD, off = wgid / NXCD; wgid = (xcd < r ? xcd * (q + 1) : r * (q + 1) + (xcd - r) * q) + off; }
        const int nig = WGM * nN, gid = wgid / nig, fm = gid * WGM, gsz = (nM - fm) < WGM ? (nM - fm) : WGM;
        u.pm = fm + ((wgid % nig) % gsz); u.pn = (wgid % nig) / gsz; u.k0 = 0; u.nt = ntf; return true;
    }
    __device__ __forceinline__ void a_ready(const Unit&) const {}
    __device__ __forceinline__ void done(const Unit&) const {}
};

struct SplitCtxOrder {
    int nN, G, c, ntf, nctx;
    __host__ __device__ void init(int N, int G_, int c_, int K_, int nctx_) { nN = N / BM; G = G_; c = c_; ntf = K_ / BK; nctx = nctx_; }
    __host__ __device__ __forceinline__ bool next(int i, Unit& u) const {
        const int L = i * G + c, nwg = 64 * nN;
        if (L >= nwg + nctx) return false;
        int wgid = L < nwg ? L : 0; { const int q = nwg / NXCD, xcd = wgid % NXCD, off = wgid / NXCD; wgid = xcd * q + off; }
        const int nig = WGM * nN, gid = wgid / nig, fm = gid * WGM;
        const int pm0 = fm + ((wgid % nig) % WGM), pn0 = (wgid % nig) / WGM;
        const int L2 = L - nwg, tt = L2 >> 1;
        const bool ctxu = L >= nwg;
        Unit r;
        r.pm = ctxu ? 64 + tt / nN : pm0; r.pn = ctxu ? tt % nN : pn0; r.nt = ctxu ? ntf / 2 : ntf; r.k0 = ctxu ? (L2 & 1) * (ntf / 2) * BK : 0;
        u = r; return true;
    }
    __device__ __forceinline__ void a_ready(const Unit&) const {}
    __device__ __forceinline__ void done(const Unit&) const {}
};

__device__ __forceinline__ unsigned cvt_pk_bf16(float lo, float hi) { unsigned r; asm volatile("v_cvt_pk_bf16_f32 %0, %1, %2" : "=v"(r) : "v"(lo), "v"(hi)); return r; }
typedef float f32x2 __attribute__((ext_vector_type(2)));
template <class Epi, class Sched, bool ALIGN_EPI = false, bool SP2 = false>
__device__ __forceinline__ void gemm_phase(PG8_LAS unsigned char* lds, const Gemm g, const Sched& S, const Epi& E) {
    int tid_ = threadIdx.x; asm volatile("" : "+v"(tid_)); const int tid = tid_, wid = __builtin_amdgcn_readfirstlane(tid >> 6), lane = tid & 63, wr = wid >> 2, wc = wid & 3, fr = lane & 15, fq = lane >> 4;
    const int K = g.K;
    unsigned voffA[2], voffB[2];
#pragma unroll
    for (int i = 0; i < 2; ++i) { int R, C; stage_rc(tid * 16 + i * 8192, R, C); const int Rb = Epi::PERM ? ((R & ~31) + perm32(R & 31)) : R;
        voffA[i] = (unsigned)(R * K + C) * 2u; voffB[i] = (unsigned)(Rb * K + C) * 2u; }
    const size_t kstep = (size_t)(BK * 2);
    const size_t hstep = (size_t)HALF * K * 2;
    const size_t tstep = 2 * hstep;
    const unsigned ldsw = (unsigned)wid * 1024u;
    const int aoff = lds_byte(wr * 64 + fr, fq * 8), boff = lds_byte(wc * 32 + fr, fq * 8);
#define PG8_SA(b, h) (((b) * 2 + (h)) * HTB)
#define PG8_SB(b, h) ((4 + (b) * 2 + (h)) * HTB)
#define PG8_STAGE(bufoff, gbase, voff) do { _Pragma("unroll") for (int _i = 0; _i < 2; ++_i) \
        __builtin_amdgcn_global_load_lds((const unsigned*)((const char*)(gbase) + (voff)[_i]), (PG8_LAS unsigned*)(lds + (bufoff) + ldsw + _i * 8192), 16, 0, 0); } while (0)
#define PG8_LDA(dst, b, h) do { _Pragma("unroll") for (int m = 0; m < 4; ++m) _Pragma("unroll") for (int k = 0; k < 2; ++k) dst[m][k] = *(const PG8_LAS bf16x8*)(lds + PG8_SA(b, h) + aoff + m * 2048 + k * 1024); } while (0)
#define PG8_LDB(dst, b, h) do { _Pragma("unroll") for (int n = 0; n < 2; ++n) _Pragma("unroll") for (int k = 0; k < 2; ++k) dst[n][k] = *(const PG8_LAS bf16x8*)(lds + PG8_SB(b, h) + boff + n * 2048 + k * 1024); } while (0)
#define PG8_MMA(ai, bj, At, Bt) do { __builtin_amdgcn_s_setprio(1); _Pragma("unroll") for (int m = 0; m < 4; ++m) _Pragma("unroll") for (int n = 0; n < 2; ++n) _Pragma("unroll") for (int k = 0; k < 2; ++k) \
        acc[ai][bj][m][n] = __builtin_amdgcn_mfma_f32_16x16x32_bf16(Bt[n][k], At[m][k], acc[ai][bj][m][n], 0, 0, 0); __builtin_amdgcn_s_setprio(0); } while (0)
#define PG8_WAIT_V(n) asm volatile("s_waitcnt vmcnt(" #n ")" ::: "memory")
#define PG8_WAIT_L(n) asm volatile("s_waitcnt lgkmcnt(" #n ")" ::: "memory")
#define PG8_BAR __builtin_amdgcn_s_barrier()
#define PG8_SCHED __builtin_amdgcn_sched_barrier(0)
    Unit cur, nxt; int ui = 0;
    if (!S.next(0, cur)) return;
    f32x4 acc[2][2][4][2];
#pragma unroll
    for (int a = 0; a < 2; ++a)
#pragma unroll
        for (int b = 0; b < 2; ++b)
#pragma unroll
            for (int m = 0; m < 4; ++m)
#pragma unroll
                for (int n = 0; n < 2; ++n) acc[a][b][m][n] = (f32x4){0.f, 0.f, 0.f, 0.f};
    bf16x8 At[4][2], B0[2][2], B1[2][2];
    const char* cA = (const char*)g.A + (size_t)cur.pm * tstep + (size_t)cur.k0 * 2; const char* cB = (const char*)g.Bt + (size_t)cur.pn * tstep + (size_t)cur.k0 * 2;
    S.a_ready(cur);
    if constexpr (SP2) {
        PG8_STAGE(PG8_SB(0, 0), cB, voffB); PG8_STAGE(PG8_SB(0, 1), cB + hstep, voffB); PG8_STAGE(PG8_SA(0, 0), cA, voffA); PG8_STAGE(PG8_SA(0, 1), cA + hstep, voffA);
        if (wr == 1) PG8_BAR;
        PG8_WAIT_V(2); PG8_BAR;
        PG8_STAGE(PG8_SB(1, 0), cB + kstep, voffB); PG8_STAGE(PG8_SA(1, 0), cA + kstep, voffA); PG8_STAGE(PG8_SB(1, 1), cB + hstep + kstep, voffB);
        PG8_WAIT_V(6); PG8_BAR;
    } else {
        PG8_STAGE(PG8_SB(0, 0), cB, voffB); PG8_STAGE(PG8_SA(0, 0), cA, voffA); PG8_STAGE(PG8_SB(0, 1), cB + hstep, voffB); PG8_STAGE(PG8_SA(0, 1), cA + hstep, voffA);
        if (wr == 1) PG8_BAR;
        PG8_WAIT_V(4); PG8_BAR;
        PG8_STAGE(PG8_SB(1, 0), cB + kstep, voffB); PG8_STAGE(PG8_SA(1, 0), cA + kstep, voffA); PG8_STAGE(PG8_SB(1, 1), cB + hstep + kstep, voffB);
        PG8_WAIT_V(6); PG8_BAR;
    }
    for (;;) {
        const bool has_next = S.next(ui + 1, nxt);
        const char* nA = has_next ? (const char*)g.A + (size_t)nxt.pm * tstep + (size_t)nxt.k0 * 2 : cA; const char* nB = has_next ? (const char*)g.Bt + (size_t)nxt.pn * tstep + (size_t)nxt.k0 * 2 : cB;
        const int nt = cur.nt;
        for (int t = 0; t < nt; t += 2) {
            const bool last = (t == nt - 2);
            const char* a1 = cA + (size_t)(t + 1) * kstep;
            const char* a2 = last ? nA : cA + (size_t)(t + 2) * kstep; const char* b2 = last ? nB : cB + (size_t)(t + 2) * kstep;
            const char* a3 = a2 + kstep; const char* b3 = b2 + kstep;
            if (last && has_next) S.a_ready(nxt);
            if constexpr (SP2) {
            PG8_LDB(B0, 0, 0); PG8_LDB(B1, 0, 1); PG8_SCHED; PG8_LDA(At, 0, 0); PG8_STAGE(PG8_SA(1, 1), a1 + hstep, voffA);
            PG8_WAIT_V(8); PG8_WAIT_L(0); PG8_BAR; PG8_MMA(0, 0, At, B0); PG8_MMA(0, 1, At, B1); PG8_BAR; PG8_SCHED;
            PG8_LDA(At, 0, 1); PG8_STAGE(PG8_SB(0, 0), b2, voffB); PG8_STAGE(PG8_SB(0, 1), b2 + hstep, voffB); PG8_STAGE(PG8_SA(0, 0), a2, voffA);
            PG8_WAIT_V(8); PG8_WAIT_L(0); PG8_BAR; PG8_MMA(1, 0, At, B0); PG8_MMA(1, 1, At, B1); PG8_BAR; PG8_SCHED;
            PG8_LDB(B0, 1, 0); PG8_LDB(B1, 1, 1); PG8_SCHED; PG8_LDA(At, 1, 0); PG8_STAGE(PG8_SA(0, 1), a2 + hstep, voffA);
            PG8_WAIT_V(8); PG8_WAIT_L(0); PG8_BAR; PG8_MMA(0, 0, At, B0); PG8_MMA(0, 1, At, B1); PG8_BAR; PG8_SCHED;
            PG8_LDA(At, 1, 1); PG8_STAGE(PG8_SB(1, 0), b3, voffB); PG8_STAGE(PG8_SB(1, 1), b3 + hstep, voffB); PG8_STAGE(PG8_SA(1, 0), a3, voffA);
            PG8_WAIT_V(8); PG8_WAIT_L(0); PG8_BAR; PG8_MMA(1, 0, At, B0); PG8_MMA(1, 1, At, B1); PG8_BAR; PG8_SCHED;
            } else {
            PG8_LDB(B0, 0, 0); PG8_SCHED; PG8_LDA(At, 0, 0); PG8_STAGE(PG8_SA(1, 1), a1 + hstep, voffA);
            PG8_WAIT_L(8); PG8_BAR; PG8_WAIT_L(0); PG8_MMA(0, 0, At, B0); PG8_BAR; PG8_SCHED;
            PG8_LDB(B1, 0, 1); PG8_STAGE(PG8_SB(0, 0), b2, voffB);
            PG8_BAR; PG8_WAIT_L(0); PG8_MMA(0, 1, At, B1); PG8_BAR;
            PG8_LDA(At, 0, 1); PG8_STAGE(PG8_SA(0, 0), a2, voffA);
            PG8_BAR; PG8_WAIT_L(0); PG8_MMA(1, 0, At, B0); PG8_BAR; PG8_SCHED;
            PG8_STAGE(PG8_SB(0, 1), b2 + hstep, voffB);
            PG8_WAIT_V(6); PG8_BAR; PG8_MMA(1, 1, At, B1); PG8_BAR;
            PG8_LDB(B0, 1, 0); PG8_SCHED; PG8_LDA(At, 1, 0); PG8_STAGE(PG8_SA(0, 1), a2 + hstep, voffA);
            PG8_WAIT_L(8); PG8_BAR; PG8_WAIT_L(0); PG8_MMA(0, 0, At, B0); PG8_BAR; PG8_SCHED;
            PG8_LDB(B1, 1, 1); PG8_STAGE(PG8_SB(1, 0), b3, voffB);
            PG8_BAR; PG8_WAIT_L(0); PG8_MMA(0, 1, At, B1); PG8_BAR;
            PG8_LDA(At, 1, 1); PG8_STAGE(PG8_SA(1, 0), a3, voffA);
            PG8_BAR; PG8_WAIT_L(0); PG8_MMA(1, 0, At, B0); PG8_BAR; PG8_SCHED;
            PG8_STAGE(PG8_SB(1, 1), b3 + hstep, voffB);
            PG8_WAIT_V(6); PG8_BAR; PG8_MMA(1, 1, At, B1); PG8_BAR;
            }
        }
        if constexpr (ALIGN_EPI) { if (wr == 0) PG8_BAR; }
        if constexpr (!Epi::AFTER_DRAIN) { E(acc, cur, wr, wc, fr, fq); S.done(cur); }
        if (!has_next) break;
#pragma unroll
        for (int a = 0; a < 2; ++a)
#pragma unroll
            for (int b = 0; b < 2; ++b)
#pragma unroll
                for (int m = 0; m < 4; ++m)
#pragma unroll
                    for (int n = 0; n < 2; ++n) acc[a][b][m][n] = (f32x4){0.f, 0.f, 0.f, 0.f};
        cur = nxt; cA = nA; cB = nB; ++ui;
        if constexpr (ALIGN_EPI) { if (wr == 1) PG8_BAR; }
    }
    PG8_WAIT_V(0);
    if constexpr (!ALIGN_EPI) { if (wr == 0) PG8_BAR; }
    PG8_BAR;
    if constexpr (Epi::AFTER_DRAIN) { E.fused(acc, cur, wr, wc, fr, fq, lds, wid, lane); S.done(cur); }
#undef PG8_SA
#undef PG8_SB
#undef PG8_STAGE
#undef PG8_LDA
#undef PG8_LDB
#undef PG8_MMA
#undef PG8_WAIT_V
#undef PG8_WAIT_L
#undef PG8_BAR
#undef PG8_SCHED
}
}
#define LAS __attribute__((address_space(3)))
typedef unsigned short bf16_t;
typedef short bf16x8 __attribute__((ext_vector_type(8)));
typedef float f32x4 __attribute__((ext_vector_type(4)));
typedef float f32x2 __attribute__((ext_vector_type(2)));
typedef unsigned u32x4 __attribute__((ext_vector_type(4)));
typedef unsigned u32x2 __attribute__((ext_vector_type(2)));

constexpr int D = 1024, NB = 8, SEQ = 2048, CTXL = 256, DFF = 2816;
constexpr int MX = NB * SEQ;
constexpr int MC = NB * CTXL;
constexpr int MT = MX + MC;
constexpr int NMOD = 9;
constexpr int NEV = 3072;
constexpr int NQKV = 1536;
constexpr float EPS = 1e-6f;
constexpr int LDS_BYTES = 147456;
constexpr int NTHREADS = 512;

constexpr size_t MiB = 1u << 20;
constexpr size_t SZ_WIN = (size_t)5632 * 1024 * 2, SZ_WOUT = (size_t)1024 * 2816 * 2;
constexpr size_t WS_WIN = 0;
constexpr size_t WS_WOUT = WS_WIN + 4 * SZ_WIN;
constexpr size_t WS_WEIN = WS_WOUT + 4 * SZ_WOUT;
constexpr size_t WS_WEOUT = WS_WEIN + (size_t)3072 * 1024 * 2;
constexpr size_t WS_WQKV = WS_WEOUT + (size_t)1024 * 1024 * 2;
constexpr size_t WS_WOOUT = WS_WQKV + (size_t)1536 * 1024 * 2;
constexpr size_t WS_MOD = WS_WOOUT + (size_t)1024 * 1024 * 2;
constexpr size_t WS_WG = WS_MOD + (size_t)2 * 9 * 9216 * 4;
constexpr size_t WS_ROPE = WS_WG + (size_t)16 * 1024 * 4;
constexpr size_t WS_GATES = WS_ROPE + 8192;
constexpr size_t WS_HC = WS_GATES + (size_t)MT * 16 * 4;
constexpr size_t WS_A0 = ((WS_HC + (size_t)MC * D * 4 + 255) / 256) * 256;
constexpr size_t WS_QC = WS_A0 + (size_t)MT * D * 2;
constexpr size_t WS_KC = WS_QC + (size_t)MT * 512 * 2;
constexpr size_t WS_KCT = WS_KC + (size_t)MT * 512 * 2;
constexpr size_t WS_A1 = WS_KCT + (size_t)576 * 128 * 128 * 2;
constexpr size_t WS_BIG = WS_A1 + (size_t)MT * D * 2;
constexpr size_t WS_CTL = WS_BIG + (size_t)MT * 3072 * 2;
constexpr size_t CTL_BYTES = 16384;
constexpr size_t WS_PC = WS_CTL + CTL_BYTES;
constexpr size_t WS_END = WS_PC + (size_t)MC * D * 4;

struct Args {
    const float* x; const float* c; const float* ctx; const float* c_ctx; const float* ada_w; const float* ada_b;
    const float* ffn_w_in; const float* ffn_w_out; const float* even_w_in; const float* even_w_out;
    const float* mlstm_conv; const float* mlstm_gate_b; const float* mlstm_norm; const float* sgu_norm; const float* sgu_ws; const float* sgu_b;
    const float* odd_w_qkv; const float* odd_w_out; const float* attn_sink; const float* final_norm;
    float* out; unsigned char* ws; int ph_lo, ph_hi;
};

typedef const __attribute__((address_space(4))) Args* kargp;
__device__ __forceinline__ kargp kargs() { kargp p = (kargp)__builtin_amdgcn_kernarg_segment_ptr(); asm volatile("" : "+s"(p)); return p; }
#define KA(f) (kargs()->f)
typedef __bf16 bf16x2_t __attribute__((ext_vector_type(2)));
__device__ __forceinline__ unsigned pk2(float lo, float hi) { f32x2 v = {lo, hi}; bf16x2_t b = __builtin_convertvector(v, bf16x2_t); return __builtin_bit_cast(unsigned, b); }
__device__ __forceinline__ bf16_t f2bf(float f) { return (bf16_t)(pk2(f, 0.f) & 0xffffu); }
__device__ __forceinline__ float bf2f(bf16_t v) { return __uint_as_float(((unsigned)v) << 16); }
__device__ __forceinline__ float bflo(unsigned w) { return __uint_as_float(w << 16); }
__device__ __forceinline__ float bfhi(unsigned w) { return __uint_as_float(w & 0xffff0000u); }
__device__ __forceinline__ float silu_f(float v) { return v * __builtin_amdgcn_rcpf(1.f + __expf(-v)); }
__device__ __forceinline__ float sigmoid_f(float v) { return __builtin_amdgcn_rcpf(1.f + __expf(-v)); }
__device__ __forceinline__ float gelu_tanh(float v) {
    const float z = 0.7978845608028654f * (v + 0.044715f * v * v * v);
    const float t = 1.f - 2.f * __builtin_amdgcn_rcpf(1.f + __expf(2.f * z));
    return 0.5f * v * (1.f + t);
}
template <int CTRL> __device__ __forceinline__ float dppf(float v) { return __builtin_bit_cast(float, __builtin_amdgcn_update_dpp(0, __builtin_bit_cast(int, v), CTRL, 0xf, 0xf, false)); }
__device__ __forceinline__ float row16_sum(float v) { v += dppf<0xB1>(v); v += dppf<0x4E>(v); v += dppf<0x141>(v); v += dppf<0x140>(v); return v; }
__device__ __forceinline__ float row16_max(float v) { v = fmaxf(v, dppf<0xB1>(v)); v = fmaxf(v, dppf<0x4E>(v)); v = fmaxf(v, dppf<0x141>(v)); v = fmaxf(v, dppf<0x140>(v)); return v; }
__device__ __forceinline__ float wave_sum(float v) { v = row16_sum(v); v += __shfl_xor(v, 16); v += __shfl_xor(v, 32); return v; }
__device__ __forceinline__ float wave_max(float v) { v = row16_max(v); v = fmaxf(v, __shfl_xor(v, 16)); v = fmaxf(v, __shfl_xor(v, 32)); return v; }
__device__ __forceinline__ f32x4 mfma16(bf16x8 a, bf16x8 b, f32x4 c) { return __builtin_amdgcn_mfma_f32_16x16x32_bf16(a, b, c, 0, 0, 0); }
__device__ __forceinline__ bf16x8 ldsfrag(const LAS unsigned char* p) { return *(const LAS bf16x8*)p; }

namespace pg8 {
struct EpiSwiglu {
    static constexpr bool PERM = true, AFTER_DRAIN = false;
    bf16_t* O;
    __device__ __forceinline__ void operator()(const f32x4 (&acc)[2][2][4][2], const Unit& u, int wr, int wc, int fr, int fq) const {
        const int row0 = u.pm * BM + wr * 64 + fr, col0 = u.pn * 128 + wc * 32 + 8 * fq;
#pragma unroll
        for (int ai = 0; ai < 2; ++ai)
#pragma unroll
            for (int m = 0; m < 4; ++m) {
                bf16_t* rowp = O + (size_t)(row0 + ai * HALF + m * 16) * DFF + col0;
                const f32x4 g0 = acc[ai][0][m][0], g1 = acc[ai][0][m][1], u0 = acc[ai][1][m][0], u1 = acc[ai][1][m][1];
                u32x4 w;
                w.x = ::pk2(::silu_f(g0[0]) * u0[0], ::silu_f(g0[1]) * u0[1]); w.y = ::pk2(::silu_f(g0[2]) * u0[2], ::silu_f(g0[3]) * u0[3]);
                w.z = ::pk2(::silu_f(g1[0]) * u1[0], ::silu_f(g1[1]) * u1[1]); w.w = ::pk2(::silu_f(g1[2]) * u1[2], ::silu_f(g1[3]) * u1[3]);
                *(u32x4*)rowp = w;
            }
    }
};
struct EpiResid {
    static constexpr bool PERM = false, AFTER_DRAIN = false;
    const float* bx; const float* bc; float* ox; float* oc; float* pc; const float* gate;
    float coef;
    __device__ __forceinline__ void operator()(const f32x4 (&acc)[2][2][4][2], const Unit& u, int wr, int wc, int fr, int fq) const {
        const bool isx = u.pm < 64; const bool split = u.k0 != 0;
        const int bi = isx ? (u.pm >> 3) : 8;
        const float* base = isx ? bx : bc - (size_t)MX * D;
        float* outp = isx ? ox : oc - (size_t)MX * D;
        const int row0 = u.pm * BM + wr * 64 + fr, col0 = u.pn * BM + wc * 32 + 4 * fq;
        const float* gp = gate + (size_t)bi * 9216 + col0;
#pragma unroll
        for (int bj = 0; bj < 2; ++bj)
#pragma unroll
            for (int n = 0; n < 2; ++n) {
                const f32x4 gv = *(const f32x4*)(gp + bj * HALF + n * 16) * coef;
#pragma unroll
                for (int ai = 0; ai < 2; ++ai)
#pragma unroll
                    for (int m = 0; m < 4; ++m) {
                        const size_t off = (size_t)(row0 + ai * HALF + m * 16) * D + col0 + bj * HALF + n * 16;
                        const f32x4 pv = gv * acc[ai][bj][m][n];
                        if (split) {
                            *(f32x4*)(pc + off - (size_t)MX * D) = pv;
                        } else {
                            const f32x4 b = *(const f32x4*)(base + off);
                            *(f32x4*)(outp + off) = b + pv;
                        }
                        if (m & 1) asm volatile("" ::: "memory");
                    }
            }
    }
};
struct EpiPlain {
    static constexpr bool PERM = true, AFTER_DRAIN = false;
    bf16_t* O; int ldc;
    __device__ __forceinline__ void operator()(const f32x4 (&acc)[2][2][4][2], const Unit& u, int wr, int wc, int fr, int fq) const {
        const int row0 = u.pm * BM + wr * 64 + fr, col0 = u.pn * BM + wc * 32 + 8 * fq;
#pragma unroll
        for (int ai = 0; ai < 2; ++ai)
#pragma unroll
            for (int m = 0; m < 4; ++m) {
                bf16_t* rowp = O + (size_t)(row0 + ai * HALF + m * 16) * ldc + col0;
#pragma unroll
                for (int bj = 0; bj < 2; ++bj) {
                    const f32x4 v0 = acc[ai][bj][m][0], v1 = acc[ai][bj][m][1];
                    u32x4 w; w.x = ::pk2(v0[0], v0[1]); w.y = ::pk2(v0[2], v0[3]); w.z = ::pk2(v1[0], v1[1]); w.w = ::pk2(v1[2], v1[3]);
                    *(u32x4*)(rowp + bj * HALF) = w;
                }
            }
    }
};
struct EpiQKV {
    static constexpr bool PERM = true, AFTER_DRAIN = false;
    bf16_t* O; const float* rope;
    __device__ __forceinline__ void operator()(const f32x4 (&acc)[2][2][4][2], const Unit& u, int wr, int wc, int fr, int fq) const {
        const int row0 = u.pm * BM + wr * 64 + fr;
        const bool isx = u.pm < 64;
#pragma unroll
        for (int bj = 0; bj < 2; ++bj) {
            const int col0 = u.pn * BM + bj * HALF + wc * 32 + 8 * fq;
            const bool dorope = isx && (col0 < 1280);
            const float qs = (col0 < 1024) ? 0.125f : 1.f;
            const int p0 = (col0 & 63) >> 1;
            const int f0 = p0 & 15;
#pragma unroll
            for (int ai = 0; ai < 2; ++ai)
#pragma unroll
                for (int m = 0; m < 4; ++m) {
                    const int row = row0 + ai * HALF + m * 16;
                    f32x4 v0 = acc[ai][bj][m][0] * qs, v1 = acc[ai][bj][m][1] * qs;
                    if (dorope) {
                        const int t = row & 2047;
                        const int pos = (p0 < 16) ? (t >> 6) : (t & 63);
                        const f32x4 cs0 = *(const f32x4*)(rope + (pos * 16 + f0) * 2), cs1 = *(const f32x4*)(rope + (pos * 16 + f0) * 2 + 4);
                        f32x4 r0, r1;
                        r0[0] = v0[0] * cs0[0] - v0[1] * cs0[1]; r0[1] = v0[0] * cs0[1] + v0[1] * cs0[0];
                        r0[2] = v0[2] * cs0[2] - v0[3] * cs0[3]; r0[3] = v0[2] * cs0[3] + v0[3] * cs0[2];
                        r1[0] = v1[0] * cs1[0] - v1[1] * cs1[1]; r1[1] = v1[0] * cs1[1] + v1[1] * cs1[0];
                        r1[2] = v1[2] * cs1[2] - v1[3] * cs1[3]; r1[3] = v1[2] * cs1[3] + v1[3] * cs1[2];
                        v0 = r0; v1 = r1;
                    }
                    u32x4 w; w.x = ::pk2(v0[0], v0[1]); w.y = ::pk2(v0[2], v0[3]); w.z = ::pk2(v1[0], v1[1]); w.w = ::pk2(v1[2], v1[3]);
                    *(u32x4*)(O + (size_t)row * NQKV + col0) = w;
                }
        }
    }
};
}

__device__ __forceinline__ void tr_item(const float* W, int ldw, int k0, int srccol0, bf16_t* WT, int K, int destrow0, LAS float* scr, int lane) {
#pragma unroll 8
    for (int i = 0; i < 32; ++i) { const int kk = 2 * i + (lane >> 5); scr[kk * 33 + (lane & 31)] = W[(size_t)(k0 + kk) * ldw + srccol0 + (lane & 31)]; }
    asm volatile("s_waitcnt lgkmcnt(0)" ::: "memory");
    const int c = lane & 7;
#pragma unroll
    for (int j = 0; j < 4; ++j) { const int n = (lane >> 3) + 8 * j; const LAS float* s = scr + (8 * c) * 33 + n;
        u32x4 o; o.x = pk2(s[0 * 33], s[1 * 33]); o.y = pk2(s[2 * 33], s[3 * 33]); o.z = pk2(s[4 * 33], s[5 * 33]); o.w = pk2(s[6 * 33], s[7 * 33]);
        *(u32x4*)(WT + (size_t)(destrow0 + n) * K + k0 + 8 * c) = o; }
    asm volatile("s_waitcnt lgkmcnt(0)" ::: "memory");
}

__device__ __forceinline__ void convert_group(LAS unsigned char* lds, int grp, int worker, int nworkers) {
    int tid_ = threadIdx.x; asm volatile("" : "+v"(tid_)); const int tid = tid_, lane = tid & 63, wid = __builtin_amdgcn_readfirstlane(tid >> 6);
    unsigned char* ws = KA(ws);
    LAS float* scr = (LAS float*)(lds + wid * 16384);
    constexpr int I_IN = 16 * 176, I_OUT = 44 * 32, I_EIN = 16 * 96, I_SQ = 16 * 32, I_QKV = 16 * 48;
    const int n2 = grp == 1 ? I_EIN : (grp == 2 ? I_QKV : 0), n3 = (grp == 1 || grp == 2) ? I_SQ : 0;
    const int total = I_IN + I_OUT + n2 + n3;
    for (int it = worker + wid; it < total; it += nworkers) {
        int r = it;
        if (r < I_IN) { const int kb = r / 176, nb = r % 176; const int n0 = nb * 32;
            const int dest = (n0 < 2816) ? ((n0 >> 7) * 256 + (n0 & 127)) : ((((n0 - 2816) >> 7) * 256) + 128 + ((n0 - 2816) & 127));
            tr_item(KA(ffn_w_in) + (size_t)grp * 1024 * 5632, 5632, kb * 64, n0, (bf16_t*)(ws + WS_WIN + grp * SZ_WIN), 1024, dest, scr, lane); continue; }
        r -= I_IN;
        if (r < I_OUT) { const int kb = r / 32, nb = r % 32;
            tr_item(KA(ffn_w_out) + (size_t)grp * 2816 * 1024, 1024, kb * 64, nb * 32, (bf16_t*)(ws + WS_WOUT + grp * SZ_WOUT), 2816, nb * 32, scr, lane); continue; }
        r -= I_OUT;
        if (r < n2) {
            if (grp == 1) { const int kb = r / 96, nb = r % 96; const int src = nb < 64 ? nb * 32 : 2064 + (nb - 64) * 32;
                tr_item(KA(even_w_in), 3088, kb * 64, src, (bf16_t*)(ws + WS_WEIN), 1024, nb * 32, scr, lane); }
            else { const int kb = r / 48, nb = r % 48; tr_item(KA(odd_w_qkv), 1536, kb * 64, nb * 32, (bf16_t*)(ws + WS_WQKV), 1024, nb * 32, scr, lane); }
            continue; }
        r -= n2;
        { const int kb = r / 32, nb = r % 32;
          if (grp == 1) tr_item(KA(even_w_out), 1024, kb * 64, nb * 32, (bf16_t*)(ws + WS_WEOUT), 1024, nb * 32, scr, lane);
          else tr_item(KA(odd_w_out), 1024, kb * 64, nb * 32, (bf16_t*)(ws + WS_WOOUT), 1024, nb * 32, scr, lane); }
    }
}

__device__ __forceinline__ void p0_phase(LAS unsigned char* lds) {
    int tid_ = threadIdx.x; asm volatile("" : "+v"(tid_)); const int tid = tid_, lane = tid & 63, wid = __builtin_amdgcn_readfirstlane(tid >> 6), G = gridDim.x;
    unsigned char* ws = KA(ws);
    {
        LAS float* s = (LAS float*)lds;
        LAS float* red = (LAS float*)(lds + 36864);
        for (int i = tid; i < 9 * 1024; i += NTHREADS) { const float v = (i < 8192) ? KA(c)[i] : KA(c_ctx)[i - 8192]; s[i] = v / (1.f + expf(-v)); }
        __syncthreads();
        float* mod = (float*)(ws + WS_MOD);
        for (int tile = blockIdx.x; tile < 288; tile += G) {
            const int l = tile / 144, cg = tile % 144, n = cg * 64 + lane, kg = wid;
            float acc[9];
#pragma unroll
            for (int bi = 0; bi < 9; ++bi) acc[bi] = 0.f;
            const float* wp = KA(ada_w) + ((size_t)l * 1024 + kg * 128) * 9216 + n;
#pragma unroll 4
            for (int kk = 0; kk < 128; ++kk) {
                const float w = wp[(size_t)kk * 9216];
#pragma unroll
                for (int bi = 0; bi < 9; ++bi) acc[bi] += s[bi * 1024 + kg * 128 + kk] * w;
            }
#pragma unroll
            for (int bi = 0; bi < 9; ++bi) red[(kg * 9 + bi) * 64 + lane] = acc[bi];
            __syncthreads();
            for (int i = tid; i < 576; i += NTHREADS) {
                const int bi = i >> 6, cc = i & 63; float sum = 0.f;
#pragma unroll
                for (int k2 = 0; k2 < 8; ++k2) sum += red[(k2 * 9 + bi) * 64 + cc];
                mod[((size_t)l * 9 + bi) * 9216 + cg * 64 + cc] = sum + KA(ada_b)[l * 9216 + cg * 64 + cc];
            }
            __syncthreads();
        }
    }
    {
        const int gt = blockIdx.x * NTHREADS + tid, GT = G * NTHREADS;
        float* wg = (float*)(ws + WS_WG);
        for (int i = gt; i < 16 * 1024; i += GT) { const int g = i >> 10, k = i & 1023; wg[i] = KA(even_w_in)[(size_t)k * 3088 + 2048 + g]; }
        float* rope = (float*)(ws + WS_ROPE);
        for (int i = gt; i < 64 * 16; i += GT) { const int pos = i >> 4, f = i & 15; const float inv = powf(10000.f, -(float)f / 16.f); const float ang = (float)pos * inv; rope[2 * i] = cosf(ang); rope[2 * i + 1] = sinf(ang); }
    }
    convert_group(lds, 0, blockIdx.x * 8, G * 8);
    if (G <= 64) { convert_group(lds, 1, blockIdx.x * 8, G * 8); convert_group(lds, 2, blockIdx.x * 8, G * 8); convert_group(lds, 3, blockIdx.x * 8, G * 8); }
}

template <bool GATES>
__device__ __forceinline__ void norm_phase(LAS unsigned char* lds, const float* hx, const float* hc, bf16_t* A0, const float* modl, int shift_i, int scale_i, int nrows,
                                           const float* wg, const float* gate_b, float* gates, float* copy_c) {
    int tid_ = threadIdx.x; asm volatile("" : "+v"(tid_)); const int tid = tid_, lane = tid & 63, wid = __builtin_amdgcn_readfirstlane(tid >> 6), G = gridDim.x;
    LAS float* wgs = (LAS float*)lds;
    if (GATES) { for (int i = tid; i < 16 * 1024 / 4; i += NTHREADS) ((LAS f32x4*)wgs)[i] = ((const f32x4*)wg)[i]; __syncthreads(); }
    const int R0 = blockIdx.x * 8 + wid, RS = G * 8;
    f32x4 vn[4], pn[4];
#define NORM_LOAD(R_) do { const bool isx_ = (R_) < MX; const float* src_ = isx_ ? hx + (size_t)(R_) * D : hc + (size_t)((R_) - MX) * D; \
        _Pragma("unroll") for (int j = 0; j < 4; ++j) { vn[j] = *(const f32x4*)(src_ + 256 * j + 4 * lane); \
            pn[j] = (copy_c && !isx_) ? *(const f32x4*)(copy_c + (size_t)((R_) - MX) * D + 256 * j + 4 * lane) : (f32x4){0.f, 0.f, 0.f, 0.f}; } } while (0)
    if (R0 < nrows) NORM_LOAD(R0);
    for (int R = R0; R < nrows; R += RS) {
        const bool isx = R < MX;
        const int bi = isx ? (R >> 11) : 8;
        const float* mb = modl + (size_t)bi * 9216;
        f32x4 v[4]; float ss = 0.f;
#pragma unroll
        for (int j = 0; j < 4; ++j) { v[j] = vn[j] + pn[j];
            if (copy_c && !isx) *(f32x4*)((float*)hc + (size_t)(R - MX) * D + 256 * j + 4 * lane) = v[j];
            ss += (v[j][0] * v[j][0] + v[j][1] * v[j][1]) + (v[j][2] * v[j][2] + v[j][3] * v[j][3]); }
        if (R + RS < nrows) NORM_LOAD(R + RS);
        const float rstd = 1.0f / sqrtf(wave_sum(ss) * (1.f / D) + EPS);
#pragma unroll
        for (int j = 0; j < 4; ++j) {
            const f32x4 sc = *(const f32x4*)(mb + scale_i * 1024 + 256 * j + 4 * lane), sh = *(const f32x4*)(mb + shift_i * 1024 + 256 * j + 4 * lane);
            v[j] = v[j] * rstd * (sc + 1.f) + sh;
            u32x2 w; w.x = pk2(v[j][0], v[j][1]); w.y = pk2(v[j][2], v[j][3]);
            *(u32x2*)(A0 + (size_t)R * D + 256 * j + 4 * lane) = w;
        }
        if (GATES) {
            float mine = 0.f;
#pragma unroll 1
            for (int g = 0; g < 16; ++g) {
                float d = 0.f;
#pragma unroll
                for (int j = 0; j < 4; ++j) { const f32x4 w = *(const LAS f32x4*)(wgs + g * 1024 + 256 * j + 4 * lane); d += (v[j][0] * w[0] + v[j][1] * w[1]) + (v[j][2] * w[2] + v[j][3] * w[3]); }
                d = wave_sum(d);
                if (lane == g) mine = d;
            }
            if (lane < 16) gates[(size_t)R * 16 + lane] = mine + gate_b[lane];
        }
    }
    if (GATES) __syncthreads();
}

__device__ __forceinline__ void qkprep_phase(LAS unsigned char* lds, const bf16_t* P, const float* convw, bf16_t* Qc, bf16_t* Kc, bf16_t* KcT) {
    int tid_ = threadIdx.x; asm volatile("" : "+v"(tid_)); const int tid = tid_;
    constexpr int LD = 136;
    LAS bf16_t* Tt = (LAS bf16_t*)lds;
    LAS float* cw = (LAS float*)(lds + 34816);
    const int seg = tid & 15;
    for (int unit = blockIdx.x; unit < 576; unit += gridDim.x) {
        const int h = unit & 3, gc = unit >> 2, n = gc % 18, b = gc / 18;
        const int sbase = n < 2 ? MX + b * CTXL : b * SEQ, T = n < 2 ? CTXL : SEQ, t0 = n < 2 ? n * 128 : (n - 2) * 128;
        for (int i = tid; i < 768; i += NTHREADS) { const int qk = i / 384, j = (i % 384) >> 7, ch = i & 127; cw[i] = convw[j * 1024 + qk * 512 + h * 128 + ch]; }
        __syncthreads();
#pragma unroll 1
        for (int it = 0; it < 4; ++it) {
            const int l = (tid + NTHREADS * it) >> 4;
            const int tin = t0 + l;
            const size_t R = (size_t)(sbase + tin);
            const bf16_t* pr = P + R * NEV + h * 128 + seg * 8;
            const u32x4 z = (u32x4){0u, 0u, 0u, 0u};
#pragma unroll
            for (int qk = 0; qk < 2; ++qk) {
                const bf16_t* pp = pr + qk * 512;
                const u32x4 c0 = *(const u32x4*)pp; const u32x4 pv = tin > 0 ? *(const u32x4*)(pp - NEV) : z; const u32x4 nx = tin < T - 1 ? *(const u32x4*)(pp + NEV) : z;
                float y[8];
#pragma unroll
                for (int hf = 0; hf < 2; ++hf) {
                    const f32x4 w0 = *(const LAS f32x4*)(cw + (qk * 3 + 0) * 128 + seg * 8 + 4 * hf), w1 = *(const LAS f32x4*)(cw + (qk * 3 + 1) * 128 + seg * 8 + 4 * hf), w2v = *(const LAS f32x4*)(cw + (qk * 3 + 2) * 128 + seg * 8 + 4 * hf);
                    y[4 * hf + 0] = w0[0] * bflo(pv[2 * hf]) + w1[0] * bflo(c0[2 * hf]) + w2v[0] * bflo(nx[2 * hf]);
                    y[4 * hf + 1] = w0[1] * bfhi(pv[2 * hf]) + w1[1] * bfhi(c0[2 * hf]) + w2v[1] * bfhi(nx[2 * hf]);
                    y[4 * hf + 2] = w0[2] * bflo(pv[2 * hf + 1]) + w1[2] * bflo(c0[2 * hf + 1]) + w2v[2] * bflo(nx[2 * hf + 1]);
                    y[4 * hf + 3] = w0[3] * bfhi(pv[2 * hf + 1]) + w1[3] * bfhi(c0[2 * hf + 1]) + w2v[3] * bfhi(nx[2 * hf + 1]);
                }
                const float scl = qk ? 0.08838834764831845f : 1.f;
                u32x4 o;
#pragma unroll
                for (int w2 = 0; w2 < 4; ++w2) o[w2] = pk2(silu_f(y[2 * w2]) * scl, silu_f(y[2 * w2 + 1]) * scl);
                *(u32x4*)((qk ? Kc : Qc) + R * 512 + h * 128 + seg * 8) = o;
                if (qk) {
#pragma unroll
                    for (int w2 = 0; w2 < 4; ++w2) { Tt[(seg * 8 + 2 * w2) * LD + l] = (bf16_t)(o[w2] & 0xffffu); Tt[(seg * 8 + 2 * w2 + 1) * LD + l] = (bf16_t)(o[w2] >> 16); }
                }
            }
        }
        __syncthreads();
#pragma unroll
        for (int it = 0; it < 4; ++it) { const int i = tid + NTHREADS * it; const int d = i >> 4, sg = i & 15;
            *(u32x4*)(KcT + ((size_t)unit * 128 + d) * 128 + sg * 8) = *(const LAS u32x4*)(Tt + d * LD + sg * 8); }
        __syncthreads();
    }
}

__device__ __forceinline__ void mlstm_phase(LAS unsigned char* lds, const bf16_t* P, const float* gates, const bf16_t* Qc, const bf16_t* Kc, const bf16_t* KcT, bf16_t* Hdir) {
    int tid_ = threadIdx.x; asm volatile("" : "+v"(tid_)); const int tid = tid_, lane = tid & 63, wid = __builtin_amdgcn_readfirstlane(tid >> 6), r = lane & 15, q = lane >> 4;
    constexpr int LD = 136, LDB = LD * 2;
    constexpr int OFF_Q = 0, OFF_K = 34816, OFF_KT = 69632, OFF_VT = 104448, OFF_VW = 113152, OFF_CT = 121856, OFF_SC = 130560;
    LAS bf16_t* Qs = (LAS bf16_t*)(lds + OFF_Q); LAS bf16_t* Ks = (LAS bf16_t*)(lds + OFF_K); LAS bf16_t* Kt = (LAS bf16_t*)(lds + OFF_KT);
    LAS bf16_t* Vt = (LAS bf16_t*)(lds + OFF_VT); LAS bf16_t* Vw = (LAS bf16_t*)(lds + OFF_VW); LAS bf16_t* Ct = (LAS bf16_t*)(lds + OFF_CT);
    LAS float* sc = (LAS float*)(lds + OFF_SC);
    LAS float* qn = sc + 1536; LAS float* nvec = sc + 1664;
    for (int unit = blockIdx.x; unit < 256; unit += gridDim.x) {
        const int es = unit & 3, dir = (unit >> 2) & 1, h = (unit >> 3) & 3, b = unit >> 5;
        for (int i = tid; i < 32 * LD / 2; i += NTHREADS) ((LAS unsigned*)Ct)[i] = 0u;
        if (tid < 128) nvec[tid] = 0.f;
        f32x4 Cacc[2]; Cacc[0] = (f32x4){0.f, 0.f, 0.f, 0.f}; Cacc[1] = Cacc[0];
        float m_state = 0.f;
        u32x4 pq[4], pvv; float pgi[2], pgf[2];
        const unsigned voffq = (unsigned)(((tid >> 4) * 512 + (tid & 15) * 8) * 2), vofft = (unsigned)(((tid >> 4) * 128 + (tid & 15) * 8) * 2);
#define MLSTM_CHUNK_INFO(ci_, n_, gc_, rb_) do { if ((ci_) < 2) n_ = dir ? 1 - (ci_) : (ci_); else n_ = dir ? 19 - (ci_) : (ci_); gc_ = b * 18 + n_; rb_ = n_ < 2 ? MX + b * CTXL + n_ * 128 : b * SEQ + (n_ - 2) * 128; } while (0)
#define MLSTM_PREFETCH(ci_) do { int n2, gc2, rb2; MLSTM_CHUNK_INFO(ci_, n2, gc2, rb2); \
            const bf16_t* qg = Qc + (size_t)rb2 * 512 + h * 128; (void)gc2; \
            _Pragma("unroll") for (int it = 0; it < 4; ++it) { \
                pq[it] = *(const u32x4*)((const char*)(qg + it * 16384) + voffq); } \
            pvv = *(const u32x4*)(P + (size_t)(rb2 + (tid >> 2)) * NEV + 1024 + h * 128 + es * 32 + (tid & 3) * 8); } while (0)
#define MLSTM_LOAD_GATES(ci_) do { int n3, gc3, rb3; MLSTM_CHUNK_INFO(ci_, n3, gc3, rb3); (void)gc3; \
            _Pragma("unroll") for (int hf = 0; hf < 2; ++hf) { const int l = lane + 64 * hf; const int R = rb3 + (dir ? 127 - l : l); \
                pgi[hf] = gates[(size_t)R * 16 + dir * 8 + h]; pgf[hf] = gates[(size_t)R * 16 + dir * 8 + 4 + h]; } } while (0)
#define MLSTM_SCALARS(D_) do { LAS float* rowf_ = (D_); LAS float* dmb_ = (D_) + 128; LAS float* inter_ = (D_) + 256; LAS float* wl_ = (D_) + 384; LAS float* en_ = (D_) + 512; LAS float* misc_ = (D_) + 640; \
            float ig[2], bc[2]; \
            _Pragma("unroll") for (int hf = 0; hf < 2; ++hf) { ig[hf] = pgi[hf]; const float fg = pgf[hf]; bc[hf] = fminf(fg, 0.f) - log1pf(expf(-fabsf(fg))); } \
            _Pragma("unroll") for (int off = 1; off < 64; off <<= 1) { const float t0 = __shfl_up(bc[0], off), t1 = __shfl_up(bc[1], off); if (lane >= off) { bc[0] += t0; bc[1] += t1; } } \
            bc[1] += __shfl(bc[0], 63); \
            const float g_ = __shfl(bc[1], 63); \
            const float d0 = ig[0] - bc[0], d1 = ig[1] - bc[1]; \
            float p0 = d0, p1 = d1; \
            _Pragma("unroll") for (int off = 1; off < 64; off <<= 1) { const float t0 = __shfl_up(p0, off), t1 = __shfl_up(p1, off); if (lane >= off) { p0 = fmaxf(p0, t0); p1 = fmaxf(p1, t1); } } \
            p1 = fmaxf(p1, __shfl(p0, 63)); \
            const float a0 = g_ + d0, a1 = g_ + d1; \
            const float mloc = wave_max(fmaxf(a0, a1)); \
            const float m_new = fmaxf(g_ + m_state, mloc); \
            const float dec_ = expf(g_ + m_state - m_new); \
            const float mt0 = bc[0] + fmaxf(m_state, p0), mt1 = bc[1] + fmaxf(m_state, p1); \
            const int i0 = dir ? 127 - lane : lane, i1 = dir ? 63 - lane : lane + 64; \
            rowf_[i0] = bc[0] - mt0; rowf_[i1] = bc[1] - mt1; \
            dmb_[i0] = d0; dmb_[i1] = d1; \
            inter_[i0] = expf(bc[0] + m_state - mt0); inter_[i1] = expf(bc[1] + m_state - mt1); \
            wl_[i0] = expf(a0 - m_new); wl_[i1] = expf(a1 - m_new); \
            en_[i0] = expf(-mt0); en_[i1] = expf(-mt1); \
            if (lane == 0) misc_[0] = dec_; \
            m_state = m_new; } while (0)
        const bool swave = wid == (dir ? 7 : 0);
        if (swave) { MLSTM_LOAD_GATES(0); MLSTM_SCALARS(sc); MLSTM_LOAD_GATES(1); }
        MLSTM_PREFETCH(0);
        __syncthreads();
        for (int ci = 0; ci < 18; ++ci) {
            int wc_ = wid, dc_ = dir; asm volatile("" : "+s"(wc_), "+s"(dc_)); const int widc = wc_, dirc = dc_;
            int n, gc, rbase;
            MLSTM_CHUNK_INFO(ci, n, gc, rbase);
            LAS float* scb = sc + (ci & 1) * 768;
            LAS float* rowf = scb; LAS float* dmb = scb + 128; LAS float* inter = scb + 256; LAS float* wl = scb + 384; LAS float* en = scb + 512; LAS float* misc = scb + 640;
            u32x4 pk[4], pt[4];
            { const bf16_t* kg = Kc + (size_t)rbase * 512 + h * 128; const bf16_t* tg = KcT + (size_t)(gc * 4 + h) * 128 * 128;
#pragma unroll
              for (int it = 0; it < 4; ++it) pk[it] = *(const u32x4*)((const char*)(kg + it * 16384) + voffq);
#pragma unroll
              for (int it = 0; it < 4; ++it) pt[it] = *(const u32x4*)((const char*)(tg + it * 4096) + vofft); }
#pragma unroll
            for (int it = 0; it < 4; ++it) { const int i = tid + NTHREADS * it; const int row = i >> 4, sg = i & 15; *(LAS u32x4*)(Qs + row * LD + sg * 8) = pq[it]; }
#pragma unroll
            for (int it = 0; it < 4; ++it) { const int i = tid + NTHREADS * it; const int row = i >> 4, sg = i & 15; *(LAS u32x4*)(Ks + row * LD + sg * 8) = pk[it]; }
            __syncthreads();
            const float dec = misc[0];
            {
                const int t = tid >> 2, sg = tid & 3;
                const u32x4 vv = pvv;
                const float w = wl[t];
#pragma unroll
                for (int w2 = 0; w2 < 4; ++w2) {
                    Vt[(sg * 8 + 2 * w2) * LD + t] = (bf16_t)(vv[w2] & 0xffffu); Vt[(sg * 8 + 2 * w2 + 1) * LD + t] = (bf16_t)(vv[w2] >> 16);
                    Vw[(sg * 8 + 2 * w2) * LD + t] = f2bf(bflo(vv[w2]) * w); Vw[(sg * 8 + 2 * w2 + 1) * LD + t] = f2bf(bfhi(vv[w2]) * w);
                }
            }
            f32x4 sacc[8];
            {
                bf16x8 af[4];
#pragma unroll
                for (int ks = 0; ks < 4; ++ks) af[ks] = ldsfrag(lds + OFF_Q + (16 * wid + r) * LDB + (32 * ks + 8 * q) * 2);
#pragma unroll
                for (int jb = 0; jb < 8; ++jb) {
                    sacc[jb] = (f32x4){0.f, 0.f, 0.f, 0.f};
                    if (dirc ? (jb >= widc) : (jb <= widc)) {
#pragma unroll
                        for (int ks = 0; ks < 4; ++ks) sacc[jb] = mfma16(af[ks], ldsfrag(lds + OFF_K + (16 * jb + r) * LDB + (32 * ks + 8 * q) * 2), sacc[jb]);
                    }
                }
            }
            {
                const int t = tid >> 2, part = tid & 3; float s = 0.f;
#pragma unroll
                for (int i = 0; i < 4; ++i) {
                    const u32x4 qv = *(const LAS u32x4*)(Qs + t * LD + part * 32 + i * 8);
                    const f32x4 n0 = *(const LAS f32x4*)(nvec + part * 32 + i * 8), n1 = *(const LAS f32x4*)(nvec + part * 32 + i * 8 + 4);
                    s += bflo(qv[0]) * n0[0] + bfhi(qv[0]) * n0[1] + bflo(qv[1]) * n0[2] + bfhi(qv[1]) * n0[3] + bflo(qv[2]) * n1[0] + bfhi(qv[2]) * n1[1] + bflo(qv[3]) * n1[2] + bfhi(qv[3]) * n1[3];
                }
                s += dppf<0xB1>(s); s += dppf<0x4E>(s);
                if (part == 0) qn[t] = s;
            }
#pragma unroll
            for (int it = 0; it < 4; ++it) { const int i = tid + NTHREADS * it; *(LAS u32x4*)(Kt + (i >> 4) * LD + (i & 15) * 8) = pt[it]; }
            __syncthreads();
            if (swave && ci + 1 < 18) { MLSTM_SCALARS(sc + ((ci + 1) & 1) * 768); if (ci + 2 < 18) MLSTM_LOAD_GATES(ci + 2); }
            LAS bf16_t* Ss = Ks;
            float rs[4] = {0.f, 0.f, 0.f, 0.f};
            {
                const f32x4 rf = *(const LAS f32x4*)(rowf + 16 * wid + 4 * q);
                const int zb = dirc ? ((widc & 1) ? widc - 1 : -1) : ((widc & 1) ? -1 : widc + 1);
#pragma unroll
                for (int jb = 0; jb < 8; ++jb) {
                    if (dirc ? (jb >= widc) : (jb <= widc)) {
                        const int s = 16 * jb + r; const float dm = dmb[s];
#pragma unroll
                        for (int reg = 0; reg < 4; ++reg) { const int t = 16 * wid + 4 * q + reg;
                            const bool ok = dirc ? (s >= t) : (s <= t);
                            const float v = ok ? sacc[jb][reg] * __expf(rf[reg] + dm) : 0.f;
                            rs[reg] += v; Ss[t * LD + s] = f2bf(v); }
                    } else if (jb == zb) {
#pragma unroll
                        for (int reg = 0; reg < 4; ++reg) Ss[(16 * wid + 4 * q + reg) * LD + 16 * jb + r] = 0;
                    }
                }
#pragma unroll
                for (int reg = 0; reg < 4; ++reg) rs[reg] = row16_sum(rs[reg]);
            }
            {
                const int kh = widc >> 1;
                const f32x4 it4 = *(const LAS f32x4*)(inter + 16 * wid + 4 * q), qn4 = *(const LAS f32x4*)(qn + 16 * wid + 4 * q), en4 = *(const LAS f32x4*)(en + 16 * wid + 4 * q);
                bf16x8 qf[4];
#pragma unroll
                for (int ks = 0; ks < 4; ++ks) qf[ks] = ldsfrag(lds + OFF_Q + (16 * wid + r) * LDB + (32 * ks + 8 * q) * 2);
#pragma unroll
                for (int nt = 0; nt < 2; ++nt) {
                    f32x4 a1 = (f32x4){0.f, 0.f, 0.f, 0.f}, a2 = a1;
#pragma unroll
                    for (int ks = 0; ks < 4; ++ks) {
                        if (dirc ? (ks >= kh) : (ks <= kh)) a1 = mfma16(ldsfrag(lds + OFF_K + (16 * wid + r) * LDB + (32 * ks + 8 * q) * 2), ldsfrag(lds + OFF_VT + (16 * nt + r) * LDB + (32 * ks + 8 * q) * 2), a1);
                        a2 = mfma16(qf[ks], ldsfrag(lds + OFF_CT + (16 * nt + r) * LDB + (32 * ks + 8 * q) * 2), a2);
                    }
#pragma unroll
                    for (int reg = 0; reg < 4; ++reg) {
                        const int t = 16 * wid + 4 * q + reg;
                        const float den = rs[reg] + it4[reg] * qn4[reg];
                        const float hv = (a1[reg] + it4[reg] * a2[reg]) / fmaxf(fabsf(den), en4[reg]);
                        Hdir[((size_t)dir * MT + rbase + t) * 512 + h * 128 + es * 32 + 16 * nt + r] = f2bf(hv);
                    }
                }
            }
            asm volatile("" ::: "memory");
            if (ci + 1 < 18) MLSTM_PREFETCH(ci + 1);
            asm volatile("" ::: "memory");
            {
                bf16x8 kf[4];
#pragma unroll
                for (int ks = 0; ks < 4; ++ks) kf[ks] = ldsfrag(lds + OFF_KT + (16 * wid + r) * LDB + (32 * ks + 8 * q) * 2);
#pragma unroll
                for (int nt = 0; nt < 2; ++nt) {
                    Cacc[nt] = Cacc[nt] * dec;
#pragma unroll
                    for (int ks = 0; ks < 4; ++ks) Cacc[nt] = mfma16(kf[ks], ldsfrag(lds + OFF_VW + (16 * nt + r) * LDB + (32 * ks + 8 * q) * 2), Cacc[nt]);
                }
            }
            float nnew;
            {
                const int d = tid >> 2, part = tid & 3; float s = 0.f;
#pragma unroll
                for (int i = 0; i < 4; ++i) {
                    const u32x4 kv = *(const LAS u32x4*)(Kt + d * LD + part * 32 + i * 8);
                    const f32x4 w0 = *(const LAS f32x4*)(wl + part * 32 + i * 8), w1 = *(const LAS f32x4*)(wl + part * 32 + i * 8 + 4);
                    s += bflo(kv[0]) * w0[0] + bfhi(kv[0]) * w0[1] + bflo(kv[1]) * w0[2] + bfhi(kv[1]) * w0[3] + bflo(kv[2]) * w1[0] + bfhi(kv[2]) * w1[1] + bflo(kv[3]) * w1[2] + bfhi(kv[3]) * w1[3];
                }
                s += dppf<0xB1>(s); s += dppf<0x4E>(s);
                nnew = dec * nvec[d] + s;
            }
            __syncthreads();
#pragma unroll
            for (int nt = 0; nt < 2; ++nt) { u32x2 w; w.x = pk2(Cacc[nt][0], Cacc[nt][1]); w.y = pk2(Cacc[nt][2], Cacc[nt][3]); *(LAS u32x2*)(Ct + (16 * nt + r) * LD + 16 * wid + 4 * q) = w; }
            if ((tid & 3) == 0) nvec[tid >> 2] = nnew;
        }
        __syncthreads();
    }
}

__device__ __forceinline__ void sgu_phase(LAS unsigned char* lds, const bf16_t* P, const float* sgu_norm, const float* sgu_ws, const float* sgu_b, bf16_t* A1) {
    int tid_ = threadIdx.x; asm volatile("" : "+v"(tid_)); const int tid = tid_, lane = tid & 63, wid = __builtin_amdgcn_readfirstlane(tid >> 6), r = lane & 15, q = lane >> 4;
    constexpr int LD = 136, LDB = LD * 2, OFF_W = 0, OFF_V = 34816, OFF_R = 69632;
    LAS bf16_t* Ws = (LAS bf16_t*)(lds + OFF_W); LAS bf16_t* Vt = (LAS bf16_t*)(lds + OFF_V); LAS float* rstd = (LAS float*)(lds + OFF_R);
    for (int unit = (int)gridDim.x - 1 - (int)blockIdx.x; unit < 144; unit += gridDim.x) {
        const int n = unit % 18, b = unit / 18;
        const int rbase = n < 2 ? MX + b * CTXL + n * 128 : b * SEQ + (n - 2) * 128;
        {
            const int tok = tid >> 2, part = tid & 3; float ss = 0.f;
            const bf16_t* pv = P + (size_t)(rbase + tok) * NEV + 2560 + part * 128;
#pragma unroll 4
            for (int i = 0; i < 16; ++i) { const u32x4 w = *(const u32x4*)(pv + i * 8);
#pragma unroll
                for (int k = 0; k < 4; ++k) { const float a0 = gelu_tanh(bflo(w[k])), a1 = gelu_tanh(bfhi(w[k])); ss += a0 * a0 + a1 * a1; } }
            ss += dppf<0xB1>(ss); ss += dppf<0x4E>(ss);
            if (part == 0) rstd[tok] = 1.0f / sqrtf(ss * (1.f / 512.f) + EPS);
        }
#pragma unroll 1
        for (int g = 0; g < 4; ++g) {
#pragma unroll
            for (int it = 0; it < 4; ++it) { const int i = tid + NTHREADS * it; const int p = i >> 4, sg = i & 15;
                const float* wp = sgu_ws + ((size_t)g * 128 + p) * 128 + sg * 8; const f32x4 w0 = *(const f32x4*)wp, w1 = *(const f32x4*)(wp + 4);
                u32x4 o; o.x = pk2(w0[0], w0[1]); o.y = pk2(w0[2], w0[3]); o.z = pk2(w1[0], w1[1]); o.w = pk2(w1[2], w1[3]);
                *(LAS u32x4*)(Ws + p * LD + sg * 8) = o; }
            if (g == 0) __syncthreads();
#pragma unroll
            for (int it = 0; it < 4; ++it) { const int i = tid + NTHREADS * it; const int tq = i >> 4, sg = i & 15;
                const u32x4 w = *(const u32x4*)(P + (size_t)(rbase + tq) * NEV + 2560 + g * 128 + sg * 8);
                const float rq = rstd[tq];
                const f32x4 g0 = *(const f32x4*)(sgu_norm + g * 128 + sg * 8), g1 = *(const f32x4*)(sgu_norm + g * 128 + sg * 8 + 4);
                Vt[(sg * 8 + 0) * LD + tq] = f2bf(gelu_tanh(bflo(w[0])) * rq * g0[0]); Vt[(sg * 8 + 1) * LD + tq] = f2bf(gelu_tanh(bfhi(w[0])) * rq * g0[1]);
                Vt[(sg * 8 + 2) * LD + tq] = f2bf(gelu_tanh(bflo(w[1])) * rq * g0[2]); Vt[(sg * 8 + 3) * LD + tq] = f2bf(gelu_tanh(bfhi(w[1])) * rq * g0[3]);
                Vt[(sg * 8 + 4) * LD + tq] = f2bf(gelu_tanh(bflo(w[2])) * rq * g1[0]); Vt[(sg * 8 + 5) * LD + tq] = f2bf(gelu_tanh(bfhi(w[2])) * rq * g1[1]);
                Vt[(sg * 8 + 6) * LD + tq] = f2bf(gelu_tanh(bflo(w[3])) * rq * g1[2]); Vt[(sg * 8 + 7) * LD + tq] = f2bf(gelu_tanh(bfhi(w[3])) * rq * g1[3]); }
            __syncthreads();
            {
                bf16x8 wf[4];
#pragma unroll
                for (int ks = 0; ks < 4; ++ks) wf[ks] = ldsfrag(lds + OFF_W + (16 * wid + r) * LDB + (32 * ks + 8 * q) * 2);
                const float sbp = sgu_b[g * 128 + 16 * wid + r];
                const size_t R = (size_t)(rbase + 16 * wid + r);
#pragma unroll
                for (int jb = 0; jb < 8; ++jb) {
                    f32x4 acc = (f32x4){0.f, 0.f, 0.f, 0.f};
#pragma unroll
                    for (int ks = 0; ks < 4; ++ks) acc = mfma16(ldsfrag(lds + OFF_V + (16 * jb + r) * LDB + (32 * ks + 8 * q) * 2), wf[ks], acc);
                    const u32x2 uu = *(const u32x2*)(P + R * NEV + 2048 + g * 128 + 16 * jb + 4 * q);
                    u32x2 w; w.x = pk2(gelu_tanh(bflo(uu.x)) * (acc[0] + sbp), gelu_tanh(bfhi(uu.x)) * (acc[1] + sbp)); w.y = pk2(gelu_tanh(bflo(uu.y)) * (acc[2] + sbp), gelu_tanh(bfhi(uu.y)) * (acc[3] + sbp));
                    *(u32x2*)(A1 + R * D + 512 + g * 128 + 16 * jb + 4 * q) = w;
                }
            }
            __syncthreads();
        }
    }
}

__device__ __forceinline__ void combine_phase(const bf16_t* Hdir, const bf16_t* P, const float* mnorm, bf16_t* A1) {
    int tid_ = threadIdx.x; asm volatile("" : "+v"(tid_)); const int tid = tid_, lane = tid & 63, wid = __builtin_amdgcn_readfirstlane(tid >> 6);
    for (int R = blockIdx.x * 8 + wid; R < MT; R += gridDim.x * 8) {
        const int col = lane * 8;
        const u32x4 h0 = *(const u32x4*)(Hdir + (size_t)R * 512 + col), h1 = *(const u32x4*)(Hdir + ((size_t)MT + R) * 512 + col);
        float a[8];
#pragma unroll
        for (int k = 0; k < 4; ++k) { a[2 * k] = bflo(h0[k]) + bflo(h1[k]); a[2 * k + 1] = bfhi(h0[k]) + bfhi(h1[k]); }
        float ss = 0.f;
#pragma unroll
        for (int k = 0; k < 8; ++k) ss += a[k] * a[k];
        ss = row16_sum(ss);
        const float rstd = 1.0f / sqrtf(ss * (1.f / 128.f) + EPS);
        const f32x4 m0 = *(const f32x4*)(mnorm + col), m1 = *(const f32x4*)(mnorm + col + 4);
        const u32x4 ov = *(const u32x4*)(P + (size_t)R * NEV + 1536 + col);
        u32x4 w;
        w.x = pk2(sigmoid_f(bflo(ov[0])) * a[0] * rstd * m0[0], sigmoid_f(bfhi(ov[0])) * a[1] * rstd * m0[1]);
        w.y = pk2(sigmoid_f(bflo(ov[1])) * a[2] * rstd * m0[2], sigmoid_f(bfhi(ov[1])) * a[3] * rstd * m0[3]);
        w.z = pk2(sigmoid_f(bflo(ov[2])) * a[4] * rstd * m1[0], sigmoid_f(bfhi(ov[2])) * a[5] * rstd * m1[1]);
        w.w = pk2(sigmoid_f(bflo(ov[3])) * a[6] * rstd * m1[2], sigmoid_f(bfhi(ov[3])) * a[7] * rstd * m1[3]);
        *(u32x4*)(A1 + (size_t)R * D + col) = w;
    }
}

__device__ __forceinline__ void attn_phase(LAS unsigned char* lds, const bf16_t* QKV, const float* sink, bf16_t* A1) {
    int tid_ = threadIdx.x; asm volatile("" : "+v"(tid_)); const int tid = tid_, lane = tid & 63, wid = __builtin_amdgcn_readfirstlane(tid >> 6), r = lane & 15, q = lane >> 4;
    constexpr int LK = 72, LKB = LK * 2, BUFB = 18432, OFF_V = 9216;
    for (int unit = blockIdx.x; unit < 512; unit += gridDim.x) {
        asm volatile("" : "+s"(QKV), "+s"(A1));
        const int hk = unit & 3, j = (unit >> 2) & 15, b = unit >> 6;
        const int g = wid >> 1, hq = hk * 4 + g, tok0 = (wid & 1) * 64;
        const int qrow0 = b * SEQ + j * 128 + tok0;
        bf16x8 qf[4][2];
#pragma unroll
        for (int mt = 0; mt < 4; ++mt)
#pragma unroll
            for (int ks = 0; ks < 2; ++ks) qf[mt][ks] = *(const bf16x8*)(QKV + (size_t)(qrow0 + 16 * mt + r) * NQKV + hq * 64 + 32 * ks + 8 * q);
        float mrun[4], lrun[4]; f32x4 oacc[4][4];
        const float sk = sink[hq];
#pragma unroll
        for (int mt = 0; mt < 4; ++mt) { mrun[mt] = sk; lrun[mt] = 1.f;
#pragma unroll
            for (int dt = 0; dt < 4; ++dt) oacc[dt][mt] = (f32x4){0.f, 0.f, 0.f, 0.f}; }
        const int tlast = (j == 15) ? 7 : 9;
        u32x4 kvn, vvn;
        const unsigned voffk = (unsigned)(((tid >> 3) * NQKV + (tid & 7) * 8) * 2);
#define ATTN_TILE_ROW(ti_) ((ti_) < 4 ? MX + b * CTXL + (ti_) * 64 : b * SEQ + (j - 1 + (((ti_) - 4) >> 1)) * 128 + (((ti_) - 4) & 1) * 64)
#define ATTN_NEXT(ti_) ((j == 0 && (ti_) == 3) ? 6 : (ti_) + 1)
#define ATTN_LOAD(ti_) do { const char* kp_ = (const char*)(QKV + (size_t)ATTN_TILE_ROW(ti_) * NQKV + 1024 + hk * 64); kvn = *(const u32x4*)(kp_ + voffk); vvn = *(const u32x4*)(kp_ + 512 + voffk); } while (0)
#define ATTN_STORE(buf_) do { const int key_ = tid >> 3, sg_ = tid & 7; LAS bf16_t* Kd_ = (LAS bf16_t*)(lds + (buf_) * BUFB); LAS bf16_t* Vd_ = (LAS bf16_t*)(lds + (buf_) * BUFB + OFF_V); \
            *(LAS u32x4*)(Kd_ + key_ * LK + sg_ * 8) = kvn; \
            _Pragma("unroll") for (int w2 = 0; w2 < 4; ++w2) { Vd_[(sg_ * 8 + 2 * w2) * LK + key_] = (bf16_t)(vvn[w2] & 0xffffu); Vd_[(sg_ * 8 + 2 * w2 + 1) * LK + key_] = (bf16_t)(vvn[w2] >> 16); } } while (0)
        ATTN_LOAD(0);
        __syncthreads();
        ATTN_STORE(0);
        ATTN_LOAD(1);
        int ti = 0, idx = 0;
        for (;;) {
            __syncthreads();
            const int buf = idx & 1, tnext = ATTN_NEXT(ti);
            if (tnext <= tlast) { ATTN_STORE(buf ^ 1); const int t2 = ATTN_NEXT(tnext); if (t2 <= tlast) ATTN_LOAD(t2); }
            int kpos0; bool band;
            if (ti < 4) { kpos0 = 0; band = false; }
            else { const int kb = j - 1 + ((ti - 4) >> 1); kpos0 = kb * 128 + ((ti - 4) & 1) * 64; band = (kb != j); }
            const LAS unsigned char* Kb = lds + buf * BUFB; const LAS unsigned char* Vb = lds + buf * BUFB + OFF_V;
            bf16x8 vf[4][2];
#pragma unroll
            for (int dt = 0; dt < 4; ++dt)
#pragma unroll
                for (int a2 = 0; a2 < 2; ++a2) {
                    const u32x2 lo = *(const LAS u32x2*)(Vb + (16 * dt + r) * LKB + (32 * a2 + 4 * q) * 2), hi = *(const LAS u32x2*)(Vb + (16 * dt + r) * LKB + (32 * a2 + 16 + 4 * q) * 2);
                    u32x4 t4; t4.x = lo.x; t4.y = lo.y; t4.z = hi.x; t4.w = hi.y; vf[dt][a2] = __builtin_bit_cast(bf16x8, t4);
                }
#pragma unroll
            for (int mt = 0; mt < 4; ++mt) {
                f32x4 s[4];
#pragma unroll
                for (int nt = 0; nt < 4; ++nt) { f32x4 a = (f32x4){0.f, 0.f, 0.f, 0.f};
                    a = mfma16(ldsfrag(Kb + (16 * nt + r) * LKB + (8 * q) * 2), qf[mt][0], a); a = mfma16(ldsfrag(Kb + (16 * nt + r) * LKB + (32 + 8 * q) * 2), qf[mt][1], a); s[nt] = a; }
                if (band) {
                    const int qp = j * 128 + tok0 + 16 * mt + r;
#pragma unroll
                    for (int nt = 0; nt < 4; ++nt)
#pragma unroll
                        for (int i = 0; i < 4; ++i) { const int df = qp - (kpos0 + 16 * nt + 4 * q + i); if (df > 128 || df < -128) s[nt][i] = -1e30f; }
                }
                float mx = fmaxf(fmaxf(fmaxf(s[0][0], s[0][1]), fmaxf(s[0][2], s[0][3])), fmaxf(fmaxf(s[1][0], s[1][1]), fmaxf(s[1][2], s[1][3])));
                mx = fmaxf(mx, fmaxf(fmaxf(fmaxf(s[2][0], s[2][1]), fmaxf(s[2][2], s[2][3])), fmaxf(fmaxf(s[3][0], s[3][1]), fmaxf(s[3][2], s[3][3]))));
                mx = fmaxf(mx, __shfl_xor(mx, 16)); mx = fmaxf(mx, __shfl_xor(mx, 32));
                const float mn = fmaxf(mrun[mt], mx), alpha = __expf(mrun[mt] - mn);
                float rsum = 0.f; u32x2 pw[4];
#pragma unroll
                for (int nt = 0; nt < 4; ++nt) {
                    const float p0 = __expf(s[nt][0] - mn), p1 = __expf(s[nt][1] - mn), p2 = __expf(s[nt][2] - mn), p3 = __expf(s[nt][3] - mn);
                    rsum += (p0 + p1) + (p2 + p3);
                    pw[nt].x = pk2(p0, p1); pw[nt].y = pk2(p2, p3);
                }
                rsum += __shfl_xor(rsum, 16); rsum += __shfl_xor(rsum, 32);
                lrun[mt] = lrun[mt] * alpha + rsum; mrun[mt] = mn;
#pragma unroll
                for (int a2 = 0; a2 < 2; ++a2) {
                    u32x4 t4; t4.x = pw[2 * a2].x; t4.y = pw[2 * a2].y; t4.z = pw[2 * a2 + 1].x; t4.w = pw[2 * a2 + 1].y;
                    const bf16x8 pb = __builtin_bit_cast(bf16x8, t4);
#pragma unroll
                    for (int dt = 0; dt < 4; ++dt) { if (a2 == 0) oacc[dt][mt] *= alpha; oacc[dt][mt] = mfma16(vf[dt][a2], pb, oacc[dt][mt]); }
                }
                asm volatile("" ::: "memory");
            }
            if (tnext > tlast) break;
            ti = tnext; ++idx;
        }
#pragma unroll
        for (int mt = 0; mt < 4; ++mt) { const float inv = 1.f / lrun[mt]; const size_t R = (size_t)(qrow0 + 16 * mt + r);
#pragma unroll
            for (int dt = 0; dt < 4; ++dt) { const f32x4 o = oacc[dt][mt] * inv; u32x2 w; w.x = pk2(o[0], o[1]); w.y = pk2(o[2], o[3]);
                *(u32x2*)(A1 + R * D + hq * 64 + 16 * dt + 4 * q) = w; } }
    }
    __syncthreads();
}

__device__ __forceinline__ void final_phase(float* out, const float* fnorm) {
    int tid_ = threadIdx.x; asm volatile("" : "+v"(tid_)); const int tid = tid_, lane = tid & 63, wid = __builtin_amdgcn_readfirstlane(tid >> 6);
    for (int R = blockIdx.x * 8 + wid; R < MX; R += gridDim.x * 8) {
        float* src = out + (size_t)R * D;
        f32x4 v[4]; float ss = 0.f;
#pragma unroll
        for (int j = 0; j < 4; ++j) { v[j] = *(const f32x4*)(src + 256 * j + 4 * lane); ss += (v[j][0] * v[j][0] + v[j][1] * v[j][1]) + (v[j][2] * v[j][2] + v[j][3] * v[j][3]); }
        const float rstd = 1.0f / sqrtf(wave_sum(ss) * (1.f / D) + EPS);
#pragma unroll
        for (int j = 0; j < 4; ++j) { const f32x4 w = *(const f32x4*)(fnorm + 256 * j + 4 * lane); *(f32x4*)(src + 256 * j + 4 * lane) = v[j] * rstd * w; }
    }
}

#define GAS __attribute__((address_space(1)))
typedef GAS unsigned gu32;
#define RLX_AGENT __ATOMIC_RELAXED, __HIP_MEMORY_SCOPE_AGENT
#define XB_TMO      128
#define XB_XCNT(j)  (256  + 64 * (j))
#define XB_XSUB(j)  (1280 + 64 * (j))
#define XB_XGEN(j)  (2304 + 64 * (j))
#define XB_TOP      3328
#define XB_TOPGEN   3392
#define XCD_BAR_WORDS 3456
#define XB_SPIN_CAP (1u << 18)

__device__ __forceinline__ unsigned xb_ld(unsigned* p)              { return __hip_atomic_load(p, __ATOMIC_RELAXED, __HIP_MEMORY_SCOPE_AGENT); }
__device__ __forceinline__ unsigned xb_add(unsigned* p, unsigned v) { return __hip_atomic_fetch_add(p, v, __ATOMIC_RELAXED, __HIP_MEMORY_SCOPE_AGENT); }
__device__ __forceinline__ unsigned xb_xcc_id() { return (unsigned)__builtin_amdgcn_s_getreg((3 << 11) | 20) & 0xFu; }
#define XB_SPIN(cond, bar) do { unsigned _sp = 0; while (cond) { __builtin_amdgcn_s_sleep(1); \
    if ((++_sp & 255u) == 0u) { if (xb_ld(&(bar)[XB_TMO])) break; if (_sp > XB_SPIN_CAP) { atomicAdd(&(bar)[XB_TMO], 1u); break; } } } } while (0)

struct XcdBarrier {
    unsigned* bar; unsigned x;
    volatile LAS unsigned* st;
};

__device__ __forceinline__ XcdBarrier xcd_barrier_post(unsigned* bar, volatile LAS unsigned* st) {
    XcdBarrier b; b.bar = bar; b.x = xb_xcc_id(); b.st = st;
    if (threadIdx.x == 0) (void)xb_add(&bar[XB_XCNT(b.x)], 1u);
    return b;
}
__device__ __forceinline__ void xcd_barrier_complete(unsigned* bar, unsigned x, unsigned& nloc, unsigned& nx) {
    const unsigned G = gridDim.x * gridDim.y * gridDim.z;
    unsigned sum, cnt, mine, sp = 0u;
    for (;;) {
        sum = 0u; cnt = 0u;
#pragma unroll 1
        for (unsigned j = 0; j < 16; ++j) { const unsigned c = xb_ld(&bar[XB_XCNT(j)]); sum += c; cnt += (c > 0u) ? 1u : 0u; }
        mine = xb_ld(&bar[XB_XCNT(x)]);
        if (sum == G) break;
        __builtin_amdgcn_s_sleep(1);
        if ((++sp & 255u) == 0u) { if (xb_ld(&bar[XB_TMO])) break; if (sp > XB_SPIN_CAP) { atomicAdd(&bar[XB_TMO], 1u); break; } }
    }
    nloc = mine > 0u ? mine : 1u; nx = cnt > 0u ? cnt : 1u;
}

__device__ __forceinline__ void xcd_barrier(const XcdBarrier& b) {
    asm volatile("s_waitcnt vmcnt(0)" ::: "memory");
    __syncthreads();
    if (threadIdx.x == 0) {
        unsigned* bar = b.bar;
        __builtin_amdgcn_s_waitcnt(0);
        unsigned nloc = b.st[0], nx = b.st[1];
        if (nloc == 0u) { xcd_barrier_complete(bar, b.x, nloc, nx); b.st[0] = nloc; b.st[1] = nx; }
        const unsigned old = xb_add(&bar[XB_XSUB(b.x)], 1u);
        const unsigned gen = old / nloc;
        if (old + 1u == (gen + 1u) * nloc) {
            __builtin_amdgcn_fence(__ATOMIC_RELEASE, "agent");
            asm volatile("s_waitcnt vmcnt(0)" ::: "memory");
            const unsigned og = xb_add(&bar[XB_TOP], 1u);
            const unsigned tg = og / nx;
            if (og + 1u == (tg + 1u) * nx) xb_add(&bar[XB_TOPGEN], 1u);
            else XB_SPIN(xb_ld(&bar[XB_TOPGEN]) == tg, bar);
            __builtin_amdgcn_fence(__ATOMIC_ACQUIRE, "agent");
            xb_add(&bar[XB_XGEN(b.x)], 1u);
            asm volatile("s_waitcnt vmcnt(0)" ::: "memory");
        } else {
            XB_SPIN(xb_ld(&bar[XB_XGEN(b.x)]) == gen, bar);
            __builtin_amdgcn_fence(__ATOMIC_ACQUIRE, "agent");
            asm volatile("s_waitcnt vmcnt(0)" ::: "memory");
        }
    }
    __syncthreads();
}

#ifndef MK_SINGLE
#define MK_SINGLE 1
#endif
constexpr int NPHASES = 24;
#ifndef EN_PREP
#define EN_PREP 1
#endif
#ifndef REP_MASK
#define REP_MASK 0
#endif
#ifndef USE_CG_FIRST
#define USE_CG_FIRST 0
#endif
#ifndef NSYNC_REP
#define NSYNC_REP 1
#endif
#ifndef EN_ALL
#define EN_ALL 1
#endif
#ifndef EN_P0
#define EN_P0 EN_ALL
#endif
#ifndef EN_NORM
#define EN_NORM EN_ALL
#endif
#ifndef EN_GEMM
#define EN_GEMM (EN_ALL ? 15 : 0)
#endif
#ifndef EN_MLSTM
#define EN_MLSTM EN_ALL
#endif
#ifndef EN_SGU
#define EN_SGU EN_ALL
#endif
#ifndef EN_COMB
#define EN_COMB EN_ALL
#endif
#ifndef EN_ATTN
#define EN_ATTN EN_ALL
#endif
#ifndef EN_FINAL
#define EN_FINAL EN_ALL
#endif
__global__ void __launch_bounds__(NTHREADS, 2) fwd_kernel(Args a_unused) {
    extern __shared__ __attribute__((aligned(16))) unsigned char lds_raw[];
    LAS unsigned char* lds = (LAS unsigned char*)lds_raw;
    cg::grid_group grid = cg::this_grid();
    unsigned char* ws = KA(ws);
    const int G = gridDim.x, c = blockIdx.x;
    float* Hx = KA(out); float* Hc = (float*)(ws + WS_HC);
    bf16_t* A0 = (bf16_t*)(ws + WS_A0); bf16_t* A1 = (bf16_t*)(ws + WS_A1); bf16_t* BIG = (bf16_t*)(ws + WS_BIG);
    bf16_t* Hdir = (bf16_t*)(ws + WS_A0);
    const float* mod = (const float*)(ws + WS_MOD);
    float* gates = (float*)(ws + WS_GATES);
    const int lo = KA(ph_lo), hi = KA(ph_hi);
    volatile LAS unsigned* barst = (volatile LAS unsigned*)(lds + LDS_BYTES - 16);
    if (threadIdx.x < 2) barst[threadIdx.x] = 0u;
    __syncthreads();
    XcdBarrier bar = xcd_barrier_post((unsigned*)(ws + WS_CTL), barst);
    enum { K_P0, K_NORM, K_NORMG, K_SWIGLU, K_RESID, K_PLAIN, K_QKV, K_MIX0, K_COMB, K_ATTN, K_FINAL, K_PREP };
    for (int ph = lo; ph < hi; ++ph) {
        const int layer = ph >= 13 ? 1 : 0;
        const int lp = ph >= 13 ? ph - 13 : ph - 1;
        const float* modl = mod + (size_t)layer * 9 * 9216;
        int kind = K_P0, M = MT, gi = 0, ffn = 0, Kd = 1024; float coef = 1.f;
        const bf16_t* Aop = A0; const bf16_t* Wop = nullptr;
        const float* bxp = Hx; const float* bcp = Hc;
        if (ph == 0) kind = K_P0;
        else if (ph == 23) kind = K_FINAL;
        else if (lp == 0) { kind = K_NORM; gi = 0; if (layer == 0) { bxp = KA(x); bcp = KA(ctx); } }
        else if (lp == 1) { kind = K_SWIGLU; ffn = layer * 2; }
        else if (lp == 2) { kind = K_RESID; Aop = BIG; Wop = (const bf16_t*)(ws + WS_WOUT + (size_t)(layer * 2) * SZ_WOUT); Kd = 2816; gi = 2; coef = 0.5f; if (layer == 0) { bxp = KA(x); bcp = KA(ctx); } }
        else if (layer == 0) {
            if (lp == 3) { kind = K_NORMG; gi = 3; }
            else if (lp == 4) kind = K_PLAIN;
            else if (lp == 5) kind = K_PREP;
            else if (lp == 6) kind = K_MIX0;
            else if (lp == 7) kind = K_COMB;
            else if (lp == 8) { kind = K_RESID; Aop = A1; Wop = (const bf16_t*)(ws + WS_WEOUT); gi = 5; }
            else if (lp == 9) { kind = K_NORM; gi = 6; }
            else if (lp == 10) { kind = K_SWIGLU; ffn = 1; }
            else { kind = K_RESID; Aop = BIG; Wop = (const bf16_t*)(ws + WS_WOUT + SZ_WOUT); Kd = 2816; gi = 8; coef = 0.5f; }
        } else {
            if (lp == 3) { kind = K_NORM; gi = 3; }
            else if (lp == 4) kind = K_QKV;
            else if (lp == 5) kind = K_ATTN;
            else if (lp == 6) { kind = K_RESID; Aop = A1; Wop = (const bf16_t*)(ws + WS_WOOUT); gi = 5; M = MX; }
            else if (lp == 7) { kind = K_NORM; gi = 6; M = MX; }
            else if (lp == 8) { kind = K_SWIGLU; ffn = 3; M = MX; }
            else { kind = K_RESID; Aop = BIG; Wop = (const bf16_t*)(ws + WS_WOUT + 3 * SZ_WOUT); Kd = 2816; gi = 8; coef = 0.5f; M = MX; }
        }
        const int nrep = ((REP_MASK >> kind) & 1) ? 2 : 1;
        for (int rep = 0; rep < nrep; ++rep) {
        if (rep == 1) { if (kind == K_RESID) { bxp = Hx; bcp = Hc; coef = 0.f; } __syncthreads(); }
        if (kind == K_P0) { if (EN_P0) p0_phase(lds); }
        else if (kind == K_NORM) { if (EN_NORM) norm_phase<false>(lds, bxp, bcp, A0, modl, gi, gi + 1, M, nullptr, nullptr, nullptr, (ph > 1 && M == MT) ? (float*)(ws + WS_PC) : nullptr); }
        else if (kind == K_NORMG) { if (EN_NORM) norm_phase<true>(lds, Hx, Hc, A0, modl, gi, gi + 1, M, (const float*)(ws + WS_WG), KA(mlstm_gate_b), gates, (float*)(ws + WS_PC)); }
        else if (kind == K_SWIGLU) { if (EN_GEMM & 1) { pg8::Gemm g{A0, (const bf16_t*)(ws + WS_WIN + (size_t)ffn * SZ_WIN), M, 5632, 1024}; pg8::StaticOrder S; S.init(M, 5632, G, c, 1024); pg8::EpiSwiglu E{BIG};
            pg8::gemm_phase<pg8::EpiSwiglu, pg8::StaticOrder, true, true>(lds, g, S, E); } }
        else if (kind == K_RESID) { if (EN_GEMM & 2) { pg8::Gemm g{Aop, Wop, M, 1024, Kd}; pg8::SplitCtxOrder S; S.init(1024, G, c, Kd, M == MT ? 64 : 0); pg8::EpiResid E{bxp, bcp, Hx, Hc, (float*)(ws + WS_PC), modl + gi * 1024, coef};
            pg8::gemm_phase<pg8::EpiResid, pg8::SplitCtxOrder, true, true>(lds, g, S, E);
            const int cgrp = (rep == 0 && M == MT && Kd == 2816) ? (layer == 0 ? (lp == 2 ? 1 : 2) : 3) : 0;
            if (cgrp != 0 && c >= 64 && G > 64) convert_group(lds, cgrp, (c - 64) * 8, (G - 64) * 8); } }
        else if (kind == K_PLAIN) { if (EN_GEMM & 4) { pg8::Gemm g{A0, (const bf16_t*)(ws + WS_WEIN), MT, NEV, 1024}; pg8::StaticOrder S; S.init(MT, NEV, G, c, 1024); pg8::EpiPlain E{BIG, NEV};
            pg8::gemm_phase<pg8::EpiPlain, pg8::StaticOrder, true, true>(lds, g, S, E); } }
        else if (kind == K_QKV) { if (EN_GEMM & 8) { pg8::Gemm g{A0, (const bf16_t*)(ws + WS_WQKV), MT, NQKV, 1024}; pg8::StaticOrder S; S.init(MT, NQKV, G, c, 1024); pg8::EpiQKV E{BIG, (const float*)(ws + WS_ROPE)};
            pg8::gemm_phase<pg8::EpiQKV, pg8::StaticOrder, true, true>(lds, g, S, E); } }
        else if (kind == K_PREP) { if (EN_MLSTM && EN_PREP) qkprep_phase(lds, BIG, KA(mlstm_conv), (bf16_t*)(ws + WS_QC), (bf16_t*)(ws + WS_KC), (bf16_t*)(ws + WS_KCT)); if (EN_SGU) sgu_phase(lds, BIG, KA(sgu_norm), KA(sgu_ws), KA(sgu_b), A1); }
        else if (kind == K_MIX0) { if (EN_MLSTM) mlstm_phase(lds, BIG, gates, (const bf16_t*)(ws + WS_QC), (const bf16_t*)(ws + WS_KC), (const bf16_t*)(ws + WS_KCT), Hdir); }
        else if (kind == K_COMB) { if (EN_COMB) combine_phase(Hdir, BIG, KA(mlstm_norm), A1); }
        else if (kind == K_ATTN) { if (EN_ATTN) attn_phase(lds, BIG, KA(attn_sink), A1); }
        else { if (EN_FINAL) final_phase(Hx, KA(final_norm)); }
        }
        if (ph + 1 < hi) {
            if (ph == 0 && USE_CG_FIRST) {
                __syncthreads();
                if (threadIdx.x < 64) { __builtin_amdgcn_fence(__ATOMIC_RELEASE, "agent"); asm volatile("s_waitcnt vmcnt(0)" ::: "memory"); }
                grid.sync();
                if (threadIdx.x < 64) { __builtin_amdgcn_fence(__ATOMIC_ACQUIRE, "agent"); asm volatile("s_waitcnt vmcnt(0)" ::: "memory"); }
                __syncthreads();
            } else {
                for (int srep = 0; srep < NSYNC_REP; ++srep) xcd_barrier(bar);
            }
        }
    }
}

extern "C" void kernel_launch(void* const* d_in, const int* in_sizes, int n_in, void* d_out, int out_size, void* d_ws, size_t ws_size, hipStream_t stream) {
    static int grid = 0;
    if (grid == 0) {
        if (n_in != 20 || out_size != MX * D || ws_size < WS_END) { fprintf(stderr, "kernel_launch: unexpected problem (n_in %d out %d ws %zu need %zu)\n", n_in, out_size, ws_size, (size_t)WS_END); grid = -1; return; }
        int dev = 0, cus = 0, per_cu = 0;
        hipGetDevice(&dev);
        hipDeviceGetAttribute(&cus, hipDeviceAttributeMultiprocessorCount, dev);
        hipFuncSetAttribute((const void*)fwd_kernel, hipFuncAttributeMaxDynamicSharedMemorySize, LDS_BYTES);
        hipOccupancyMaxActiveBlocksPerMultiprocessor(&per_cu, (const void*)fwd_kernel, NTHREADS, LDS_BYTES);
        if (per_cu < 1) { fprintf(stderr, "kernel_launch: occupancy query says %d blocks per CU\n", per_cu); grid = -1; return; }
        grid = cus;
    }
    if (grid < 0) return;
    if (hipMemsetAsync((char*)d_ws + WS_CTL, 0, CTL_BYTES, stream) != hipSuccess) { fprintf(stderr, "kernel_launch: memset failed\n"); return; }
    Args a{};
#ifdef DBG_MEMSET
    hipMemsetAsync(d_ws, 0, WS_END, stream); hipMemsetAsync(d_out, 0, (size_t)out_size * 4, stream);
#endif
    a.x = (const float*)d_in[0]; a.c = (const float*)d_in[1]; a.ctx = (const float*)d_in[2]; a.c_ctx = (const float*)d_in[3]; a.ada_w = (const float*)d_in[4]; a.ada_b = (const float*)d_in[5];
    a.ffn_w_in = (const float*)d_in[6]; a.ffn_w_out = (const float*)d_in[7]; a.even_w_in = (const float*)d_in[8]; a.even_w_out = (const float*)d_in[9];
    a.mlstm_conv = (const float*)d_in[10]; a.mlstm_gate_b = (const float*)d_in[11]; a.mlstm_norm = (const float*)d_in[12]; a.sgu_norm = (const float*)d_in[13]; a.sgu_ws = (const float*)d_in[14]; a.sgu_b = (const float*)d_in[15];
    a.odd_w_qkv = (const float*)d_in[16]; a.odd_w_out = (const float*)d_in[17]; a.attn_sink = (const float*)d_in[18]; a.final_norm = (const float*)d_in[19];
    a.out = (float*)d_out; a.ws = (unsigned char*)d_ws;
#if MK_SINGLE
    a.ph_lo = 0; a.ph_hi = NPHASES;
    { void* args[] = {&a}; hipError_t e = hipLaunchCooperativeKernel((const void*)fwd_kernel, dim3(grid), dim3(NTHREADS), args, LDS_BYTES, stream);
      if (e != hipSuccess) fprintf(stderr, "cooperative launch failed: %s\n", hipGetErrorString(e)); }
#else
    for (int p = 0; p < NPHASES; ++p) { a.ph_lo = p; a.ph_hi = p + 1; void* args[] = {&a};
        hipError_t e = hipLaunchCooperativeKernel((const void*)fwd_kernel, dim3(grid), dim3(NTHREADS), args, LDS_BYTES, stream);
        if (e != hipSuccess) { fprintf(stderr, "launch %d failed: %s\n", p, hipGetErrorString(e)); break; } }
#endif
}
```

```cpp
#include <hip/hip_runtime.h>
#include <hip/hip_cooperative_groups.h>
#include <cstdio>
#include <cstdint>
namespace cg = cooperative_groups;
namespace pg8 {
#define PG8_LAS __attribute__((address_space(3)))
typedef unsigned short bf16_t;
typedef short bf16x8 __attribute__((ext_vector_type(8)));
typedef float f32x4 __attribute__((ext_vector_type(4)));
typedef unsigned u32x4 __attribute__((ext_vector_type(4)));
constexpr int BM = 256, BK = 64, HALF = 128, HTB = HALF * BK * 2  , STAGE_BYTES = 8 * HTB, NXCD = 8, WGM = 8;

__host__ __device__ __forceinline__ int lds_byte(int r, int c) { const int st = (r >> 4) * 2 + (c >> 5), rr = r & 15, cc = c & 31, ob = rr * 64 + cc * 2; return st * 1024 + (ob ^ (((ob >> 9) & 1) << 5)); }
__host__ __device__ __forceinline__ void stage_rc(int b, int& R, int& C) { const int st = b / 1024, sb = b % 1024, swz = sb ^ (((sb >> 9) & 1) << 5); R = (st >> 1) * 16 + swz / 64; C = (st & 1) * 32 + (swz % 64) / 2; }
__host__ __device__ __forceinline__ int perm32(int rho) { const int n = rho >> 4, i = rho & 15; return 8 * (i >> 2) + 4 * n + (i & 3); }

struct Unit { int pm, pn, k0, nt; };
struct Gemm { const bf16_t* A; const bf16_t* Bt; int M, N, K; };

struct StaticOrder {
    int nM, nN, nwg, G, c, ntf;
    __host__ __device__ void init(int M, int N, int G_, int c_, int K_) { nM = M / BM; nN = N / BM; nwg = nM * nN; G = G_; c = c_; ntf = K_ / BK; }
    __host__ __device__ __forceinline__ bool next(int i, Unit& u) const {
        const long L = (long)i * G + c; if (L >= nwg) return false;
        int wgid = (int)L; { const int q = nwg / NXCD, r = nwg % NXCD, xcd = wgid % NXCD, off = wgid / NXCD; wgid = (xcd < r ? xcd * (q + 1) : r * (q + 1) + (xcd - r) * q) + off; }
        const int nig = WGM * nN, gid = wgid / nig, fm = gid * WGM, gsz = (nM - fm) < WGM ? (nM - fm) : WGM;
        u.pm = fm + ((wgid % nig) % gsz); u.pn = (wgid % nig) / gsz; u.k0 = 0; u.nt = ntf; return true;
    }
    __device__ __forceinline__ void a_ready(const Unit&) const {}
    __device__ __forceinline__ void done(const Unit&) const {}
};

struct SplitCtxOrder {
    int nN, G, c, ntf, nctx;
    __host__ __device__ void init(int N, int G_, int c_, int K_, int nctx_) { nN = N / BM; G = G_; c = c_; ntf = K_ / BK; nctx = nctx_; }
    __host__ __device__ __forceinline__ bool next(int i, Unit& u) const {
        const int L = i * G + c, nwg = 64 * nN;
        if (L >= nwg + nctx) return false;
        int wgid = L < nwg ? L : 0; { const int q = nwg / NXCD, xcd = wgid % NXCD, off = wgid / NXCD; wgid = xcd * q + off; }
        const int nig = WGM * nN, gid = wgid / nig, fm = gid * WGM;
        const int pm0 = fm + ((wgid % nig) % WGM), pn0 = (wgid % nig) / WGM;
        const int L2 = L - nwg, tt = L2 >> 1;
        const bool ctxu = L >= nwg;
        Unit r;
        r.pm = ctxu ? 64 + tt / nN : pm0; r.pn = ctxu ? tt % nN : pn0; r.nt = ctxu ? ntf / 2 : ntf; r.k0 = ctxu ? (L2 & 1) * (ntf / 2) * BK : 0;
        u = r; return true;
    }
    __device__ __forceinline__ void a_ready(const Unit&) const {}
    __device__ __forceinline__ void done(const Unit&) const {}
};

__device__ __forceinline__ unsigned cvt_pk_bf16(float lo, float hi) { unsigned r; asm volatile("v_cvt_pk_bf16_f32 %0, %1, %2" : "=v"(r) : "v"(lo), "v"(hi)); return r; }
typedef float f32x2 __attribute__((ext_vector_type(2)));
template <class Epi, class Sched, bool ALIGN_EPI = false, bool SP2 = false>
__device__ __forceinline__ void gemm_phase(PG8_LAS unsigned char* lds, const Gemm g, const Sched& S, const Epi& E) {
    int tid_ = threadIdx.x; asm volatile("" : "+v"(tid_)); const int tid = tid_, wid = __builtin_amdgcn_readfirstlane(tid >> 6), lane = tid & 63, wr = wid >> 2, wc = wid & 3, fr = lane & 15, fq = lane >> 4;
    const int K = g.K;
    unsigned voffA[2], voffB[2];
#pragma unroll
    for (int i = 0; i < 2; ++i) { int R, C; stage_rc(tid * 16 + i * 8192, R, C); const int Rb = Epi::PERM ? ((R & ~31) + perm32(R & 31)) : R;
        voffA[i] = (unsigned)(R * K + C) * 2u; voffB[i] = (unsigned)(Rb * K + C) * 2u; }
    const size_t kstep = (size_t)(BK * 2);
    const size_t hstep = (size_t)HALF * K * 2;
    const size_t tstep = 2 * hstep;
    const unsigned ldsw = (unsigned)wid * 1024u;
    const int aoff = lds_byte(wr * 64 + fr, fq * 8), boff = lds_byte(wc * 32 + fr, fq * 8);
#define PG8_SA(b, h) (((b) * 2 + (h)) * HTB)
#define PG8_SB(b, h) ((4 + (b) * 2 + (h)) * HTB)
#define PG8_STAGE(bufoff, gbase, voff) do { _Pragma("unroll") for (int _i = 0; _i < 2; ++_i) \
        __builtin_amdgcn_global_load_lds((const unsigned*)((const char*)(gbase) + (voff)[_i]), (PG8_LAS unsigned*)(lds + (bufoff) + ldsw + _i * 8192), 16, 0, 0); } while (0)
#define PG8_LDA(dst, b, h) do { _Pragma("unroll") for (int m = 0; m < 4; ++m) _Pragma("unroll") for (int k = 0; k < 2; ++k) dst[m][k] = *(const PG8_LAS bf16x8*)(lds + PG8_SA(b, h) + aoff + m * 2048 + k * 1024); } while (0)
#define PG8_LDB(dst, b, h) do { _Pragma("unroll") for (int n = 0; n < 2; ++n) _Pragma("unroll") for (int k = 0; k < 2; ++k) dst[n][k] = *(const PG8_LAS bf16x8*)(lds + PG8_SB(b, h) + boff + n * 2048 + k * 1024); } while (0)
#define PG8_MMA(ai, bj, At, Bt) do { __builtin_amdgcn_s_setprio(1); _Pragma("unroll") for (int m = 0; m < 4; ++m) _Pragma("unroll") for (int n = 0; n < 2; ++n) _Pragma("unroll") for (int k = 0; k < 2; ++k) \
        acc[ai][bj][m][n] = __builtin_amdgcn_mfma_f32_16x16x32_bf16(Bt[n][k], At[m][k], acc[ai][bj][m][n], 0, 0, 0); __builtin_amdgcn_s_setprio(0); } while (0)
#define PG8_WAIT_V(n) asm volatile("s_waitcnt vmcnt(" #n ")" ::: "memory")
#define PG8_WAIT_L(n) asm volatile("s_waitcnt lgkmcnt(" #n ")" ::: "memory")
#define PG8_BAR __builtin_amdgcn_s_barrier()
#define PG8_SCHED __builtin_amdgcn_sched_barrier(0)
    Unit cur, nxt; int ui = 0;
    if (!S.next(0, cur)) return;
    f32x4 acc[2][2][4][2];
#pragma unroll
    for (int a = 0; a < 2; ++a)
#pragma unroll
        for (int b = 0; b < 2; ++b)
#pragma unroll
            for (int m = 0; m < 4; ++m)
#pragma unroll
                for (int n = 0; n < 2; ++n) acc[a][b][m][n] = (f32x4){0.f, 0.f, 0.f, 0.f};
    bf16x8 At[4][2], B0[2][2], B1[2][2];
    const char* cA = (const char*)g.A + (size_t)cur.pm * tstep + (size_t)cur.k0 * 2; const char* cB = (const char*)g.Bt + (size_t)cur.pn * tstep + (size_t)cur.k0 * 2;
    S.a_ready(cur);
    if constexpr (SP2) {
        PG8_STAGE(PG8_SB(0, 0), cB, voffB); PG8_STAGE(PG8_SB(0, 1), cB + hstep, voffB); PG8_STAGE(PG8_SA(0, 0), cA, voffA); PG8_STAGE(PG8_SA(0, 1), cA + hstep, voffA);
        if (wr == 1) PG8_BAR;
        PG8_WAIT_V(2); PG8_BAR;
        PG8_STAGE(PG8_SB(1, 0), cB + kstep, voffB); PG8_STAGE(PG8_SA(1, 0), cA + kstep, voffA); PG8_STAGE(PG8_SB(1, 1), cB + hstep + kstep, voffB);
        PG8_WAIT_V(6); PG8_BAR;
    } else {
        PG8_STAGE(PG8_SB(0, 0), cB, voffB); PG8_STAGE(PG8_SA(0, 0), cA, voffA); PG8_STAGE(PG8_SB(0, 1), cB + hstep, voffB); PG8_STAGE(PG8_SA(0, 1), cA + hstep, voffA);
        if (wr == 1) PG8_BAR;
        PG8_WAIT_V(4); PG8_BAR;
        PG8_STAGE(PG8_SB(1, 0), cB + kstep, voffB); PG8_STAGE(PG8_SA(1, 0), cA + kstep, voffA); PG8_STAGE(PG8_SB(1, 1), cB + hstep + kstep, voffB);
        PG8_WAIT_V(6); PG8_BAR;
    }
    for (;;) {
        const bool has_next = S.next(ui + 1, nxt);
        const char* nA = has_next ? (const char*)g.A + (size_t)nxt.pm * tstep + (size_t)nxt.k0 * 2 : cA; const char* nB = has_next ? (const char*)g.Bt + (size_t)nxt.pn * tstep + (size_t)nxt.k0 * 2 : cB;
        const int nt = cur.nt;
        for (int t = 0; t < nt; t += 2) {
            const bool last = (t == nt - 2);
            const char* a1 = cA + (size_t)(t + 1) * kstep;
            const char* a2 = last ? nA : cA + (size_t)(t + 2) * kstep; const char* b2 = last ? nB : cB + (size_t)(t + 2) * kstep;
            const char* a3 = a2 + kstep; const char* b3 = b2 + kstep;
            if (last && has_next) S.a_ready(nxt);
            if constexpr (SP2) {
            PG8_LDB(B0, 0, 0); PG8_LDB(B1, 0, 1); PG8_SCHED; PG8_LDA(At, 0, 0); PG8_STAGE(PG8_SA(1, 1), a1 + hstep, voffA);
            PG8_WAIT_V(8); PG8_WAIT_L(0); PG8_BAR; PG8_MMA(0, 0, At, B0); PG8_MMA(0, 1, At, B1); PG8_BAR; PG8_SCHED;
            PG8_LDA(At, 0, 1); PG8_STAGE(PG8_SB(0, 0), b2, voffB); PG8_STAGE(PG8_SB(0, 1), b2 + hstep, voffB); PG8_STAGE(PG8_SA(0, 0), a2, voffA);
            PG8_WAIT_V(8); PG8_WAIT_L(0); PG8_BAR; PG8_MMA(1, 0, At, B0); PG8_MMA(1, 1, At, B1); PG8_BAR; PG8_SCHED;
            PG8_LDB(B0, 1, 0); PG8_LDB(B1, 1, 1); PG8_SCHED; PG8_LDA(At, 1, 0); PG8_STAGE(PG8_SA(0, 1), a2 + hstep, voffA);
            PG8_WAIT_V(8); PG8_WAIT_L(0); PG8_BAR; PG8_MMA(0, 0, At, B0); PG8_MMA(0, 1, At, B1); PG8_BAR; PG8_SCHED;
            PG8_LDA(At, 1, 1); PG8_STAGE(PG8_SB(1, 0), b3, voffB); PG8_STAGE(PG8_SB(1, 1), b3 + hstep, voffB); PG8_STAGE(PG8_SA(1, 0), a3, voffA);
            PG8_WAIT_V(8); PG8_WAIT_L(0); PG8_BAR; PG8_MMA(1, 0, At, B0); PG8_MMA(1, 1, At, B1); PG8_BAR; PG8_SCHED;
            } else {
            PG8_LDB(B0, 0, 0); PG8_SCHED; PG8_LDA(At, 0, 0); PG8_STAGE(PG8_SA(1, 1), a1 + hstep, voffA);
            PG8_WAIT_L(8); PG8_BAR; PG8_WAIT_L(0); PG8_MMA(0, 0, At, B0); PG8_BAR; PG8_SCHED;
            PG8_LDB(B1, 0, 1); PG8_STAGE(PG8_SB(0, 0), b2, voffB);
            PG8_BAR; PG8_WAIT_L(0); PG8_MMA(0, 1, At, B1); PG8_BAR;
            PG8_LDA(At, 0, 1); PG8_STAGE(PG8_SA(0, 0), a2, voffA);
            PG8_BAR; PG8_WAIT_L(0); PG8_MMA(1, 0, At, B0); PG8_BAR; PG8_SCHED;
            PG8_STAGE(PG8_SB(0, 1), b2 + hstep, voffB);
            PG8_WAIT_V(6); PG8_BAR; PG8_MMA(1, 1, At, B1); PG8_BAR;
            PG8_LDB(B0, 1, 0); PG8_SCHED; PG8_LDA(At, 1, 0); PG8_STAGE(PG8_SA(0, 1), a2 + hstep, voffA);
            PG8_WAIT_L(8); PG8_BAR; PG8_WAIT_L(0); PG8_MMA(0, 0, At, B0); PG8_BAR; PG8_SCHED;
            PG8_LDB(B1, 1, 1); PG8_STAGE(PG8_SB(1, 0), b3, voffB);
            PG8_BAR; PG8_WAIT_L(0); PG8_MMA(0, 1, At, B1); PG8_BAR;
            PG8_LDA(At, 1, 1); PG8_STAGE(PG8_SA(1, 0), a3, voffA);
            PG8_BAR; PG8_WAIT_L(0); PG8_MMA(1, 0, At, B0); PG8_BAR; PG8_SCHED;
            PG8_STAGE(PG8_SB(1, 1), b3 + hstep, voffB);
            PG8_WAIT_V(6); PG8_BAR; PG8_MMA(1, 1, At, B1); PG8_BAR;
            }
        }
        if constexpr (ALIGN_EPI) { if (wr == 0) PG8_BAR; }
        if constexpr (!Epi::AFTER_DRAIN) { E(acc, cur, wr, wc, fr, fq); S.done(cur); }
        if (!has_next) break;
#pragma unroll
        for (int a = 0; a < 2; ++a)
#pragma unroll
            for (int b = 0; b < 2; ++b)
#pragma unroll
                for (int m = 0; m < 4; ++m)
#pragma unroll
                    for (int n = 0; n < 2; ++n) acc[a][b][m][n] = (f32x4){0.f, 0.f, 0.f, 0.f};
        cur = nxt; cA = nA; cB = nB; ++ui;
        if constexpr (ALIGN_EPI) { if (wr == 1) PG8_BAR; }
    }
    PG8_WAIT_V(0);
    if constexpr (!ALIGN_EPI) { if (wr == 0) PG8_BAR; }
    PG8_BAR;
    if constexpr (Epi::AFTER_DRAIN) { E.fused(acc, cur, wr, wc, fr, fq, lds, wid, lane); S.done(cur); }
#undef PG8_SA
#undef PG8_SB
#undef PG8_STAGE
#undef PG8_LDA
#undef PG8_LDB
#undef PG8_MMA
#undef PG8_WAIT_V
#undef PG8_WAIT_L
#undef PG8_BAR
#undef PG8_SCHED
}
}
#define LAS __attribute__((address_space(3)))
typedef unsigned short bf16_t;
typedef short bf16x8 __attribute__((ext_vector_type(8)));
typedef float f32x4 __attribute__((ext_vector_type(4)));
typedef float f32x2 __attribute__((ext_vector_type(2)));
typedef unsigned u32x4 __attribute__((ext_vector_type(4)));
typedef unsigned u32x2 __attribute__((ext_vector_type(2)));

constexpr int D = 1024, NB = 8, SEQ = 2048, CTXL = 256, DFF = 2816;
constexpr int MX = NB * SEQ;
constexpr int MC = NB * CTXL;
constexpr int MT = MX + MC;
constexpr int NMOD = 9;
constexpr int NEV = 3072;
constexpr int NQKV = 1536;
constexpr float EPS = 1e-6f;
constexpr int LDS_BYTES = 147456;
constexpr int NTHREADS = 512;

constexpr size_t MiB = 1u << 20;
constexpr size_t SZ_WIN = (size_t)5632 * 1024 * 2, SZ_WOUT = (size_t)1024 * 2816 * 2;
constexpr size_t WS_WIN = 0;
constexpr size_t WS_WOUT = WS_WIN + 4 * SZ_WIN;
constexpr size_t WS_WEIN = WS_WOUT + 4 * SZ_WOUT;
constexpr size_t WS_WEOUT = WS_WEIN + (size_t)3072 * 1024 * 2;
constexpr size_t WS_WQKV = WS_WEOUT + (size_t)1024 * 1024 * 2;
constexpr size_t WS_WOOUT = WS_WQKV + (size_t)1536 * 1024 * 2;
constexpr size_t WS_MOD = WS_WOOUT + (size_t)1024 * 1024 * 2;
constexpr size_t WS_WG = WS_MOD + (size_t)2 * 9 * 9216 * 4;
constexpr size_t WS_ROPE = WS_WG + (size_t)16 * 1024 * 4;
constexpr size_t WS_GATES = WS_ROPE + 8192;
constexpr size_t WS_HC = WS_GATES + (size_t)MT * 16 * 4;
constexpr size_t WS_A0 = ((WS_HC + (size_t)MC * D * 4 + 255) / 256) * 256;
constexpr size_t WS_QC = WS_A0 + (size_t)MT * D * 2;
constexpr size_t WS_KC = WS_QC + (size_t)MT * 512 * 2;
constexpr size_t WS_KCT = WS_KC + (size_t)MT * 512 * 2;
constexpr size_t WS_A1 = WS_KCT + (size_t)576 * 128 * 128 * 2;
constexpr size_t WS_BIG = WS_A1 + (size_t)MT * D * 2;
constexpr size_t WS_CTL = WS_BIG + (size_t)MT * 3072 * 2;
constexpr size_t CTL_BYTES = 16384;
constexpr size_t WS_PC = WS_CTL + CTL_BYTES;
constexpr size_t WS_END = WS_PC + (size_t)MC * D * 4;

struct Args {
    const float* x; const float* c; const float* ctx; const float* c_ctx; const float* ada_w; const float* ada_b;
    const float* ffn_w_in; const float* ffn_w_out; const float* even_w_in; const float* even_w_out;
    const float* mlstm_conv; const float* mlstm_gate_b; const float* mlstm_norm; const float* sgu_norm; const float* sgu_ws; const float* sgu_b;
    const float* odd_w_qkv; const float* odd_w_out; const float* attn_sink; const float* final_norm;
    float* out; unsigned char* ws; int ph_lo, ph_hi;
};

typedef const __attribute__((address_space(4))) Args* kargp;
__device__ __forceinline__ kargp kargs() { kargp p = (kargp)__builtin_amdgcn_kernarg_segment_ptr(); asm volatile("" : "+s"(p)); return p; }
#define KA(f) (kargs()->f)
typedef __bf16 bf16x2_t __attribute__((ext_vector_type(2)));
__device__ __forceinline__ unsigned pk2(float lo, float hi) { f32x2 v = {lo, hi}; bf16x2_t b = __builtin_convertvector(v, bf16x2_t); return __builtin_bit_cast(unsigned, b); }
__device__ __forceinline__ bf16_t f2bf(float f) { return (bf16_t)(pk2(f, 0.f) & 0xffffu); }
__device__ __forceinline__ float bf2f(bf16_t v) { return __uint_as_float(((unsigned)v) << 16); }
__device__ __forceinline__ float bflo(unsigned w) { return __uint_as_float(w << 16); }
__device__ __forceinline__ float bfhi(unsigned w) { return __uint_as_float(w & 0xffff0000u); }
__device__ __forceinline__ float silu_f(float v) { return v * __builtin_amdgcn_rcpf(1.f + __expf(-v)); }
__device__ __forceinline__ float sigmoid_f(float v) { return __builtin_amdgcn_rcpf(1.f + __expf(-v)); }
__device__ __forceinline__ float gelu_tanh(float v) {
    const float z = 0.7978845608028654f * (v + 0.044715f * v * v * v);
    const float t = 1.f - 2.f * __builtin_amdgcn_rcpf(1.f + __expf(2.f * z));
    return 0.5f * v * (1.f + t);
}
template <int CTRL> __device__ __forceinline__ float dppf(float v) { return __builtin_bit_cast(float, __builtin_amdgcn_update_dpp(0, __builtin_bit_cast(int, v), CTRL, 0xf, 0xf, false)); }
__device__ __forceinline__ float row16_sum(float v) { v += dppf<0xB1>(v); v += dppf<0x4E>(v); v += dppf<0x141>(v); v += dppf<0x140>(v); return v; }
__device__ __forceinline__ float row16_max(float v) { v = fmaxf(v, dppf<0xB1>(v)); v = fmaxf(v, dppf<0x4E>(v)); v = fmaxf(v, dppf<0x141>(v)); v = fmaxf(v, dppf<0x140>(v)); return v; }
__device__ __forceinline__ float wave_sum(float v) { v = row16_sum(v); v += __shfl_xor(v, 16); v += __shfl_xor(v, 32); return v; }
__device__ __forceinline__ float wave_max(float v) { v = row16_max(v); v = fmaxf(v, __shfl_xor(v, 16)); v = fmaxf(v, __shfl_xor(v, 32)); return v; }
__device__ __forceinline__ f32x4 mfma16(bf16x8 a, bf16x8 b, f32x4 c) { return __builtin_amdgcn_mfma_f32_16x16x32_bf16(a, b, c, 0, 0, 0); }
__device__ __forceinline__ bf16x8 ldsfrag(const LAS unsigned char* p) { return *(const LAS bf16x8*)p; }

namespace pg8 {
struct EpiSwiglu {
    static constexpr bool PERM = true, AFTER_DRAIN = false;
    bf16_t* O;
    __device__ __forceinline__ void operator()(const f32x4 (&acc)[2][2][4][2], const Unit& u, int wr, int wc, int fr, int fq) const {
        const int row0 = u.pm * BM + wr * 64 + fr, col0 = u.pn * 128 + wc * 32 + 8 * fq;
#pragma unroll
        for (int ai = 0; ai < 2; ++ai)
#pragma unroll
            for (int m = 0; m < 4; ++m) {
                bf16_t* rowp = O + (size_t)(row0 + ai * HALF + m * 16) * DFF + col0;
                const f32x4 g0 = acc[ai][0][m][0], g1 = acc[ai][0][m][1], u0 = acc[ai][1][m][0], u1 = acc[ai][1][m][1];
                u32x4 w;
                w.x = ::pk2(::silu_f(g0[0]) * u0[0], ::silu_f(g0[1]) * u0[1]); w.y = ::pk2(::silu_f(g0[2]) * u0[2], ::silu_f(g0[3]) * u0[3]);
                w.z = ::pk2(::silu_f(g1[0]) * u1[0], ::silu_f(g1[1]) * u1[1]); w.w = ::pk2(::silu_f(g1[2]) * u1[2], ::silu_f(g1[3]) * u1[3]);
                *(u32x4*)rowp = w;
            }
    }
};
struct EpiResid {
    static constexpr bool PERM = false, AFTER_DRAIN = false;
    const float* bx; const float* bc; float* ox; float* oc; float* pc; const float* gate;
    float coef;
    __device__ __forceinline__ void operator()(const f32x4 (&acc)[2][2][4][2], const Unit& u, int wr, int wc, int fr, int fq) const {
        const bool isx = u.pm < 64; const bool split = u.k0 != 0;
        const int bi = isx ? (u.pm >> 3) : 8;
        const float* base = isx ? bx : bc - (size_t)MX * D;
        float* outp = isx ? ox : oc - (size_t)MX * D;
        const int row0 = u.pm * BM + wr * 64 + fr, col0 = u.pn * BM + wc * 32 + 4 * fq;
        const float* gp = gate + (size_t)bi * 9216 + col0;
#pragma unroll
        for (int bj = 0; bj < 2; ++bj)
#pragma unroll
            for (int n = 0; n < 2; ++n) {
                const f32x4 gv = *(const f32x4*)(gp + bj * HALF + n * 16) * coef;
#pragma unroll
                for (int ai = 0; ai < 2; ++ai)
#pragma unroll
                    for (int m = 0; m < 4; ++m) {
                        const size_t off = (size_t)(row0 + ai * HALF + m * 16) * D + col0 + bj * HALF + n * 16;
                        const f32x4 pv = gv * acc[ai][bj][m][n];
                        if (split) {
                            *(f32x4*)(pc + off - (size_t)MX * D) = pv;
                        } else {
                            const f32x4 b = *(const f32x4*)(base + off);
                            *(f32x4*)(outp + off) = b + pv;
                        }
                        if (m & 1) asm volatile("" ::: "memory");
                    }
            }
    }
};
struct EpiPlain {
    static constexpr bool PERM = true, AFTER_DRAIN = false;
    bf16_t* O; int ldc;
    __device__ __forceinline__ void operator()(const f32x4 (&acc)[2][2][4][2], const Unit& u, int wr, int wc, int fr, int fq) const {
        const int row0 = u.pm * BM + wr * 64 + fr, col0 = u.pn * BM + wc * 32 + 8 * fq;
#pragma unroll
        for (int ai = 0; ai < 2; ++ai)
#pragma unroll
            for (int m = 0; m < 4; ++m) {
                bf16_t* rowp = O + (size_t)(row0 + ai * HALF + m * 16) * ldc + col0;
#pragma unroll
                for (int bj = 0; bj < 2; ++bj) {
                    const f32x4 v0 = acc[ai][bj][m][0], v1 = acc[ai][bj][m][1];
                    u32x4 w; w.x = ::pk2(v0[0], v0[1]); w.y = ::pk2(v0[2], v0[3]); w.z = ::pk2(v1[0], v1[1]); w.w = ::pk2(v1[2], v1[3]);
                    *(u32x4*)(rowp + bj * HALF) = w;
                }
            }
    }
};
struct EpiQKV {
    static constexpr bool PERM = true, AFTER_DRAIN = false;
    bf16_t* O; const float* rope;
    __device__ __forceinline__ void operator()(const f32x4 (&acc)[2][2][4][2], const Unit& u, int wr, int wc, int fr, int fq) const {
        const int row0 = u.pm * BM + wr * 64 + fr;
        const bool isx = u.pm < 64;
#pragma unroll
        for (int bj = 0; bj < 2; ++bj) {
            const int col0 = u.pn * BM + bj * HALF + wc * 32 + 8 * fq;
            const bool dorope = isx && (col0 < 1280);
            const float qs = (col0 < 1024) ? 0.125f : 1.f;
            const int p0 = (col0 & 63) >> 1;
            const int f0 = p0 & 15;
#pragma unroll
            for (int ai = 0; ai < 2; ++ai)
#pragma unroll
                for (int m = 0; m < 4; ++m) {
                    const int row = row0 + ai * HALF + m * 16;
                    f32x4 v0 = acc[ai][bj][m][0] * qs, v1 = acc[ai][bj][m][1] * qs;
                    if (dorope) {
                        const int t = row & 2047;
                        const int pos = (p0 < 16) ? (t >> 6) : (t & 63);
                        const f32x4 cs0 = *(const f32x4*)(rope + (pos * 16 + f0) * 2), cs1 = *(const f32x4*)(rope + (pos * 16 + f0) * 2 + 4);
                        f32x4 r0, r1;
                        r0[0] = v0[0] * cs0[0] - v0[1] * cs0[1]; r0[1] = v0[0] * cs0[1] + v0[1] * cs0[0];
                        r0[2] = v0[2] * cs0[2] - v0[3] * cs0[3]; r0[3] = v0[2] * cs0[3] + v0[3] * cs0[2];
                        r1[0] = v1[0] * cs1[0] - v1[1] * cs1[1]; r1[1] = v1[0] * cs1[1] + v1[1] * cs1[0];
                        r1[2] = v1[2] * cs1[2] - v1[3] * cs1[3]; r1[3] = v1[2] * cs1[3] + v1[3] * cs1[2];
                        v0 = r0; v1 = r1;
                    }
                    u32x4 w; w.x = ::pk2(v0[0], v0[1]); w.y = ::pk2(v0[2], v0[3]); w.z = ::pk2(v1[0], v1[1]); w.w = ::pk2(v1[2], v1[3]);
                    *(u32x4*)(O + (size_t)row * NQKV + col0) = w;
                }
        }
    }
};
}

__device__ __forceinline__ void tr_item(const float* W, int ldw, int k0, int srccol0, bf16_t* WT, int K, int destrow0, LAS float* scr, int lane) {
#pragma unroll 8
    for (int i = 0; i < 32; ++i) { const int kk = 2 * i + (lane >> 5); scr[kk * 33 + (lane & 31)] = W[(size_t)(k0 + kk) * ldw + srccol0 + (lane & 31)]; }
    asm volatile("s_waitcnt lgkmcnt(0)" ::: "memory");
    const int c = lane & 7;
#pragma unroll
    for (int j = 0; j < 4; ++j) { const int n = (lane >> 3) + 8 * j; const LAS float* s = scr + (8 * c) * 33 + n;
        u32x4 o; o.x = pk2(s[0 * 33], s[1 * 33]); o.y = pk2(s[2 * 33], s[3 * 33]); o.z = pk2(s[4 * 33], s[5 * 33]); o.w = pk2(s[6 * 33], s[7 * 33]);
        *(u32x4*)(WT + (size_t)(destrow0 + n) * K + k0 + 8 * c) = o; }
    asm volatile("s_waitcnt lgkmcnt(0)" ::: "memory");
}

__device__ __forceinline__ void convert_group(LAS unsigned char* lds, int grp, int worker, int nworkers) {
    int tid_ = threadIdx.x; asm volatile("" : "+v"(tid_)); const int tid = tid_, lane = tid & 63, wid = __builtin_amdgcn_readfirstlane(tid >> 6);
    unsigned char* ws = KA(ws);
    LAS float* scr = (LAS float*)(lds + wid * 16384);
    constexpr int I_IN = 16 * 176, I_OUT = 44 * 32, I_EIN = 16 * 96, I_SQ = 16 * 32, I_QKV = 16 * 48;
    const int n2 = grp == 1 ? I_EIN : (grp == 2 ? I_QKV : 0), n3 = (grp == 1 || grp == 2) ? I_SQ : 0;
    const int total = I_IN + I_OUT + n2 + n3;
    for (int it = worker + wid; it < total; it += nworkers) {
        int r = it;
        if (r < I_IN) { const int kb = r / 176, nb = r % 176; const int n0 = nb * 32;
            const int dest = (n0 < 2816) ? ((n0 >> 7) * 256 + (n0 & 127)) : ((((n0 - 2816) >> 7) * 256) + 128 + ((n0 - 2816) & 127));
            tr_item(KA(ffn_w_in) + (size_t)grp * 1024 * 5632, 5632, kb * 64, n0, (bf16_t*)(ws + WS_WIN + grp * SZ_WIN), 1024, dest, scr, lane); continue; }
        r -= I_IN;
        if (r < I_OUT) { const int kb = r / 32, nb = r % 32;
            tr_item(KA(ffn_w_out) + (size_t)grp * 2816 * 1024, 1024, kb * 64, nb * 32, (bf16_t*)(ws + WS_WOUT + grp * SZ_WOUT), 2816, nb * 32, scr, lane); continue; }
        r -= I_OUT;
        if (r < n2) {
            if (grp == 1) { const int kb = r / 96, nb = r % 96; const int src = nb < 64 ? nb * 32 : 2064 + (nb - 64) * 32;
                tr_item(KA(even_w_in), 3088, kb * 64, src, (bf16_t*)(ws + WS_WEIN), 1024, nb * 32, scr, lane); }
            else { const int kb = r / 48, nb = r % 48; tr_item(KA(odd_w_qkv), 1536, kb * 64, nb * 32, (bf16_t*)(ws + WS_WQKV), 1024, nb * 32, scr, lane); }
            continue; }
        r -= n2;
        { const int kb = r / 32, nb = r % 32;
          if (grp == 1) tr_item(KA(even_w_out), 1024, kb * 64, nb * 32, (bf16_t*)(ws + WS_WEOUT), 1024, nb * 32, scr, lane);
          else tr_item(KA(odd_w_out), 1024, kb * 64, nb * 32, (bf16_t*)(ws + WS_WOOUT), 1024, nb * 32, scr, lane); }
    }
}

__device__ __forceinline__ void p0_phase(LAS unsigned char* lds) {
    int tid_ = threadIdx.x; asm volatile("" : "+v"(tid_)); const int tid = tid_, lane = tid & 63, wid = __builtin_amdgcn_readfirstlane(tid >> 6), G = gridDim.x;
    unsigned char* ws = KA(ws);
    {
        LAS float* s = (LAS float*)lds;
        LAS float* red = (LAS float*)(lds + 36864);
        for (int i = tid; i < 9 * 1024; i += NTHREADS) { const float v = (i < 8192) ? KA(c)[i] : KA(c_ctx)[i - 8192]; s[i] = v / (1.f + expf(-v)); }
        __syncthreads();
        float* mod = (float*)(ws + WS_MOD);
        for (int tile = blockIdx.x; tile < 288; tile += G) {
            const int l = tile / 144, cg = tile % 144, n = cg * 64 + lane, kg = wid;
            float acc[9];
#pragma unroll
            for (int bi = 0; bi < 9; ++bi) acc[bi] = 0.f;
            const float* wp = KA(ada_w) + ((size_t)l * 1024 + kg * 128) * 9216 + n;
#pragma unroll 4
            for (int kk = 0; kk < 128; ++kk) {
                const float w = wp[(size_t)kk * 9216];
#pragma unroll
                for (int bi = 0; bi < 9; ++bi) acc[bi] += s[bi * 1024 + kg * 128 + kk] * w;
            }
#pragma unroll
            for (int bi = 0; bi < 9; ++bi) red[(kg * 9 + bi) * 64 + lane] = acc[bi];
            __syncthreads();
            for (int i = tid; i < 576; i += NTHREADS) {
                const int bi = i >> 6, cc = i & 63; float sum = 0.f;
#pragma unroll
                for (int k2 = 0; k2 < 8; ++k2) sum += red[(k2 * 9 + bi) * 64 + cc];
                mod[((size_t)l * 9 + bi) * 9216 + cg * 64 + cc] = sum + KA(ada_b)[l * 9216 + cg * 64 + cc];
            }
            __syncthreads();
        }
    }
    {
        const int gt = blockIdx.x * NTHREADS + tid, GT = G * NTHREADS;
        float* wg = (float*)(ws + WS_WG);
        for (int i = gt; i < 16 * 1024; i += GT) { const int g = i >> 10, k = i & 1023; wg[i] = KA(even_w_in)[(size_t)k * 3088 + 2048 + g]; }
        float* rope = (float*)(ws + WS_ROPE);
        for (int i = gt; i < 64 * 16; i += GT) { const int pos = i >> 4, f = i & 15; const float inv = powf(10000.f, -(float)f / 16.f); const float ang = (float)pos * inv; rope[2 * i] = cosf(ang); rope[2 * i + 1] = sinf(ang); }
    }
    convert_group(lds, 0, blockIdx.x * 8, G * 8);
    if (G <= 64) { convert_group(lds, 1, blockIdx.x * 8, G * 8); convert_group(lds, 2, blockIdx.x * 8, G * 8); convert_group(lds, 3, blockIdx.x * 8, G * 8); }
}

template <bool GATES>
__device__ __forceinline__ void norm_phase(LAS unsigned char* lds, const float* hx, const float* hc, bf16_t* A0, const float* modl, int shift_i, int scale_i, int nrows,
                                           const float* wg, const float* gate_b, float* gates, float* copy_c) {
    int tid_ = threadIdx.x; asm volatile("" : "+v"(tid_)); const int tid = tid_, lane = tid & 63, wid = __builtin_amdgcn_readfirstlane(tid >> 6), G = gridDim.x;
    LAS float* wgs = (LAS float*)lds;
    if (GATES) { for (int i = tid; i < 16 * 1024 / 4; i += NTHREADS) ((LAS f32x4*)wgs)[i] = ((const f32x4*)wg)[i]; __syncthreads(); }
    const int R0 = blockIdx.x * 8 + wid, RS = G * 8;
    f32x4 vn[4], pn[4];
#define NORM_LOAD(R_) do { const bool isx_ = (R_) < MX; const float* src_ = isx_ ? hx + (size_t)(R_) * D : hc + (size_t)((R_) - MX) * D; \
        _Pragma("unroll") for (int j = 0; j < 4; ++j) { vn[j] = *(const f32x4*)(src_ + 256 * j + 4 * lane); \
            pn[j] = (copy_c && !isx_) ? *(const f32x4*)(copy_c + (size_t)((R_) - MX) * D + 256 * j + 4 * lane) : (f32x4){0.f, 0.f, 0.f, 0.f}; } } while (0)
    if (R0 < nrows) NORM_LOAD(R0);
    for (int R = R0; R < nrows; R += RS) {
        const bool isx = R < MX;
        const int bi = isx ? (R >> 11) : 8;
        const float* mb = modl + (size_t)bi * 9216;
        f32x4 v[4]; float ss = 0.f;
#pragma unroll
        for (int j = 0; j < 4; ++j) { v[j] = vn[j] + pn[j];
            if (copy_c && !isx) *(f32x4*)((float*)hc + (size_t)(R - MX) * D + 256 * j + 4 * lane) = v[j];
            ss += (v[j][0] * v[j][0] + v[j][1] * v[j][1]) + (v[j][2] * v[j][2] + v[j][3] * v[j][3]); }
        if (R + RS < nrows) NORM_LOAD(R + RS);
        const float rstd = 1.0f / sqrtf(wave_sum(ss) * (1.f / D) + EPS);
#pragma unroll
        for (int j = 0; j < 4; ++j) {
            const f32x4 sc = *(const f32x4*)(mb + scale_i * 1024 + 256 * j + 4 * lane), sh = *(const f32x4*)(mb + shift_i * 1024 + 256 * j + 4 * lane);
            v[j] = v[j] * rstd * (sc + 1.f) + sh;
            u32x2 w; w.x = pk2(v[j][0], v[j][1]); w.y = pk2(v[j][2], v[j][3]);
            *(u32x2*)(A0 + (size_t)R * D + 256 * j + 4 * lane) = w;
        }
        if (GATES) {
            float mine = 0.f;
#pragma unroll 1
            for (int g = 0; g < 16; ++g) {
                float d = 0.f;
#pragma unroll
                for (int j = 0; j < 4; ++j) { const f32x4 w = *(const LAS f32x4*)(wgs + g * 1024 + 256 * j + 4 * lane); d += (v[j][0] * w[0] + v[j][1] * w[1]) + (v[j][2] * w[2] + v[j][3] * w[3]); }
                d = wave_sum(d);
                if (lane == g) mine = d;
            }
            if (lane < 16) gates[(size_t)R * 16 + lane] = mine + gate_b[lane];
        }
    }
    if (GATES) __syncthreads();
}

__device__ __forceinline__ void qkprep_phase(LAS unsigned char* lds, const bf16_t* P, const float* convw, bf16_t* Qc, bf16_t* Kc, bf16_t* KcT) {
    int tid_ = threadIdx.x; asm volatile("" : "+v"(tid_)); const int tid = tid_;
    constexpr int LD = 136;
    LAS bf16_t* Tt = (LAS bf16_t*)lds;
    LAS float* cw = (LAS float*)(lds + 34816);
    const int seg = tid & 15;
    for (int unit = blockIdx.x; unit < 576; unit += gridDim.x) {
        const int h = unit & 3, gc = unit >> 2, n = gc % 18, b = gc / 18;
        const int sbase = n < 2 ? MX + b * CTXL : b * SEQ, T = n < 2 ? CTXL : SEQ, t0 = n < 2 ? n * 128 : (n - 2) * 128;
        for (int i = tid; i < 768; i += NTHREADS) { const int qk = i / 384, j = (i % 384) >> 7, ch = i & 127; cw[i] = convw[j * 1024 + qk * 512 + h * 128 + ch]; }
        __syncthreads();
#pragma unroll 1
        for (int it = 0; it < 4; ++it) {
            const int l = (tid + NTHREADS * it) >> 4;
            const int tin = t0 + l;
            const size_t R = (size_t)(sbase + tin);
            const bf16_t* pr = P + R * NEV + h * 128 + seg * 8;
            const u32x4 z = (u32x4){0u, 0u, 0u, 0u};
#pragma unroll
            for (int qk = 0; qk < 2; ++qk) {
                const bf16_t* pp = pr + qk * 512;
                const u32x4 c0 = *(const u32x4*)pp; const u32x4 pv = tin > 0 ? *(const u32x4*)(pp - NEV) : z; const u32x4 nx = tin < T - 1 ? *(const u32x4*)(pp + NEV) : z;
                float y[8];
#pragma unroll
                for (int hf = 0; hf < 2; ++hf) {
                    const f32x4 w0 = *(const LAS f32x4*)(cw + (qk * 3 + 0) * 128 + seg * 8 + 4 * hf), w1 = *(const LAS f32x4*)(cw + (qk * 3 + 1) * 128 + seg * 8 + 4 * hf), w2v = *(const LAS f32x4*)(cw + (qk * 3 + 2) * 128 + seg * 8 + 4 * hf);
                    y[4 * hf + 0] = w0[0] * bflo(pv[2 * hf]) + w1[0] * bflo(c0[2 * hf]) + w2v[0] * bflo(nx[2 * hf]);
                    y[4 * hf + 1] = w0[1] * bfhi(pv[2 * hf]) + w1[1] * bfhi(c0[2 * hf]) + w2v[1] * bfhi(nx[2 * hf]);
                    y[4 * hf + 2] = w0[2] * bflo(pv[2 * hf + 1]) + w1[2] * bflo(c0[2 * hf + 1]) + w2v[2] * bflo(nx[2 * hf + 1]);
                    y[4 * hf + 3] = w0[3] * bfhi(pv[2 * hf + 1]) + w1[3] * bfhi(c0[2 * hf + 1]) + w2v[3] * bfhi(nx[2 * hf + 1]);
                }
                const float scl = qk ? 0.08838834764831845f : 1.f;
                u32x4 o;
#pragma unroll
                for (int w2 = 0; w2 < 4; ++w2) o[w2] = pk2(silu_f(y[2 * w2]) * scl, silu_f(y[2 * w2 + 1]) * scl);
                *(u32x4*)((qk ? Kc : Qc) + R * 512 + h * 128 + seg * 8) = o;
                if (qk) {
#pragma unroll
                    for (int w2 = 0; w2 < 4; ++w2) { Tt[(seg * 8 + 2 * w2) * LD + l] = (bf16_t)(o[w2] & 0xffffu); Tt[(seg * 8 + 2 * w2 + 1) * LD + l] = (bf16_t)(o[w2] >> 16); }
                }
            }
        }
        __syncthreads();
#pragma unroll
        for (int it = 0; it < 4; ++it) { const int i = tid + NTHREADS * it; const int d = i >> 4, sg = i & 15;
            *(u32x4*)(KcT + ((size_t)unit * 128 + d) * 128 + sg * 8) = *(const LAS u32x4*)(Tt + d * LD + sg * 8); }
        __syncthreads();
    }
}

__device__ __forceinline__ void mlstm_phase(LAS unsigned char* lds, const bf16_t* P, const float* gates, const bf16_t* Qc, const bf16_t* Kc, const bf16_t* KcT, bf16_t* Hdir) {
    int tid_ = threadIdx.x; asm volatile("" : "+v"(tid_)); const int tid = tid_, lane = tid & 63, wid = __builtin_amdgcn_readfirstlane(tid >> 6), r = lane & 15, q = lane >> 4;
    constexpr int LD = 136, LDB = LD * 2;
    constexpr int OFF_Q = 0, OFF_K = 34816, OFF_KT = 69632, OFF_VT = 104448, OFF_VW = 113152, OFF_CT = 121856, OFF_SC = 130560;
    LAS bf16_t* Qs = (LAS bf16_t*)(lds + OFF_Q); LAS bf16_t* Ks = (LAS bf16_t*)(lds + OFF_K); LAS bf16_t* Kt = (LAS bf16_t*)(lds + OFF_KT);
    LAS bf16_t* Vt = (LAS bf16_t*)(lds + OFF_VT); LAS bf16_t* Vw = (LAS bf16_t*)(lds + OFF_VW); LAS bf16_t* Ct = (LAS bf16_t*)(lds + OFF_CT);
    LAS float* sc = (LAS float*)(lds + OFF_SC);
    LAS float* qn = sc + 1536; LAS float* nvec = sc + 1664;
    for (int unit = blockIdx.x; unit < 256; unit += gridDim.x) {
        const int es = unit & 3, dir = (unit >> 2) & 1, h = (unit >> 3) & 3, b = unit >> 5;
        for (int i = tid; i < 32 * LD / 2; i += NTHREADS) ((LAS unsigned*)Ct)[i] = 0u;
        if (tid < 128) nvec[tid] = 0.f;
        f32x4 Cacc[2]; Cacc[0] = (f32x4){0.f, 0.f, 0.f, 0.f}; Cacc[1] = Cacc[0];
        float m_state = 0.f;
        u32x4 pq[4], pk[4], pt[4], pvv; float pgi[2], pgf[2];
        const unsigned voffq = (unsigned)(((tid >> 4) * 512 + (tid & 15) * 8) * 2), vofft = (unsigned)(((tid >> 4) * 128 + (tid & 15) * 8) * 2);
#define MLSTM_CHUNK_INFO(ci_, n_, gc_, rb_) do { if ((ci_) < 2) n_ = dir ? 1 - (ci_) : (ci_); else n_ = dir ? 19 - (ci_) : (ci_); gc_ = b * 18 + n_; rb_ = n_ < 2 ? MX + b * CTXL + n_ * 128 : b * SEQ + (n_ - 2) * 128; } while (0)
#define MLSTM_PREFETCH(ci_) do { int n2, gc2, rb2; MLSTM_CHUNK_INFO(ci_, n2, gc2, rb2); \
            const bf16_t* qg = Qc + (size_t)rb2 * 512 + h * 128; const bf16_t* kg2 = Kc + (size_t)rb2 * 512 + h * 128; const bf16_t* tg2 = KcT + (size_t)(gc2 * 4 + h) * 128 * 128; \
            _Pragma("unroll") for (int it = 0; it < 4; ++it) { \
                pq[it] = *(const u32x4*)((const char*)(qg + it * 16384) + voffq); pk[it] = *(const u32x4*)((const char*)(kg2 + it * 16384) + voffq); pt[it] = *(const u32x4*)((const char*)(tg2 + it * 4096) + vofft); } \
            pvv = *(const u32x4*)(P + (size_t)(rb2 + (tid >> 2)) * NEV + 1024 + h * 128 + es * 32 + (tid & 3) * 8); } while (0)
#define MLSTM_LOAD_GATES(ci_) do { int n3, gc3, rb3; MLSTM_CHUNK_INFO(ci_, n3, gc3, rb3); (void)gc3; \
            _Pragma("unroll") for (int hf = 0; hf < 2; ++hf) { const int l = lane + 64 * hf; const int R = rb3 + (dir ? 127 - l : l); \
                pgi[hf] = gates[(size_t)R * 16 + dir * 8 + h]; pgf[hf] = gates[(size_t)R * 16 + dir * 8 + 4 + h]; } } while (0)
#define MLSTM_SCALARS(D_) do { LAS float* rowf_ = (D_); LAS float* dmb_ = (D_) + 128; LAS float* inter_ = (D_) + 256; LAS float* wl_ = (D_) + 384; LAS float* en_ = (D_) + 512; LAS float* misc_ = (D_) + 640; \
            float ig[2], bc[2]; \
            _Pragma("unroll") for (int hf = 0; hf < 2; ++hf) { ig[hf] = pgi[hf]; const float fg = pgf[hf]; bc[hf] = fminf(fg, 0.f) - log1pf(expf(-fabsf(fg))); } \
            _Pragma("unroll") for (int off = 1; off < 64; off <<= 1) { const float t0 = __shfl_up(bc[0], off), t1 = __shfl_up(bc[1], off); if (lane >= off) { bc[0] += t0; bc[1] += t1; } } \
            bc[1] += __shfl(bc[0], 63); \
            const float g_ = __shfl(bc[1], 63); \
            const float d0 = ig[0] - bc[0], d1 = ig[1] - bc[1]; \
            float p0 = d0, p1 = d1; \
            _Pragma("unroll") for (int off = 1; off < 64; off <<= 1) { const float t0 = __shfl_up(p0, off), t1 = __shfl_up(p1, off); if (lane >= off) { p0 = fmaxf(p0, t0); p1 = fmaxf(p1, t1); } } \
            p1 = fmaxf(p1, __shfl(p0, 63)); \
            const float a0 = g_ + d0, a1 = g_ + d1; \
            const float mloc = wave_max(fmaxf(a0, a1)); \
            const float m_new = fmaxf(g_ + m_state, mloc); \
            const float dec_ = expf(g_ + m_state - m_new); \
            const float mt0 = bc[0] + fmaxf(m_state, p0), mt1 = bc[1] + fmaxf(m_state, p1); \
            const int i0 = dir ? 127 - lane : lane, i1 = dir ? 63 - lane : lane + 64; \
            rowf_[i0] = bc[0] - mt0; rowf_[i1] = bc[1] - mt1; \
            dmb_[i0] = d0; dmb_[i1] = d1; \
            inter_[i0] = expf(bc[0] + m_state - mt0); inter_[i1] = expf(bc[1] + m_state - mt1); \
            wl_[i0] = expf(a0 - m_new); wl_[i1] = expf(a1 - m_new); \
            en_[i0] = expf(-mt0); en_[i1] = expf(-mt1); \
            if (lane == 0) misc_[0] = dec_; \
            m_state = m_new; } while (0)
        const bool swave = wid == (dir ? 7 : 0);
        if (swave) { MLSTM_LOAD_GATES(0); MLSTM_SCALARS(sc); MLSTM_LOAD_GATES(1); }
        MLSTM_PREFETCH(0);
        __syncthreads();
        for (int ci = 0; ci < 18; ++ci) {
            int wc_ = wid, dc_ = dir; asm volatile("" : "+s"(wc_), "+s"(dc_)); const int widc = wc_, dirc = dc_;
            int n, gc, rbase;
            MLSTM_CHUNK_INFO(ci, n, gc, rbase); (void)gc;
            LAS float* scb = sc + (ci & 1) * 768;
            LAS float* rowf = scb; LAS float* dmb = scb + 128; LAS float* inter = scb + 256; LAS float* wl = scb + 384; LAS float* en = scb + 512; LAS float* misc = scb + 640;
#pragma unroll
            for (int it = 0; it < 4; ++it) { const int i = tid + NTHREADS * it; const int row = i >> 4, sg = i & 15; *(LAS u32x4*)(Qs + row * LD + sg * 8) = pq[it]; }
            {
                const int t = tid >> 2, sg = tid & 3;
                const u32x4 vv = pvv;
                const float w = wl[t];
#pragma unroll
                for (int w2 = 0; w2 < 4; ++w2) {
                    Vt[(sg * 8 + 2 * w2) * LD + t] = (bf16_t)(vv[w2] & 0xffffu); Vt[(sg * 8 + 2 * w2 + 1) * LD + t] = (bf16_t)(vv[w2] >> 16);
                    Vw[(sg * 8 + 2 * w2) * LD + t] = f2bf(bflo(vv[w2]) * w); Vw[(sg * 8 + 2 * w2 + 1) * LD + t] = f2bf(bfhi(vv[w2]) * w);
                }
            }
#pragma unroll
            for (int it = 0; it < 4; ++it) { const int i = tid + NTHREADS * it; const int row = i >> 4, sg = i & 15; *(LAS u32x4*)(Ks + row * LD + sg * 8) = pk[it]; *(LAS u32x4*)(Kt + row * LD + sg * 8) = pt[it]; }
            __syncthreads();
            const float dec = misc[0];
            if (swave && ci + 1 < 18) { MLSTM_SCALARS(sc + ((ci + 1) & 1) * 768); if (ci + 2 < 18) MLSTM_LOAD_GATES(ci + 2); }
            {
                const int t = tid >> 2, part = tid & 3; float s = 0.f;
#pragma unroll
                for (int i = 0; i < 4; ++i) {
                    const u32x4 qv = *(const LAS u32x4*)(Qs + t * LD + part * 32 + i * 8);
                    const f32x4 n0 = *(const LAS f32x4*)(nvec + part * 32 + i * 8), n1 = *(const LAS f32x4*)(nvec + part * 32 + i * 8 + 4);
                    s += bflo(qv[0]) * n0[0] + bfhi(qv[0]) * n0[1] + bflo(qv[1]) * n0[2] + bfhi(qv[1]) * n0[3] + bflo(qv[2]) * n1[0] + bfhi(qv[2]) * n1[1] + bflo(qv[3]) * n1[2] + bfhi(qv[3]) * n1[3];
                }
                s += dppf<0xB1>(s); s += dppf<0x4E>(s);
                if (part == 0) qn[t] = s;
            }
            bf16x8 qfr[4];
#pragma unroll
            for (int ks = 0; ks < 4; ++ks) qfr[ks] = ldsfrag(lds + OFF_Q + (16 * wid + r) * LDB + (32 * ks + 8 * q) * 2);
            u32x2 pw[8]; float rs = 0.f;
            {
                const float rf = rowf[16 * wid + r]; const int t = 16 * wid + r;
#pragma unroll
                for (int jb = 0; jb < 8; ++jb) {
                    pw[jb].x = 0u; pw[jb].y = 0u;
                    if (dirc ? (jb >= widc) : (jb <= widc)) {
                        f32x4 acc = (f32x4){0.f, 0.f, 0.f, 0.f};
#pragma unroll
                        for (int ks = 0; ks < 4; ++ks) acc = mfma16(ldsfrag(lds + OFF_K + (16 * jb + r) * LDB + (32 * ks + 8 * q) * 2), qfr[ks], acc);
                        const f32x4 dm = *(const LAS f32x4*)(dmb + 16 * jb + 4 * q);
                        float v[4];
#pragma unroll
                        for (int reg = 0; reg < 4; ++reg) { const int sidx = 16 * jb + 4 * q + reg; const bool ok = dirc ? (sidx >= t) : (sidx <= t);
                            v[reg] = ok ? acc[reg] * __expf(rf + dm[reg]) : 0.f; }
                        rs += (v[0] + v[1]) + (v[2] + v[3]);
                        pw[jb].x = pk2(v[0], v[1]); pw[jb].y = pk2(v[2], v[3]);
                    }
                }
                rs += __shfl_xor(rs, 16); rs += __shfl_xor(rs, 32);
            }
            {
                const int kh = widc >> 1, t = 16 * wid + r;
                const float it_ = inter[t], den = rs + it_ * qn[t];
                const float inv = 1.f / fmaxf(fabsf(den), en[t]);
#pragma unroll
                for (int nt = 0; nt < 2; ++nt) {
                    f32x4 a1 = (f32x4){0.f, 0.f, 0.f, 0.f}, a2 = a1;
#pragma unroll
                    for (int a4 = 0; a4 < 4; ++a4) {
                        if (dirc ? (a4 >= kh) : (a4 <= kh)) {
                            const u32x2 lo = *(const LAS u32x2*)(lds + OFF_VT + (16 * nt + r) * LDB + (32 * a4 + 4 * q) * 2), hi = *(const LAS u32x2*)(lds + OFF_VT + (16 * nt + r) * LDB + (32 * a4 + 16 + 4 * q) * 2);
                            u32x4 va; va.x = lo.x; va.y = lo.y; va.z = hi.x; va.w = hi.y;
                            u32x4 pb; pb.x = pw[2 * a4].x; pb.y = pw[2 * a4].y; pb.z = pw[2 * a4 + 1].x; pb.w = pw[2 * a4 + 1].y;
                            a1 = mfma16(__builtin_bit_cast(bf16x8, va), __builtin_bit_cast(bf16x8, pb), a1);
                        }
                        a2 = mfma16(ldsfrag(lds + OFF_CT + (16 * nt + r) * LDB + (32 * a4 + 8 * q) * 2), qfr[a4], a2);
                    }
                    u32x2 w; w.x = pk2((a1[0] + it_ * a2[0]) * inv, (a1[1] + it_ * a2[1]) * inv); w.y = pk2((a1[2] + it_ * a2[2]) * inv, (a1[3] + it_ * a2[3]) * inv);
                    *(u32x2*)(Hdir + ((size_t)dir * MT + rbase + t) * 512 + h * 128 + es * 32 + 16 * nt + 4 * q) = w;
                }
            }
            asm volatile("" ::: "memory");
            if (ci + 1 < 18) MLSTM_PREFETCH(ci + 1);
            asm volatile("" ::: "memory");
            {
                bf16x8 kf[4];
#pragma unroll
                for (int ks = 0; ks < 4; ++ks) kf[ks] = ldsfrag(lds + OFF_KT + (16 * wid + r) * LDB + (32 * ks + 8 * q) * 2);
#pragma unroll
                for (int nt = 0; nt < 2; ++nt) {
                    Cacc[nt] = Cacc[nt] * dec;
#pragma unroll
                    for (int ks = 0; ks < 4; ++ks) Cacc[nt] = mfma16(kf[ks], ldsfrag(lds + OFF_VW + (16 * nt + r) * LDB + (32 * ks + 8 * q) * 2), Cacc[nt]);
                }
            }
            float nnew;
            {
                const int d = tid >> 2, part = tid & 3; float s = 0.f;
#pragma unroll
                for (int i = 0; i < 4; ++i) {
                    const u32x4 kv = *(const LAS u32x4*)(Kt + d * LD + part * 32 + i * 8);
                    const f32x4 w0 = *(const LAS f32x4*)(wl + part * 32 + i * 8), w1 = *(const LAS f32x4*)(wl + part * 32 + i * 8 + 4);
                    s += bflo(kv[0]) * w0[0] + bfhi(kv[0]) * w0[1] + bflo(kv[1]) * w0[2] + bfhi(kv[1]) * w0[3] + bflo(kv[2]) * w1[0] + bfhi(kv[2]) * w1[1] + bflo(kv[3]) * w1[2] + bfhi(kv[3]) * w1[3];
                }
                s += dppf<0xB1>(s); s += dppf<0x4E>(s);
                nnew = dec * nvec[d] + s;
            }
            __syncthreads();
#pragma unroll
            for (int nt = 0; nt < 2; ++nt) { u32x2 w; w.x = pk2(Cacc[nt][0], Cacc[nt][1]); w.y = pk2(Cacc[nt][2], Cacc[nt][3]); *(LAS u32x2*)(Ct + (16 * nt + r) * LD + 16 * wid + 4 * q) = w; }
            if ((tid & 3) == 0) nvec[tid >> 2] = nnew;
        }
        __syncthreads();
    }
}

__device__ __forceinline__ void sgu_phase(LAS unsigned char* lds, const bf16_t* P, const float* sgu_norm, const float* sgu_ws, const float* sgu_b, bf16_t* A1) {
    int tid_ = threadIdx.x; asm volatile("" : "+v"(tid_)); const int tid = tid_, lane = tid & 63, wid = __builtin_amdgcn_readfirstlane(tid >> 6), r = lane & 15, q = lane >> 4;
    constexpr int LD = 136, LDB = LD * 2, OFF_W = 0, OFF_V = 34816, OFF_R = 69632;
    LAS bf16_t* Ws = (LAS bf16_t*)(lds + OFF_W); LAS bf16_t* Vt = (LAS bf16_t*)(lds + OFF_V); LAS float* rstd = (LAS float*)(lds + OFF_R);
    for (int unit = (int)gridDim.x - 1 - (int)blockIdx.x; unit < 144; unit += gridDim.x) {
        const int n = unit % 18, b = unit / 18;
        const int rbase = n < 2 ? MX + b * CTXL + n * 128 : b * SEQ + (n - 2) * 128;
        {
            const int tok = tid >> 2, part = tid & 3; float ss = 0.f;
            const bf16_t* pv = P + (size_t)(rbase + tok) * NEV + 2560 + part * 128;
#pragma unroll 4
            for (int i = 0; i < 16; ++i) { const u32x4 w = *(const u32x4*)(pv + i * 8);
#pragma unroll
                for (int k = 0; k < 4; ++k) { const float a0 = gelu_tanh(bflo(w[k])), a1 = gelu_tanh(bfhi(w[k])); ss += a0 * a0 + a1 * a1; } }
            ss += dppf<0xB1>(ss); ss += dppf<0x4E>(ss);
            if (part == 0) rstd[tok] = 1.0f / sqrtf(ss * (1.f / 512.f) + EPS);
        }
#pragma unroll 1
        for (int g = 0; g < 4; ++g) {
#pragma unroll
            for (int it = 0; it < 4; ++it) { const int i = tid + NTHREADS * it; const int p = i >> 4, sg = i & 15;
                const float* wp = sgu_ws + ((size_t)g * 128 + p) * 128 + sg * 8; const f32x4 w0 = *(const f32x4*)wp, w1 = *(const f32x4*)(wp + 4);
                u32x4 o; o.x = pk2(w0[0], w0[1]); o.y = pk2(w0[2], w0[3]); o.z = pk2(w1[0], w1[1]); o.w = pk2(w1[2], w1[3]);
                *(LAS u32x4*)(Ws + p * LD + sg * 8) = o; }
            if (g == 0) __syncthreads();
#pragma unroll
            for (int it = 0; it < 4; ++it) { const int i = tid + NTHREADS * it; const int tq = i >> 4, sg = i & 15;
                const u32x4 w = *(const u32x4*)(P + (size_t)(rbase + tq) * NEV + 2560 + g * 128 + sg * 8);
                const float rq = rstd[tq];
                const f32x4 g0 = *(const f32x4*)(sgu_norm + g * 128 + sg * 8), g1 = *(const f32x4*)(sgu_norm + g * 128 + sg * 8 + 4);
                Vt[(sg * 8 + 0) * LD + tq] = f2bf(gelu_tanh(bflo(w[0])) * rq * g0[0]); Vt[(sg * 8 + 1) * LD + tq] = f2bf(gelu_tanh(bfhi(w[0])) * rq * g0[1]);
                Vt[(sg * 8 + 2) * LD + tq] = f2bf(gelu_tanh(bflo(w[1])) * rq * g0[2]); Vt[(sg * 8 + 3) * LD + tq] = f2bf(gelu_tanh(bfhi(w[1])) * rq * g0[3]);
                Vt[(sg * 8 + 4) * LD + tq] = f2bf(gelu_tanh(bflo(w[2])) * rq * g1[0]); Vt[(sg * 8 + 5) * LD + tq] = f2bf(gelu_tanh(bfhi(w[2])) * rq * g1[1]);
                Vt[(sg * 8 + 6) * LD + tq] = f2bf(gelu_tanh(bflo(w[3])) * rq * g1[2]); Vt[(sg * 8 + 7) * LD + tq] = f2bf(gelu_tanh(bfhi(w[3])) * rq * g1[3]); }
            __syncthreads();
            {
                bf16x8 wf[4];
#pragma unroll
                for (int ks = 0; ks < 4; ++ks) wf[ks] = ldsfrag(lds + OFF_W + (16 * wid + r) * LDB + (32 * ks + 8 * q) * 2);
                const float sbp = sgu_b[g * 128 + 16 * wid + r];
                const size_t R = (size_t)(rbase + 16 * wid + r);
#pragma unroll
                for (int jb = 0; jb < 8; ++jb) {
                    f32x4 acc = (f32x4){0.f, 0.f, 0.f, 0.f};
#pragma unroll
                    for (int ks = 0; ks < 4; ++ks) acc = mfma16(ldsfrag(lds + OFF_V + (16 * jb + r) * LDB + (32 * ks + 8 * q) * 2), wf[ks], acc);
                    const u32x2 uu = *(const u32x2*)(P + R * NEV + 2048 + g * 128 + 16 * jb + 4 * q);
                    u32x2 w; w.x = pk2(gelu_tanh(bflo(uu.x)) * (acc[0] + sbp), gelu_tanh(bfhi(uu.x)) * (acc[1] + sbp)); w.y = pk2(gelu_tanh(bflo(uu.y)) * (acc[2] + sbp), gelu_tanh(bfhi(uu.y)) * (acc[3] + sbp));
                    *(u32x2*)(A1 + R * D + 512 + g * 128 + 16 * jb + 4 * q) = w;
                }
            }
            __syncthreads();
        }
    }
}

__device__ __forceinline__ void combine_phase(const bf16_t* Hdir, const bf16_t* P, const float* mnorm, bf16_t* A1) {
    int tid_ = threadIdx.x; asm volatile("" : "+v"(tid_)); const int tid = tid_, lane = tid & 63, wid = __builtin_amdgcn_readfirstlane(tid >> 6);
    for (int R = blockIdx.x * 8 + wid; R < MT; R += gridDim.x * 8) {
        const int col = lane * 8;
        const u32x4 h0 = *(const u32x4*)(Hdir + (size_t)R * 512 + col), h1 = *(const u32x4*)(Hdir + ((size_t)MT + R) * 512 + col);
        float a[8];
#pragma unroll
        for (int k = 0; k < 4; ++k) { a[2 * k] = bflo(h0[k]) + bflo(h1[k]); a[2 * k + 1] = bfhi(h0[k]) + bfhi(h1[k]); }
        float ss = 0.f;
#pragma unroll
        for (int k = 0; k < 8; ++k) ss += a[k] * a[k];
        ss = row16_sum(ss);
        const float rstd = 1.0f / sqrtf(ss * (1.f / 128.f) + EPS);
        const f32x4 m0 = *(const f32x4*)(mnorm + col), m1 = *(const f32x4*)(mnorm + col + 4);
        const u32x4 ov = *(const u32x4*)(P + (size_t)R * NEV + 1536 + col);
        u32x4 w;
        w.x = pk2(sigmoid_f(bflo(ov[0])) * a[0] * rstd * m0[0], sigmoid_f(bfhi(ov[0])) * a[1] * rstd * m0[1]);
        w.y = pk2(sigmoid_f(bflo(ov[1])) * a[2] * rstd * m0[2], sigmoid_f(bfhi(ov[1])) * a[3] * rstd * m0[3]);
        w.z = pk2(sigmoid_f(bflo(ov[2])) * a[4] * rstd * m1[0], sigmoid_f(bfhi(ov[2])) * a[5] * rstd * m1[1]);
        w.w = pk2(sigmoid_f(bflo(ov[3])) * a[6] * rstd * m1[2], sigmoid_f(bfhi(ov[3])) * a[7] * rstd * m1[3]);
        *(u32x4*)(A1 + (size_t)R * D + col) = w;
    }
}

__device__ __forceinline__ void attn_phase(LAS unsigned char* lds, const bf16_t* QKV, const float* sink, bf16_t* A1) {
    int tid_ = threadIdx.x; asm volatile("" : "+v"(tid_)); const int tid = tid_, lane = tid & 63, wid = __builtin_amdgcn_readfirstlane(tid >> 6), r = lane & 15, q = lane >> 4;
    constexpr int LK = 72, LKB = LK * 2, BUFB = 18432, OFF_V = 9216;
    for (int unit = blockIdx.x; unit < 512; unit += gridDim.x) {
        asm volatile("" : "+s"(QKV), "+s"(A1));
        const int hk = unit & 3, j = (unit >> 2) & 15, b = unit >> 6;
        const int g = wid >> 1, hq = hk * 4 + g, tok0 = (wid & 1) * 64;
        const int qrow0 = b * SEQ + j * 128 + tok0;
        bf16x8 qf[4][2];
#pragma unroll
        for (int mt = 0; mt < 4; ++mt)
#pragma unroll
            for (int ks = 0; ks < 2; ++ks) qf[mt][ks] = *(const bf16x8*)(QKV + (size_t)(qrow0 + 16 * mt + r) * NQKV + hq * 64 + 32 * ks + 8 * q);
        float mrun[4], lrun[4]; f32x4 oacc[4][4];
        const float sk = sink[hq];
#pragma unroll
        for (int mt = 0; mt < 4; ++mt) { mrun[mt] = sk; lrun[mt] = 1.f;
#pragma unroll
            for (int dt = 0; dt < 4; ++dt) oacc[dt][mt] = (f32x4){0.f, 0.f, 0.f, 0.f}; }
        const int tlast = (j == 15) ? 7 : 9;
        u32x4 kvn, vvn;
        const unsigned voffk = (unsigned)(((tid >> 3) * NQKV + (tid & 7) * 8) * 2);
#define ATTN_TILE_ROW(ti_) ((ti_) < 4 ? MX + b * CTXL + (ti_) * 64 : b * SEQ + (j - 1 + (((ti_) - 4) >> 1)) * 128 + (((ti_) - 4) & 1) * 64)
#define ATTN_NEXT(ti_) ((j == 0 && (ti_) == 3) ? 6 : (ti_) + 1)
#define ATTN_LOAD(ti_) do { const char* kp_ = (const char*)(QKV + (size_t)ATTN_TILE_ROW(ti_) * NQKV + 1024 + hk * 64); kvn = *(const u32x4*)(kp_ + voffk); vvn = *(const u32x4*)(kp_ + 512 + voffk); } while (0)
#define ATTN_STORE(buf_) do { const int key_ = tid >> 3, sg_ = tid & 7; LAS bf16_t* Kd_ = (LAS bf16_t*)(lds + (buf_) * BUFB); LAS bf16_t* Vd_ = (LAS bf16_t*)(lds + (buf_) * BUFB + OFF_V); \
            *(LAS u32x4*)(Kd_ + key_ * LK + sg_ * 8) = kvn; \
            _Pragma("unroll") for (int w2 = 0; w2 < 4; ++w2) { Vd_[(sg_ * 8 + 2 * w2) * LK + key_] = (bf16_t)(vvn[w2] & 0xffffu); Vd_[(sg_ * 8 + 2 * w2 + 1) * LK + key_] = (bf16_t)(vvn[w2] >> 16); } } while (0)
        ATTN_LOAD(0);
        __syncthreads();
        ATTN_STORE(0);
        ATTN_LOAD(1);
        int ti = 0, idx = 0;
        for (;;) {
            __syncthreads();
            const int buf = idx & 1, tnext = ATTN_NEXT(ti);
            if (tnext <= tlast) { ATTN_STORE(buf ^ 1); const int t2 = ATTN_NEXT(tnext); if (t2 <= tlast) ATTN_LOAD(t2); }
            int kpos0; bool band;
            if (ti < 4) { kpos0 = 0; band = false; }
            else { const int kb = j - 1 + ((ti - 4) >> 1); kpos0 = kb * 128 + ((ti - 4) & 1) * 64; band = (kb != j); }
            const LAS unsigned char* Kb = lds + buf * BUFB; const LAS unsigned char* Vb = lds + buf * BUFB + OFF_V;
            bf16x8 vf[4][2];
#pragma unroll
            for (int dt = 0; dt < 4; ++dt)
#pragma unroll
                for (int a2 = 0; a2 < 2; ++a2) {
                    const u32x2 lo = *(const LAS u32x2*)(Vb + (16 * dt + r) * LKB + (32 * a2 + 4 * q) * 2), hi = *(const LAS u32x2*)(Vb + (16 * dt + r) * LKB + (32 * a2 + 16 + 4 * q) * 2);
                    u32x4 t4; t4.x = lo.x; t4.y = lo.y; t4.z = hi.x; t4.w = hi.y; vf[dt][a2] = __builtin_bit_cast(bf16x8, t4);
                }
#pragma unroll
            for (int mt = 0; mt < 4; ++mt) {
                f32x4 s[4];
#pragma unroll
                for (int nt = 0; nt < 4; ++nt) { f32x4 a = (f32x4){0.f, 0.f, 0.f, 0.f};
                    a = mfma16(ldsfrag(Kb + (16 * nt + r) * LKB + (8 * q) * 2), qf[mt][0], a); a = mfma16(ldsfrag(Kb + (16 * nt + r) * LKB + (32 + 8 * q) * 2), qf[mt][1], a); s[nt] = a; }
                if (band) {
                    const int qp = j * 128 + tok0 + 16 * mt + r;
#pragma unroll
                    for (int nt = 0; nt < 4; ++nt)
#pragma unroll
                        for (int i = 0; i < 4; ++i) { const int df = qp - (kpos0 + 16 * nt + 4 * q + i); if (df > 128 || df < -128) s[nt][i] = -1e30f; }
                }
                float mx = fmaxf(fmaxf(fmaxf(s[0][0], s[0][1]), fmaxf(s[0][2], s[0][3])), fmaxf(fmaxf(s[1][0], s[1][1]), fmaxf(s[1][2], s[1][3])));
                mx = fmaxf(mx, fmaxf(fmaxf(fmaxf(s[2][0], s[2][1]), fmaxf(s[2][2], s[2][3])), fmaxf(fmaxf(s[3][0], s[3][1]), fmaxf(s[3][2], s[3][3]))));
                mx = fmaxf(mx, __shfl_xor(mx, 16)); mx = fmaxf(mx, __shfl_xor(mx, 32));
                const float mn = fmaxf(mrun[mt], mx), alpha = __expf(mrun[mt] - mn);
                float rsum = 0.f; u32x2 pw[4];
#pragma unroll
                for (int nt = 0; nt < 4; ++nt) {
                    const float p0 = __expf(s[nt][0] - mn), p1 = __expf(s[nt][1] - mn), p2 = __expf(s[nt][2] - mn), p3 = __expf(s[nt][3] - mn);
                    rsum += (p0 + p1) + (p2 + p3);
                    pw[nt].x = pk2(p0, p1); pw[nt].y = pk2(p2, p3);
                }
                rsum += __shfl_xor(rsum, 16); rsum += __shfl_xor(rsum, 32);
                lrun[mt] = lrun[mt] * alpha + rsum; mrun[mt] = mn;
#pragma unroll
                for (int a2 = 0; a2 < 2; ++a2) {
                    u32x4 t4; t4.x = pw[2 * a2].x; t4.y = pw[2 * a2].y; t4.z = pw[2 * a2 + 1].x; t4.w = pw[2 * a2 + 1].y;
                    const bf16x8 pb = __builtin_bit_cast(bf16x8, t4);
#pragma unroll
                    for (int dt = 0; dt < 4; ++dt) { if (a2 == 0) oacc[dt][mt] *= alpha; oacc[dt][mt] = mfma16(vf[dt][a2], pb, oacc[dt][mt]); }
                }
                asm volatile("" ::: "memory");
            }
            if (tnext > tlast) break;
            ti = tnext; ++idx;
        }
#pragma unroll
        for (int mt = 0; mt < 4; ++mt) { const float inv = 1.f / lrun[mt]; const size_t R = (size_t)(qrow0 + 16 * mt + r);
#pragma unroll
            for (int dt = 0; dt < 4; ++dt) { const f32x4 o = oacc[dt][mt] * inv; u32x2 w; w.x = pk2(o[0], o[1]); w.y = pk2(o[2], o[3]);
                *(u32x2*)(A1 + R * D + hq * 64 + 16 * dt + 4 * q) = w; } }
    }
    __syncthreads();
}

__device__ __forceinline__ void final_phase(float* out, const float* fnorm) {
    int tid_ = threadIdx.x; asm volatile("" : "+v"(tid_)); const int tid = tid_, lane = tid & 63, wid = __builtin_amdgcn_readfirstlane(tid >> 6);
    for (int R = blockIdx.x * 8 + wid; R < MX; R += gridDim.x * 8) {
        float* src = out + (size_t)R * D;
        f32x4 v[4]; float ss = 0.f;
#pragma unroll
        for (int j = 0; j < 4; ++j) { v[j] = *(const f32x4*)(src + 256 * j + 4 * lane); ss += (v[j][0] * v[j][0] + v[j][1] * v[j][1]) + (v[j][2] * v[j][2] + v[j][3] * v[j][3]); }
        const float rstd = 1.0f / sqrtf(wave_sum(ss) * (1.f / D) + EPS);
#pragma unroll
        for (int j = 0; j < 4; ++j) { const f32x4 w = *(const f32x4*)(fnorm + 256 * j + 4 * lane); *(f32x4*)(src + 256 * j + 4 * lane) = v[j] * rstd * w; }
    }
}

#define GAS __attribute__((address_space(1)))
typedef GAS unsigned gu32;
#define RLX_AGENT __ATOMIC_RELAXED, __HIP_MEMORY_SCOPE_AGENT
#define XB_TMO      128
#define XB_XCNT(j)  (256  + 64 * (j))
#define XB_XSUB(j)  (1280 + 64 * (j))
#define XB_XGEN(j)  (2304 + 64 * (j))
#define XB_TOP      3328
#define XB_TOPGEN   3392
#define XCD_BAR_WORDS 3456
#define XB_SPIN_CAP (1u << 18)

__device__ __forceinline__ unsigned xb_ld(unsigned* p)              { return __hip_atomic_load(p, __ATOMIC_RELAXED, __HIP_MEMORY_SCOPE_AGENT); }
__device__ __forceinline__ unsigned xb_add(unsigned* p, unsigned v) { return __hip_atomic_fetch_add(p, v, __ATOMIC_RELAXED, __HIP_MEMORY_SCOPE_AGENT); }
__device__ __forceinline__ unsigned xb_xcc_id() { return (unsigned)__builtin_amdgcn_s_getreg((3 << 11) | 20) & 0xFu; }
#define XB_SPIN(cond, bar) do { unsigned _sp = 0; while (cond) { __builtin_amdgcn_s_sleep(1); \
    if ((++_sp & 255u) == 0u) { if (xb_ld(&(bar)[XB_TMO])) break; if (_sp > XB_SPIN_CAP) { atomicAdd(&(bar)[XB_TMO], 1u); break; } } } } while (0)

struct XcdBarrier {
    unsigned* bar; unsigned x;
    volatile LAS unsigned* st;
};

__device__ __forceinline__ XcdBarrier xcd_barrier_post(unsigned* bar, volatile LAS unsigned* st) {
    XcdBarrier b; b.bar = bar; b.x = xb_xcc_id(); b.st = st;
    if (threadIdx.x == 0) (void)xb_add(&bar[XB_XCNT(b.x)], 1u);
    return b;
}
__device__ __forceinline__ void xcd_barrier_complete(unsigned* bar, unsigned x, unsigned& nloc, unsigned& nx) {
    const unsigned G = gridDim.x * gridDim.y * gridDim.z;
    unsigned sum, cnt, mine, sp = 0u;
    for (;;) {
        sum = 0u; cnt = 0u;
#pragma unroll 1
        for (unsigned j = 0; j < 16; ++j) { const unsigned c = xb_ld(&bar[XB_XCNT(j)]); sum += c; cnt += (c > 0u) ? 1u : 0u; }
        mine = xb_ld(&bar[XB_XCNT(x)]);
        if (sum == G) break;
        __builtin_amdgcn_s_sleep(1);
        if ((++sp & 255u) == 0u) { if (xb_ld(&bar[XB_TMO])) break; if (sp > XB_SPIN_CAP) { atomicAdd(&bar[XB_TMO], 1u); break; } }
    }
    nloc = mine > 0u ? mine : 1u; nx = cnt > 0u ? cnt : 1u;
}

__device__ __forceinline__ void xcd_barrier(const XcdBarrier& b) {
    asm volatile("s_waitcnt vmcnt(0)" ::: "memory");
    __syncthreads();
    if (threadIdx.x == 0) {
        unsigned* bar = b.bar;
        __builtin_amdgcn_s_waitcnt(0);
        unsigned nloc = b.st[0], nx = b.st[1];
        if (nloc == 0u) { xcd_barrier_complete(bar, b.x, nloc, nx); b.st[0] = nloc; b.st[1] = nx; }
        const unsigned old = xb_add(&bar[XB_XSUB(b.x)], 1u);
        const unsigned gen = old / nloc;
        if (old + 1u == (gen + 1u) * nloc) {
            __builtin_amdgcn_fence(__ATOMIC_RELEASE, "agent");
            asm volatile("s_waitcnt vmcnt(0)" ::: "memory");
            const unsigned og = xb_add(&bar[XB_TOP], 1u);
            const unsigned tg = og / nx;
            if (og + 1u == (tg + 1u) * nx) xb_add(&bar[XB_TOPGEN], 1u);
            else XB_SPIN(xb_ld(&bar[XB_TOPGEN]) == tg, bar);
            __builtin_amdgcn_fence(__ATOMIC_ACQUIRE, "agent");
            xb_add(&bar[XB_XGEN(b.x)], 1u);
            asm volatile("s_waitcnt vmcnt(0)" ::: "memory");
        } else {
            XB_SPIN(xb_ld(&bar[XB_XGEN(b.x)]) == gen, bar);
            __builtin_amdgcn_fence(__ATOMIC_ACQUIRE, "agent");
            asm volatile("s_waitcnt vmcnt(0)" ::: "memory");
        }
    }
    __syncthreads();
}

#ifndef MK_SINGLE
#define MK_SINGLE 1
#endif
constexpr int NPHASES = 24;
#ifndef EN_PREP
#define EN_PREP 1
#endif
#ifndef REP_MASK
#define REP_MASK 0
#endif
#ifndef USE_CG_FIRST
#define USE_CG_FIRST 0
#endif
#ifndef NSYNC_REP
#define NSYNC_REP 1
#endif
#ifndef EN_ALL
#define EN_ALL 1
#endif
#ifndef EN_P0
#define EN_P0 EN_ALL
#endif
#ifndef EN_NORM
#define EN_NORM EN_ALL
#endif
#ifndef EN_GEMM
#define EN_GEMM (EN_ALL ? 15 : 0)
#endif
#ifndef EN_MLSTM
#define EN_MLSTM EN_ALL
#endif
#ifndef EN_SGU
#define EN_SGU EN_ALL
#endif
#ifndef EN_COMB
#define EN_COMB EN_ALL
#endif
#ifndef EN_ATTN
#define EN_ATTN EN_ALL
#endif
#ifndef EN_FINAL
#define EN_FINAL EN_ALL
#endif
__global__ void __launch_bounds__(NTHREADS, 2) fwd_kernel(Args a_unused) {
    extern __shared__ __attribute__((aligned(16))) unsigned char lds_raw[];
    LAS unsigned char* lds = (LAS unsigned char*)lds_raw;
    cg::grid_group grid = cg::this_grid();
    unsigned char* ws = KA(ws);
    const int G = gridDim.x, c = blockIdx.x;
    float* Hx = KA(out); float* Hc = (float*)(ws + WS_HC);
    bf16_t* A0 = (bf16_t*)(ws + WS_A0); bf16_t* A1 = (bf16_t*)(ws + WS_A1); bf16_t* BIG = (bf16_t*)(ws + WS_BIG);
    bf16_t* Hdir = (bf16_t*)(ws + WS_A0);
    const float* mod = (const float*)(ws + WS_MOD);
    float* gates = (float*)(ws + WS_GATES);
    const int lo = KA(ph_lo), hi = KA(ph_hi);
    volatile LAS unsigned* barst = (volatile LAS unsigned*)(lds + LDS_BYTES - 16);
    if (threadIdx.x < 2) barst[threadIdx.x] = 0u;
    __syncthreads();
    XcdBarrier bar = xcd_barrier_post((unsigned*)(ws + WS_CTL), barst);
    enum { K_P0, K_NORM, K_NORMG, K_SWIGLU, K_RESID, K_PLAIN, K_QKV, K_MIX0, K_COMB, K_ATTN, K_FINAL, K_PREP };
    for (int ph = lo; ph < hi; ++ph) {
        const int layer = ph >= 13 ? 1 : 0;
        const int lp = ph >= 13 ? ph - 13 : ph - 1;
        const float* modl = mod + (size_t)layer * 9 * 9216;
        int kind = K_P0, M = MT, gi = 0, ffn = 0, Kd = 1024; float coef = 1.f;
        const bf16_t* Aop = A0; const bf16_t* Wop = nullptr;
        const float* bxp = Hx; const float* bcp = Hc;
        if (ph == 0) kind = K_P0;
        else if (ph == 23) kind = K_FINAL;
        else if (lp == 0) { kind = K_NORM; gi = 0; if (layer == 0) { bxp = KA(x); bcp = KA(ctx); } }
        else if (lp == 1) { kind = K_SWIGLU; ffn = layer * 2; }
        else if (lp == 2) { kind = K_RESID; Aop = BIG; Wop = (const bf16_t*)(ws + WS_WOUT + (size_t)(layer * 2) * SZ_WOUT); Kd = 2816; gi = 2; coef = 0.5f; if (layer == 0) { bxp = KA(x); bcp = KA(ctx); } }
        else if (layer == 0) {
            if (lp == 3) { kind = K_NORMG; gi = 3; }
            else if (lp == 4) kind = K_PLAIN;
            else if (lp == 5) kind = K_PREP;
            else if (lp == 6) kind = K_MIX0;
            else if (lp == 7) kind = K_COMB;
            else if (lp == 8) { kind = K_RESID; Aop = A1; Wop = (const bf16_t*)(ws + WS_WEOUT); gi = 5; }
            else if (lp == 9) { kind = K_NORM; gi = 6; }
            else if (lp == 10) { kind = K_SWIGLU; ffn = 1; }
            else { kind = K_RESID; Aop = BIG; Wop = (const bf16_t*)(ws + WS_WOUT + SZ_WOUT); Kd = 2816; gi = 8; coef = 0.5f; }
        } else {
            if (lp == 3) { kind = K_NORM; gi = 3; }
            else if (lp == 4) kind = K_QKV;
            else if (lp == 5) kind = K_ATTN;
            else if (lp == 6) { kind = K_RESID; Aop = A1; Wop = (const bf16_t*)(ws + WS_WOOUT); gi = 5; M = MX; }
            else if (lp == 7) { kind = K_NORM; gi = 6; M = MX; }
            else if (lp == 8) { kind = K_SWIGLU; ffn = 3; M = MX; }
            else { kind = K_RESID; Aop = BIG; Wop = (const bf16_t*)(ws + WS_WOUT + 3 * SZ_WOUT); Kd = 2816; gi = 8; coef = 0.5f; M = MX; }
        }
        const int nrep = ((REP_MASK >> kind) & 1) ? 2 : 1;
        for (int rep = 0; rep < nrep; ++rep) {
        if (rep == 1) { if (kind == K_RESID) { bxp = Hx; bcp = Hc; coef = 0.f; } __syncthreads(); }
        if (kind == K_P0) { if (EN_P0) p0_phase(lds); }
        else if (kind == K_NORM) { if (EN_NORM) norm_phase<false>(lds, bxp, bcp, A0, modl, gi, gi + 1, M, nullptr, nullptr, nullptr, (ph > 1 && M == MT) ? (float*)(ws + WS_PC) : nullptr); }
        else if (kind == K_NORMG) { if (EN_NORM) norm_phase<true>(lds, Hx, Hc, A0, modl, gi, gi + 1, M, (const float*)(ws + WS_WG), KA(mlstm_gate_b), gates, (float*)(ws + WS_PC)); }
        else if (kind == K_SWIGLU) { if (EN_GEMM & 1) { pg8::Gemm g{A0, (const bf16_t*)(ws + WS_WIN + (size_t)ffn * SZ_WIN), M, 5632, 1024}; pg8::StaticOrder S; S.init(M, 5632, G, c, 1024); pg8::EpiSwiglu E{BIG};
            pg8::gemm_phase<pg8::EpiSwiglu, pg8::StaticOrder, true, true>(lds, g, S, E); } }
        else if (kind == K_RESID) { if (EN_GEMM & 2) { pg8::Gemm g{Aop, Wop, M, 1024, Kd}; pg8::SplitCtxOrder S; S.init(1024, G, c, Kd, M == MT ? 64 : 0); pg8::EpiResid E{bxp, bcp, Hx, Hc, (float*)(ws + WS_PC), modl + gi * 1024, coef};
            pg8::gemm_phase<pg8::EpiResid, pg8::SplitCtxOrder, true, true>(lds, g, S, E);
            const int cgrp = (rep == 0 && M == MT && Kd == 2816) ? (layer == 0 ? (lp == 2 ? 1 : 2) : 3) : 0;
            if (cgrp != 0 && c >= 64 && G > 64) convert_group(lds, cgrp, (c - 64) * 8, (G - 64) * 8); } }
        else if (kind == K_PLAIN) { if (EN_GEMM & 4) { pg8::Gemm g{A0, (const bf16_t*)(ws + WS_WEIN), MT, NEV, 1024}; pg8::StaticOrder S; S.init(MT, NEV, G, c, 1024); pg8::EpiPlain E{BIG, NEV};
            pg8::gemm_phase<pg8::EpiPlain, pg8::StaticOrder, true, true>(lds, g, S, E); } }
        else if (kind == K_QKV) { if (EN_GEMM & 8) { pg8::Gemm g{A0, (const bf16_t*)(ws + WS_WQKV), MT, NQKV, 1024}; pg8::StaticOrder S; S.init(MT, NQKV, G, c, 1024); pg8::EpiQKV E{BIG, (const float*)(ws + WS_ROPE)};
            pg8::gemm_phase<pg8::EpiQKV, pg8::StaticOrder, true, true>(lds, g, S, E); } }
        else if (kind == K_PREP) { if (EN_MLSTM && EN_PREP) qkprep_phase(lds, BIG, KA(mlstm_conv), (bf16_t*)(ws + WS_QC), (bf16_t*)(ws + WS_KC), (bf16_t*)(ws + WS_KCT)); if (EN_SGU) sgu_phase(lds, BIG, KA(sgu_norm), KA(sgu_ws), KA(sgu_b), A1); }
        else if (kind == K_MIX0) { if (EN_MLSTM) mlstm_phase(lds, BIG, gates, (const bf16_t*)(ws + WS_QC), (const bf16_t*)(ws + WS_KC), (const bf16_t*)(ws + WS_KCT), Hdir); }
        else if (kind == K_COMB) { if (EN_COMB) combine_phase(Hdir, BIG, KA(mlstm_norm), A1); }
        else if (kind == K_ATTN) { if (EN_ATTN) attn_phase(lds, BIG, KA(attn_sink), A1); }
        else { if (EN_FINAL) final_phase(Hx, KA(final_norm)); }
        }
        if (ph + 1 < hi) {
            if (ph == 0 && USE_CG_FIRST) {
                __syncthreads();
                if (threadIdx.x < 64) { __builtin_amdgcn_fence(__ATOMIC_RELEASE, "agent"); asm volatile("s_waitcnt vmcnt(0)" ::: "memory"); }
                grid.sync();
                if (threadIdx.x < 64) { __builtin_amdgcn_fence(__ATOMIC_ACQUIRE, "agent"); asm volatile("s_waitcnt vmcnt(0)" ::: "memory"); }
                __syncthreads();
            } else {
                for (int srep = 0; srep < NSYNC_REP; ++srep) xcd_barrier(bar);
            }
        }
    }
}

extern "C" void kernel_launch(void* const* d_in, const int* in_sizes, int n_in, void* d_out, int out_size, void* d_ws, size_t ws_size, hipStream_t stream) {
    static int grid = 0;
    if (grid == 0) {
        if (n_in != 20 || out_size != MX * D || ws_size < WS_END) { fprintf(stderr, "kernel_launch: unexpected problem (n_in %d out %d ws %zu need %zu)\n", n_in, out_size, ws_size, (size_t)WS_END); grid = -1; return; }
        int dev = 0, cus = 0, per_cu = 0;
        hipGetDevice(&dev);
        hipDeviceGetAttribute(&cus, hipDeviceAttributeMultiprocessorCount, dev);
        hipFuncSetAttribute((const void*)fwd_kernel, hipFuncAttributeMaxDynamicSharedMemorySize, LDS_BYTES);
        hipOccupancyMaxActiveBlocksPerMultiprocessor(&per_cu, (const void*)fwd_kernel, NTHREADS, LDS_BYTES);
        if (per_cu < 1) { fprintf(stderr, "kernel_launch: occupancy query says %d blocks per CU\n", per_cu); grid = -1; return; }
        grid = cus;
    }
    if (grid < 0) return;
    if (hipMemsetAsync((char*)d_ws + WS_CTL, 0, CTL_BYTES, stream) != hipSuccess) { fprintf(stderr, "kernel_launch: memset failed\n"); return; }
    Args a{};
#ifdef DBG_MEMSET
    hipMemsetAsync(d_ws, 0, WS_END, stream); hipMemsetAsync(d_out, 0, (size_t)out_size * 4, stream);
#endif
    a.x = (const float*)d_in[0]; a.c = (const float*)d_in[1]; a.ctx = (const float*)d_in[2]; a.c_ctx = (const float*)d_in[3]; a.ada_w = (const float*)d_in[4]; a.ada_b = (const float*)d_in[5];
    a.ffn_w_in = (const float*)d_in[6]; a.ffn_w_out = (const float*)d_in[7]; a.even_w_in = (const float*)d_in[8]; a.even_w_out = (const float*)d_in[9];
    a.mlstm_conv = (const float*)d_in[10]; a.mlstm_gate_b = (const float*)d_in[11]; a.mlstm_norm = (const float*)d_in[12]; a.sgu_norm = (const float*)d_in[13]; a.sgu_ws = (const float*)d_in[14]; a.sgu_b = (const float*)d_in[15];
    a.odd_w_qkv = (const float*)d_in[16]; a.odd_w_out = (const float*)d_in[17]; a.attn_sink = (const float*)d_in[18]; a.final_norm = (const float*)d_in[19];
    a.out = (float*)d_out; a.ws = (unsigned char*)d_ws;
#if MK_SINGLE
    a.ph_lo = 0; a.ph_hi = NPHASES;
    { void* args[] = {&a}; hipError_t e = hipLaunchCooperativeKernel((const void*)fwd_kernel, dim3(grid), dim3(NTHREADS), args, LDS_BYTES, stream);
      if (e != hipSuccess) fprintf(stderr, "cooperative launch failed: %s\n", hipGetErrorString(e)); }
#else
    for (int p = 0; p < NPHASES; ++p) { a.ph_lo = p; a.ph_hi = p + 1; void* args[] = {&a};
        hipError_t e = hipLaunchCooperativeKernel((const void*)fwd_kernel, dim3(grid), dim3(NTHREADS), args, LDS_BYTES, stream);
        if (e != hipSuccess) { fprintf(stderr, "launch %d failed: %s\n", p, hipGetErrorString(e)); break; } }
#endif
}
```
